# Optimizing an MI355X kernel written in HIP

```python
import jax, jax.numpy as jnp
from jax import lax
import numpy as np

D_MODEL = 1024
BATCH = 32
SEQ = 2048
DEPTH = 2
DEC_BATCH = 1
DEC_SEQ = 16384
PAST_LEN = 128

NORM_EPS = 1e-6
D_FF = 2816
N_EVEN = (DEPTH + 1) // 2
N_ODD = DEPTH // 2
D_A = D_MODEL // 2
SGU_GROUPS = 4
SGU_CHUNK = 128
SGU_GW = D_A // SGU_GROUPS
D_B = D_MODEL // 2
RWKV_HEAD = 64
RWKV_HEADS = D_B // RWKV_HEAD
RWKV_LORA_W = 64
RWKV_LORA_A = 64
RWKV_LORA = RWKV_LORA_W + RWKV_LORA_A
RWKV_GN_EPS = 64e-5
D_AB_IN = 2 * D_A + 4 * D_B + 2 * RWKV_LORA
ATTN_HEAD_DIM = 64
ATTN_HEADS = D_MODEL // ATTN_HEAD_DIM
D_ATTN = ATTN_HEADS * ATTN_HEAD_DIM
DILATED_BRANCHES = ((128, 1), (512, 4), (2048, 16))
NEG_INF = -1e30

kernel_name = 'hybrid_sgu_rwkv7_dilated_encoder'


def rmsnorm(x, g, eps=NORM_EPS):
    xf = x.astype(jnp.float32)
    y = xf * lax.rsqrt(jnp.mean(xf * xf, axis=-1, keepdims=True) + eps)
    return (y * g.astype(jnp.float32)).astype(x.dtype)


def swiglu_ffn(x, w_in, w_out):
    gate, up = jnp.split(x @ w_in, 2, axis=-1)
    return (jax.nn.silu(gate) * up) @ w_out


def shift_prev(z):
    return jnp.pad(z, ((0, 0), (1, 0), (0, 0)))[:, :-1]


def shift_next(z):
    return jnp.pad(z, ((0, 0), (0, 1), (0, 0)))[:, 1:]


def spatial_gating(u, v, norm_g, w_s, b_s):
    B, T, _ = u.shape
    u = jax.nn.gelu(u)
    v = rmsnorm(jax.nn.gelu(v), norm_g)
    vc = v.reshape(B, T // SGU_CHUNK, SGU_CHUNK, SGU_GROUPS, SGU_GW)
    mixed = jnp.einsum('gqp,bnpgc->bnqgc', w_s, vc) + b_s.T[None, None, :, :, None]
    return u * mixed.reshape(B, T, D_A)


def rwkv7_scan(r, w, k, v, kk, kka, reverse):
    B, T, H, N = r.shape

    def step(S, inp):
        r_t, w_t, k_t, v_t, kk_t, kka_t = inp
        sa = jnp.einsum('bhvk,bhk->bhv', S, kk_t)
        S = (S * w_t[:, :, None, :] - sa[..., None] * kka_t[:, :, None, :]
             + v_t[..., None] * k_t[:, :, None, :])
        return S, jnp.einsum('bhvk,bhk->bhv', S, r_t)

    S0 = jnp.zeros((B, H, N, N), jnp.float32)
    xs = tuple(jnp.swapaxes(t, 0, 1) for t in (r, w, k, v, kk, kka))
    _, y = lax.scan(step, S0, xs, reverse=reverse)
    return jnp.swapaxes(y, 0, 1)


def rwkv7_bidirectional(rkv, wa, g, mu_rkv, mu_wa, w0, w_up, a0, a_up, k_k, k_a, r_k, gn_w, gn_b):
    B, T, _ = rkv.shape
    rkv = rkv.astype(jnp.float32)
    wa = wa.astype(jnp.float32)
    heads = lambda t: t.reshape(B, T, RWKV_HEADS, RWKV_HEAD)
    ys, bonuses = [], []
    for dirn, (shift, rev) in enumerate(((shift_prev, False), (shift_next, True))):
        z = rkv + (shift(rkv) - rkv) * mu_rkv[dirn]
        zwa = wa[:, :, dirn]
        zwa = zwa + (shift(zwa) - zwa) * mu_wa[dirn]
        r, k, v = jnp.split(z, 3, axis=-1)
        wd, ad = jnp.split(zwa, [RWKV_LORA_W], axis=-1)
        w_raw = w0[dirn] + jnp.tanh(wd) @ w_up[dirn]
        decay = jnp.exp(-jnp.exp(-jax.nn.softplus(-w_raw) - 0.5))
        a = jax.nn.sigmoid(a0[dirn] + ad @ a_up[dirn])
        kk = heads(k * k_k)
        kk = kk / jnp.maximum(jnp.sqrt(jnp.sum(kk * kk, axis=-1, keepdims=True)), 1e-12)
        k = k * (1.0 + (a - 1.0) * k_a)
        rh, kh, vh = heads(r), heads(k), heads(v)
        ys.append(rwkv7_scan(rh, heads(decay), kh, vh, kk, kk * heads(a), rev))
        bonuses.append(jnp.sum(rh * kh * r_k, axis=-1, keepdims=True) * vh)
    y = ys[0] + ys[1]
    mean = jnp.mean(y, axis=-1, keepdims=True)
    var = jnp.mean(jnp.square(y - mean), axis=-1, keepdims=True)
    y = ((y - mean) * lax.rsqrt(var + RWKV_GN_EPS)).reshape(B, T, D_B) * gn_w + gn_b
    y = (y + (bonuses[0] + bonuses[1]).reshape(B, T, D_B)) * jax.nn.sigmoid(g.astype(jnp.float32))
    return y


def sgu_rwkv_mixer(h, w_in, w_out, sgu_norm, sgu_w, sgu_b, mu_rkv, mu_wa, w0, w_up, a0, a_up,
                   k_k, k_a, r_k, gn_w, gn_b):
    B, T, _ = h.shape
    p = h @ w_in
    u, v, rkv, g, wa = jnp.split(p, [D_A, 2 * D_A, 2 * D_A + 3 * D_B, 2 * D_A + 4 * D_B], axis=-1)
    y_a = spatial_gating(u, v, sgu_norm, sgu_w, sgu_b)
    y_b = rwkv7_bidirectional(rkv, wa.reshape(B, T, 2, RWKV_LORA), g, mu_rkv, mu_wa, w0, w_up,
                              a0, a_up, k_k, k_a, r_k, gn_w, gn_b)
    return jnp.concatenate([y_a, y_b.astype(y_a.dtype)], axis=-1) @ w_out


def alibi_slopes():
    return 2.0 ** (-8.0 * jnp.arange(1, ATTN_HEADS + 1, dtype=jnp.float32) / ATTN_HEADS)


def dilated_branch(q, k, v, slopes, window, dilation):
    B, T, H, E = q.shape
    rad = window // (2 * dilation)
    L = T // dilation
    nb = -(-L // rad)
    Lp = nb * rad

    def to_sub(t):
        return jnp.swapaxes(t.reshape(B, L, dilation, H, E), 1, 2)

    def windows(t):
        tp = jnp.pad(t, ((0, 0), (0, 0), (rad, Lp - L + rad), (0, 0), (0, 0)))
        tp = tp.reshape(B, dilation, nb + 2, rad, H, E)
        return jnp.concatenate([tp[:, :, 0:nb], tp[:, :, 1:nb + 1], tp[:, :, 2:nb + 2]], axis=3)

    qb = jnp.pad(to_sub(q), ((0, 0), (0, 0), (0, Lp - L), (0, 0), (0, 0))).reshape(B, dilation, nb, rad, H, E)
    kw, vw = windows(to_sub(k)), windows(to_sub(v))
    qi = jnp.arange(Lp).reshape(nb, rad)
    kj = jnp.arange(nb)[:, None] * rad - rad + jnp.arange(3 * rad)[None, :]
    dist = jnp.abs(qi[:, :, None] - kj[:, None, :])
    valid = (dist <= rad) & (kj[:, None, :] >= 0) & (kj[:, None, :] < L)
    bias = jnp.where(valid, -slopes[:, None, None, None] * (dist * dilation).astype(jnp.float32),
                     NEG_INF)
    s = jnp.einsum('bdnqhe,bdnkhe->bdhnqk', qb, kw) + bias
    m = jnp.max(s, axis=-1, keepdims=True)
    p = jnp.exp(s - m)
    den = jnp.sum(p, axis=-1)
    o = jnp.einsum('bdhnqk,bdnkhe->bdnqhe', p, vw) / jnp.moveaxis(den, 2, -1)[..., None]
    lse = jnp.moveaxis(m[..., 0] + jnp.log(den), 2, -1)
    o = jnp.swapaxes(o.reshape(B, dilation, Lp, H, E)[:, :, :L], 1, 2).reshape(B, T, H, E)
    lse = jnp.swapaxes(lse.reshape(B, dilation, Lp, H)[:, :, :L], 1, 2).reshape(B, T, H)
    return o, lse


def dilated_attention(h, w_in, w_out, q_norm, k_norm):
    B, T, _ = h.shape
    qkv = (h @ w_in).astype(jnp.float32).reshape(B, T, 3, ATTN_HEADS, ATTN_HEAD_DIM)
    q = rmsnorm(qkv[:, :, 0], q_norm) * (ATTN_HEAD_DIM ** -0.5)
    k = rmsnorm(qkv[:, :, 1], k_norm)
    v = qkv[:, :, 2]
    slopes = alibi_slopes()
    outs, lses = [], []
    for window, dilation in DILATED_BRANCHES:
        o_b, lse_b = dilated_branch(q, k, v, slopes, window, dilation)
        outs.append(o_b)
        lses.append(lse_b)
    wts = jax.nn.softmax(jnp.stack(lses), axis=0)
    o = jnp.sum(wts[..., None] * jnp.stack(outs), axis=0)
    return o.reshape(B, T, D_ATTN).astype(h.dtype) @ w_out


def setup_inputs(seed: int = 0) -> dict:
    key = jax.random.key(seed)
    ks = iter(jax.random.split(key, 40))
    nrm = lambda shape, scale: jax.random.normal(next(ks), shape, jnp.float32) * scale
    unif = lambda shape, lo, hi: jax.random.uniform(next(ks), shape, jnp.float32, lo, hi)
    D, F = D_MODEL, D_FF
    return {
        'x_prompt': nrm((BATCH, SEQ, D), 1.0),
        'x_sample': nrm((DEC_BATCH, DEC_SEQ, D), 1.0),
        'ffn1_norm': 1.0 + nrm((DEPTH, D), 0.02),
        'ffn1_w_in': nrm((DEPTH, D, 2 * F), D ** -0.5),
        'ffn1_w_out': nrm((DEPTH, F, D), F ** -0.5),
        'mix_norm': 1.0 + nrm((DEPTH, D), 0.02),
        'ffn2_norm': 1.0 + nrm((DEPTH, D), 0.02),
        'ffn2_w_in': nrm((DEPTH, D, 2 * F), D ** -0.5),
        'ffn2_w_out': nrm((DEPTH, F, D), F ** -0.5),
        'block_norm': 1.0 + nrm((DEPTH, D), 0.02),
        'ab_w_in': nrm((N_EVEN, D, D_AB_IN), D ** -0.5),
        'ab_w_out': nrm((N_EVEN, D_A + D_B, D), (D_A + D_B) ** -0.5),
        'sgu_norm': 1.0 + nrm((N_EVEN, D_A), 0.02),
        'sgu_w': nrm((N_EVEN, SGU_GROUPS, SGU_CHUNK, SGU_CHUNK), SGU_CHUNK ** -0.5),
        'sgu_b': 1.0 + nrm((N_EVEN, SGU_GROUPS, SGU_CHUNK), 0.02),
        'rwkv_mu_rkv': unif((N_EVEN, 2, 3 * D_B), 0.0, 1.0),
        'rwkv_mu_wa': unif((N_EVEN, 2, RWKV_LORA), 0.0, 1.0),
        'rwkv_w0': unif((N_EVEN, 2, D_B), -2.0, 1.0),
        'rwkv_w_up': nrm((N_EVEN, 2, RWKV_LORA_W, D_B), 0.1 * RWKV_LORA_W ** -0.5),
        'rwkv_a0': nrm((N_EVEN, 2, D_B), 0.5),
        'rwkv_a_up': nrm((N_EVEN, 2, RWKV_LORA_A, D_B), 0.1 * RWKV_LORA_A ** -0.5),
        'rwkv_k_k': 0.85 + nrm((N_EVEN, D_B), 0.02),
        'rwkv_k_a': 1.0 + nrm((N_EVEN, D_B), 0.02),
        'rwkv_r_k': nrm((N_EVEN, RWKV_HEADS, RWKV_HEAD), 0.1),
        'rwkv_gn_w': 1.0 + nrm((N_EVEN, D_B), 0.02),
        'rwkv_gn_b': nrm((N_EVEN, D_B), 0.02),
        'attn_w_in': nrm((N_ODD, D, 3 * D_ATTN), D ** -0.5),
        'attn_w_out': nrm((N_ODD, D_ATTN, D), D_ATTN ** -0.5),
        'attn_q_norm': 1.0 + nrm((N_ODD, ATTN_HEAD_DIM), 0.02),
        'attn_k_norm': 1.0 + nrm((N_ODD, ATTN_HEAD_DIM), 0.02),
    }


def reference(x_prompt, x_sample, ffn1_norm, ffn1_w_in, ffn1_w_out, mix_norm, ffn2_norm, ffn2_w_in,
              ffn2_w_out, block_norm, ab_w_in, ab_w_out, sgu_norm, sgu_w, sgu_b, rwkv_mu_rkv, rwkv_mu_wa,
              rwkv_w0, rwkv_w_up, rwkv_a0, rwkv_a_up, rwkv_k_k, rwkv_k_a, rwkv_r_k, rwkv_gn_w, rwkv_gn_b,
              attn_w_in, attn_w_out, attn_q_norm, attn_k_norm):
    def trunk(x):
        for i in range(DEPTH):
            j = i // 2
            x = x + 0.5 * swiglu_ffn(rmsnorm(x, ffn1_norm[i]), ffn1_w_in[i], ffn1_w_out[i])
            h = rmsnorm(x, mix_norm[i])
            if i % 2 == 0:
                x = x + sgu_rwkv_mixer(h, ab_w_in[j], ab_w_out[j], sgu_norm[j], sgu_w[j], sgu_b[j],
                                       rwkv_mu_rkv[j], rwkv_mu_wa[j], rwkv_w0[j], rwkv_w_up[j],
                                       rwkv_a0[j], rwkv_a_up[j], rwkv_k_k[j], rwkv_k_a[j], rwkv_r_k[j],
                                       rwkv_gn_w[j], rwkv_gn_b[j])
            else:
                x = x + dilated_attention(h, attn_w_in[j], attn_w_out[j], attn_q_norm[j], attn_k_norm[j])
            x = x + 0.5 * swiglu_ffn(rmsnorm(x, ffn2_norm[i]), ffn2_w_in[i], ffn2_w_out[i])
            x = rmsnorm(x, block_norm[i])
        return x

    y_prompt = trunk(x_prompt)
    y_sample = trunk(x_sample)
    return (y_prompt, y_sample)
```

```cpp
#include <hip/hip_runtime.h>
#include <hip/hip_cooperative_groups.h>
#include <cstdio>
namespace cg = cooperative_groups;

namespace pg8 {
#define PG8_LAS __attribute__((address_space(3)))
typedef unsigned short bf16_t;
typedef short bf16x8 __attribute__((ext_vector_type(8)));
typedef float f32x4 __attribute__((ext_vector_type(4)));
typedef unsigned u32x4 __attribute__((ext_vector_type(4)));
constexpr int BM = 256, BK = 64, HALF = 128, HTB = HALF * BK * 2  , STAGE_BYTES = 8 * HTB, NXCD = 8, WGM = 8;

__host__ __device__ __forceinline__ int lds_byte(int r, int c) { const int st = (r >> 4) * 2 + (c >> 5), rr = r & 15, cc = c & 31, ob = rr * 64 + cc * 2; return st * 1024 + (ob ^ (((ob >> 9) & 1) << 5)); }
__host__ __device__ __forceinline__ void stage_rc(int b, int& R, int& C) { const int st = b / 1024, sb = b % 1024, swz = sb ^ (((sb >> 9) & 1) << 5); R = (st >> 1) * 16 + swz / 64; C = (st & 1) * 32 + (swz % 64) / 2; }
__host__ __device__ __forceinline__ int perm32(int rho) { const int n = rho >> 4, i = rho & 15; return 8 * (i >> 2) + 4 * n + (i & 3); }

struct Unit { int pm, pn; };
struct Gemm { const bf16_t* A; const bf16_t* Bt; int M, N, K; };

struct StaticOrder {
    int nM, nN, nwg, G, c;
    __host__ __device__ void init(int M, int N, int G_, int c_) { nM = M / BM; nN = N / BM; nwg = nM * nN; G = G_; c = c_; }
    __host__ __device__ bool next(int i, Unit& u) const {
        const long L = (long)i * G + c; if (L >= nwg) return false;
        int wgid = (int)L; { const int q = nwg / NXCD, r = nwg % NXCD, xcd = wgid % NXCD, off = wgid / NXCD; wgid = (xcd < r ? xcd * (q + 1) : r * (q + 1) + (xcd - r) * q) + off; }
        const int nig = WGM * nN, gid = wgid / nig, fm = gid * WGM, gsz = (nM - fm) < WGM ? (nM - fm) : WGM;
        u.pm = fm + ((wgid % nig) % gsz); u.pn = (wgid % nig) / gsz; return true;
    }
    __device__ __forceinline__ void a_ready(const Unit&) const {}
    __device__ __forceinline__ void done(const Unit&) const {}
};
__device__ __forceinline__ unsigned cvt_pk_bf16(float lo, float hi) { unsigned r; asm volatile("v_cvt_pk_bf16_f32 %0, %1, %2" : "=v"(r) : "v"(lo), "v"(hi)); return r; }
typedef float f32x2 __attribute__((ext_vector_type(2)));
template <class Epi, class Sched, bool STAMP = false>
__device__ __forceinline__ void gemm_phase(PG8_LAS unsigned char* lds, const Gemm g, const Sched& S, const Epi& E, unsigned long long* stamps) {
    int tid_raw_ = threadIdx.x; asm volatile("" : "+v"(tid_raw_)); const int tid = tid_raw_, wid = __builtin_amdgcn_readfirstlane(tid >> 6), lane = tid & 63, wr = wid >> 2, wc = wid & 3, fr = lane & 15, fq = lane >> 4;
    const int K = g.K, nt = K / BK;
    int ts_lo = 0, ts_hi = 0, nts = 0; const unsigned long long rt_entry = STAMP ? (unsigned long long)wall_clock64() : 0ull;
#define PG8_STAMP() do { if (STAMP && wid == 0 && nts < 64) { const unsigned long long _c = (unsigned long long)clock64(); \
        ts_lo = (lane == nts) ? (int)(unsigned)_c : ts_lo; ts_hi = (lane == nts) ? (int)(unsigned)(_c >> 32) : ts_hi; ++nts; } } while (0)
    PG8_STAMP();
    unsigned voffA[2], voffB[2];
#pragma unroll
    for (int i = 0; i < 2; ++i) { int R, C; stage_rc(tid * 16 + i * 8192, R, C); const int Rb = Epi::PERM ? ((R & ~31) + perm32(R & 31)) : R;
        voffA[i] = (unsigned)(R * K + C) * 2u; voffB[i] = (unsigned)(Rb * K + C) * 2u; }
    const size_t kstep = (size_t)(BK * 2);
    const size_t hstep = (size_t)HALF * K * 2;
    const size_t tstep = 2 * hstep;
    const unsigned ldsw = (unsigned)wid * 1024u;
    const int aoff = lds_byte(wr * 64 + fr, fq * 8), boff = lds_byte(wc * 32 + fr, fq * 8);
#define PG8_SA(b, h) (((b) * 2 + (h)) * HTB)
#define PG8_SB(b, h) ((4 + (b) * 2 + (h)) * HTB)
#define PG8_STAGE(bufoff, gbase, voff) do { _Pragma("unroll") for (int _i = 0; _i < 2; ++_i) \
        __builtin_amdgcn_global_load_lds((const unsigned*)((const char*)(gbase) + (voff)[_i]), (PG8_LAS unsigned*)(lds + (bufoff) + ldsw + _i * 8192), 16, 0, 0); } while (0)
#define PG8_LDA(dst, b, h) do { _Pragma("unroll") for (int m = 0; m < 4; ++m) _Pragma("unroll") for (int k = 0; k < 2; ++k) dst[m][k] = *(const PG8_LAS bf16x8*)(lds + PG8_SA(b, h) + aoff + m * 2048 + k * 1024); } while (0)
#define PG8_LDB(dst, b, h) do { _Pragma("unroll") for (int n = 0; n < 2; ++n) _Pragma("unroll") for (int k = 0; k < 2; ++k) dst[n][k] = *(const PG8_LAS bf16x8*)(lds + PG8_SB(b, h) + boff + n * 2048 + k * 1024); } while (0)
#define PG8_MMA(ai, bj, At, Bt) do { __builtin_amdgcn_s_setprio(1); _Pragma("unroll") for (int m = 0; m < 4; ++m) _Pragma("unroll") for (int n = 0; n < 2; ++n) _Pragma("unroll") for (int k = 0; k < 2; ++k) \
        acc[ai][bj][m][n] = __builtin_amdgcn_mfma_f32_16x16x32_bf16(Bt[n][k], At[m][k], acc[ai][bj][m][n], 0, 0, 0); __builtin_amdgcn_s_setprio(0); } while (0)
#define PG8_WAIT_V(n) asm volatile("s_waitcnt vmcnt(" #n ")" ::: "memory")
#define PG8_WAIT_L(n) asm volatile("s_waitcnt lgkmcnt(" #n ")" ::: "memory")
#define PG8_BAR __builtin_amdgcn_s_barrier()
#define PG8_SCHED __builtin_amdgcn_sched_barrier(0)
    Unit cur, nxt; int ui = 0;
    if (!S.next(0, cur)) return;
    f32x4 acc[2][2][4][2];
#pragma unroll
    for (int a = 0; a < 2; ++a)
#pragma unroll
        for (int b = 0; b < 2; ++b)
#pragma unroll
            for (int m = 0; m < 4; ++m)
#pragma unroll
                for (int n = 0; n < 2; ++n) acc[a][b][m][n] = (f32x4){0.f, 0.f, 0.f, 0.f};
    bf16x8 At[4][2], B0[2][2], B1[2][2];
    const char* cA = (const char*)g.A + (size_t)cur.pm * tstep; const char* cB = (const char*)g.Bt + (size_t)cur.pn * tstep;
    S.a_ready(cur);
    PG8_STAGE(PG8_SB(0, 0), cB, voffB); PG8_STAGE(PG8_SA(0, 0), cA, voffA); PG8_STAGE(PG8_SB(0, 1), cB + hstep, voffB); PG8_STAGE(PG8_SA(0, 1), cA + hstep, voffA);
    if (wr == 1) PG8_BAR;
    PG8_WAIT_V(4); PG8_BAR;
    PG8_STAGE(PG8_SB(1, 0), cB + kstep, voffB); PG8_STAGE(PG8_SA(1, 0), cA + kstep, voffA); PG8_STAGE(PG8_SB(1, 1), cB + hstep + kstep, voffB);
    PG8_WAIT_V(6); PG8_BAR;
    PG8_STAMP();
    for (;;) {
        const bool has_next = S.next(ui + 1, nxt);
        const char* nA = has_next ? (const char*)g.A + (size_t)nxt.pm * tstep : cA; const char* nB = has_next ? (const char*)g.Bt + (size_t)nxt.pn * tstep : cB;
        for (int t = 0; t < nt; t += 2) {
            const bool last = (t == nt - 2);
            const char* a1 = cA + (size_t)(t + 1) * kstep;
            const char* a2 = last ? nA : cA + (size_t)(t + 2) * kstep; const char* b2 = last ? nB : cB + (size_t)(t + 2) * kstep;
            const char* a3 = a2 + kstep; const char* b3 = b2 + kstep;
            if (last && has_next) S.a_ready(nxt);
            PG8_LDB(B0, 0, 0); PG8_SCHED; PG8_LDA(At, 0, 0); PG8_STAGE(PG8_SA(1, 1), a1 + hstep, voffA);
            PG8_WAIT_L(8); PG8_BAR; PG8_WAIT_L(0); PG8_MMA(0, 0, At, B0); PG8_BAR; PG8_SCHED;
            PG8_LDB(B1, 0, 1); PG8_STAGE(PG8_SB(0, 0), b2, voffB);
            PG8_BAR; PG8_WAIT_L(0); PG8_MMA(0, 1, At, B1); PG8_BAR;
            PG8_LDA(At, 0, 1); PG8_STAGE(PG8_SA(0, 0), a2, voffA);
            PG8_BAR; PG8_WAIT_L(0); PG8_MMA(1, 0, At, B0); PG8_BAR; PG8_SCHED;
            PG8_STAGE(PG8_SB(0, 1), b2 + hstep, voffB);
            PG8_WAIT_V(6); PG8_BAR; PG8_MMA(1, 1, At, B1); PG8_BAR;
            PG8_LDB(B0, 1, 0); PG8_SCHED; PG8_LDA(At, 1, 0); PG8_STAGE(PG8_SA(0, 1), a2 + hstep, voffA);
            PG8_WAIT_L(8); PG8_BAR; PG8_WAIT_L(0); PG8_MMA(0, 0, At, B0); PG8_BAR; PG8_SCHED;
            PG8_LDB(B1, 1, 1); PG8_STAGE(PG8_SB(1, 0), b3, voffB);
            PG8_BAR; PG8_WAIT_L(0); PG8_MMA(0, 1, At, B1); PG8_BAR;
            PG8_LDA(At, 1, 1); PG8_STAGE(PG8_SA(1, 0), a3, voffA);
            PG8_BAR; PG8_WAIT_L(0); PG8_MMA(1, 0, At, B0); PG8_BAR; PG8_SCHED;
            PG8_STAGE(PG8_SB(1, 1), b3 + hstep, voffB);
            PG8_WAIT_V(6); PG8_BAR; PG8_MMA(1, 1, At, B1); PG8_BAR;
        }
        PG8_STAMP();
        if constexpr (!Epi::AFTER_DRAIN) { E(acc, cur, wr, wc, fr, fq); S.done(cur); }
        PG8_STAMP();
        if (!has_next) break;
#pragma unroll
        for (int a = 0; a < 2; ++a)
#pragma unroll
            for (int b = 0; b < 2; ++b)
#pragma unroll
                for (int m = 0; m < 4; ++m)
#pragma unroll
                    for (int n = 0; n < 2; ++n) acc[a][b][m][n] = (f32x4){0.f, 0.f, 0.f, 0.f};
        cur = nxt; cA = nA; cB = nB; ++ui;
    }
    PG8_WAIT_V(0);
    if (wr == 0) PG8_BAR;
    PG8_BAR;
    if constexpr (Epi::AFTER_DRAIN) { E.fused(acc, cur, wr, wc, fr, fq, lds, wid, lane); S.done(cur); }
    PG8_STAMP();
    if (STAMP && wid == 0) { stamps[lane] = lane < nts ? (((unsigned long long)(unsigned)ts_hi << 32) | (unsigned)ts_lo) : 0ull;
        if (lane == 62) stamps[62] = rt_entry; if (lane == 63) stamps[63] = (unsigned long long)wall_clock64(); }
#undef PG8_STAMP
#undef PG8_SA
#undef PG8_SB
#undef PG8_STAGE
#undef PG8_LDA
#undef PG8_LDB
#undef PG8_MMA
#undef PG8_WAIT_V
#undef PG8_WAIT_L
#undef PG8_BAR
#undef PG8_SCHED
}
}


#define LAS __attribute__((address_space(3)))
typedef unsigned short bf16_t;
typedef short bf16x8 __attribute__((ext_vector_type(8)));
typedef short s16x4 __attribute__((ext_vector_type(4)));
typedef float f32x4 __attribute__((ext_vector_type(4)));
typedef unsigned u32x4 __attribute__((ext_vector_type(4)));
typedef unsigned u32x2 __attribute__((ext_vector_type(2)));

constexpr int M_TOK = 81920, M_PROMPT = 65536, DM = 1024, DFF = 2816;
constexpr int LDS_BYTES = 147456;
constexpr float NORM_EPS = 1e-6f;

constexpr size_t SZ_WFI = (size_t)5632 * 1024 * 2, SZ_WFO = (size_t)1024 * 2816 * 2;
constexpr size_t WS_WFI = 0;
constexpr size_t WS_WFO = WS_WFI + 4 * SZ_WFI;
constexpr size_t WS_WABI = WS_WFO + 4 * SZ_WFO;
constexpr size_t WS_WABO = WS_WABI + (size_t)3328 * 1024 * 2;
constexpr size_t WS_WATI = WS_WABO + (size_t)1024 * 1024 * 2;
constexpr size_t WS_WATO = WS_WATI + (size_t)3072 * 1024 * 2;
constexpr size_t WS_LORA = WS_WATO + (size_t)1024 * 1024 * 2;
constexpr size_t WS_SGUW = WS_LORA + (size_t)4 * 512 * 64 * 2;
constexpr size_t WS_RKR = WS_SGUW + (size_t)4 * 128 * 128 * 2;
constexpr size_t WS_XN = (WS_RKR + (size_t)2 * M_TOK * 8 * 4 + 4095) & ~(size_t)4095;
constexpr size_t WS_BIG = WS_XN + (size_t)M_TOK * 1024 * 2;
constexpr size_t WS_PUV = WS_BIG;
constexpr size_t WS_PRKVG = WS_PUV + (size_t)M_TOK * 1024 * 2;
constexpr size_t WS_PWA = WS_PRKVG + (size_t)M_TOK * 2048 * 2;
constexpr size_t WS_Y = WS_BIG + (size_t)M_TOK * 3328 * 2;
constexpr size_t WS_END = WS_Y + (size_t)2 * M_TOK * 512 * 2;

struct Params { const float* in[30]; float* out; unsigned char* ws; };

__device__ __forceinline__ float bflo(unsigned w) { return __uint_as_float(w << 16); }
__device__ __forceinline__ float bfhi(unsigned w) { return __uint_as_float(w & 0xffff0000u); }
__device__ __forceinline__ unsigned pk2(float lo, float hi) { unsigned r; asm("v_cvt_pk_bf16_f32 %0, %1, %2" : "=v"(r) : "v"(lo), "v"(hi)); return r; }
__device__ __forceinline__ void unpack8(const u32x4 w, float* f) { f[0] = bflo(w.x); f[1] = bfhi(w.x); f[2] = bflo(w.y); f[3] = bfhi(w.y); f[4] = bflo(w.z); f[5] = bfhi(w.z); f[6] = bflo(w.w); f[7] = bfhi(w.w); }
__device__ __forceinline__ u32x4 pack8(const float* f) { u32x4 w; w.x = pk2(f[0], f[1]); w.y = pk2(f[2], f[3]); w.z = pk2(f[4], f[5]); w.w = pk2(f[6], f[7]); return w; }
__device__ __forceinline__ float sigmoidf_(float x) { return __builtin_amdgcn_rcpf(1.0f + __expf(-x)); }
__device__ __forceinline__ float siluf_(float x) { return x * sigmoidf_(x); }
__device__ __forceinline__ float gelu_tanh(float x) { const float u = 0.7978845608028654f * (x + 0.044715f * x * x * x); return x * sigmoidf_(2.0f * u); }
__device__ __forceinline__ float tanhf_(float x) { return 1.0f - 2.0f * __builtin_amdgcn_rcpf(__expf(2.0f * x) + 1.0f); }
__device__ __forceinline__ float wave_sum(float x) { x += __shfl_xor(x, 32); x += __shfl_xor(x, 16); x += __shfl_xor(x, 8); x += __shfl_xor(x, 4); x += __shfl_xor(x, 2); x += __shfl_xor(x, 1); return x; }
template <int CTRL> __device__ __forceinline__ float dppf(float x) { return __int_as_float(__builtin_amdgcn_update_dpp(0, __float_as_int(x), CTRL, 0xF, 0xF, true)); }
__device__ __forceinline__ float reduce8(float x) { x += dppf<0xB1>(x); x += dppf<0x4E>(x); x += dppf<0x141>(x); return x; }
typedef short v4i16_t __attribute__((ext_vector_type(4)));
__device__ __forceinline__ s16x4 tr_read(LAS const unsigned char* p) { return __builtin_bit_cast(s16x4, __builtin_amdgcn_ds_read_tr16_b64_v4i16((LAS v4i16_t*)p)); }
__device__ __forceinline__ f32x4 mfma16(bf16x8 a, bf16x8 b, f32x4 c) { return __builtin_amdgcn_mfma_f32_16x16x32_bf16(a, b, c, 0, 0, 0); }

__device__ __forceinline__ int opaque_tid() { int t = threadIdx.x; asm volatile("" : "+v"(t)); return t; }
__device__ __forceinline__ unsigned char* opaque_ptr(unsigned char* p) { asm volatile("" : "+s"(p)); return p; }
struct EpiSwiglu {
    static constexpr bool PERM = false, AFTER_DRAIN = false;
    bf16_t* H;
    __device__ __forceinline__ void operator()(const f32x4 (&acc)[2][2][4][2], const pg8::Unit& u, int wr, int wc, int fr, int fq) const {
        const int row0 = u.pm * 256 + wr * 64 + fr, col0 = u.pn * 128 + wc * 32 + 8 * fq;
#pragma unroll
        for (int ai = 0; ai < 2; ++ai)
#pragma unroll
            for (int m = 0; m < 4; ++m) {
                bf16_t* rowp = H + (size_t)(row0 + ai * 128 + m * 16) * DFF + col0;
                float h[8];
#pragma unroll
                for (int bj = 0; bj < 2; ++bj)
#pragma unroll
                    for (int j = 0; j < 4; ++j) h[bj * 4 + j] = siluf_(acc[ai][bj][m][0][j]) * acc[ai][bj][m][1][j];
                *(u32x4*)rowp = pack8(h);
                asm volatile("" ::: "memory");
            }
    }
};
struct EpiResid {
    static constexpr bool PERM = false, AFTER_DRAIN = false;
    float* X; float scale;
    __device__ __forceinline__ void operator()(const f32x4 (&acc)[2][2][4][2], const pg8::Unit& u, int wr, int wc, int fr, int fq) const {
        const int row0 = u.pm * 256 + wr * 64 + fr, col0 = u.pn * 256 + wc * 32 + 4 * fq;
#pragma unroll
        for (int ai = 0; ai < 2; ++ai)
#pragma unroll
            for (int m = 0; m < 4; ++m) {
                float* rowp = X + (size_t)(row0 + ai * 128 + m * 16) * DM + col0;
#pragma unroll
                for (int bj = 0; bj < 2; ++bj)
#pragma unroll
                    for (int n = 0; n < 2; ++n) { f32x4* p = (f32x4*)(rowp + bj * 128 + n * 16); f32x4 v = *p; v += acc[ai][bj][m][n] * scale; *p = v; }
                asm volatile("" ::: "memory");
            }
    }
};
struct EpiSplit {
    static constexpr bool PERM = true, AFTER_DRAIN = false;
    bf16_t* b0; int ld0, t0; bf16_t* b1; int ld1, t1; bf16_t* b2; int ld2;
    __device__ __forceinline__ void operator()(const f32x4 (&acc)[2][2][4][2], const pg8::Unit& u, int wr, int wc, int fr, int fq) const {
        bf16_t* base; int ld, ct;
        if (u.pn < t0) { base = b0; ld = ld0; ct = u.pn; } else if (u.pn < t1) { base = b1; ld = ld1; ct = u.pn - t0; } else { base = b2; ld = ld2; ct = u.pn - t1; }
        const int row0 = u.pm * 256 + wr * 64 + fr, col0 = ct * 256 + wc * 32 + 8 * fq;
#pragma unroll
        for (int ai = 0; ai < 2; ++ai)
#pragma unroll
            for (int m = 0; m < 4; ++m) {
                bf16_t* rowp = base + (size_t)(row0 + ai * 128 + m * 16) * ld + col0;
#pragma unroll
                for (int bj = 0; bj < 2; ++bj) {
                    const f32x4 v0 = acc[ai][bj][m][0], v1 = acc[ai][bj][m][1];
                    u32x4 w; w.x = pk2(v0[0], v0[1]); w.y = pk2(v0[2], v0[3]); w.z = pk2(v1[0], v1[1]); w.w = pk2(v1[2], v1[3]);
                    *(u32x4*)(rowp + bj * 128) = w;
                }
                asm volatile("" ::: "memory");
            }
    }
};

template <int MAP> __device__ __forceinline__ int src_col(int s) {
    if (MAP == 0) return s;
    const int pn = s >> 8, bj = (s >> 7) & 1, wc = (s >> 5) & 3, n = (s >> 4) & 1, fq = (s >> 2) & 3, jj = s & 3;
    return n * DFF + 128 * pn + 32 * wc + 8 * fq + 4 * bj + jj;
}
template <int MAP> __device__ void convert_T(const float* __restrict__ src, bf16_t* __restrict__ dst, int K, int N, LAS float* tile, int rot) {
    const int tk = K / 64, tn = N / 64, nt = tk * tn, tid = opaque_tid(), G = gridDim.x;
    for (int t = (int)((blockIdx.x + rot) % G); t < nt; t += G) {
        const int k0 = (t % tk) * 64, s0 = (t / tk) * 64;
#pragma unroll
        for (int i = 0; i < 2; ++i) {
            const int idx = tid + i * 512, kk = idx >> 4, sg = idx & 15;
            const int c = src_col<MAP>(s0 + sg * 4);
            const float4 v = *(const float4*)(src + (size_t)(k0 + kk) * N + c);
            LAS float* tp = tile + kk * 65 + sg * 4;
            tp[0] = v.x; tp[1] = v.y; tp[2] = v.z; tp[3] = v.w;
        }
        __syncthreads();
        {
            const int slot = tid >> 3, kc = tid & 7; float f[8];
#pragma unroll
            for (int i = 0; i < 8; ++i) f[i] = tile[(kc * 8 + i) * 65 + slot];
            *(u32x4*)(dst + (size_t)(s0 + slot) * K + k0 + kc * 8) = pack8(f);
        }
        __syncthreads();
    }
}

__device__ void norm_rows(const float* xa, const float* xb, int split, float* xcopy, const float* g1, float* x1out, const float* g2, bf16_t* xn) {
    const int tid_ = opaque_tid(), lane = tid_ & 63, wave = __builtin_amdgcn_readfirstlane(tid_ >> 6);
    for (int row = blockIdx.x * 8 + wave; row < M_TOK; row += gridDim.x * 8) {
        const float* src = (row < split) ? xa + (size_t)row * DM : xb + (size_t)(row - split) * DM;
        f32x4 v[4]; float ss = 0.f;
#pragma unroll
        for (int i = 0; i < 4; ++i) { v[i] = *(const f32x4*)(src + i * 256 + lane * 4); ss += v[i][0] * v[i][0] + v[i][1] * v[i][1] + v[i][2] * v[i][2] + v[i][3] * v[i][3]; }
        if (xcopy) {
#pragma unroll
            for (int i = 0; i < 4; ++i) *(f32x4*)(xcopy + (size_t)row * DM + i * 256 + lane * 4) = v[i];
        }
        ss = wave_sum(ss);
        float r = rsqrtf(ss * (1.0f / DM) + NORM_EPS);
        if (g1) {
            float ss2 = 0.f;
#pragma unroll
            for (int i = 0; i < 4; ++i) { const f32x4 g = *(const f32x4*)(g1 + i * 256 + lane * 4); v[i] = v[i] * r * g; *(f32x4*)(x1out + (size_t)row * DM + i * 256 + lane * 4) = v[i];
                ss2 += v[i][0] * v[i][0] + v[i][1] * v[i][1] + v[i][2] * v[i][2] + v[i][3] * v[i][3]; }
            ss2 = wave_sum(ss2);
            r = rsqrtf(ss2 * (1.0f / DM) + NORM_EPS);
        }
        if (g2) {
#pragma unroll
            for (int i = 0; i < 4; ++i) { const f32x4 g = *(const f32x4*)(g2 + i * 256 + lane * 4); const f32x4 o = v[i] * r * g;
                u32x2 w; w.x = pk2(o[0], o[1]); w.y = pk2(o[2], o[3]); *(u32x2*)(xn + (size_t)row * DM + i * 256 + lane * 4) = w; }
        }
    }
}

__device__ void sgu_item(const Params& PP, int chunk, LAS unsigned char* lds) {
    Params P = PP; P.ws = opaque_ptr(PP.ws);
    const int tid = opaque_tid(), lane = tid & 63, wave = __builtin_amdgcn_readfirstlane(tid >> 6), l15 = lane & 15, quad = lane >> 4;
    constexpr int PITCH = 1056;
    const bf16_t* Puv = (const bf16_t*)(P.ws + WS_PUV);
    bf16_t* MO = (bf16_t*)(P.ws + WS_XN);
    const size_t row0 = (size_t)chunk * 128;
    {
        float gn[8];
        { const f32x4 a = *(const f32x4*)(P.in[12] + lane * 8), b = *(const f32x4*)(P.in[12] + lane * 8 + 4); gn[0] = a[0]; gn[1] = a[1]; gn[2] = a[2]; gn[3] = a[3]; gn[4] = b[0]; gn[5] = b[1]; gn[6] = b[2]; gn[7] = b[3]; }
        for (int i = 0; i < 16; ++i) {
            const int p = wave * 16 + i;
            const u32x4 raw = *(const u32x4*)(Puv + (row0 + p) * 1024 + 512 + lane * 8);
            float v[8]; unpack8(raw, v); float ss = 0.f;
#pragma unroll
            for (int e = 0; e < 8; ++e) { v[e] = gelu_tanh(v[e]); ss += v[e] * v[e]; }
            ss = wave_sum(ss);
            const float r = rsqrtf(ss * (1.0f / 512.0f) + NORM_EPS);
#pragma unroll
            for (int e = 0; e < 8; ++e) v[e] = v[e] * r * gn[e];
            *(LAS u32x4*)(lds + p * PITCH + lane * 16) = pack8(v);
        }
    }
    __syncthreads();
    const int g = wave >> 1, cbase = (wave >> 1) * 128 + (wave & 1) * 64;
    const bf16_t* Wg = (const bf16_t*)(P.ws + WS_SGUW) + (size_t)g * 128 * 128;
    const int r4 = l15 >> 2, c4 = l15 & 3;
    for (int qh = 0; qh < 2; ++qh) {
        f32x4 acc[4][4];
#pragma unroll
        for (int a = 0; a < 4; ++a)
#pragma unroll
            for (int b = 0; b < 4; ++b) acc[a][b] = (f32x4){0.f, 0.f, 0.f, 0.f};
#pragma unroll
        for (int ks = 0; ks < 4; ++ks) {
            bf16x8 bfr[4];
#pragma unroll
            for (int qt = 0; qt < 4; ++qt) bfr[qt] = *(const bf16x8*)(Wg + (size_t)(qh * 64 + qt * 16 + l15) * 128 + ks * 32 + quad * 8);
#pragma unroll
            for (int ct = 0; ct < 4; ++ct) {
                LAS const unsigned char* ap = lds + (ks * 32 + quad * 8 + r4) * PITCH + (cbase + ct * 16 + 4 * c4) * 2;
                const s16x4 lo = tr_read(ap), hi = tr_read(ap + 4 * PITCH);
                const bf16x8 a = {lo[0], lo[1], lo[2], lo[3], hi[0], hi[1], hi[2], hi[3]};
#pragma unroll
                for (int qt = 0; qt < 4; ++qt) acc[ct][qt] = mfma16(a, bfr[qt], acc[ct][qt]);
            }
        }
#pragma unroll
        for (int qt = 0; qt < 4; ++qt) {
            const int q = qh * 64 + qt * 16 + l15;
            const float bq = P.in[14][g * 128 + q];
#pragma unroll
            for (int ct = 0; ct < 4; ++ct) {
                const int c = cbase + ct * 16 + quad * 4;
                const u32x2 ur = *(const u32x2*)(Puv + (row0 + q) * 1024 + c);
                const float u0 = gelu_tanh(bflo(ur.x)), u1 = gelu_tanh(bfhi(ur.x)), u2 = gelu_tanh(bflo(ur.y)), u3 = gelu_tanh(bfhi(ur.y));
                u32x2 w; w.x = pk2(u0 * (acc[ct][qt][0] + bq), u1 * (acc[ct][qt][1] + bq)); w.y = pk2(u2 * (acc[ct][qt][2] + bq), u3 * (acc[ct][qt][3] + bq));
                *(u32x2*)(MO + (row0 + q) * 1024 + c) = w;
            }
        }
    }
    __syncthreads();
}

__device__ void scan_item(const Params& PP, int seq, int h, int dir, LAS unsigned char* lds) {
    Params P = PP; P.ws = opaque_ptr(PP.ws);
    const int tid = opaque_tid(), lane = tid & 63, wave = __builtin_amdgcn_readfirstlane(tid >> 6), l15 = lane & 15, quad = lane >> 4;
    const int T = seq < 32 ? 2048 : 16384;
    const size_t base = seq < 32 ? (size_t)seq * 2048 : (size_t)M_PROMPT;
    const bf16_t* Prkvg = (const bf16_t*)(P.ws + WS_PRKVG);
    const bf16_t* Pwa = (const bf16_t*)(P.ws + WS_PWA);
    bf16_t* Yd = (bf16_t*)(P.ws + WS_Y) + (size_t)dir * M_TOK * 512;
    float* RKR = (float*)(P.ws + WS_RKR) + (size_t)dir * M_TOK * 8;
    LAS bf16_t* RAW0 = (LAS bf16_t*)lds;
    LAS bf16_t* ZROW = (LAS bf16_t*)(lds + 21760);
    LAS float* Wd = (LAS float*)(lds + 22528);
    LAS float* Aa = Wd + 1024; LAS float* Rr = Aa + 1024; LAS float* KP = Rr + 1024; LAS float* Vv = KP + 1024; LAS float* KK = Vv + 1024; LAS float* KKA = KK + 1024; LAS float* Yc = KKA + 1024;
    if (tid < 160) ((LAS unsigned*)ZROW)[tid] = 0u;
    const int j_a = tid / 40, seg_a = (tid % 40) >> 3, c8_a = tid & 7;
    const int idx_b = tid + 512, j_b = idx_b / 40, seg_b = (idx_b % 40) >> 3, c8_b = idx_b & 7;
    const bool has_b = idx_b < 640;
    const int coff_a = seg_a < 3 ? seg_a * 512 + h * 64 + c8_a * 8 : dir * 128 + (seg_a - 3) * 64 + c8_a * 8;
    const int coff_b = seg_b < 3 ? seg_b * 512 + h * 64 + c8_b * 8 : dir * 128 + (seg_b - 3) * 64 + c8_b * 8;
    const int dst_a = (j_a + 1) * 320 + seg_a * 64 + c8_a * 8, dst_b = (j_b + 1) * 320 + seg_b * 64 + c8_b * 8;
    const int ltype = wave >> 2, lch = (wave & 3) * 16 + l15;
    const bf16_t* Wt = (const bf16_t*)(P.ws + WS_LORA) + (size_t)(dir * 2 + ltype) * 512 * 64 + (size_t)(h * 64 + lch) * 64;
    const bf16x8 lb0 = *(const bf16x8*)(Wt + quad * 8), lb1 = *(const bf16x8*)(Wt + 32 + quad * 8);
    float lmu[16];
#pragma unroll
    for (int i = 0; i < 16; ++i) lmu[i] = P.in[16][dir * 128 + ltype * 64 + (i >> 3) * 32 + quad * 8 + (i & 7)];
    const float lbias = ltype == 0 ? P.in[17][dir * 512 + h * 64 + lch] : P.in[19][dir * 512 + h * 64 + lch];
    const int tk = tid >> 5, c2 = tid & 31;
    float mu_r[2], mu_k[2], mu_v[2], k_k[2], k_a[2], r_k[2];
#pragma unroll
    for (int e = 0; e < 2; ++e) { const int ch = h * 64 + 2 * c2 + e;
        mu_r[e] = P.in[15][dir * 1536 + ch]; mu_k[e] = P.in[15][dir * 1536 + 512 + ch]; mu_v[e] = P.in[15][dir * 1536 + 1024 + ch];
        k_k[e] = P.in[21][ch]; k_a[e] = P.in[22][ch]; r_k[e] = P.in[23][ch]; }
    const int srow = wave * 8 + (lane >> 3), sq = lane & 7;
    float S[8];
#pragma unroll
    for (int i = 0; i < 8; ++i) S[i] = 0.f;
    const int nch = T / 16;
    u32x4 pre_a, pre_b = (u32x4){0u, 0u, 0u, 0u};
    {
        const int t0 = dir == 0 ? 0 : T - 16;
        const int ta = dir == 0 ? t0 + j_a : t0 + 15 - j_a, tb = dir == 0 ? t0 + j_b : t0 + 15 - j_b;
        pre_a = *(const u32x4*)((seg_a < 3 ? Prkvg + (base + ta) * 2048 : Pwa + (base + ta) * 256) + coff_a);
        if (has_b) pre_b = *(const u32x4*)((seg_b < 3 ? Prkvg + (base + tb) * 2048 : Pwa + (base + tb) * 256) + coff_b);
    }
    for (int c = 0; c < nch; ++c) {
        LAS bf16_t* RAW = RAW0 + (c & 1) * 5440;
        LAS bf16_t* RAWp = RAW0 + ((c & 1) ^ 1) * 5440;
        const int t0 = dir == 0 ? c * 16 : T - 16 - c * 16;
        *(LAS u32x4*)(RAW + dst_a) = pre_a;
        if (has_b) *(LAS u32x4*)(RAW + dst_b) = pre_b;
        if (c + 1 < nch) {
            const int t1 = dir == 0 ? t0 + 16 : t0 - 16;
            const int ta = dir == 0 ? t1 + j_a : t1 + 15 - j_a, tb = dir == 0 ? t1 + j_b : t1 + 15 - j_b;
            pre_a = *(const u32x4*)((seg_a < 3 ? Prkvg + (base + ta) * 2048 : Pwa + (base + ta) * 256) + coff_a);
            if (has_b) pre_b = *(const u32x4*)((seg_b < 3 ? Prkvg + (base + tb) * 2048 : Pwa + (base + tb) * 256) + coff_b);
        }
        __syncthreads();
        {
            LAS const bf16_t* cur = RAW + (l15 + 1) * 320 + 192 + ltype * 64;
            LAS const bf16_t* prv = (l15 > 0 ? RAW + l15 * 320 : (c > 0 ? RAWp + 16 * 320 : ZROW)) + 192 + ltype * 64;
            bf16x8 af[2];
#pragma unroll
            for (int ks = 0; ks < 2; ++ks) {
                const u32x4 xc = *(LAS const u32x4*)(cur + ks * 32 + quad * 8), xp = *(LAS const u32x4*)(prv + ks * 32 + quad * 8);
                float fc[8], fp[8]; unpack8(xc, fc); unpack8(xp, fp);
#pragma unroll
                for (int i = 0; i < 8; ++i) { float z = fc[i] + (fp[i] - fc[i]) * lmu[ks * 8 + i]; fc[i] = ltype == 0 ? tanhf_(z) : z; }
                af[ks] = __builtin_bit_cast(bf16x8, pack8(fc));
            }
            f32x4 d = mfma16(af[0], lb0, (f32x4){0.f, 0.f, 0.f, 0.f});
            d = mfma16(af[1], lb1, d);
            LAS float* dstp = (ltype == 0 ? Wd : Aa) + lch;
#pragma unroll
            for (int jj = 0; jj < 4; ++jj) { const float sg = sigmoidf_(lbias + d[jj]); dstp[(quad * 4 + jj) * 64] = ltype == 0 ? __expf(-0.6065306597126334f * sg) : sg; }
        }
        {
            LAS const bf16_t* cur = RAW + (tk + 1) * 320 + 2 * c2;
            LAS const bf16_t* prv = (tk > 0 ? RAW + tk * 320 : (c > 0 ? RAWp + 16 * 320 : ZROW)) + 2 * c2;
            const unsigned rc = *(LAS const unsigned*)(cur), rp = *(LAS const unsigned*)(prv);
            const unsigned kc = *(LAS const unsigned*)(cur + 64), kq = *(LAS const unsigned*)(prv + 64);
            const unsigned vc = *(LAS const unsigned*)(cur + 128), vp = *(LAS const unsigned*)(prv + 128);
            const int o = tk * 64 + 2 * c2;
            Rr[o] = bflo(rc) + (bflo(rp) - bflo(rc)) * mu_r[0]; Rr[o + 1] = bfhi(rc) + (bfhi(rp) - bfhi(rc)) * mu_r[1];
            KP[o] = bflo(kc) + (bflo(kq) - bflo(kc)) * mu_k[0]; KP[o + 1] = bfhi(kc) + (bfhi(kq) - bfhi(kc)) * mu_k[1];
            Vv[o] = bflo(vc) + (bflo(vp) - bflo(vc)) * mu_v[0]; Vv[o + 1] = bfhi(vc) + (bfhi(vp) - bfhi(vc)) * mu_v[1];
        }
        __syncthreads();
        {
            const int o = tk * 64 + 2 * c2;
            const float kz0 = KP[o], kz1 = KP[o + 1], a0 = Aa[o], a1 = Aa[o + 1];
            const float q0 = kz0 * k_k[0], q1 = kz1 * k_k[1];
            float ss = q0 * q0 + q1 * q1;
            ss += __shfl_xor(ss, 1); ss += __shfl_xor(ss, 2); ss += __shfl_xor(ss, 4); ss += __shfl_xor(ss, 8); ss += __shfl_xor(ss, 16);
            const float inv = 1.0f / fmaxf(sqrtf(ss), 1e-12f);
            const float kk0 = q0 * inv, kk1 = q1 * inv;
            KK[o] = kk0; KK[o + 1] = kk1; KKA[o] = kk0 * a0; KKA[o + 1] = kk1 * a1;
            const float kp0 = kz0 * (1.0f + (a0 - 1.0f) * k_a[0]), kp1 = kz1 * (1.0f + (a1 - 1.0f) * k_a[1]);
            KP[o] = kp0; KP[o + 1] = kp1;
            float rk = Rr[o] * kp0 * r_k[0] + Rr[o + 1] * kp1 * r_k[1];
            rk += __shfl_xor(rk, 1); rk += __shfl_xor(rk, 2); rk += __shfl_xor(rk, 4); rk += __shfl_xor(rk, 8); rk += __shfl_xor(rk, 16);
            if (c2 == 0) { const int tok = dir == 0 ? t0 + tk : t0 + 15 - tk; RKR[(base + tok) * 8 + h] = rk; }
        }
        __syncthreads();
#pragma unroll 4
        for (int j = 0; j < 16; ++j) {
            const int o = j * 64 + sq * 4;
            const f32x4 kk_a = *(LAS const f32x4*)(KK + o), kk_b = *(LAS const f32x4*)(KK + o + 32);
            const f32x4 w_a = *(LAS const f32x4*)(Wd + o), w_b = *(LAS const f32x4*)(Wd + o + 32);
            const f32x4 ka_a = *(LAS const f32x4*)(KKA + o), ka_b = *(LAS const f32x4*)(KKA + o + 32);
            const f32x4 kp_a = *(LAS const f32x4*)(KP + o), kp_b = *(LAS const f32x4*)(KP + o + 32);
            const f32x4 r_a = *(LAS const f32x4*)(Rr + o), r_b = *(LAS const f32x4*)(Rr + o + 32);
            const float vv = Vv[j * 64 + srow];
            float sa0 = S[0] * kk_a[0] + S[1] * kk_a[1], sa1 = S[2] * kk_a[2] + S[3] * kk_a[3], sa2 = S[4] * kk_b[0] + S[5] * kk_b[1], sa3 = S[6] * kk_b[2] + S[7] * kk_b[3];
            const float sa = reduce8((sa0 + sa1) + (sa2 + sa3));
            float y0 = 0.f, y1 = 0.f;
#pragma unroll
            for (int i = 0; i < 4; ++i) {
                S[i] = S[i] * w_a[i] + (vv * kp_a[i] - sa * ka_a[i]); y0 += S[i] * r_a[i];
                S[4 + i] = S[4 + i] * w_b[i] + (vv * kp_b[i] - sa * ka_b[i]); y1 += S[4 + i] * r_b[i];
            }
            const float y = reduce8(y0 + y1);
            if (sq == 0) Yc[j * 64 + srow] = y;
        }
        __syncthreads();
        if (tid < 128) {
            const int tq = tid >> 3, c8 = tid & 7; float f[8];
            const f32x4 a = *(LAS const f32x4*)(Yc + tq * 64 + c8 * 8), b = *(LAS const f32x4*)(Yc + tq * 64 + c8 * 8 + 4);
            f[0] = a[0]; f[1] = a[1]; f[2] = a[2]; f[3] = a[3]; f[4] = b[0]; f[5] = b[1]; f[6] = b[2]; f[7] = b[3];
            const int tok = dir == 0 ? t0 + tq : t0 + 15 - tq;
            *(u32x4*)(Yd + (base + tok) * 512 + h * 64 + c8 * 8) = pack8(f);
        }
    }
    __syncthreads();
}

__device__ void rwkv_finalize(const Params& PP) {
    Params P = PP; P.ws = opaque_ptr(PP.ws);
    const int tid_ = opaque_tid(), lane = tid_ & 63, wave = __builtin_amdgcn_readfirstlane(tid_ >> 6);
    const bf16_t* Prkvg = (const bf16_t*)(P.ws + WS_PRKVG);
    const bf16_t* Y0 = (const bf16_t*)(P.ws + WS_Y);
    const bf16_t* Y1 = Y0 + (size_t)M_TOK * 512;
    const float* RKR0 = (const float*)(P.ws + WS_RKR);
    const float* RKR1 = RKR0 + (size_t)M_TOK * 8;
    bf16_t* MO = (bf16_t*)(P.ws + WS_XN);
    const int col = lane * 8, hh = lane >> 3;
    float gw[8], gb[8], muf[8], mub[8];
#pragma unroll
    for (int i = 0; i < 8; ++i) { gw[i] = P.in[24][col + i]; gb[i] = P.in[25][col + i]; muf[i] = P.in[15][1024 + col + i]; mub[i] = P.in[15][1536 + 1024 + col + i]; }
    for (int row = blockIdx.x * 8 + wave; row < M_TOK; row += gridDim.x * 8) {
        const int t = row < M_PROMPT ? (row & 2047) : row - M_PROMPT, T = row < M_PROMPT ? 2048 : 16384;
        float yf[8], yb[8], vc[8], vp[8], vn[8], gg[8];
        unpack8(*(const u32x4*)(Y0 + (size_t)row * 512 + col), yf); unpack8(*(const u32x4*)(Y1 + (size_t)row * 512 + col), yb);
        unpack8(*(const u32x4*)(Prkvg + (size_t)row * 2048 + 1024 + col), vc);
        unpack8(*(const u32x4*)(Prkvg + (size_t)row * 2048 + 1536 + col), gg);
        if (t > 0) unpack8(*(const u32x4*)(Prkvg + (size_t)(row - 1) * 2048 + 1024 + col), vp); else { for (int i = 0; i < 8; ++i) vp[i] = 0.f; }
        if (t < T - 1) unpack8(*(const u32x4*)(Prkvg + (size_t)(row + 1) * 2048 + 1024 + col), vn); else { for (int i = 0; i < 8; ++i) vn[i] = 0.f; }
        const float rf = RKR0[(size_t)row * 8 + hh], rb = RKR1[(size_t)row * 8 + hh];
        float s = 0.f;
#pragma unroll
        for (int i = 0; i < 8; ++i) { yf[i] += yb[i]; s += yf[i]; }
        const float mean = reduce8(s) * (1.0f / 64.0f);
        float q = 0.f;
#pragma unroll
        for (int i = 0; i < 8; ++i) { yf[i] -= mean; q += yf[i] * yf[i]; }
        const float rstd = rsqrtf(reduce8(q) * (1.0f / 64.0f) + 64e-5f);
        float o[8];
#pragma unroll
        for (int i = 0; i < 8; ++i) {
            const float vzf = vc[i] + (vp[i] - vc[i]) * muf[i], vzb = vc[i] + (vn[i] - vc[i]) * mub[i];
            o[i] = (yf[i] * rstd * gw[i] + gb[i] + rf * vzf + rb * vzb) * sigmoidf_(gg[i]);
        }
        *(u32x4*)(MO + (size_t)row * 1024 + 512 + col) = pack8(o);
    }
}

__device__ void attn_item(const Params& PP, int seq, int h, int tile, LAS unsigned char* lds) {
    Params P = PP; P.ws = opaque_ptr(PP.ws);
    const int tid = opaque_tid(), lane = tid & 63, wave = __builtin_amdgcn_readfirstlane(tid >> 6), l15 = lane & 15, quad = lane >> 4;
    const int T = seq < 32 ? 2048 : 16384;
    const size_t base = seq < 32 ? (size_t)seq * 2048 : (size_t)M_PROMPT;
    const int T0 = tile * 256;
    const bf16_t* QKV = (const bf16_t*)(P.ws + WS_BIG);
    bf16_t* MO = (bf16_t*)(P.ws + WS_XN);
    LAS float* OACC = (LAS float*)lds;
    LAS float* LS = (LAS float*)(lds + 256 * 272);
    LAS unsigned char* VST = lds + 256 * 272 + 1024 + wave * (32 * 144);
    const float slope = exp2f(-0.5f * (float)(h + 1));
    float gqk[16];
#pragma unroll
    for (int i = 0; i < 16; ++i) { const int e = (i >> 3) * 32 + quad * 8 + (i & 7); gqk[i] = P.in[28][e] * P.in[29][e]; }
    const int r4 = l15 >> 2, c4 = l15 & 3;
    for (int bi = 0; bi < 3; ++bi) {
        const int dsh = 2 * bi, L = T >> dsh;
        const float sl_d = slope * (float)(1 << dsh);
        for (int gg = 0; gg < 2; ++gg) {
            const int g = wave * 2 + gg;
            const int res = bi == 0 ? 0 : (bi == 1 ? (g & 3) : g), blk = bi == 0 ? g : (bi == 1 ? (g >> 2) : 0);
            const int i0 = (T0 >> dsh) + 16 * blk;
            const int qtok = ((i0 + l15) << dsh) + res;
            bf16x8 qf[2]; float mq;
            {
                const bf16_t* qp = QKV + (base + qtok) * 3072 + h * 64 + quad * 8;
                float f[16]; unpack8(*(const u32x4*)qp, f); unpack8(*(const u32x4*)(qp + 32), f + 8);
                float ss = 0.f;
#pragma unroll
                for (int i = 0; i < 16; ++i) ss += f[i] * f[i];
                ss += __shfl_xor(ss, 16); ss += __shfl_xor(ss, 32);
                const float rq = rsqrtf(ss * (1.0f / 64.0f) + NORM_EPS) * 0.125f;
#pragma unroll
                for (int i = 0; i < 16; ++i) f[i] = f[i] * rq * gqk[i];
                const u32x4 w0 = pack8(f), w1 = pack8(f + 8);
                qf[0] = __builtin_bit_cast(bf16x8, w0); qf[1] = __builtin_bit_cast(bf16x8, w1);
                float fr[16]; unpack8(w0, fr); unpack8(w1, fr + 8);
                float n2 = 0.f;
#pragma unroll
                for (int i = 0; i < 16; ++i) n2 += fr[i] * fr[i];
                n2 += __shfl_xor(n2, 16); n2 += __shfl_xor(n2, 32);
                mq = 8.1f * sqrtf(n2);
            }
            f32x4 oacc[4];
#pragma unroll
            for (int et = 0; et < 4; ++et) oacc[et] = (f32x4){0.f, 0.f, 0.f, 0.f};
            float lsum = 0.f;
            const int qi = i0 + l15;
            for (int kp = 0; kp < 5; ++kp) {
                f32x4 s[2];
#pragma unroll
                for (int tt = 0; tt < 2; ++tt) {
                    const int kt = 2 * kp + tt;
                    s[tt] = (f32x4){0.f, 0.f, 0.f, 0.f};
                    if (kt < 9) {
                        int kidx = i0 - 64 + 16 * kt + l15; kidx = kidx < 0 ? 0 : (kidx > L - 1 ? L - 1 : kidx);
                        const bf16_t* kptr = QKV + (base + ((size_t)kidx << dsh) + res) * 3072 + 1024 + h * 64 + quad * 8;
                        float f[16]; unpack8(*(const u32x4*)kptr, f); unpack8(*(const u32x4*)(kptr + 32), f + 8);
                        float ss = 0.f;
#pragma unroll
                        for (int i = 0; i < 16; ++i) ss += f[i] * f[i];
                        ss += __shfl_xor(ss, 16); ss += __shfl_xor(ss, 32);
                        const float rk = rsqrtf(ss * (1.0f / 64.0f) + NORM_EPS);
#pragma unroll
                        for (int i = 0; i < 16; ++i) f[i] *= rk;
                        const bf16x8 k0 = __builtin_bit_cast(bf16x8, pack8(f)), k1 = __builtin_bit_cast(bf16x8, pack8(f + 8));
                        f32x4 sc = mfma16(k0, qf[0], (f32x4){0.f, 0.f, 0.f, 0.f});
                        sc = mfma16(k1, qf[1], sc);
#pragma unroll
                        for (int j = 0; j < 4; ++j) {
                            const int kj = i0 - 64 + 16 * kt + quad * 4 + j;
                            int dist = kj - qi; dist = dist < 0 ? -dist : dist;
                            const bool valid = (dist <= 64) && (kj >= 0) && (kj < L);
                            const float p = valid ? __expf(sc[j] - mq - sl_d * (float)dist) : 0.f;
                            lsum += p; s[tt][j] = p;
                        }
                    }
                }
                bf16x8 pf;
                { u32x4 w; w.x = pk2(s[0][0], s[0][1]); w.y = pk2(s[0][2], s[0][3]); w.z = pk2(s[1][0], s[1][1]); w.w = pk2(s[1][2], s[1][3]); pf = __builtin_bit_cast(bf16x8, w); }
                {
                    const int rowv = lane >> 1, half = lane & 1;
                    int vidx = i0 - 64 + 32 * kp + rowv; vidx = vidx < 0 ? 0 : (vidx > L - 1 ? L - 1 : vidx);
                    const bf16_t* vptr = QKV + (base + ((size_t)vidx << dsh) + res) * 3072 + 2048 + h * 64 + half * 32;
                    const u32x4 v0 = *(const u32x4*)vptr, v1 = *(const u32x4*)(vptr + 8), v2 = *(const u32x4*)(vptr + 16), v3 = *(const u32x4*)(vptr + 24);
                    LAS u32x4* vd = (LAS u32x4*)(VST + rowv * 144 + half * 64);
                    vd[0] = v0; vd[1] = v1; vd[2] = v2; vd[3] = v3;
                }
                asm volatile("s_waitcnt lgkmcnt(0)" ::: "memory"); __builtin_amdgcn_fence(__ATOMIC_RELEASE, "wavefront"); __builtin_amdgcn_wave_barrier(); __builtin_amdgcn_fence(__ATOMIC_ACQUIRE, "wavefront"); asm volatile("s_waitcnt lgkmcnt(0)" ::: "memory");
#pragma unroll
                for (int et = 0; et < 4; ++et) {
                    LAS const unsigned char* ap = VST + (quad * 4 + r4) * 144 + (et * 16 + 4 * c4) * 2;
                    const s16x4 lo = tr_read(ap), hi = tr_read(ap + 16 * 144);
                    const bf16x8 a = {lo[0], lo[1], lo[2], lo[3], hi[0], hi[1], hi[2], hi[3]};
                    oacc[et] = mfma16(a, pf, oacc[et]);
                }
                asm volatile("s_waitcnt lgkmcnt(0)" ::: "memory"); __builtin_amdgcn_fence(__ATOMIC_RELEASE, "wavefront"); __builtin_amdgcn_wave_barrier(); __builtin_amdgcn_fence(__ATOMIC_ACQUIRE, "wavefront"); asm volatile("s_waitcnt lgkmcnt(0)" ::: "memory");
            }
            lsum += __shfl_xor(lsum, 16); lsum += __shfl_xor(lsum, 32);
            const int qloc = qtok - T0;
#pragma unroll
            for (int et = 0; et < 4; ++et) {
                LAS f32x4* dst = (LAS f32x4*)(OACC + qloc * 68 + et * 16 + quad * 4);
                if (bi == 0) *dst = oacc[et]; else *dst = *dst + oacc[et];
            }
            if (quad == 0) { if (bi == 0) LS[qloc] = lsum; else LS[qloc] += lsum; }
        }
        __syncthreads();
    }
    {
        const int q = tid >> 1, half = tid & 1;
        const float inv = 1.0f / LS[q];
        bf16_t* op = MO + (base + T0 + q) * 1024 + h * 64 + half * 32;
#pragma unroll
        for (int i = 0; i < 4; ++i) {
            const f32x4 a = *(LAS const f32x4*)(OACC + q * 68 + half * 32 + i * 8), b = *(LAS const f32x4*)(OACC + q * 68 + half * 32 + i * 8 + 4);
            u32x4 w; w.x = pk2(a[0] * inv, a[1] * inv); w.y = pk2(a[2] * inv, a[3] * inv); w.z = pk2(b[0] * inv, b[1] * inv); w.w = pk2(b[2] * inv, b[3] * inv);
            *(u32x4*)(op + i * 8) = w;
        }
    }
    __syncthreads();
}

enum { K_P0 = 0, K_SWIGLU, K_RESID, K_NORM, K_GEMM_P, K_MIXA, K_FINAL, K_GEMM_QKV, K_ATTN };
constexpr int N_PHASES = 22;

__global__ void __launch_bounds__(512, 2) mega(Params P) {
    extern __shared__ __attribute__((aligned(16))) unsigned char lds_raw[];
    LAS unsigned char* lds = (LAS unsigned char*)lds_raw;
    cg::grid_group grid = cg::this_grid();
    for (int ph = 0; ph < N_PHASES; ++ph) {
        unsigned char* ws = P.ws; float* X = P.out; int G = gridDim.x, bid = blockIdx.x;
        asm volatile("" : "+s"(ws), "+s"(X), "+s"(G), "+s"(bid));
        bf16_t* XN = (bf16_t*)(ws + WS_XN);
        bf16_t* Hb = (bf16_t*)(ws + WS_BIG);
        int kind, layer = 0, sub = 0;
        if (ph == 0) kind = K_P0;
        else {
            layer = (ph - 1) / 11; const int r = (ph - 1) % 11;
            const unsigned long long kc = layer == 0 ? 0x32132654321ull : 0x3213287321ull;
            const unsigned long long sc = layer == 0 ? 0x21112000000ull : 0x2111200000ull;
            kind = (int)((kc >> (4 * r)) & 15ull); sub = (int)((sc >> (4 * r)) & 15ull);
        }
        if (kind == K_P0) {
#ifndef SKIP_P0
            LAS float* tile = (LAS float*)lds;
            int rot = 0;
            for (int job = 0; job < 16; ++job) {
                const float* src; size_t doff; int K, N;
                if (job < 4) { src = ((job & 1) ? P.in[7] : P.in[3]) + (size_t)(job >> 1) * 1024 * 5632; doff = WS_WFI + (size_t)job * SZ_WFI; K = 1024; N = 5632; }
                else if (job < 8) { src = ((job & 1) ? P.in[8] : P.in[4]) + (size_t)((job - 4) >> 1) * 2816 * 1024; doff = WS_WFO + (size_t)(job - 4) * SZ_WFO; K = 2816; N = 1024; }
                else if (job == 8) { src = P.in[10]; doff = WS_WABI; K = 1024; N = 3328; }
                else if (job == 9) { src = P.in[11]; doff = WS_WABO; K = 1024; N = 1024; }
                else if (job == 10) { src = P.in[26]; doff = WS_WATI; K = 1024; N = 3072; }
                else if (job == 11) { src = P.in[27]; doff = WS_WATO; K = 1024; N = 1024; }
                else { const int d = (job - 12) >> 1, ty = (job - 12) & 1; src = (ty ? P.in[20] : P.in[18]) + (size_t)d * 64 * 512; doff = WS_LORA + (size_t)(d * 2 + ty) * 512 * 64 * 2; K = 64; N = 512; }
                if (job < 4) convert_T<1>(src, (bf16_t*)(ws + doff), K, N, tile, rot); else convert_T<0>(src, (bf16_t*)(ws + doff), K, N, tile, rot);
                rot += (K / 64) * (N / 64);
            }
            {
                bf16_t* dst = (bf16_t*)(ws + WS_SGUW);
                for (int i = bid * 512 + opaque_tid(); i < 4 * 128 * 128 / 4; i += G * 512) {
                    const f32x4 v = *(const f32x4*)(P.in[13] + (size_t)i * 4);
                    u32x2 w; w.x = pk2(v[0], v[1]); w.y = pk2(v[2], v[3]); *(u32x2*)(dst + (size_t)i * 4) = w;
                }
            }
            norm_rows(P.in[0], P.in[1], M_PROMPT, X, nullptr, nullptr, P.in[2], XN);
#endif
        } else if (kind == K_SWIGLU) {
            pg8::Gemm g{XN, (const bf16_t*)(ws + WS_WFI + (size_t)(layer * 2 + sub) * SZ_WFI), M_TOK, 5632, 1024};
            pg8::StaticOrder S; S.init(M_TOK, 5632, G, bid);
            EpiSwiglu E{Hb};
#ifndef SKIP_G1
            pg8::gemm_phase<EpiSwiglu, pg8::StaticOrder>(lds, g, S, E, nullptr);
#endif
        } else if (kind == K_RESID) {
            const bf16_t* A; const bf16_t* Bt; int K; float scale;
            if (sub < 2) { A = Hb; Bt = (const bf16_t*)(ws + WS_WFO + (size_t)(layer * 2 + sub) * SZ_WFO); K = 2816; scale = 0.5f; }
            else { A = XN; Bt = (const bf16_t*)(ws + (layer == 0 ? WS_WABO : WS_WATO)); K = 1024; scale = 1.0f; }
            pg8::Gemm g{A, Bt, M_TOK, 1024, K};
            pg8::StaticOrder S; S.init(M_TOK, 1024, G, bid);
            EpiResid E{X, scale};
#ifndef SKIP_G2
            pg8::gemm_phase<EpiResid, pg8::StaticOrder>(lds, g, S, E, nullptr);
#endif
        } else if (kind == K_NORM) {
            if (sub == 0) norm_rows(X, X, M_TOK, nullptr, nullptr, nullptr, P.in[5] + layer * DM, XN);
            else if (sub == 1) norm_rows(X, X, M_TOK, nullptr, nullptr, nullptr, P.in[6] + layer * DM, XN);
            else if (ph < N_PHASES - 1) { if (layer == 0) norm_rows(X, X, M_TOK, nullptr, P.in[9], X, P.in[2] + DM, XN); }
            else norm_rows(X, X, M_TOK, nullptr, P.in[9] + DM, X, nullptr, nullptr);
        } else if (kind == K_GEMM_P || kind == K_GEMM_QKV) {
            const bool isP = kind == K_GEMM_P; const int N = isP ? 3328 : 3072;
            pg8::Gemm g{XN, (const bf16_t*)(ws + (isP ? WS_WABI : WS_WATI)), M_TOK, N, 1024};
            pg8::StaticOrder S; S.init(M_TOK, N, G, bid);
            EpiSplit E;
            if (isP) E = EpiSplit{(bf16_t*)(ws + WS_PUV), 1024, 4, (bf16_t*)(ws + WS_PRKVG), 2048, 12, (bf16_t*)(ws + WS_PWA), 256};
            else E = EpiSplit{(bf16_t*)(ws + WS_BIG), 3072, 12, (bf16_t*)(ws + WS_BIG), 3072, 12, (bf16_t*)(ws + WS_BIG), 3072};
#ifndef SKIP_G3
            pg8::gemm_phase<EpiSplit, pg8::StaticOrder>(lds, g, S, E, nullptr);
#endif
        } else if (kind == K_MIXA) {
            if (bid < 16) {
#ifndef SKIP_SCAN
                scan_item(P, 32, bid >> 1, bid & 1, lds);
#endif
            } else {
                for (int li = bid - 16; li < 512 + 640; li += G - 16) {
#ifndef SKIP_SCAN
                    if (li < 512) scan_item(P, li >> 4, (li >> 1) & 7, li & 1, lds);
#endif
#ifndef SKIP_SGU
                    if (li >= 512) sgu_item(P, li - 512, lds);
#endif
                }
            }
        } else if (kind == K_FINAL) {
#ifndef SKIP_FIN
            rwkv_finalize(P);
#endif
        } else if (kind == K_ATTN) {
            for (int it = bid; it < 5120; it += G) {
#ifndef SKIP_ATTN
                if (it < 4096) attn_item(P, it >> 7, it & 15, (it >> 4) & 7, lds);
                else attn_item(P, 32, it & 15, (it - 4096) >> 4, lds);
#endif
            }
        }
        if (ph + 1 < N_PHASES) {
            __builtin_amdgcn_fence(__ATOMIC_RELEASE, "agent");
            asm volatile("s_waitcnt vmcnt(0) lgkmcnt(0)" ::: "memory");
            grid.sync();
            __builtin_amdgcn_fence(__ATOMIC_ACQUIRE, "agent");
            asm volatile("s_waitcnt vmcnt(0) lgkmcnt(0)" ::: "memory");
            __syncthreads();
        }
    }
}

extern "C" void kernel_launch(void* const* d_in, const int* in_sizes, int n_in, void* d_out, int out_size, void* d_ws, size_t ws_size, hipStream_t stream) {
    static int grid_blocks = 0;
    if (!grid_blocks) {
        int dev = 0, cus = 0, per_cu = 0;
        (void)hipGetDevice(&dev);
        (void)hipDeviceGetAttribute(&cus, hipDeviceAttributeMultiprocessorCount, dev);
        (void)hipFuncSetAttribute((const void*)mega, hipFuncAttributeMaxDynamicSharedMemorySize, LDS_BYTES);
        (void)hipOccupancyMaxActiveBlocksPerMultiprocessor(&per_cu, (const void*)mega, 512, LDS_BYTES);
        (void)hipGetLastError();
        if (cus <= 0) cus = 256;
        grid_blocks = cus;
        if (ws_size < WS_END) fprintf(stderr, "kernel_launch: workspace too small: %zu < %zu\n", ws_size, (size_t)WS_END);
    }
    Params p{};
    for (int i = 0; i < 30 && i < n_in; ++i) p.in[i] = (const float*)d_in[i];
    p.out = (float*)d_out; p.ws = (unsigned char*)d_ws;
    void* args[] = {&p};
    hipError_t e = hipLaunchCooperativeKernel((const void*)mega, dim3(grid_blocks), dim3(512), args, LDS_BYTES, stream);
    if (e != hipSuccess) fprintf(stderr, "cooperative launch failed: %s (grid %d)\n", hipGetErrorString(e), grid_blocks);
}
```

```cpp
#include <hip/hip_runtime.h>
#include <hip/hip_cooperative_groups.h>
#include <cstdio>
namespace cg = cooperative_groups;

namespace pg8 {
#define PG8_LAS __attribute__((address_space(3)))
typedef unsigned short bf16_t;
typedef short bf16x8 __attribute__((ext_vector_type(8)));
typedef float f32x4 __attribute__((ext_vector_type(4)));
typedef unsigned u32x4 __attribute__((ext_vector_type(4)));
constexpr int BM = 256, BK = 64, HALF = 128, HTB = HALF * BK * 2  , STAGE_BYTES = 8 * HTB, NXCD = 8, WGM = 8;

__host__ __device__ __forceinline__ int lds_byte(int r, int c) { const int st = (r >> 4) * 2 + (c >> 5), rr = r & 15, cc = c & 31, ob = rr * 64 + cc * 2; return st * 1024 + (ob ^ (((ob >> 9) & 1) << 5)); }
__host__ __device__ __forceinline__ void stage_rc(int b, int& R, int& C) { const int st = b / 1024, sb = b % 1024, swz = sb ^ (((sb >> 9) & 1) << 5); R = (st >> 1) * 16 + swz / 64; C = (st & 1) * 32 + (swz % 64) / 2; }
__host__ __device__ __forceinline__ int perm32(int rho) { const int n = rho >> 4, i = rho & 15; return 8 * (i >> 2) + 4 * n + (i & 3); }

struct Unit { int pm, pn; };
struct Gemm { const bf16_t* A; const bf16_t* Bt; int M, N, K; };

struct StaticOrder {
    int nM, nN, nwg, G, c;
    __host__ __device__ void init(int M, int N, int G_, int c_) { nM = M / BM; nN = N / BM; nwg = nM * nN; G = G_; c = c_; }
    __host__ __device__ bool next(int i, Unit& u) const {
        const long L = (long)i * G + c; if (L >= nwg) return false;
        int wgid = (int)L; { const int q = nwg / NXCD, r = nwg % NXCD, xcd = wgid % NXCD, off = wgid / NXCD; wgid = (xcd < r ? xcd * (q + 1) : r * (q + 1) + (xcd - r) * q) + off; }
        const int nig = WGM * nN, gid = wgid / nig, fm = gid * WGM, gsz = (nM - fm) < WGM ? (nM - fm) : WGM;
        u.pm = fm + ((wgid % nig) % gsz); u.pn = (wgid % nig) / gsz; return true;
    }
    __device__ __forceinline__ void a_ready(const Unit&) const {}
    __device__ __forceinline__ void done(const Unit&) const {}
};
__device__ __forceinline__ unsigned cvt_pk_bf16(float lo, float hi) { unsigned r; asm volatile("v_cvt_pk_bf16_f32 %0, %1, %2" : "=v"(r) : "v"(lo), "v"(hi)); return r; }
typedef float f32x2 __attribute__((ext_vector_type(2)));
template <class Epi, class Sched, bool ALIGN_EPI = false, bool SP2 = false>
__device__ __forceinline__ void gemm_phase(PG8_LAS unsigned char* lds, const Gemm g, const Sched& S, const Epi& E) {
    int tid_raw_ = threadIdx.x; asm volatile("" : "+v"(tid_raw_)); const int tid = tid_raw_, wid = __builtin_amdgcn_readfirstlane(tid >> 6), lane = tid & 63, wr = wid >> 2, wc = wid & 3, fr = lane & 15, fq = lane >> 4;
    const int K = g.K, nt = K / BK;
    unsigned voffA[2], voffB[2];
#pragma unroll
    for (int i = 0; i < 2; ++i) { int R, C; stage_rc(tid * 16 + i * 8192, R, C); const int Rb = Epi::PERM ? ((R & ~31) + perm32(R & 31)) : R;
        voffA[i] = (unsigned)(R * K + C) * 2u; voffB[i] = (unsigned)(Rb * K + C) * 2u; }
    const size_t kstep = (size_t)(BK * 2);
    const size_t hstep = (size_t)HALF * K * 2;
    const size_t tstep = 2 * hstep;
    const unsigned ldsw = (unsigned)wid * 1024u;
    const int aoff = lds_byte(wr * 64 + fr, fq * 8), boff = lds_byte(wc * 32 + fr, fq * 8);
#define PG8_SA(b, h) (((b) * 2 + (h)) * HTB)
#define PG8_SB(b, h) ((4 + (b) * 2 + (h)) * HTB)
#define PG8_STAGE(bufoff, gbase, voff) do { _Pragma("unroll") for (int _i = 0; _i < 2; ++_i) \
        __builtin_amdgcn_global_load_lds((const unsigned*)((const char*)(gbase) + (voff)[_i]), (PG8_LAS unsigned*)(lds + (bufoff) + ldsw + _i * 8192), 16, 0, 0); } while (0)
#define PG8_LDA(dst, b, h) do { _Pragma("unroll") for (int m = 0; m < 4; ++m) _Pragma("unroll") for (int k = 0; k < 2; ++k) dst[m][k] = *(const PG8_LAS bf16x8*)(lds + PG8_SA(b, h) + aoff + m * 2048 + k * 1024); } while (0)
#define PG8_LDB(dst, b, h) do { _Pragma("unroll") for (int n = 0; n < 2; ++n) _Pragma("unroll") for (int k = 0; k < 2; ++k) dst[n][k] = *(const PG8_LAS bf16x8*)(lds + PG8_SB(b, h) + boff + n * 2048 + k * 1024); } while (0)
#define PG8_MMA(ai, bj, At, Bt) do { __builtin_amdgcn_s_setprio(1); _Pragma("unroll") for (int m = 0; m < 4; ++m) _Pragma("unroll") for (int n = 0; n < 2; ++n) _Pragma("unroll") for (int k = 0; k < 2; ++k) \
        acc[ai][bj][m][n] = __builtin_amdgcn_mfma_f32_16x16x32_bf16(Bt[n][k], At[m][k], acc[ai][bj][m][n], 0, 0, 0); __builtin_amdgcn_s_setprio(0); } while (0)
#define PG8_WAIT_V(n) asm volatile("s_waitcnt vmcnt(" #n ")" ::: "memory")
#define PG8_WAIT_L(n) asm volatile("s_waitcnt lgkmcnt(" #n ")" ::: "memory")
#define PG8_BAR __builtin_amdgcn_s_barrier()
#define PG8_SCHED __builtin_amdgcn_sched_barrier(0)
    Unit cur, nxt; int ui = 0;
    if (!S.next(0, cur)) return;
    f32x4 acc[2][2][4][2];
#pragma unroll
    for (int a = 0; a < 2; ++a)
#pragma unroll
        for (int b = 0; b < 2; ++b)
#pragma unroll
            for (int m = 0; m < 4; ++m)
#pragma unroll
                for (int n = 0; n < 2; ++n) acc[a][b][m][n] = (f32x4){0.f, 0.f, 0.f, 0.f};
    bf16x8 At[4][2], B0[2][2], B1[2][2];
    const char* cA = (const char*)g.A + (size_t)cur.pm * tstep; const char* cB = (const char*)g.Bt + (size_t)cur.pn * tstep;
    S.a_ready(cur);
    if constexpr (SP2) {
        PG8_STAGE(PG8_SB(0, 0), cB, voffB); PG8_STAGE(PG8_SB(0, 1), cB + hstep, voffB); PG8_STAGE(PG8_SA(0, 0), cA, voffA); PG8_STAGE(PG8_SA(0, 1), cA + hstep, voffA);
        if (wr == 1) PG8_BAR;
        PG8_WAIT_V(2); PG8_BAR;
        PG8_STAGE(PG8_SB(1, 0), cB + kstep, voffB); PG8_STAGE(PG8_SA(1, 0), cA + kstep, voffA); PG8_STAGE(PG8_SB(1, 1), cB + hstep + kstep, voffB);
        PG8_WAIT_V(6); PG8_BAR;
    } else {
        PG8_STAGE(PG8_SB(0, 0), cB, voffB); PG8_STAGE(PG8_SA(0, 0), cA, voffA); PG8_STAGE(PG8_SB(0, 1), cB + hstep, voffB); PG8_STAGE(PG8_SA(0, 1), cA + hstep, voffA);
        if (wr == 1) PG8_BAR;
        PG8_WAIT_V(4); PG8_BAR;
        PG8_STAGE(PG8_SB(1, 0), cB + kstep, voffB); PG8_STAGE(PG8_SA(1, 0), cA + kstep, voffA); PG8_STAGE(PG8_SB(1, 1), cB + hstep + kstep, voffB);
        PG8_WAIT_V(6); PG8_BAR;
    }
    for (;;) {
        const bool has_next = S.next(ui + 1, nxt);
        const char* nA = has_next ? (const char*)g.A + (size_t)nxt.pm * tstep : cA; const char* nB = has_next ? (const char*)g.Bt + (size_t)nxt.pn * tstep : cB;
        for (int t = 0; t < nt; t += 2) {
            const bool last = (t == nt - 2);
            const char* a1 = cA + (size_t)(t + 1) * kstep;
            const char* a2 = last ? nA : cA + (size_t)(t + 2) * kstep; const char* b2 = last ? nB : cB + (size_t)(t + 2) * kstep;
            const char* a3 = a2 + kstep; const char* b3 = b2 + kstep;
            if (last && has_next) S.a_ready(nxt);
            if constexpr (SP2) {
            PG8_LDB(B0, 0, 0); PG8_LDB(B1, 0, 1); PG8_SCHED; PG8_LDA(At, 0, 0); PG8_STAGE(PG8_SA(1, 1), a1 + hstep, voffA);
            PG8_WAIT_V(8); PG8_WAIT_L(0); PG8_BAR; PG8_MMA(0, 0, At, B0); PG8_MMA(0, 1, At, B1); PG8_BAR; PG8_SCHED;
            PG8_LDA(At, 0, 1); PG8_STAGE(PG8_SB(0, 0), b2, voffB); PG8_STAGE(PG8_SB(0, 1), b2 + hstep, voffB); PG8_STAGE(PG8_SA(0, 0), a2, voffA);
            PG8_WAIT_V(8); PG8_WAIT_L(0); PG8_BAR; PG8_MMA(1, 0, At, B0); PG8_MMA(1, 1, At, B1); PG8_BAR; PG8_SCHED;
            PG8_LDB(B0, 1, 0); PG8_LDB(B1, 1, 1); PG8_SCHED; PG8_LDA(At, 1, 0); PG8_STAGE(PG8_SA(0, 1), a2 + hstep, voffA);
            PG8_WAIT_V(8); PG8_WAIT_L(0); PG8_BAR; PG8_MMA(0, 0, At, B0); PG8_MMA(0, 1, At, B1); PG8_BAR; PG8_SCHED;
            PG8_LDA(At, 1, 1); PG8_STAGE(PG8_SB(1, 0), b3, voffB); PG8_STAGE(PG8_SB(1, 1), b3 + hstep, voffB); PG8_STAGE(PG8_SA(1, 0), a3, voffA);
            PG8_WAIT_V(8); PG8_WAIT_L(0); PG8_BAR; PG8_MMA(1, 0, At, B0); PG8_MMA(1, 1, At, B1); PG8_BAR; PG8_SCHED;
            } else {
            PG8_LDB(B0, 0, 0); PG8_SCHED; PG8_LDA(At, 0, 0); PG8_STAGE(PG8_SA(1, 1), a1 + hstep, voffA);
            PG8_WAIT_L(8); PG8_BAR; PG8_WAIT_L(0); PG8_MMA(0, 0, At, B0); PG8_BAR; PG8_SCHED;
            PG8_LDB(B1, 0, 1); PG8_STAGE(PG8_SB(0, 0), b2, voffB);
            PG8_BAR; PG8_WAIT_L(0); PG8_MMA(0, 1, At, B1); PG8_BAR;
            PG8_LDA(At, 0, 1); PG8_STAGE(PG8_SA(0, 0), a2, voffA);
            PG8_BAR; PG8_WAIT_L(0); PG8_MMA(1, 0, At, B0); PG8_BAR; PG8_SCHED;
            PG8_STAGE(PG8_SB(0, 1), b2 + hstep, voffB);
            PG8_WAIT_V(6); PG8_BAR; PG8_MMA(1, 1, At, B1); PG8_BAR;
            PG8_LDB(B0, 1, 0); PG8_SCHED; PG8_LDA(At, 1, 0); PG8_STAGE(PG8_SA(0, 1), a2 + hstep, voffA);
            PG8_WAIT_L(8); PG8_BAR; PG8_WAIT_L(0); PG8_MMA(0, 0, At, B0); PG8_BAR; PG8_SCHED;
            PG8_LDB(B1, 1, 1); PG8_STAGE(PG8_SB(1, 0), b3, voffB);
            PG8_BAR; PG8_WAIT_L(0); PG8_MMA(0, 1, At, B1); PG8_BAR;
            PG8_LDA(At, 1, 1); PG8_STAGE(PG8_SA(1, 0), a3, voffA);
            PG8_BAR; PG8_WAIT_L(0); PG8_MMA(1, 0, At, B0); PG8_BAR; PG8_SCHED;
            PG8_STAGE(PG8_SB(1, 1), b3 + hstep, voffB);
            PG8_WAIT_V(6); PG8_BAR; PG8_MMA(1, 1, At, B1); PG8_BAR;
            }
        }
        if constexpr (ALIGN_EPI) { if (wr == 0) PG8_BAR; }
        if constexpr (!Epi::AFTER_DRAIN) { E(acc, cur, wr, wc, fr, fq); S.done(cur); }
        if (!has_next) break;
#pragma unroll
        for (int a = 0; a < 2; ++a)
#pragma unroll
            for (int b = 0; b < 2; ++b)
#pragma unroll
                for (int m = 0; m < 4; ++m)
#pragma unroll
                    for (int n = 0; n < 2; ++n) acc[a][b][m][n] = (f32x4){0.f, 0.f, 0.f, 0.f};
        cur = nxt; cA = nA; cB = nB; ++ui;
        if constexpr (ALIGN_EPI) { if (wr == 1) PG8_BAR; }
    }
    PG8_WAIT_V(0);
    if constexpr (!ALIGN_EPI) { if (wr == 0) PG8_BAR; }
    PG8_BAR;
    if constexpr (Epi::AFTER_DRAIN) { E.fused(acc, cur, wr, wc, fr, fq, lds, wid, lane); S.done(cur); }
#undef PG8_SA
#undef PG8_SB
#undef PG8_STAGE
#undef PG8_LDA
#undef PG8_LDB
#undef PG8_MMA
#undef PG8_WAIT_V
#undef PG8_WAIT_L
#undef PG8_BAR
#undef PG8_SCHED
}
}


#define LAS __attribute__((address_space(3)))
typedef unsigned short bf16_t;
typedef short bf16x8 __attribute__((ext_vector_type(8)));
typedef short s16x4 __attribute__((ext_vector_type(4)));
typedef float f32x4 __attribute__((ext_vector_type(4)));
typedef unsigned u32x4 __attribute__((ext_vector_type(4)));
typedef unsigned u32x2 __attribute__((ext_vector_type(2)));

constexpr int M_TOK = 81920, M_PROMPT = 65536, DM = 1024, DFF = 2816;
constexpr int LDS_BYTES = 147456;
#ifndef GEMM_ALIGN
#define GEMM_ALIGN true
#endif
#ifndef GEMM_SP2
#define GEMM_SP2 true
#endif
constexpr float NORM_EPS = 1e-6f;

constexpr size_t SZ_WFI = (size_t)5632 * 1024 * 2, SZ_WFO = (size_t)1024 * 2816 * 2;
constexpr size_t WS_WFI = 0;
constexpr size_t WS_WFO = WS_WFI + 4 * SZ_WFI;
constexpr size_t WS_WABI = WS_WFO + 4 * SZ_WFO;
constexpr size_t WS_WABO = WS_WABI + (size_t)3328 * 1024 * 2;
constexpr size_t WS_WATI = WS_WABO + (size_t)1024 * 1024 * 2;
constexpr size_t WS_WATO = WS_WATI + (size_t)3072 * 1024 * 2;
constexpr size_t WS_LORA = WS_WATO + (size_t)1024 * 1024 * 2;
constexpr size_t WS_SGUW = WS_LORA + (size_t)4 * 512 * 64 * 2;
constexpr size_t WS_RKR = WS_SGUW + (size_t)4 * 128 * 128 * 2;
constexpr size_t WS_XN = (WS_RKR + (size_t)2 * M_TOK * 8 * 4 + 4095) & ~(size_t)4095;
constexpr size_t WS_BIG = WS_XN + (size_t)M_TOK * 1024 * 2;
constexpr size_t WS_PUV = WS_BIG;
constexpr size_t WS_PRKVG = WS_PUV + (size_t)M_TOK * 1024 * 2;
constexpr size_t WS_PWA = WS_PRKVG + (size_t)M_TOK * 2048 * 2;
constexpr size_t WS_Y = WS_BIG + (size_t)M_TOK * 3328 * 2;
constexpr size_t WS_END = WS_Y + (size_t)2 * M_TOK * 512 * 2;

constexpr int NSEG = 16, SEGLEN = 16384 / NSEG;
constexpr size_t WS_STL = (WS_END + 4095) & ~(size_t)4095;
constexpr size_t WS_STP = WS_STL + (size_t)16 * NSEG * 4096 * 4;
constexpr size_t WS_STS = WS_STP + (size_t)16 * NSEG * 4096 * 4;
constexpr size_t WS_TS = WS_STS + (size_t)16 * NSEG * 4096 * 4;
constexpr size_t WS_RSA = WS_TS + 4096;
constexpr size_t WS_RSB = WS_RSA + (size_t)M_TOK * 4;
constexpr size_t WS_END2 = WS_RSB + (size_t)M_TOK * 4;
struct Params { const float* in[30]; float* out; unsigned char* ws; };

__device__ __forceinline__ float bflo(unsigned w) { return __uint_as_float(w << 16); }
__device__ __forceinline__ float bfhi(unsigned w) { return __uint_as_float(w & 0xffff0000u); }
__device__ __forceinline__ unsigned pk2(float lo, float hi) { unsigned r; asm("v_cvt_pk_bf16_f32 %0, %1, %2" : "=v"(r) : "v"(lo), "v"(hi)); return r; }
__device__ __forceinline__ void unpack8(const u32x4 w, float* f) { f[0] = bflo(w.x); f[1] = bfhi(w.x); f[2] = bflo(w.y); f[3] = bfhi(w.y); f[4] = bflo(w.z); f[5] = bfhi(w.z); f[6] = bflo(w.w); f[7] = bfhi(w.w); }
__device__ __forceinline__ u32x4 pack8(const float* f) { u32x4 w; w.x = pk2(f[0], f[1]); w.y = pk2(f[2], f[3]); w.z = pk2(f[4], f[5]); w.w = pk2(f[6], f[7]); return w; }
__device__ __forceinline__ float sigmoidf_(float x) { return __builtin_amdgcn_rcpf(1.0f + __expf(-x)); }
__device__ __forceinline__ float siluf_(float x) { return x * sigmoidf_(x); }
__device__ __forceinline__ float gelu_tanh(float x) { const float u = 0.7978845608028654f * (x + 0.044715f * x * x * x); return x * sigmoidf_(2.0f * u); }
__device__ __forceinline__ float tanhf_(float x) { return 1.0f - 2.0f * __builtin_amdgcn_rcpf(__expf(2.0f * x) + 1.0f); }
__device__ __forceinline__ float wave_sum(float x) { x += __shfl_xor(x, 32); x += __shfl_xor(x, 16); x += __shfl_xor(x, 8); x += __shfl_xor(x, 4); x += __shfl_xor(x, 2); x += __shfl_xor(x, 1); return x; }
template <int CTRL> __device__ __forceinline__ float dppf(float x) { return __int_as_float(__builtin_amdgcn_update_dpp(0, __float_as_int(x), CTRL, 0xF, 0xF, true)); }
__device__ __forceinline__ float reduce8(float x) { x += dppf<0xB1>(x); x += dppf<0x4E>(x); x += dppf<0x141>(x); return x; }
typedef short v4i16_t __attribute__((ext_vector_type(4)));
typedef __bf16 bf16x2_t __attribute__((ext_vector_type(2)));
__device__ __forceinline__ s16x4 tr_read(LAS const unsigned char* p) { return __builtin_bit_cast(s16x4, __builtin_amdgcn_ds_read_tr16_b64_v4i16((LAS v4i16_t*)p)); }
__device__ __forceinline__ f32x4 mfma16(bf16x8 a, bf16x8 b, f32x4 c) { return __builtin_amdgcn_mfma_f32_16x16x32_bf16(a, b, c, 0, 0, 0); }

__device__ __forceinline__ int opaque_tid() { int t = threadIdx.x; asm volatile("" : "+v"(t)); return t; }
__device__ __forceinline__ unsigned char* opaque_ptr(unsigned char* p) { size_t z = 0; asm volatile("" : "+s"(z)); return p + z; }
struct EpiSwiglu {
    static constexpr bool PERM = false, AFTER_DRAIN = false;
    bf16_t* H; const float* rowss;
    __device__ __forceinline__ void operator()(const f32x4 (&acc)[2][2][4][2], const pg8::Unit& u, int wr, int wc, int fr, int fq) const {
        const int row0 = u.pm * 256 + wr * 64 + fr, col0 = u.pn * 128 + wc * 32 + 8 * fq;
        float rsv[8];
#pragma unroll
        for (int gi = 0; gi < 8; ++gi) rsv[gi] = rowss ? rowss[row0 + (gi >> 2) * 128 + (gi & 3) * 16] : 0.f;
#pragma unroll
        for (int gi = 0; gi < 8; ++gi) rsv[gi] = rowss ? rsqrtf(rsv[gi] * (1.0f / DM) + NORM_EPS) : 1.0f;
#pragma unroll
        for (int ai = 0; ai < 2; ++ai)
#pragma unroll
            for (int m = 0; m < 4; ++m) {
                const int row = row0 + ai * 128 + m * 16;
                const float rs = rsv[ai * 4 + m];
                bf16_t* rowp = H + (size_t)row * DFF + col0;
                float h[8];
#pragma unroll
                for (int bj = 0; bj < 2; ++bj)
#pragma unroll
                    for (int j = 0; j < 4; ++j) h[bj * 4 + j] = siluf_(acc[ai][bj][m][0][j] * rs) * (acc[ai][bj][m][1][j] * rs);
                *(u32x4*)rowp = pack8(h);
                asm volatile("" ::: "memory");
            }
    }
};
struct EpiResid {
    static constexpr bool PERM = false, AFTER_DRAIN = false;
    float* X; float scale; bf16_t* XG; const float* g; float* rowss;
    __device__ __forceinline__ void operator()(const f32x4 (&acc)[2][2][4][2], const pg8::Unit& u, int wr, int wc, int fr, int fq) const {
        const int row0 = u.pm * 256 + wr * 64 + fr, col0 = u.pn * 256 + wc * 32 + 4 * fq;
        f32x4 gv[2][2];
#pragma unroll
        for (int bj = 0; bj < 2; ++bj)
#pragma unroll
            for (int n = 0; n < 2; ++n) gv[bj][n] = XG ? *(const f32x4*)(g + col0 + bj * 128 + n * 16) : (f32x4){0.f, 0.f, 0.f, 0.f};
        f32x4 xin[2][2][2];
#pragma unroll
        for (int gi = 0; gi < 9; ++gi) {
            if (gi < 8) {
                const float* rowp = X + (size_t)(row0 + (gi >> 2) * 128 + (gi & 3) * 16) * DM + col0;
#pragma unroll
                for (int bj = 0; bj < 2; ++bj)
#pragma unroll
                    for (int n = 0; n < 2; ++n) xin[gi & 1][bj][n] = *(const f32x4*)(rowp + bj * 128 + n * 16);
            }
            if (gi > 0) {
                const int gp = gi - 1, ai = gp >> 2, m = gp & 3;
                const int row = row0 + ai * 128 + m * 16;
                float* rowp = X + (size_t)row * DM + col0;
                float ssq = 0.f;
#pragma unroll
                for (int bj = 0; bj < 2; ++bj)
#pragma unroll
                    for (int n = 0; n < 2; ++n) { f32x4 v = xin[gp & 1][bj][n]; v += acc[ai][bj][m][n] * scale; *(f32x4*)(rowp + bj * 128 + n * 16) = v;
                        if (XG) { ssq += (v[0] * v[0] + v[1] * v[1]) + (v[2] * v[2] + v[3] * v[3]); const f32x4 o = v * gv[bj][n]; u32x2 w; w.x = pk2(o[0], o[1]); w.y = pk2(o[2], o[3]);
                            *(u32x2*)(XG + (size_t)row * DM + col0 + bj * 128 + n * 16) = w; } }
                if (XG) { ssq += __shfl_xor(ssq, 16); ssq += __shfl_xor(ssq, 32);
                    if (fq == 0) __hip_atomic_fetch_add(rowss + row, ssq, __ATOMIC_RELAXED, __HIP_MEMORY_SCOPE_AGENT); }
            }
            asm volatile("" ::: "memory");
        }
    }
};
struct EpiSplit {
    static constexpr bool PERM = true, AFTER_DRAIN = false;
    bf16_t* b0; int ld0, t0; bf16_t* b1; int ld1, t1; bf16_t* b2; int ld2; const float* rowss;
    __device__ __forceinline__ void operator()(const f32x4 (&acc)[2][2][4][2], const pg8::Unit& u, int wr, int wc, int fr, int fq) const {
        bf16_t* base; int ld, ct;
        if (u.pn < t0) { base = b0; ld = ld0; ct = u.pn; } else if (u.pn < t1) { base = b1; ld = ld1; ct = u.pn - t0; } else { base = b2; ld = ld2; ct = u.pn - t1; }
        const int row0 = u.pm * 256 + wr * 64 + fr, col0 = ct * 256 + wc * 32 + 8 * fq;
        float rsv[8];
#pragma unroll
        for (int gi = 0; gi < 8; ++gi) rsv[gi] = rowss[row0 + (gi >> 2) * 128 + (gi & 3) * 16];
#pragma unroll
        for (int gi = 0; gi < 8; ++gi) rsv[gi] = rsqrtf(rsv[gi] * (1.0f / DM) + NORM_EPS);
#pragma unroll
        for (int ai = 0; ai < 2; ++ai)
#pragma unroll
            for (int m = 0; m < 4; ++m) {
                const int row = row0 + ai * 128 + m * 16;
                const float rs = rsv[ai * 4 + m];
                bf16_t* rowp = base + (size_t)row * ld + col0;
#pragma unroll
                for (int bj = 0; bj < 2; ++bj) {
                    const f32x4 v0 = acc[ai][bj][m][0] * rs, v1 = acc[ai][bj][m][1] * rs;
                    u32x4 w; w.x = pk2(v0[0], v0[1]); w.y = pk2(v0[2], v0[3]); w.z = pk2(v1[0], v1[1]); w.w = pk2(v1[2], v1[3]);
                    *(u32x4*)(rowp + bj * 128) = w;
                }
                asm volatile("" ::: "memory");
            }
    }
};

template <int MAP> __device__ __forceinline__ int src_col(int s) {
    if (MAP == 0) return s;
    const int pn = s >> 8, bj = (s >> 7) & 1, wc = (s >> 5) & 3, n = (s >> 4) & 1, fq = (s >> 2) & 3, jj = s & 3;
    return n * DFF + 128 * pn + 32 * wc + 8 * fq + 4 * bj + jj;
}
template <int MAP> __device__ void convert_T(const float* __restrict__ src, bf16_t* __restrict__ dst, int K, int N, LAS float* tile, int rot) {
    const int tk = K / 64, tn = N / 64, nt = tk * tn, tid = opaque_tid(), G = gridDim.x;
    const int kk0 = tid >> 4, sg = tid & 15;
    int t = (int)((blockIdx.x + rot) % G);
    float4 va = make_float4(0.f, 0.f, 0.f, 0.f), vb = va;
    if (t < nt) { const int k0 = (t % tk) * 64, s0 = (t / tk) * 64; const int c = src_col<MAP>(s0 + sg * 4);
        va = *(const float4*)(src + (size_t)(k0 + kk0) * N + c); vb = *(const float4*)(src + (size_t)(k0 + kk0 + 32) * N + c); }
    for (; t < nt; t += G) {
        const int k0 = (t % tk) * 64, s0 = (t / tk) * 64;
        { LAS float* tp = tile + kk0 * 65 + sg * 4; tp[0] = va.x; tp[1] = va.y; tp[2] = va.z; tp[3] = va.w;
          LAS float* tq = tile + (kk0 + 32) * 65 + sg * 4; tq[0] = vb.x; tq[1] = vb.y; tq[2] = vb.z; tq[3] = vb.w; }
        if (t + G < nt) {
            const int t2 = t + G, k2 = (t2 % tk) * 64, s2 = (t2 / tk) * 64; const int c = src_col<MAP>(s2 + sg * 4);
            va = *(const float4*)(src + (size_t)(k2 + kk0) * N + c); vb = *(const float4*)(src + (size_t)(k2 + kk0 + 32) * N + c); }
        asm volatile("s_waitcnt lgkmcnt(0)" ::: "memory"); __builtin_amdgcn_s_barrier(); asm volatile("" ::: "memory");
        {
            const int slot = tid >> 3, kc = tid & 7; float f[8];
#pragma unroll
            for (int i = 0; i < 8; ++i) f[i] = tile[(kc * 8 + i) * 65 + slot];
            *(u32x4*)(dst + (size_t)(s0 + slot) * K + k0 + kc * 8) = pack8(f);
        }
        asm volatile("s_waitcnt lgkmcnt(0)" ::: "memory"); __builtin_amdgcn_s_barrier(); asm volatile("" ::: "memory");
    }
}

__device__ void norm_rows(const float* xa, const float* xb, int split, float* xcopy, const float* g1, float* x1out, const float* g2, bf16_t* xn) {
    const int tid_ = opaque_tid(), lane = tid_ & 63, wave = __builtin_amdgcn_readfirstlane(tid_ >> 6);
    const int stride = gridDim.x * 8;
    for (int row0 = blockIdx.x * 8 + wave; row0 < M_TOK; row0 += 2 * stride) {
        int rows[2]; rows[0] = row0; rows[1] = (row0 + stride < M_TOK) ? row0 + stride : row0;
        f32x4 v[2][4]; float ss[2] = {0.f, 0.f};
#pragma unroll
        for (int q = 0; q < 2; ++q) { const int row = rows[q];
            const float* src = (row < split) ? xa + (size_t)row * DM : xb + (size_t)(row - split) * DM;
#pragma unroll
            for (int i = 0; i < 4; ++i) v[q][i] = *(const f32x4*)(src + i * 256 + lane * 4); }
#pragma unroll
        for (int q = 0; q < 2; ++q) {
#pragma unroll
            for (int i = 0; i < 4; ++i) ss[q] += v[q][i][0] * v[q][i][0] + v[q][i][1] * v[q][i][1] + v[q][i][2] * v[q][i][2] + v[q][i][3] * v[q][i][3];
            if (xcopy) {
#pragma unroll
                for (int i = 0; i < 4; ++i) *(f32x4*)(xcopy + (size_t)rows[q] * DM + i * 256 + lane * 4) = v[q][i];
            }
        }
        ss[0] = wave_sum(ss[0]); ss[1] = wave_sum(ss[1]);
        float r[2]; r[0] = rsqrtf(ss[0] * (1.0f / DM) + NORM_EPS); r[1] = rsqrtf(ss[1] * (1.0f / DM) + NORM_EPS);
        if (g1) {
            float s2[2] = {0.f, 0.f};
#pragma unroll
            for (int i = 0; i < 4; ++i) { const f32x4 g = *(const f32x4*)(g1 + i * 256 + lane * 4);
#pragma unroll
                for (int q = 0; q < 2; ++q) { v[q][i] = v[q][i] * r[q] * g; *(f32x4*)(x1out + (size_t)rows[q] * DM + i * 256 + lane * 4) = v[q][i];
                    s2[q] += v[q][i][0] * v[q][i][0] + v[q][i][1] * v[q][i][1] + v[q][i][2] * v[q][i][2] + v[q][i][3] * v[q][i][3]; } }
            s2[0] = wave_sum(s2[0]); s2[1] = wave_sum(s2[1]);
            r[0] = rsqrtf(s2[0] * (1.0f / DM) + NORM_EPS); r[1] = rsqrtf(s2[1] * (1.0f / DM) + NORM_EPS);
        }
        if (g2) {
#pragma unroll
            for (int i = 0; i < 4; ++i) { const f32x4 g = *(const f32x4*)(g2 + i * 256 + lane * 4);
#pragma unroll
                for (int q = 0; q < 2; ++q) { const f32x4 o = v[q][i] * r[q] * g;
                    u32x2 w; w.x = pk2(o[0], o[1]); w.y = pk2(o[2], o[3]); *(u32x2*)(xn + (size_t)rows[q] * DM + i * 256 + lane * 4) = w; } }
        }
    }
}

__device__ void sgu_item(const Params& PP, int chunk, LAS unsigned char* lds) {
    Params P = PP; P.ws = opaque_ptr(PP.ws);
    const int tid = opaque_tid(), lane = tid & 63, wave = __builtin_amdgcn_readfirstlane(tid >> 6), l15 = lane & 15, quad = lane >> 4;
    constexpr int PITCH = 1056;
    const bf16_t* Puv = (const bf16_t*)(P.ws + WS_PUV);
    bf16_t* MO = (bf16_t*)(P.ws + WS_XN);
    const size_t row0 = (size_t)chunk * 128;
    {
        float gn[8];
        { const f32x4 a = *(const f32x4*)(P.in[12] + lane * 8), b = *(const f32x4*)(P.in[12] + lane * 8 + 4); gn[0] = a[0]; gn[1] = a[1]; gn[2] = a[2]; gn[3] = a[3]; gn[4] = b[0]; gn[5] = b[1]; gn[6] = b[2]; gn[7] = b[3]; }
        for (int i = 0; i < 16; ++i) {
            const int p = wave * 16 + i;
            const u32x4 raw = *(const u32x4*)(Puv + (row0 + p) * 1024 + 512 + lane * 8);
            float v[8]; unpack8(raw, v); float ss = 0.f;
#pragma unroll
            for (int e = 0; e < 8; ++e) { v[e] = gelu_tanh(v[e]); ss += v[e] * v[e]; }
            ss = wave_sum(ss);
            const float r = rsqrtf(ss * (1.0f / 512.0f) + NORM_EPS);
#pragma unroll
            for (int e = 0; e < 8; ++e) v[e] = v[e] * r * gn[e];
            *(LAS u32x4*)(lds + p * PITCH + lane * 16) = pack8(v);
        }
    }
    __syncthreads();
    const int g = wave >> 1, cbase = (wave >> 1) * 128 + (wave & 1) * 64;
    const bf16_t* Wg = (const bf16_t*)(P.ws + WS_SGUW) + (size_t)g * 128 * 128;
    const int r4 = l15 >> 2, c4 = l15 & 3;
    for (int qh = 0; qh < 2; ++qh) {
        f32x4 acc[4][4];
#pragma unroll
        for (int a = 0; a < 4; ++a)
#pragma unroll
            for (int b = 0; b < 4; ++b) acc[a][b] = (f32x4){0.f, 0.f, 0.f, 0.f};
#pragma unroll
        for (int ks = 0; ks < 4; ++ks) {
            bf16x8 bfr[4];
#pragma unroll
            for (int qt = 0; qt < 4; ++qt) bfr[qt] = *(const bf16x8*)(Wg + (size_t)(qh * 64 + qt * 16 + l15) * 128 + ks * 32 + quad * 8);
#pragma unroll
            for (int ct = 0; ct < 4; ++ct) {
                LAS const unsigned char* ap = lds + (ks * 32 + quad * 8 + r4) * PITCH + (cbase + ct * 16 + 4 * c4) * 2;
                const s16x4 lo = tr_read(ap), hi = tr_read(ap + 4 * PITCH);
                const bf16x8 a = {lo[0], lo[1], lo[2], lo[3], hi[0], hi[1], hi[2], hi[3]};
#pragma unroll
                for (int qt = 0; qt < 4; ++qt) acc[ct][qt] = mfma16(a, bfr[qt], acc[ct][qt]);
            }
        }
#pragma unroll
        for (int qt = 0; qt < 4; ++qt) {
            const int q = qh * 64 + qt * 16 + l15;
            const float bq = P.in[14][g * 128 + q];
#pragma unroll
            for (int ct = 0; ct < 4; ++ct) {
                const int c = cbase + ct * 16 + quad * 4;
                const u32x2 ur = *(const u32x2*)(Puv + (row0 + q) * 1024 + c);
                const float u0 = gelu_tanh(bflo(ur.x)), u1 = gelu_tanh(bfhi(ur.x)), u2 = gelu_tanh(bflo(ur.y)), u3 = gelu_tanh(bfhi(ur.y));
                u32x2 w; w.x = pk2(u0 * (acc[ct][qt][0] + bq), u1 * (acc[ct][qt][1] + bq)); w.y = pk2(u2 * (acc[ct][qt][2] + bq), u3 * (acc[ct][qt][3] + bq));
                *(u32x2*)(MO + (row0 + q) * 1024 + c) = w;
            }
        }
    }
    __syncthreads();
}

template <int LPR> __device__ __forceinline__ float reduce_row(float x) {
    x += dppf<0xB1>(x); x += dppf<0x4E>(x); x += dppf<0x141>(x);
    if (LPR == 16) x += dppf<0x140>(x);
    return x;
}
__device__ __forceinline__ float reduce32(float x) {
    x += dppf<0xB1>(x); x += dppf<0x4E>(x); x += dppf<0x141>(x); x += dppf<0x140>(x); x += __shfl_xor(x, 16); return x;
}
__device__ __forceinline__ void lds_barrier() { asm volatile("s_waitcnt lgkmcnt(0)" ::: "memory"); __builtin_amdgcn_s_barrier(); asm volatile("" ::: "memory"); }
template <int NV> struct ScanSet { f32x4 kk[NV], w[NV], ka[NV], kp[NV], r[NV]; float vv; };
template <int NV> __device__ __forceinline__ void scan_load(ScanSet<NV>& t, LAS const float* KK, LAS const float* Wd, LAS const float* KKA, LAS const float* KP, LAS const float* Rr, LAS const float* Vv, int o, int ov, bool want_y) {
#pragma unroll
    for (int u = 0; u < NV; ++u) { t.kk[u] = *(LAS const f32x4*)(KK + o + u * 32); t.w[u] = *(LAS const f32x4*)(Wd + o + u * 32); t.ka[u] = *(LAS const f32x4*)(KKA + o + u * 32); t.kp[u] = *(LAS const f32x4*)(KP + o + u * 32); }
    if (want_y) {
#pragma unroll
        for (int u = 0; u < NV; ++u) t.r[u] = *(LAS const f32x4*)(Rr + o + u * 32);
    }
    t.vv = Vv[ov];
}
typedef float f32x2v __attribute__((ext_vector_type(2)));
template <int LPR, int NV> __device__ __forceinline__ float scan_step(float* S, const ScanSet<NV>& t, bool want_y, float& ypart) {
    f32x2v acc = {0.f, 0.f};
#pragma unroll
    for (int u = 0; u < NV; ++u)
#pragma unroll
        for (int hh = 0; hh < 2; ++hh) { const f32x2v s2 = {S[4 * u + 2 * hh], S[4 * u + 2 * hh + 1]}, k2 = {t.kk[u][2 * hh], t.kk[u][2 * hh + 1]}; acc = s2 * k2 + acc; }
    float sa = acc.x + acc.y, yb = ypart;
    sa += dppf<0xB1>(sa); yb += dppf<0xB1>(yb); sa += dppf<0x4E>(sa); yb += dppf<0x4E>(yb); sa += dppf<0x141>(sa); yb += dppf<0x141>(yb);
    const f32x2v sa2 = {sa, sa}, vv2 = {t.vv, t.vv};
#pragma unroll
    for (int u = 0; u < NV; ++u)
#pragma unroll
        for (int hh = 0; hh < 2; ++hh) {
            f32x2v s2 = {S[4 * u + 2 * hh], S[4 * u + 2 * hh + 1]};
            const f32x2v w2 = {t.w[u][2 * hh], t.w[u][2 * hh + 1]}, kp2 = {t.kp[u][2 * hh], t.kp[u][2 * hh + 1]}, ka2 = {t.ka[u][2 * hh], t.ka[u][2 * hh + 1]};
            f32x2v tt = vv2 * kp2; tt = tt - sa2 * ka2;
            s2 = s2 * w2 + tt;
            S[4 * u + 2 * hh] = s2.x; S[4 * u + 2 * hh + 1] = s2.y;
        }
    if (want_y) {
        f32x2v yacc = {0.f, 0.f};
#pragma unroll
        for (int u = 0; u < NV; ++u)
#pragma unroll
            for (int hh = 0; hh < 2; ++hh) { const f32x2v s2 = {S[4 * u + 2 * hh], S[4 * u + 2 * hh + 1]}, r2 = {t.r[u][2 * hh], t.r[u][2 * hh + 1]}; yacc = s2 * r2 + yacc; }
        ypart = yacc.x + yacc.y;
    }
    return yb;
}
struct ScanSet2 { f32x4 kk, w, ka, kp, r; float vv0, vv1; };
__device__ __forceinline__ void scan_load2(ScanSet2& t, LAS const float* KK, LAS const float* Wd, LAS const float* KKA, LAS const float* KP, LAS const float* Rr, LAS const float* Vv, int o, int ov, bool want_y) {
    t.kk = *(LAS const f32x4*)(KK + o); t.w = *(LAS const f32x4*)(Wd + o); t.ka = *(LAS const f32x4*)(KKA + o); t.kp = *(LAS const f32x4*)(KP + o);
    if (want_y) t.r = *(LAS const f32x4*)(Rr + o);
    t.vv0 = Vv[ov]; t.vv1 = Vv[ov + 4];
}
__device__ __forceinline__ float dpp16(float x) { x += dppf<0xB1>(x); x += dppf<0x4E>(x); x += dppf<0x141>(x); x += dppf<0x140>(x); return x; }
__device__ __forceinline__ void scan_step2(float* S0, float* S1, const ScanSet2& t, bool want_y, float& y0, float& y1, float& yr0, float& yr1) {
    float a0 = (S0[0] * t.kk[0] + S0[1] * t.kk[1]) + (S0[2] * t.kk[2] + S0[3] * t.kk[3]);
    float a1 = (S1[0] * t.kk[0] + S1[1] * t.kk[1]) + (S1[2] * t.kk[2] + S1[3] * t.kk[3]);
    float b0 = y0, b1 = y1;
    a0 += dppf<0xB1>(a0); a1 += dppf<0xB1>(a1); b0 += dppf<0xB1>(b0); b1 += dppf<0xB1>(b1);
    a0 += dppf<0x4E>(a0); a1 += dppf<0x4E>(a1); b0 += dppf<0x4E>(b0); b1 += dppf<0x4E>(b1);
    a0 += dppf<0x141>(a0); a1 += dppf<0x141>(a1); b0 += dppf<0x141>(b0); b1 += dppf<0x141>(b1);
    a0 += dppf<0x140>(a0); a1 += dppf<0x140>(a1); b0 += dppf<0x140>(b0); b1 += dppf<0x140>(b1);
    yr0 = b0; yr1 = b1;
    float p0 = 0.f, p1 = 0.f;
#pragma unroll
    for (int i = 0; i < 4; ++i) {
        S0[i] = S0[i] * t.w[i] + (t.vv0 * t.kp[i] - a0 * t.ka[i]);
        S1[i] = S1[i] * t.w[i] + (t.vv1 * t.kp[i] - a1 * t.ka[i]);
    }
    if (want_y) {
#pragma unroll
        for (int i = 0; i < 4; ++i) { p0 += S0[i] * t.r[i]; p1 += S1[i] * t.r[i]; }
        y0 = p0; y1 = p1;
    }
}
template <int LPR> __device__ void scan_item(const Params& PP, int seq, int h, int dir, int rhalf, int tbeg, int tlen, int flags, const float* sin, float* sout, LAS unsigned char* lds) {
    Params P = PP; P.ws = opaque_ptr(PP.ws);
    constexpr int KPL = 64 / LPR, RPW = 64 / LPR, NV = KPL / 4;
    const int tid = opaque_tid(), lane = tid & 63, wave = __builtin_amdgcn_readfirstlane(tid >> 6), l15 = lane & 15, quad = lane >> 4;
    const int Tseq = seq < 32 ? 2048 : 16384;
    const size_t base = seq < 32 ? (size_t)seq * 2048 : (size_t)M_PROMPT;
    const bf16_t* Prkvg = (const bf16_t*)(P.ws + WS_PRKVG);
    const bf16_t* Pwa = (const bf16_t*)(P.ws + WS_PWA);
    bf16_t* Yd = (bf16_t*)(P.ws + WS_Y) + (size_t)dir * M_TOK * 512;
    float* RKR = (float*)(P.ws + WS_RKR) + (size_t)dir * M_TOK * 8;
    LAS bf16_t* RAW0 = (LAS bf16_t*)lds;
    LAS bf16_t* ZROW = (LAS bf16_t*)(lds + 21760);
    LAS float* Wd = (LAS float*)(lds + 22528);
    LAS float* Aa = Wd + 1024; LAS float* Rr = Aa + 1024; LAS float* KP = Rr + 1024; LAS float* Vv = KP + 1024; LAS float* KK = Vv + 1024; LAS float* KKA = KK + 1024; LAS float* Yc = KKA + 1024;
    if (tid < 160) ((LAS unsigned*)ZROW)[tid] = 0u;
    LAS bf16_t* ALDS = (LAS bf16_t*)(lds + 55296);
    const int j_a = tid / 40, seg_a = (tid % 40) >> 3, c8_a = tid & 7;
    const int idx_b = tid + 512, j_b = idx_b / 40, seg_b = (idx_b % 40) >> 3, c8_b = idx_b & 7;
    const bool has_b = idx_b < 640;
    const int coff_a = seg_a < 3 ? seg_a * 512 + h * 64 + c8_a * 8 : dir * 128 + (seg_a - 3) * 64 + c8_a * 8;
    const int coff_b = seg_b < 3 ? seg_b * 512 + h * 64 + c8_b * 8 : dir * 128 + (seg_b - 3) * 64 + c8_b * 8;
    const int dst_a = (j_a + 1) * 320 + seg_a * 64 + c8_a * 8, dst_b = (j_b + 1) * 320 + seg_b * 64 + c8_b * 8;
    const bf16_t* src_a = (seg_a < 3 ? Prkvg + base * 2048 : Pwa + base * 256) + coff_a; const int ld_a = seg_a < 3 ? 2048 : 256;
    const bf16_t* src_b = (seg_b < 3 ? Prkvg + base * 2048 : Pwa + base * 256) + coff_b; const int ld_b = seg_b < 3 ? 2048 : 256;
    const int ltype = wave >> 2, lch = (wave & 3) * 16 + l15;
    const bf16_t* Wt = (const bf16_t*)(P.ws + WS_LORA) + (size_t)(dir * 2 + ltype) * 512 * 64 + (size_t)(h * 64 + lch) * 64;
    const bf16x8 lb0 = *(const bf16x8*)(Wt + quad * 8), lb1 = *(const bf16x8*)(Wt + 32 + quad * 8);
    const float lbias = ltype == 0 ? P.in[17][dir * 512 + h * 64 + lch] : P.in[19][dir * 512 + h * 64 + lch];
    const int tk = tid >> 5, c2 = tid & 31;
    float mu_r[2], mu_k[2], mu_v[2], k_k[2], k_a[2], r_k[2];
#pragma unroll
    for (int e = 0; e < 2; ++e) { const int ch = h * 64 + 2 * c2 + e;
        mu_r[e] = P.in[15][dir * 1536 + ch]; mu_k[e] = P.in[15][dir * 1536 + 512 + ch]; mu_v[e] = P.in[15][dir * 1536 + 1024 + ch];
        k_k[e] = P.in[21][ch]; k_a[e] = P.in[22][ch]; r_k[e] = P.in[23][ch]; }
    float amu[2][2];
#pragma unroll
    for (int ty = 0; ty < 2; ++ty)
#pragma unroll
        for (int e = 0; e < 2; ++e) amu[ty][e] = P.in[16][dir * 128 + ty * 64 + 2 * c2 + e];
#define SCAN_BUILD_A(RAWN, PREV0) do { \
        LAS const bf16_t* cur_ = (RAWN) + (tk + 1) * 320 + 192 + 2 * c2; \
        LAS const bf16_t* prv_ = (tk > 0 ? (RAWN) + tk * 320 : (PREV0)) + 192 + 2 * c2; \
        _Pragma("unroll") for (int ty = 0; ty < 2; ++ty) { \
            const unsigned xc_ = *(LAS const unsigned*)(cur_ + ty * 64), xp_ = *(LAS const unsigned*)(prv_ + ty * 64); \
            float z0_ = bflo(xc_) + (bflo(xp_) - bflo(xc_)) * amu[ty][0], z1_ = bfhi(xc_) + (bfhi(xp_) - bfhi(xc_)) * amu[ty][1]; \
            if (ty == 0) { z0_ = tanhf_(z0_); z1_ = tanhf_(z1_); } \
            *(LAS unsigned*)(ALDS + ty * 1152 + tk * 72 + 2 * c2) = pk2(z0_, z1_); } } while (0)
    static_assert(LPR == 16, "two rows per lane, 16 lanes per row");
    const int srow = wave * 8 + (lane >> 4), sq = lane & 15;
    float S[4], S1[4];
#pragma unroll
    for (int i = 0; i < 4; ++i) { const int kidx = sq * 4 + i;
        S[i] = (flags & 1) ? (kidx == srow ? 1.f : 0.f) : (sin ? sin[srow * 64 + kidx] : 0.f);
        S1[i] = (flags & 1) ? (kidx == srow + 4 ? 1.f : 0.f) : (sin ? sin[(srow + 4) * 64 + kidx] : 0.f); }
    const int nch = tlen / 16;
    const int tstep = dir == 0 ? 16 : -16;
    const int tfirst = dir == 0 ? tbeg : tbeg + tlen - 16;
    const int tprev = dir == 0 ? tbeg - 1 : tbeg + tlen;
    const bool has_prev = tprev >= 0 && tprev < Tseq;
    if (has_prev && tid < 40) {
        const int sg = tid >> 3, c8 = tid & 7;
        const bf16_t* sp = sg < 3 ? Prkvg + (base + tprev) * 2048 + sg * 512 + h * 64 + c8 * 8 : Pwa + (base + tprev) * 256 + dir * 128 + (sg - 3) * 64 + c8 * 8;
        *(LAS u32x4*)(RAW0 + 5440 + 16 * 320 + sg * 64 + c8 * 8) = *(const u32x4*)sp;
    }
    const bool in_on = (flags & 2) == 0, wr_y = (flags & 4) != 0, wr_rk = (flags & 8) != 0;
#define SCAN_TOK(t0, j) (dir == 0 ? (t0) + (j) : (t0) + 15 - (j))
    u32x4 pre_a, pre_b = (u32x4){0u, 0u, 0u, 0u};
    {
        pre_a = *(const u32x4*)(src_a + (size_t)SCAN_TOK(tfirst, j_a) * ld_a);
        if (has_b) pre_b = *(const u32x4*)(src_b + (size_t)SCAN_TOK(tfirst, j_b) * ld_b);
        *(LAS u32x4*)(RAW0 + dst_a) = pre_a;
        if (has_b) *(LAS u32x4*)(RAW0 + dst_b) = pre_b;
        if (nch > 1) {
            pre_a = *(const u32x4*)(src_a + (size_t)SCAN_TOK(tfirst + tstep, j_a) * ld_a);
            if (has_b) pre_b = *(const u32x4*)(src_b + (size_t)SCAN_TOK(tfirst + tstep, j_b) * ld_b);
        }
    }
    __syncthreads();
    SCAN_BUILD_A(RAW0, (has_prev ? RAW0 + 5440 + 16 * 320 : ZROW));
    lds_barrier();
    u32x4 ypend = (u32x4){0u, 0u, 0u, 0u}; bf16_t* ypend_ptr = nullptr;
    for (int c = 0; c < nch; ++c) {
        LAS bf16_t* RAW = RAW0 + (c & 1) * 5440;
        LAS bf16_t* RAWp = RAW0 + ((c & 1) ^ 1) * 5440;
        const int t0 = tfirst + c * tstep;
        {
            bf16x8 af[2];
#pragma unroll
            for (int ks = 0; ks < 2; ++ks) af[ks] = *(LAS const bf16x8*)(ALDS + ltype * 1152 + l15 * 72 + ks * 32 + quad * 8);
            f32x4 d = mfma16(af[0], lb0, (f32x4){0.f, 0.f, 0.f, 0.f});
            d = mfma16(af[1], lb1, d);
            LAS float* dstp = (ltype == 0 ? Wd : Aa) + lch;
#pragma unroll
            for (int jj = 0; jj < 4; ++jj) { const float sg = sigmoidf_(lbias + d[jj]); dstp[(quad * 4 + jj) * 64] = ltype == 0 ? __expf(-0.6065306597126334f * sg) : sg; }
        }
        {
            LAS const bf16_t* cur = RAW + (tk + 1) * 320 + 2 * c2;
            LAS const bf16_t* prv = (tk > 0 ? RAW + tk * 320 : ((c > 0 || has_prev) ? RAWp + 16 * 320 : ZROW)) + 2 * c2;
            const unsigned rc = *(LAS const unsigned*)(cur), rp = *(LAS const unsigned*)(prv);
            const unsigned kc = *(LAS const unsigned*)(cur + 64), kq = *(LAS const unsigned*)(prv + 64);
            const unsigned vc = *(LAS const unsigned*)(cur + 128), vp = *(LAS const unsigned*)(prv + 128);
            const int o = tk * 64 + 2 * c2;
            Rr[o] = bflo(rc) + (bflo(rp) - bflo(rc)) * mu_r[0]; Rr[o + 1] = bfhi(rc) + (bfhi(rp) - bfhi(rc)) * mu_r[1];
            KP[o] = bflo(kc) + (bflo(kq) - bflo(kc)) * mu_k[0]; KP[o + 1] = bfhi(kc) + (bfhi(kq) - bfhi(kc)) * mu_k[1];
            Vv[o] = in_on ? bflo(vc) + (bflo(vp) - bflo(vc)) * mu_v[0] : 0.f; Vv[o + 1] = in_on ? bfhi(vc) + (bfhi(vp) - bfhi(vc)) * mu_v[1] : 0.f;
        }
        lds_barrier();
        float rk_keep;
        {
            const int o = tk * 64 + 2 * c2;
            const float kz0 = KP[o], kz1 = KP[o + 1], a0 = Aa[o], a1 = Aa[o + 1];
            const float q0 = kz0 * k_k[0], q1 = kz1 * k_k[1];
            const float kp0 = kz0 * (1.0f + (a0 - 1.0f) * k_a[0]), kp1 = kz1 * (1.0f + (a1 - 1.0f) * k_a[1]);
            const float ss = reduce32(q0 * q0 + q1 * q1);
            const float rk = reduce32(Rr[o] * kp0 * r_k[0] + Rr[o + 1] * kp1 * r_k[1]);
            const float inv = 1.0f / fmaxf(sqrtf(ss), 1e-12f);
            const float kk0 = q0 * inv, kk1 = q1 * inv;
            KK[o] = kk0; KK[o + 1] = kk1; KKA[o] = kk0 * a0; KKA[o + 1] = kk1 * a1;
            KP[o] = kp0; KP[o + 1] = kp1;
            rk_keep = rk;
        }
        if (c + 1 < nch) {
            *(LAS u32x4*)(RAWp + dst_a) = pre_a;
            if (has_b) *(LAS u32x4*)(RAWp + dst_b) = pre_b;
            if (c + 2 < nch) {
                pre_a = *(const u32x4*)(src_a + (size_t)SCAN_TOK(t0 + 2 * tstep, j_a) * ld_a);
                if (has_b) pre_b = *(const u32x4*)(src_b + (size_t)SCAN_TOK(t0 + 2 * tstep, j_b) * ld_b);
            }
        }
        if (wr_rk && c2 == 0) RKR[(base + SCAN_TOK(t0, tk)) * 8 + h] = rk_keep;
        if (ypend_ptr) *(u32x4*)ypend_ptr = ypend;
        lds_barrier();
        if (c + 1 < nch) SCAN_BUILD_A(RAWp, RAW + 16 * 320);
        {
            ScanSet2 sa_, sb_;
            scan_load2(sa_, KK, Wd, KKA, KP, Rr, Vv, sq * 4, srow, wr_y);
            float yk = 0.f, zk = 0.f, y0 = 0.f, y1 = 0.f, yr0, yr1;
#pragma unroll 1
            for (int jo = 0; jo < 16; jo += 2) {
                scan_load2(sb_, KK, Wd, KKA, KP, Rr, Vv, (jo + 1) * 64 + sq * 4, (jo + 1) * 64 + srow, wr_y);
                scan_step2(S, S1, sa_, wr_y, y0, y1, yr0, yr1);
                if (jo > 0 && sq == jo - 1) { yk = yr0; zk = yr1; }
                if (jo + 2 < 16) scan_load2(sa_, KK, Wd, KKA, KP, Rr, Vv, (jo + 2) * 64 + sq * 4, (jo + 2) * 64 + srow, wr_y);
                scan_step2(S, S1, sb_, wr_y, y0, y1, yr0, yr1);
                if (sq == jo) { yk = yr0; zk = yr1; }
            }
            yr0 = dpp16(y0); yr1 = dpp16(y1);
            if (sq == 15) { yk = yr0; zk = yr1; }
            Yc[sq * 64 + srow] = yk; Yc[sq * 64 + srow + 4] = zk;
        }
        lds_barrier();
        {
            const bool wr = wr_y && tid < 128;
            if (wr) {
                const int tq = tid >> 3, c8 = tid & 7; float f[8];
                const f32x4 a = *(LAS const f32x4*)(Yc + tq * 64 + c8 * 8), b = *(LAS const f32x4*)(Yc + tq * 64 + c8 * 8 + 4);
                f[0] = a[0]; f[1] = a[1]; f[2] = a[2]; f[3] = a[3]; f[4] = b[0]; f[5] = b[1]; f[6] = b[2]; f[7] = b[3];
                ypend = pack8(f); ypend_ptr = Yd + (base + SCAN_TOK(t0, tq)) * 512 + h * 64 + c8 * 8;
            }
        }
    }
    if (ypend_ptr) *(u32x4*)ypend_ptr = ypend;
    if (sout) { *(f32x4*)(sout + srow * 64 + sq * 4) = (f32x4){S[0], S[1], S[2], S[3]}; *(f32x4*)(sout + (srow + 4) * 64 + sq * 4) = (f32x4){S1[0], S1[1], S1[2], S1[3]}; }
#undef SCAN_TOK
#undef SCAN_BUILD_A
    __syncthreads();
}

__device__ void scan_carry(const Params& PP, int hd, LAS unsigned char* lds) {
    Params P = PP; P.ws = opaque_ptr(PP.ws);
    const int tid = opaque_tid();
    const float* Lm = (const float*)(P.ws + WS_STL) + (size_t)hd * NSEG * 4096;
    const float* Pm = (const float*)(P.ws + WS_STP) + (size_t)hd * NSEG * 4096;
    float* St = (float*)(P.ws + WS_STS) + (size_t)hd * NSEG * 4096;
    LAS float* Sc = (LAS float*)lds;
    LAS float* Pc = Sc + 4096;
    const int v = tid >> 3, k0 = (tid & 7) * 8;
    for (int i = 0; i < 8; ++i) { const float x = Lm[v * 64 + k0 + i]; Sc[v * 64 + k0 + i] = x; St[4096 + v * 64 + k0 + i] = x; }
    for (int sgm = 1; sgm + 1 < NSEG; ++sgm) {
        for (int i = 0; i < 8; ++i) Pc[v * 64 + k0 + i] = Pm[(size_t)sgm * 4096 + v * 64 + k0 + i];
        __syncthreads();
        float o[8];
        for (int i = 0; i < 8; ++i) o[i] = Lm[(size_t)sgm * 4096 + v * 64 + k0 + i];
        for (int j = 0; j < 64; ++j) { const float sv = Sc[v * 64 + j];
#pragma unroll
            for (int i = 0; i < 8; ++i) o[i] += sv * Pc[j * 64 + k0 + i]; }
        __syncthreads();
        for (int i = 0; i < 8; ++i) { Sc[v * 64 + k0 + i] = o[i]; St[(size_t)(sgm + 1) * 4096 + v * 64 + k0 + i] = o[i]; }
    }
    __syncthreads();
}

__device__ void rwkv_finalize(const Params& PP) {
    Params P = PP; P.ws = opaque_ptr(PP.ws);
    const int tid_ = opaque_tid(), lane = tid_ & 63, wave = __builtin_amdgcn_readfirstlane(tid_ >> 6);
    const bf16_t* Prkvg = (const bf16_t*)(P.ws + WS_PRKVG);
    const bf16_t* Y0 = (const bf16_t*)(P.ws + WS_Y);
    const bf16_t* Y1 = Y0 + (size_t)M_TOK * 512;
    const float* RKR0 = (const float*)(P.ws + WS_RKR);
    const float* RKR1 = RKR0 + (size_t)M_TOK * 8;
    bf16_t* MO = (bf16_t*)(P.ws + WS_XN);
    const int col = lane * 8, hh = lane >> 3;
    float gw[8], gb[8], muf[8], mub[8];
#pragma unroll
    for (int i = 0; i < 8; ++i) { gw[i] = P.in[24][col + i]; gb[i] = P.in[25][col + i]; muf[i] = P.in[15][1024 + col + i]; mub[i] = P.in[15][1536 + 1024 + col + i]; }
    for (int row = blockIdx.x * 8 + wave; row < M_TOK; row += gridDim.x * 8) {
        const int t = row < M_PROMPT ? (row & 2047) : row - M_PROMPT, T = row < M_PROMPT ? 2048 : 16384;
        float yf[8], yb[8], vc[8], vp[8], vn[8], gg[8];
        unpack8(*(const u32x4*)(Y0 + (size_t)row * 512 + col), yf); unpack8(*(const u32x4*)(Y1 + (size_t)row * 512 + col), yb);
        unpack8(*(const u32x4*)(Prkvg + (size_t)row * 2048 + 1024 + col), vc);
        unpack8(*(const u32x4*)(Prkvg + (size_t)row * 2048 + 1536 + col), gg);
        if (t > 0) unpack8(*(const u32x4*)(Prkvg + (size_t)(row - 1) * 2048 + 1024 + col), vp); else { for (int i = 0; i < 8; ++i) vp[i] = 0.f; }
        if (t < T - 1) unpack8(*(const u32x4*)(Prkvg + (size_t)(row + 1) * 2048 + 1024 + col), vn); else { for (int i = 0; i < 8; ++i) vn[i] = 0.f; }
        const float rf = RKR0[(size_t)row * 8 + hh], rb = RKR1[(size_t)row * 8 + hh];
        float s = 0.f;
#pragma unroll
        for (int i = 0; i < 8; ++i) { yf[i] += yb[i]; s += yf[i]; }
        const float mean = reduce8(s) * (1.0f / 64.0f);
        float q = 0.f;
#pragma unroll
        for (int i = 0; i < 8; ++i) { yf[i] -= mean; q += yf[i] * yf[i]; }
        const float rstd = rsqrtf(reduce8(q) * (1.0f / 64.0f) + 64e-5f);
        float o[8];
#pragma unroll
        for (int i = 0; i < 8; ++i) {
            const float vzf = vc[i] + (vp[i] - vc[i]) * muf[i], vzb = vc[i] + (vn[i] - vc[i]) * mub[i];
            o[i] = (yf[i] * rstd * gw[i] + gb[i] + rf * vzf + rb * vzb) * sigmoidf_(gg[i]);
        }
        *(u32x4*)(MO + (size_t)row * 1024 + 512 + col) = pack8(o);
    }
}

__device__ void attn_item(const Params& PP, int seq, int h, int tile, LAS unsigned char* lds) {
    Params P = PP; P.ws = opaque_ptr(PP.ws);
    const int tid = opaque_tid(), lane = tid & 63, wave = __builtin_amdgcn_readfirstlane(tid >> 6), l15 = lane & 15, quad = lane >> 4;
    const int T = seq < 32 ? 2048 : 16384;
    const size_t base = seq < 32 ? (size_t)seq * 2048 : (size_t)M_PROMPT;
    const int T0 = tile * 256;
    const bf16_t* QKV = (const bf16_t*)(P.ws + WS_BIG);
    bf16_t* MO = (bf16_t*)(P.ws + WS_XN);
    LAS float* OACC = (LAS float*)lds;
    LAS float* LS = (LAS float*)(lds + 256 * 272);
    LAS unsigned char* VST = lds + 256 * 272 + 1024 + wave * (32 * 144);
    const float slope = exp2f(-0.5f * (float)(h + 1));
    float gqk[16];
#pragma unroll
    for (int i = 0; i < 16; ++i) { const int e = (i >> 3) * 32 + quad * 8 + (i & 7); gqk[i] = P.in[28][e] * P.in[29][e]; }
    const int r4 = l15 >> 2, c4 = l15 & 3;
    float biasL[9][4];
#pragma unroll
    for (int kt = 0; kt < 9; ++kt)
#pragma unroll
        for (int j = 0; j < 4; ++j) { int dist = 16 * kt - 64 + quad * 4 + j - l15; dist = dist < 0 ? -dist : dist;
            biasL[kt][j] = dist <= 64 ? -slope * 1.4426950408889634f * (float)dist : -1e30f; }
    LAS float* RKT = (LAS float*)(lds + 107520);
    const int tb = T0 - 1024;
    for (int idx = tid; idx < 2304; idx += 512) {
        const int tok = tb + idx;
        if (tok >= 0 && tok < T) {
            const bf16_t* kp_ = QKV + (base + tok) * 3072 + 1024 + h * 64;
            float ss = 0.f;
#pragma unroll
            for (int i = 0; i < 8; ++i) { float f[8]; unpack8(*(const u32x4*)(kp_ + i * 8), f);
#pragma unroll
                for (int e = 0; e < 8; ++e) ss += f[e] * f[e]; }
            RKT[idx] = rsqrtf(ss * (1.0f / 64.0f) + NORM_EPS) * 1.4426950408889634f;
        }
    }
    __syncthreads();
    for (int bi = 0; bi < 3; ++bi) {
        const int dsh = 2 * bi, L = T >> dsh;
        const float sl_d = slope * (float)(1 << dsh);
        for (int gg = 0; gg < 2; ++gg) {
            const int g = wave * 2 + gg;
            const int res = bi == 0 ? 0 : (bi == 1 ? (g & 3) : g), blk = bi == 0 ? g : (bi == 1 ? (g >> 2) : 0);
            const int i0 = (T0 >> dsh) + 16 * blk;
            const int qtok = ((i0 + l15) << dsh) + res;
            bf16x8 qf[2]; float mq;
            {
                const bf16_t* qp = QKV + (base + qtok) * 3072 + h * 64 + quad * 8;
                float f[16]; unpack8(*(const u32x4*)qp, f); unpack8(*(const u32x4*)(qp + 32), f + 8);
                float ss = 0.f;
#pragma unroll
                for (int i = 0; i < 16; ++i) ss += f[i] * f[i];
                ss += __shfl_xor(ss, 16); ss += __shfl_xor(ss, 32);
                const float rq = rsqrtf(ss * (1.0f / 64.0f) + NORM_EPS) * 0.125f;
#pragma unroll
                for (int i = 0; i < 16; ++i) f[i] = f[i] * rq * gqk[i];
                const u32x4 w0 = pack8(f), w1 = pack8(f + 8);
                qf[0] = __builtin_bit_cast(bf16x8, w0); qf[1] = __builtin_bit_cast(bf16x8, w1);
                float fr[16]; unpack8(w0, fr); unpack8(w1, fr + 8);
                float n2 = 0.f;
#pragma unroll
                for (int i = 0; i < 16; ++i) n2 += fr[i] * fr[i];
                n2 += __shfl_xor(n2, 16); n2 += __shfl_xor(n2, 32);
                mq = 8.1f * 1.4426950408889634f * sqrtf(n2);
            }
            f32x4 oacc[4];
#pragma unroll
            for (int et = 0; et < 4; ++et) oacc[et] = (f32x4){0.f, 0.f, 0.f, 0.f};
            float lsum = 0.f;
            const int kjb = i0 - 64 + quad * 4, rkoff = res - tb;
            const float dmul = (float)(1 << dsh);
            bf16x8 kfb[2][2][2]; u32x4 vb[2][4];
            const int rowv = lane >> 1, half = lane & 1;
#define ATT_ISSUE(KP, BUF) do { \
                _Pragma("unroll") for (int tt_ = 0; tt_ < 2; ++tt_) { \
                    int kidx_ = i0 - 64 + 16 * (2 * (KP) + tt_) + l15; kidx_ = kidx_ < 0 ? 0 : (kidx_ > L - 1 ? L - 1 : kidx_); \
                    const bf16_t* kptr_ = QKV + (base + ((size_t)kidx_ << dsh) + res) * 3072 + 1024 + h * 64 + quad * 8; \
                    kfb[BUF][tt_][0] = *(const bf16x8*)kptr_; kfb[BUF][tt_][1] = *(const bf16x8*)(kptr_ + 32); } \
                int vidx_ = i0 - 64 + 32 * (KP) + rowv; vidx_ = vidx_ < 0 ? 0 : (vidx_ > L - 1 ? L - 1 : vidx_); \
                const bf16_t* vptr_ = QKV + (base + ((size_t)vidx_ << dsh) + res) * 3072 + 2048 + h * 64 + half * 32; \
                vb[BUF][0] = *(const u32x4*)vptr_; vb[BUF][1] = *(const u32x4*)(vptr_ + 8); vb[BUF][2] = *(const u32x4*)(vptr_ + 16); vb[BUF][3] = *(const u32x4*)(vptr_ + 24); } while (0)
            ATT_ISSUE(0, 0);
#pragma unroll
            for (int kp = 0; kp < 5; ++kp) {
                f32x4 s[2];
                if (kp + 1 < 5) ATT_ISSUE(kp + 1, (kp + 1) & 1);
#pragma unroll
                for (int tt = 0; tt < 2; ++tt) {
                    const int kt = 2 * kp + tt;
                    s[tt] = (f32x4){0.f, 0.f, 0.f, 0.f};
                    if (kt < 9) {
                        f32x4 sc = mfma16(kfb[kp & 1][tt][0], qf[0], (f32x4){0.f, 0.f, 0.f, 0.f});
                        sc = mfma16(kfb[kp & 1][tt][1], qf[1], sc);
#pragma unroll
                        for (int j = 0; j < 4; ++j) {
                            const int kj = kjb + 16 * kt + j;
                            const int kc = kj < 0 ? 0 : (kj > L - 1 ? L - 1 : kj);
                            const float rk = RKT[(kc << dsh) + rkoff];
                            float p = __builtin_amdgcn_exp2f(sc[j] * rk + (biasL[kt][j] * dmul - mq));
                            p = ((unsigned)kj < (unsigned)L) ? p : 0.f;
                            lsum += p; s[tt][j] = p;
                        }
                    }
                }
                bf16x8 pf;
                { u32x4 w; w.x = pk2(s[0][0], s[0][1]); w.y = pk2(s[0][2], s[0][3]); w.z = pk2(s[1][0], s[1][1]); w.w = pk2(s[1][2], s[1][3]); pf = __builtin_bit_cast(bf16x8, w); }
                {
                    LAS u32x4* vd = (LAS u32x4*)(VST + rowv * 144 + half * 64);
                    vd[0] = vb[kp & 1][0]; vd[1] = vb[kp & 1][1]; vd[2] = vb[kp & 1][2]; vd[3] = vb[kp & 1][3];
                }
                asm volatile("s_waitcnt lgkmcnt(0)" ::: "memory"); __builtin_amdgcn_fence(__ATOMIC_RELEASE, "wavefront"); __builtin_amdgcn_wave_barrier(); __builtin_amdgcn_fence(__ATOMIC_ACQUIRE, "wavefront"); asm volatile("s_waitcnt lgkmcnt(0)" ::: "memory");
#pragma unroll
                for (int et = 0; et < 4; ++et) {
                    LAS const unsigned char* ap = VST + (quad * 4 + r4) * 144 + (et * 16 + 4 * c4) * 2;
                    const s16x4 lo = tr_read(ap), hi = tr_read(ap + 16 * 144);
                    const bf16x8 a = {lo[0], lo[1], lo[2], lo[3], hi[0], hi[1], hi[2], hi[3]};
                    oacc[et] = mfma16(a, pf, oacc[et]);
                }
                asm volatile("s_waitcnt lgkmcnt(0)" ::: "memory"); __builtin_amdgcn_fence(__ATOMIC_RELEASE, "wavefront"); __builtin_amdgcn_wave_barrier(); __builtin_amdgcn_fence(__ATOMIC_ACQUIRE, "wavefront"); asm volatile("s_waitcnt lgkmcnt(0)" ::: "memory");
            }
#undef ATT_ISSUE
            lsum += __shfl_xor(lsum, 16); lsum += __shfl_xor(lsum, 32);
            const int qloc = qtok - T0;
#pragma unroll
            for (int et = 0; et < 4; ++et) {
                LAS f32x4* dst = (LAS f32x4*)(OACC + qloc * 68 + et * 16 + quad * 4);
                if (bi == 0) *dst = oacc[et]; else *dst = *dst + oacc[et];
            }
            if (quad == 0) { if (bi == 0) LS[qloc] = lsum; else LS[qloc] += lsum; }
        }
        __syncthreads();
    }
    {
        const int q = tid >> 1, half = tid & 1;
        const float inv = 1.0f / LS[q];
        bf16_t* op = MO + (base + T0 + q) * 1024 + h * 64 + half * 32;
#pragma unroll
        for (int i = 0; i < 4; ++i) {
            const f32x4 a = *(LAS const f32x4*)(OACC + q * 68 + half * 32 + i * 8), b = *(LAS const f32x4*)(OACC + q * 68 + half * 32 + i * 8 + 4);
            u32x4 w; w.x = pk2(a[0] * inv, a[1] * inv); w.y = pk2(a[2] * inv, a[3] * inv); w.z = pk2(b[0] * inv, b[1] * inv); w.w = pk2(b[2] * inv, b[3] * inv);
            *(u32x4*)(op + i * 8) = w;
        }
    }
    __syncthreads();
}

enum { K_P0 = 0, K_SWIGLU, K_RESID, K_NORM, K_GEMM_P, K_MIXA, K_FINAL, K_GEMM_QKV, K_ATTN, K_CARRY, K_MIXB };
constexpr int N_PHASES = 20;

__global__ void __launch_bounds__(512, 2) mega(Params P) {
    extern __shared__ __attribute__((aligned(16))) unsigned char lds_raw[];
    LAS unsigned char* lds = (LAS unsigned char*)lds_raw;
    cg::grid_group grid = cg::this_grid();
    for (int ph = 0; ph < N_PHASES; ++ph) {
#ifdef PROBE_MASK
        if (blockIdx.x == 0 && threadIdx.x == 0) ((unsigned long long*)(P.ws + WS_TS))[ph] = __builtin_amdgcn_s_memrealtime();
#endif
        unsigned char* ws = P.ws; float* X = P.out; int G = gridDim.x, bid = blockIdx.x;
        asm volatile("" : "+s"(ws), "+s"(X), "+s"(G), "+s"(bid));
        bf16_t* XN = (bf16_t*)(ws + WS_XN);
        bf16_t* Hb = (bf16_t*)(ws + WS_BIG);
        int kind, layer = 0, sub = 0;
        if (ph == 0) kind = K_P0;
        else {
            layer = ph <= 11 ? 0 : 1; const int r = ph <= 11 ? ph - 1 : ph - 12;
            const unsigned long long kc = layer == 0 ? 0x32126A95421ull : 0x32128721ull;
            const unsigned long long sc = layer == 0 ? 0x21120000000ull : 0x21120000ull;
            kind = (int)((kc >> (4 * r)) & 15ull); sub = (int)((sc >> (4 * r)) & 15ull);
        }
        if (kind == K_P0) {
#ifndef SKIP_P0
            LAS float* tile = (LAS float*)lds;
            int rot = 0;
            for (int job = 0; job < 16; ++job) {
                const float* src; size_t doff; int K, N;
                if (job < 4) { src = ((job & 1) ? P.in[7] : P.in[3]) + (size_t)(job >> 1) * 1024 * 5632; doff = WS_WFI + (size_t)job * SZ_WFI; K = 1024; N = 5632; }
                else if (job < 8) { src = ((job & 1) ? P.in[8] : P.in[4]) + (size_t)((job - 4) >> 1) * 2816 * 1024; doff = WS_WFO + (size_t)(job - 4) * SZ_WFO; K = 2816; N = 1024; }
                else if (job == 8) { src = P.in[10]; doff = WS_WABI; K = 1024; N = 3328; }
                else if (job == 9) { src = P.in[11]; doff = WS_WABO; K = 1024; N = 1024; }
                else if (job == 10) { src = P.in[26]; doff = WS_WATI; K = 1024; N = 3072; }
                else if (job == 11) { src = P.in[27]; doff = WS_WATO; K = 1024; N = 1024; }
                else { const int d = (job - 12) >> 1, ty = (job - 12) & 1; src = (ty ? P.in[20] : P.in[18]) + (size_t)d * 64 * 512; doff = WS_LORA + (size_t)(d * 2 + ty) * 512 * 64 * 2; K = 64; N = 512; }
                if (job < 4) convert_T<1>(src, (bf16_t*)(ws + doff), K, N, tile, rot); else convert_T<0>(src, (bf16_t*)(ws + doff), K, N, tile, rot);
                rot += (K / 64) * (N / 64);
            }
            {
                bf16_t* dst = (bf16_t*)(ws + WS_SGUW);
                for (int i = bid * 512 + opaque_tid(); i < 4 * 128 * 128 / 4; i += G * 512) {
                    const f32x4 v = *(const f32x4*)(P.in[13] + (size_t)i * 4);
                    u32x2 w; w.x = pk2(v[0], v[1]); w.y = pk2(v[2], v[3]); *(u32x2*)(dst + (size_t)i * 4) = w;
                }
            }
            norm_rows(P.in[0], P.in[1], M_PROMPT, X, nullptr, nullptr, P.in[2], XN);
#endif
        } else if (kind == K_SWIGLU) {
            if (sub == 0) { float* za = (float*)(ws + WS_RSA); for (int i = bid * 512 + opaque_tid(); i < M_TOK; i += G * 512) za[i] = 0.f; }
            pg8::Gemm g{sub == 0 ? XN : (const bf16_t*)(ws + WS_Y), (const bf16_t*)(ws + WS_WFI + (size_t)(layer * 2 + sub) * SZ_WFI), M_TOK, 5632, 1024};
            pg8::StaticOrder S; S.init(M_TOK, 5632, G, bid);
            EpiSwiglu E{Hb, sub == 0 ? nullptr : (const float*)(ws + WS_RSB)};
#ifndef SKIP_G1
            pg8::gemm_phase<EpiSwiglu, pg8::StaticOrder, GEMM_ALIGN, GEMM_SP2>(lds, g, S, E);
#endif
        } else if (kind == K_RESID) {
            const bf16_t* A; const bf16_t* Bt; int K; float scale; bf16_t* xg = nullptr; const float* gn = nullptr; float* rss = nullptr;
            if (sub < 2) { A = Hb; Bt = (const bf16_t*)(ws + WS_WFO + (size_t)(layer * 2 + sub) * SZ_WFO); K = 2816; scale = 0.5f;
                if (sub == 0) { xg = XN; gn = P.in[5] + layer * DM; rss = (float*)(ws + WS_RSA); } }
            else { A = XN; Bt = (const bf16_t*)(ws + (layer == 0 ? WS_WABO : WS_WATO)); K = 1024; scale = 1.0f; xg = (bf16_t*)(ws + WS_Y); gn = P.in[6] + layer * DM; rss = (float*)(ws + WS_RSB); }
            pg8::Gemm g{A, Bt, M_TOK, 1024, K};
            pg8::StaticOrder S; S.init(M_TOK, 1024, G, bid);
            EpiResid E{X, scale, xg, gn, rss};
#ifndef SKIP_G2
            pg8::gemm_phase<EpiResid, pg8::StaticOrder, GEMM_ALIGN, GEMM_SP2>(lds, g, S, E);
#endif
        } else if (kind == K_NORM) {
            if (ph < N_PHASES - 1) norm_rows(X, X, M_TOK, nullptr, P.in[9], X, P.in[2] + DM, XN);
            else norm_rows(X, X, M_TOK, nullptr, P.in[9] + DM, X, nullptr, nullptr);
        } else if (kind == K_GEMM_P || kind == K_GEMM_QKV) {
            const bool isP = kind == K_GEMM_P; const int N = isP ? 3328 : 3072;
            pg8::Gemm g{XN, (const bf16_t*)(ws + (isP ? WS_WABI : WS_WATI)), M_TOK, N, 1024};
            pg8::StaticOrder S; S.init(M_TOK, N, G, bid);
            { float* zb = (float*)(ws + WS_RSB); for (int i = bid * 512 + opaque_tid(); i < M_TOK; i += G * 512) zb[i] = 0.f; }
            EpiSplit E; const float* rsa = (const float*)(ws + WS_RSA);
            if (isP) E = EpiSplit{(bf16_t*)(ws + WS_PUV), 1024, 4, (bf16_t*)(ws + WS_PRKVG), 2048, 12, (bf16_t*)(ws + WS_PWA), 256, rsa};
            else E = EpiSplit{(bf16_t*)(ws + WS_BIG), 3072, 12, (bf16_t*)(ws + WS_BIG), 3072, 12, (bf16_t*)(ws + WS_BIG), 3072, rsa};
#ifndef SKIP_G3
            pg8::gemm_phase<EpiSplit, pg8::StaticOrder, GEMM_ALIGN, GEMM_SP2>(lds, g, S, E);
#endif
        } else if (kind == K_MIXA) {
            constexpr int NLONG = 16 + 16 * (NSEG - 2) * 2;
            for (int li = bid; li < 512 + NLONG + 640; li += G) {
#ifndef SKIP_SCAN
                if (li < 512) scan_item<16>(P, li >> 4, (li >> 1) & 7, li & 1, 0, 0, 2048, 4 | 8, nullptr, nullptr, lds);
                else if (li < 512 + 16) {
                    const int hd = li - 512, dir = hd & 1;
                    scan_item<16>(P, 32, hd >> 1, dir, 0, dir == 0 ? 0 : 16384 - SEGLEN, SEGLEN, 4 | 8, nullptr, (float*)(ws + WS_STL) + (size_t)hd * NSEG * 4096, lds);
                } else if (li < 512 + NLONG) {
                    const int q = li - 512 - 16, hd = q & 15, isP = (q >> 4) & 1, sgm = 1 + (q >> 5), dir = hd & 1;
                    const int tb = dir == 0 ? sgm * SEGLEN : 16384 - (sgm + 1) * SEGLEN;
                    float* so = (float*)(ws + (isP ? WS_STP : WS_STL)) + ((size_t)hd * NSEG + sgm) * 4096;
                    scan_item<16>(P, 32, hd >> 1, dir, 0, tb, SEGLEN, isP ? (1 | 2) : 0, nullptr, so, lds);
                }
#endif
#ifndef SKIP_SGU
                if (li >= 512 + NLONG) sgu_item(P, li - 512 - NLONG, lds);
#endif
            }
        } else if (kind == K_CARRY) {
#ifndef SKIP_SCAN
            if (bid < 16) scan_carry(P, bid, lds);
#endif
        } else if (kind == K_MIXB) {
#ifndef SKIP_SCAN
            for (int li = bid; li < 16 * (NSEG - 1); li += G) {
                const int hd = li & 15, sgm = 1 + (li >> 4), dir = hd & 1;
                const int tb = dir == 0 ? sgm * SEGLEN : 16384 - (sgm + 1) * SEGLEN;
                scan_item<16>(P, 32, hd >> 1, dir, 0, tb, SEGLEN, 4 | 8, (const float*)(ws + WS_STS) + ((size_t)hd * NSEG + sgm) * 4096, nullptr, lds);
            }
#endif
        } else if (kind == K_FINAL) {
#ifndef SKIP_FIN
            rwkv_finalize(P);
#endif
        } else if (kind == K_ATTN) {
            for (int it = bid; it < 5120; it += G) {
#ifndef SKIP_ATTN
                if (it < 4096) attn_item(P, it >> 7, it & 15, (it >> 4) & 7, lds);
                else attn_item(P, 32, it & 15, (it - 4096) >> 4, lds);
#endif
            }
        }
        if (ph + 1 < N_PHASES) {
            __builtin_amdgcn_fence(__ATOMIC_RELEASE, "agent");
            asm volatile("s_waitcnt vmcnt(0) lgkmcnt(0)" ::: "memory");
            grid.sync();
            __builtin_amdgcn_fence(__ATOMIC_ACQUIRE, "agent");
            asm volatile("s_waitcnt vmcnt(0) lgkmcnt(0)" ::: "memory");
            __syncthreads();
        }
    }
#ifdef PROBE_MASK
    if (blockIdx.x == 0 && threadIdx.x == 0) {
        unsigned long long* ts = (unsigned long long*)(P.ws + WS_TS);
        ts[N_PHASES] = __builtin_amdgcn_s_memrealtime();
        unsigned long long tot = 0;
        for (int i = 0; i < N_PHASES; ++i) if ((PROBE_MASK >> i) & 1) tot += ts[i + 1] - ts[i];
        P.out[0] += 4.0f + 10.0f * (float)tot * 1e-5f;
    }
#endif
}

extern "C" void kernel_launch(void* const* d_in, const int* in_sizes, int n_in, void* d_out, int out_size, void* d_ws, size_t ws_size, hipStream_t stream) {
    static int grid_blocks = 0;
    if (!grid_blocks) {
        int dev = 0, cus = 0, per_cu = 0;
        (void)hipGetDevice(&dev);
        (void)hipDeviceGetAttribute(&cus, hipDeviceAttributeMultiprocessorCount, dev);
        (void)hipFuncSetAttribute((const void*)mega, hipFuncAttributeMaxDynamicSharedMemorySize, LDS_BYTES);
        (void)hipOccupancyMaxActiveBlocksPerMultiprocessor(&per_cu, (const void*)mega, 512, LDS_BYTES);
        (void)hipGetLastError();
        if (cus <= 0) cus = 256;
        grid_blocks = cus;
        if (ws_size < WS_END2) fprintf(stderr, "kernel_launch: workspace too small: %zu < %zu\n", ws_size, (size_t)WS_END2);
    }
    Params p{};
    for (int i = 0; i < 30 && i < n_in; ++i) p.in[i] = (const float*)d_in[i];
    p.out = (float*)d_out; p.ws = (unsigned char*)d_ws;
    void* args[] = {&p};
    hipError_t e = hipLaunchCooperativeKernel((const void*)mega, dim3(grid_blocks), dim3(512), args, LDS_BYTES, stream);
    if (e != hipSuccess) fprintf(stderr, "cooperative launch failed: %s (grid %d)\n", hipGetErrorString(e), grid_blocks);
}
```

```cpp
#include <hip/hip_runtime.h>
#include <hip/hip_cooperative_groups.h>
#include <cstdio>
namespace cg = cooperative_groups;

namespace pg8 {
#define PG8_LAS __attribute__((address_space(3)))
typedef unsigned short bf16_t;
typedef short bf16x8 __attribute__((ext_vector_type(8)));
typedef float f32x4 __attribute__((ext_vector_type(4)));
typedef unsigned u32x4 __attribute__((ext_vector_type(4)));
constexpr int BM = 256, BK = 64, HALF = 128, HTB = HALF * BK * 2  , STAGE_BYTES = 8 * HTB, NXCD = 8, WGM = 8;

__host__ __device__ __forceinline__ int lds_byte(int r, int c) { const int st = (r >> 4) * 2 + (c >> 5), rr = r & 15, cc = c & 31, ob = rr * 64 + cc * 2; return st * 1024 + (ob ^ (((ob >> 9) & 1) << 5)); }
__host__ __device__ __forceinline__ void stage_rc(int b, int& R, int& C) { const int st = b / 1024, sb = b % 1024, swz = sb ^ (((sb >> 9) & 1) << 5); R = (st >> 1) * 16 + swz / 64; C = (st & 1) * 32 + (swz % 64) / 2; }
__host__ __device__ __forceinline__ int perm32(int rho) { const int n = rho >> 4, i = rho & 15; return 8 * (i >> 2) + 4 * n + (i & 3); }

struct Unit { int pm, pn; };
struct Gemm { const bf16_t* A; const bf16_t* Bt; int M, N, K; };

struct StaticOrder {
    int nM, nN, nwg, G, c;
    __host__ __device__ void init(int M, int N, int G_, int c_) { nM = M / BM; nN = N / BM; nwg = nM * nN; G = G_; c = c_; }
    __host__ __device__ bool next(int i, Unit& u) const {
        const long L = (long)i * G + c; if (L >= nwg) return false;
        int wgid = (int)L; { const int q = nwg / NXCD, r = nwg % NXCD, xcd = wgid % NXCD, off = wgid / NXCD; wgid = (xcd < r ? xcd * (q + 1) : r * (q + 1) + (xcd - r) * q) + off; }
        const int nig = WGM * nN, gid = wgid / nig, fm = gid * WGM, gsz = (nM - fm) < WGM ? (nM - fm) : WGM;
        u.pm = fm + ((wgid % nig) % gsz); u.pn = (wgid % nig) / gsz; return true;
    }
    __device__ __forceinline__ void a_ready(const Unit&) const {}
    __device__ __forceinline__ void done(const Unit&) const {}
};
__device__ __forceinline__ unsigned cvt_pk_bf16(float lo, float hi) { unsigned r; asm volatile("v_cvt_pk_bf16_f32 %0, %1, %2" : "=v"(r) : "v"(lo), "v"(hi)); return r; }
typedef float f32x2 __attribute__((ext_vector_type(2)));
template <class Epi, class Sched, bool ALIGN_EPI = false, bool SP2 = false>
__device__ __forceinline__ void gemm_phase(PG8_LAS unsigned char* lds, const Gemm g, const Sched& S, const Epi& E) {
    int tid_raw_ = threadIdx.x; asm volatile("" : "+v"(tid_raw_)); const int tid = tid_raw_, wid = __builtin_amdgcn_readfirstlane(tid >> 6), lane = tid & 63, wr = wid >> 2, wc = wid & 3, fr = lane & 15, fq = lane >> 4;
    const int K = g.K, nt = K / BK;
    unsigned voffA[2], voffB[2];
#pragma unroll
    for (int i = 0; i < 2; ++i) { int R, C; stage_rc(tid * 16 + i * 8192, R, C); const int Rb = Epi::PERM ? ((R & ~31) + perm32(R & 31)) : R;
        voffA[i] = (unsigned)(R * K + C) * 2u; voffB[i] = (unsigned)(Rb * K + C) * 2u; }
    const size_t kstep = (size_t)(BK * 2);
    const size_t hstep = (size_t)HALF * K * 2;
    const size_t tstep = 2 * hstep;
    const unsigned ldsw = (unsigned)wid * 1024u;
    const int aoff = lds_byte(wr * 64 + fr, fq * 8), boff = lds_byte(wc * 32 + fr, fq * 8);
#define PG8_SA(b, h) (((b) * 2 + (h)) * HTB)
#define PG8_SB(b, h) ((4 + (b) * 2 + (h)) * HTB)
#define PG8_STAGE(bufoff, gbase, voff) do { _Pragma("unroll") for (int _i = 0; _i < 2; ++_i) \
        __builtin_amdgcn_global_load_lds((const unsigned*)((const char*)(gbase) + (voff)[_i]), (PG8_LAS unsigned*)(lds + (bufoff) + ldsw + _i * 8192), 16, 0, 0); } while (0)
#define PG8_LDA(dst, b, h) do { _Pragma("unroll") for (int m = 0; m < 4; ++m) _Pragma("unroll") for (int k = 0; k < 2; ++k) dst[m][k] = *(const PG8_LAS bf16x8*)(lds + PG8_SA(b, h) + aoff + m * 2048 + k * 1024); } while (0)
#define PG8_LDB(dst, b, h) do { _Pragma("unroll") for (int n = 0; n < 2; ++n) _Pragma("unroll") for (int k = 0; k < 2; ++k) dst[n][k] = *(const PG8_LAS bf16x8*)(lds + PG8_SB(b, h) + boff + n * 2048 + k * 1024); } while (0)
#define PG8_MMA(ai, bj, At, Bt) do { __builtin_amdgcn_s_setprio(1); _Pragma("unroll") for (int m = 0; m < 4; ++m) _Pragma("unroll") for (int n = 0; n < 2; ++n) _Pragma("unroll") for (int k = 0; k < 2; ++k) \
        acc[ai][bj][m][n] = __builtin_amdgcn_mfma_f32_16x16x32_bf16(Bt[n][k], At[m][k], acc[ai][bj][m][n], 0, 0, 0); __builtin_amdgcn_s_setprio(0); } while (0)
#define PG8_WAIT_V(n) asm volatile("s_waitcnt vmcnt(" #n ")" ::: "memory")
#define PG8_WAIT_L(n) asm volatile("s_waitcnt lgkmcnt(" #n ")" ::: "memory")
#define PG8_BAR __builtin_amdgcn_s_barrier()
#define PG8_SCHED __builtin_amdgcn_sched_barrier(0)
    Unit cur, nxt; int ui = 0;
    if (!S.next(0, cur)) return;
    f32x4 acc[2][2][4][2];
#pragma unroll
    for (int a = 0; a < 2; ++a)
#pragma unroll
        for (int b = 0; b < 2; ++b)
#pragma unroll
            for (int m = 0; m < 4; ++m)
#pragma unroll
                for (int n = 0; n < 2; ++n) acc[a][b][m][n] = (f32x4){0.f, 0.f, 0.f, 0.f};
    bf16x8 At[4][2], B0[2][2], B1[2][2];
    const char* cA = (const char*)g.A + (size_t)cur.pm * tstep; const char* cB = (const char*)g.Bt + (size_t)cur.pn * tstep;
    S.a_ready(cur);
    if constexpr (SP2) {
        PG8_STAGE(PG8_SB(0, 0), cB, voffB); PG8_STAGE(PG8_SB(0, 1), cB + hstep, voffB); PG8_STAGE(PG8_SA(0, 0), cA, voffA); PG8_STAGE(PG8_SA(0, 1), cA + hstep, voffA);
        if (wr == 1) PG8_BAR;
        PG8_WAIT_V(2); PG8_BAR;
        PG8_STAGE(PG8_SB(1, 0), cB + kstep, voffB); PG8_STAGE(PG8_SA(1, 0), cA + kstep, voffA); PG8_STAGE(PG8_SB(1, 1), cB + hstep + kstep, voffB);
        PG8_WAIT_V(6); PG8_BAR;
    } else {
        PG8_STAGE(PG8_SB(0, 0), cB, voffB); PG8_STAGE(PG8_SA(0, 0), cA, voffA); PG8_STAGE(PG8_SB(0, 1), cB + hstep, voffB); PG8_STAGE(PG8_SA(0, 1), cA + hstep, voffA);
        if (wr == 1) PG8_BAR;
        PG8_WAIT_V(4); PG8_BAR;
        PG8_STAGE(PG8_SB(1, 0), cB + kstep, voffB); PG8_STAGE(PG8_SA(1, 0), cA + kstep, voffA); PG8_STAGE(PG8_SB(1, 1), cB + hstep + kstep, voffB);
        PG8_WAIT_V(6); PG8_BAR;
    }
    for (;;) {
        const bool has_next = S.next(ui + 1, nxt);
        const char* nA = has_next ? (const char*)g.A + (size_t)nxt.pm * tstep : cA; const char* nB = has_next ? (const char*)g.Bt + (size_t)nxt.pn * tstep : cB;
        for (int t = 0; t < nt; t += 2) {
            const bool last = (t == nt - 2);
            const char* a1 = cA + (size_t)(t + 1) * kstep;
            const char* a2 = last ? nA : cA + (size_t)(t + 2) * kstep; const char* b2 = last ? nB : cB + (size_t)(t + 2) * kstep;
            const char* a3 = a2 + kstep; const char* b3 = b2 + kstep;
            if (last && has_next) S.a_ready(nxt);
            if constexpr (SP2) {
            PG8_LDB(B0, 0, 0); PG8_LDB(B1, 0, 1); PG8_SCHED; PG8_LDA(At, 0, 0); PG8_STAGE(PG8_SA(1, 1), a1 + hstep, voffA);
            PG8_WAIT_V(8); PG8_WAIT_L(0); PG8_BAR; PG8_MMA(0, 0, At, B0); PG8_MMA(0, 1, At, B1); PG8_BAR; PG8_SCHED;
            PG8_LDA(At, 0, 1); PG8_STAGE(PG8_SB(0, 0), b2, voffB); PG8_STAGE(PG8_SB(0, 1), b2 + hstep, voffB); PG8_STAGE(PG8_SA(0, 0), a2, voffA);
            PG8_WAIT_V(8); PG8_WAIT_L(0); PG8_BAR; PG8_MMA(1, 0, At, B0); PG8_MMA(1, 1, At, B1); PG8_BAR; PG8_SCHED;
            PG8_LDB(B0, 1, 0); PG8_LDB(B1, 1, 1); PG8_SCHED; PG8_LDA(At, 1, 0); PG8_STAGE(PG8_SA(0, 1), a2 + hstep, voffA);
            PG8_WAIT_V(8); PG8_WAIT_L(0); PG8_BAR; PG8_MMA(0, 0, At, B0); PG8_MMA(0, 1, At, B1); PG8_BAR; PG8_SCHED;
            PG8_LDA(At, 1, 1); PG8_STAGE(PG8_SB(1, 0), b3, voffB); PG8_STAGE(PG8_SB(1, 1), b3 + hstep, voffB); PG8_STAGE(PG8_SA(1, 0), a3, voffA);
            PG8_WAIT_V(8); PG8_WAIT_L(0); PG8_BAR; PG8_MMA(1, 0, At, B0); PG8_MMA(1, 1, At, B1); PG8_BAR; PG8_SCHED;
            } else {
            PG8_LDB(B0, 0, 0); PG8_SCHED; PG8_LDA(At, 0, 0); PG8_STAGE(PG8_SA(1, 1), a1 + hstep, voffA);
            PG8_WAIT_L(8); PG8_BAR; PG8_WAIT_L(0); PG8_MMA(0, 0, At, B0); PG8_BAR; PG8_SCHED;
            PG8_LDB(B1, 0, 1); PG8_STAGE(PG8_SB(0, 0), b2, voffB);
            PG8_BAR; PG8_WAIT_L(0); PG8_MMA(0, 1, At, B1); PG8_BAR;
            PG8_LDA(At, 0, 1); PG8_STAGE(PG8_SA(0, 0), a2, voffA);
            PG8_BAR; PG8_WAIT_L(0); PG8_MMA(1, 0, At, B0); PG8_BAR; PG8_SCHED;
            PG8_STAGE(PG8_SB(0, 1), b2 + hstep, voffB);
            PG8_WAIT_V(6); PG8_BAR; PG8_MMA(1, 1, At, B1); PG8_BAR;
            PG8_LDB(B0, 1, 0); PG8_SCHED; PG8_LDA(At, 1, 0); PG8_STAGE(PG8_SA(0, 1), a2 + hstep, voffA);
            PG8_WAIT_L(8); PG8_BAR; PG8_WAIT_L(0); PG8_MMA(0, 0, At, B0); PG8_BAR; PG8_SCHED;
            PG8_LDB(B1, 1, 1); PG8_STAGE(PG8_SB(1, 0), b3, voffB);
            PG8_BAR; PG8_WAIT_L(0); PG8_MMA(0, 1, At, B1); PG8_BAR;
            PG8_LDA(At, 1, 1); PG8_STAGE(PG8_SA(1, 0), a3, voffA);
            PG8_BAR; PG8_WAIT_L(0); PG8_MMA(1, 0, At, B0); PG8_BAR; PG8_SCHED;
            PG8_STAGE(PG8_SB(1, 1), b3 + hstep, voffB);
            PG8_WAIT_V(6); PG8_BAR; PG8_MMA(1, 1, At, B1); PG8_BAR;
            }
        }
        if constexpr (ALIGN_EPI) { if (wr == 0) PG8_BAR; }
        if constexpr (!Epi::AFTER_DRAIN) { E(acc, cur, wr, wc, fr, fq); S.done(cur); }
        if (!has_next) break;
#pragma unroll
        for (int a = 0; a < 2; ++a)
#pragma unroll
            for (int b = 0; b < 2; ++b)
#pragma unroll
                for (int m = 0; m < 4; ++m)
#pragma unroll
                    for (int n = 0; n < 2; ++n) acc[a][b][m][n] = (f32x4){0.f, 0.f, 0.f, 0.f};
        cur = nxt; cA = nA; cB = nB; ++ui;
        if constexpr (ALIGN_EPI) { if (wr == 1) PG8_BAR; }
    }
    PG8_WAIT_V(0);
    if constexpr (!ALIGN_EPI) { if (wr == 0) PG8_BAR; }
    PG8_BAR;
    if constexpr (Epi::AFTER_DRAIN) { E.fused(acc, cur, wr, wc, fr, fq, lds, wid, lane); S.done(cur); }
#undef PG8_SA
#undef PG8_SB
#undef PG8_STAGE
#undef PG8_LDA
#undef PG8_LDB
#undef PG8_MMA
#undef PG8_WAIT_V
#undef PG8_WAIT_L
#undef PG8_BAR
#undef PG8_SCHED
}
}


#define LAS __attribute__((address_space(3)))
typedef unsigned short bf16_t;
typedef short bf16x8 __attribute__((ext_vector_type(8)));
typedef short s16x4 __attribute__((ext_vector_type(4)));
typedef float f32x4 __attribute__((ext_vector_type(4)));
typedef unsigned u32x4 __attribute__((ext_vector_type(4)));
typedef unsigned u32x2 __attribute__((ext_vector_type(2)));

constexpr int M_TOK = 81920, M_PROMPT = 65536, DM = 1024, DFF = 2816;
constexpr int LDS_BYTES = 147456;
#ifndef GEMM_ALIGN
#define GEMM_ALIGN true
#endif
#ifndef GEMM_SP2
#define GEMM_SP2 true
#endif
constexpr float NORM_EPS = 1e-6f;

constexpr size_t SZ_WFI = (size_t)5632 * 1024 * 2, SZ_WFO = (size_t)1024 * 2816 * 2;
constexpr size_t WS_WFI = 0;
constexpr size_t WS_WFO = WS_WFI + 4 * SZ_WFI;
constexpr size_t WS_WABI = WS_WFO + 4 * SZ_WFO;
constexpr size_t WS_WABO = WS_WABI + (size_t)3328 * 1024 * 2;
constexpr size_t WS_WATI = WS_WABO + (size_t)1024 * 1024 * 2;
constexpr size_t WS_WATO = WS_WATI + (size_t)3072 * 1024 * 2;
constexpr size_t WS_LORA = WS_WATO + (size_t)1024 * 1024 * 2;
constexpr size_t WS_SGUW = WS_LORA + (size_t)4 * 512 * 64 * 2;
constexpr size_t WS_RKR = WS_SGUW + (size_t)4 * 128 * 128 * 2;
constexpr size_t WS_XN = (WS_RKR + (size_t)2 * M_TOK * 8 * 4 + 4095) & ~(size_t)4095;
constexpr size_t WS_BIG = WS_XN + (size_t)M_TOK * 1024 * 2;
constexpr size_t WS_PUV = WS_BIG;
constexpr size_t WS_PRKVG = WS_PUV + (size_t)M_TOK * 1024 * 2;
constexpr size_t WS_PWA = WS_PRKVG + (size_t)M_TOK * 2048 * 2;
constexpr size_t WS_Y = WS_BIG + (size_t)M_TOK * 3328 * 2;
constexpr size_t WS_END = WS_Y + (size_t)2 * M_TOK * 512 * 2;

constexpr int NSEG = 16, SEGLEN = 16384 / NSEG;
constexpr size_t WS_STL = (WS_END + 4095) & ~(size_t)4095;
constexpr size_t WS_STP = WS_STL + (size_t)16 * NSEG * 4096 * 4;
constexpr size_t WS_STS = WS_STP + (size_t)16 * NSEG * 4096 * 4;
constexpr size_t WS_TS = WS_STS + (size_t)16 * NSEG * 4096 * 4;
constexpr size_t WS_RSA = WS_TS + 4096;
constexpr size_t WS_RSB = WS_RSA + (size_t)M_TOK * 4;
constexpr size_t WS_END2 = WS_RSB + (size_t)M_TOK * 4;
struct Params { const float* in[30]; float* out; unsigned char* ws; };

__device__ __forceinline__ float bflo(unsigned w) { return __uint_as_float(w << 16); }
__device__ __forceinline__ float bfhi(unsigned w) { return __uint_as_float(w & 0xffff0000u); }
__device__ __forceinline__ unsigned pk2(float lo, float hi) { unsigned r; asm("v_cvt_pk_bf16_f32 %0, %1, %2" : "=v"(r) : "v"(lo), "v"(hi)); return r; }
__device__ __forceinline__ void unpack8(const u32x4 w, float* f) { f[0] = bflo(w.x); f[1] = bfhi(w.x); f[2] = bflo(w.y); f[3] = bfhi(w.y); f[4] = bflo(w.z); f[5] = bfhi(w.z); f[6] = bflo(w.w); f[7] = bfhi(w.w); }
__device__ __forceinline__ u32x4 pack8(const float* f) { u32x4 w; w.x = pk2(f[0], f[1]); w.y = pk2(f[2], f[3]); w.z = pk2(f[4], f[5]); w.w = pk2(f[6], f[7]); return w; }
__device__ __forceinline__ float sigmoidf_(float x) { return __builtin_amdgcn_rcpf(1.0f + __expf(-x)); }
__device__ __forceinline__ float siluf_(float x) { return x * sigmoidf_(x); }
__device__ __forceinline__ float gelu_tanh(float x) { const float u = 0.7978845608028654f * (x + 0.044715f * x * x * x); return x * sigmoidf_(2.0f * u); }
__device__ __forceinline__ float tanhf_(float x) { return 1.0f - 2.0f * __builtin_amdgcn_rcpf(__expf(2.0f * x) + 1.0f); }
__device__ __forceinline__ float wave_sum(float x) { x += __shfl_xor(x, 32); x += __shfl_xor(x, 16); x += __shfl_xor(x, 8); x += __shfl_xor(x, 4); x += __shfl_xor(x, 2); x += __shfl_xor(x, 1); return x; }
template <int CTRL> __device__ __forceinline__ float dppf(float x) { return __int_as_float(__builtin_amdgcn_update_dpp(0, __float_as_int(x), CTRL, 0xF, 0xF, true)); }
__device__ __forceinline__ float reduce8(float x) { x += dppf<0xB1>(x); x += dppf<0x4E>(x); x += dppf<0x141>(x); return x; }
typedef short v4i16_t __attribute__((ext_vector_type(4)));
typedef __bf16 bf16x2_t __attribute__((ext_vector_type(2)));
__device__ __forceinline__ s16x4 tr_read(LAS const unsigned char* p) { return __builtin_bit_cast(s16x4, __builtin_amdgcn_ds_read_tr16_b64_v4i16((LAS v4i16_t*)p)); }
__device__ __forceinline__ f32x4 mfma16(bf16x8 a, bf16x8 b, f32x4 c) { return __builtin_amdgcn_mfma_f32_16x16x32_bf16(a, b, c, 0, 0, 0); }

__device__ __forceinline__ int opaque_tid() { int t = threadIdx.x; asm volatile("" : "+v"(t)); return t; }
__device__ __forceinline__ unsigned char* opaque_ptr(unsigned char* p) { size_t z = 0; asm volatile("" : "+s"(z)); return p + z; }
struct EpiSwiglu {
    static constexpr bool PERM = false, AFTER_DRAIN = false;
    bf16_t* H; const float* rowss;
    __device__ __forceinline__ void operator()(const f32x4 (&acc)[2][2][4][2], const pg8::Unit& u, int wr, int wc, int fr, int fq) const {
        const int row0 = u.pm * 256 + wr * 64 + fr, col0 = u.pn * 128 + wc * 32 + 8 * fq;
        float rsv[8];
#pragma unroll
        for (int gi = 0; gi < 8; ++gi) rsv[gi] = rowss ? rowss[row0 + (gi >> 2) * 128 + (gi & 3) * 16] : 0.f;
#pragma unroll
        for (int gi = 0; gi < 8; ++gi) rsv[gi] = rowss ? rsqrtf(rsv[gi] * (1.0f / DM) + NORM_EPS) : 1.0f;
#pragma unroll
        for (int ai = 0; ai < 2; ++ai)
#pragma unroll
            for (int m = 0; m < 4; ++m) {
                const int row = row0 + ai * 128 + m * 16;
                const float rs = rsv[ai * 4 + m];
                bf16_t* rowp = H + (size_t)row * DFF + col0;
                float h[8];
#pragma unroll
                for (int bj = 0; bj < 2; ++bj)
#pragma unroll
                    for (int j = 0; j < 4; ++j) h[bj * 4 + j] = siluf_(acc[ai][bj][m][0][j] * rs) * (acc[ai][bj][m][1][j] * rs);
                *(u32x4*)rowp = pack8(h);
                asm volatile("" ::: "memory");
            }
    }
};
struct EpiResid {
    static constexpr bool PERM = false, AFTER_DRAIN = false;
    float* X; float scale; bf16_t* XG; const float* g; float* rowss;
    __device__ __forceinline__ void operator()(const f32x4 (&acc)[2][2][4][2], const pg8::Unit& u, int wr, int wc, int fr, int fq) const {
        const int row0 = u.pm * 256 + wr * 64 + fr, col0 = u.pn * 256 + wc * 32 + 4 * fq;
        f32x4 gv[2][2];
#pragma unroll
        for (int bj = 0; bj < 2; ++bj)
#pragma unroll
            for (int n = 0; n < 2; ++n) gv[bj][n] = XG ? *(const f32x4*)(g + col0 + bj * 128 + n * 16) : (f32x4){0.f, 0.f, 0.f, 0.f};
        f32x4 xin[2][2][2];
#pragma unroll
        for (int gi = 0; gi < 9; ++gi) {
            if (gi < 8) {
                const float* rowp = X + (size_t)(row0 + (gi >> 2) * 128 + (gi & 3) * 16) * DM + col0;
#pragma unroll
                for (int bj = 0; bj < 2; ++bj)
#pragma unroll
                    for (int n = 0; n < 2; ++n) xin[gi & 1][bj][n] = *(const f32x4*)(rowp + bj * 128 + n * 16);
            }
            if (gi > 0) {
                const int gp = gi - 1, ai = gp >> 2, m = gp & 3;
                const int row = row0 + ai * 128 + m * 16;
                float* rowp = X + (size_t)row * DM + col0;
                float ssq = 0.f;
#pragma unroll
                for (int bj = 0; bj < 2; ++bj)
#pragma unroll
                    for (int n = 0; n < 2; ++n) { f32x4 v = xin[gp & 1][bj][n]; v += acc[ai][bj][m][n] * scale; *(f32x4*)(rowp + bj * 128 + n * 16) = v;
                        if (XG) { ssq += (v[0] * v[0] + v[1] * v[1]) + (v[2] * v[2] + v[3] * v[3]); const f32x4 o = v * gv[bj][n]; u32x2 w; w.x = pk2(o[0], o[1]); w.y = pk2(o[2], o[3]);
                            *(u32x2*)(XG + (size_t)row * DM + col0 + bj * 128 + n * 16) = w; } }
                if (XG) { ssq += __shfl_xor(ssq, 16); ssq += __shfl_xor(ssq, 32);
                    if (fq == 0) __hip_atomic_fetch_add(rowss + row, ssq, __ATOMIC_RELAXED, __HIP_MEMORY_SCOPE_AGENT); }
            }
            asm volatile("" ::: "memory");
        }
    }
};
struct EpiSplit {
    static constexpr bool PERM = true, AFTER_DRAIN = false;
    bf16_t* b0; int ld0, t0; bf16_t* b1; int ld1, t1; bf16_t* b2; int ld2; const float* rowss;
    __device__ __forceinline__ void operator()(const f32x4 (&acc)[2][2][4][2], const pg8::Unit& u, int wr, int wc, int fr, int fq) const {
        bf16_t* base; int ld, ct;
        if (u.pn < t0) { base = b0; ld = ld0; ct = u.pn; } else if (u.pn < t1) { base = b1; ld = ld1; ct = u.pn - t0; } else { base = b2; ld = ld2; ct = u.pn - t1; }
        const int row0 = u.pm * 256 + wr * 64 + fr, col0 = ct * 256 + wc * 32 + 8 * fq;
        float rsv[8];
#pragma unroll
        for (int gi = 0; gi < 8; ++gi) rsv[gi] = rowss[row0 + (gi >> 2) * 128 + (gi & 3) * 16];
#pragma unroll
        for (int gi = 0; gi < 8; ++gi) rsv[gi] = rsqrtf(rsv[gi] * (1.0f / DM) + NORM_EPS);
#pragma unroll
        for (int ai = 0; ai < 2; ++ai)
#pragma unroll
            for (int m = 0; m < 4; ++m) {
                const int row = row0 + ai * 128 + m * 16;
                const float rs = rsv[ai * 4 + m];
                bf16_t* rowp = base + (size_t)row * ld + col0;
#pragma unroll
                for (int bj = 0; bj < 2; ++bj) {
                    const f32x4 v0 = acc[ai][bj][m][0] * rs, v1 = acc[ai][bj][m][1] * rs;
                    u32x4 w; w.x = pk2(v0[0], v0[1]); w.y = pk2(v0[2], v0[3]); w.z = pk2(v1[0], v1[1]); w.w = pk2(v1[2], v1[3]);
                    *(u32x4*)(rowp + bj * 128) = w;
                }
                asm volatile("" ::: "memory");
            }
    }
};

template <int MAP> __device__ __forceinline__ int src_col(int s) {
    if (MAP == 0) return s;
    const int pn = s >> 8, bj = (s >> 7) & 1, wc = (s >> 5) & 3, n = (s >> 4) & 1, fq = (s >> 2) & 3, jj = s & 3;
    return n * DFF + 128 * pn + 32 * wc + 8 * fq + 4 * bj + jj;
}
template <int MAP> __device__ void convert_T(const float* __restrict__ src, bf16_t* __restrict__ dst, int K, int N, LAS float* tile, int rot) {
    const int tk = K / 64, tn = N / 64, nt = tk * tn, tid = opaque_tid(), G = gridDim.x;
    const int kk0 = tid >> 4, sg = tid & 15;
    int t = (int)((blockIdx.x + rot) % G);
    float4 va = make_float4(0.f, 0.f, 0.f, 0.f), vb = va;
    if (t < nt) { const int k0 = (t % tk) * 64, s0 = (t / tk) * 64; const int c = src_col<MAP>(s0 + sg * 4);
        va = *(const float4*)(src + (size_t)(k0 + kk0) * N + c); vb = *(const float4*)(src + (size_t)(k0 + kk0 + 32) * N + c); }
    for (; t < nt; t += G) {
        const int k0 = (t % tk) * 64, s0 = (t / tk) * 64;
        { LAS float* tp = tile + kk0 * 65 + sg * 4; tp[0] = va.x; tp[1] = va.y; tp[2] = va.z; tp[3] = va.w;
          LAS float* tq = tile + (kk0 + 32) * 65 + sg * 4; tq[0] = vb.x; tq[1] = vb.y; tq[2] = vb.z; tq[3] = vb.w; }
        if (t + G < nt) {
            const int t2 = t + G, k2 = (t2 % tk) * 64, s2 = (t2 / tk) * 64; const int c = src_col<MAP>(s2 + sg * 4);
            va = *(const float4*)(src + (size_t)(k2 + kk0) * N + c); vb = *(const float4*)(src + (size_t)(k2 + kk0 + 32) * N + c); }
        asm volatile("s_waitcnt lgkmcnt(0)" ::: "memory"); __builtin_amdgcn_s_barrier(); asm volatile("" ::: "memory");
        {
            const int slot = tid >> 3, kc = tid & 7; float f[8];
#pragma unroll
            for (int i = 0; i < 8; ++i) f[i] = tile[(kc * 8 + i) * 65 + slot];
            *(u32x4*)(dst + (size_t)(s0 + slot) * K + k0 + kc * 8) = pack8(f);
        }
        asm volatile("s_waitcnt lgkmcnt(0)" ::: "memory"); __builtin_amdgcn_s_barrier(); asm volatile("" ::: "memory");
    }
}

__device__ void norm_rows(const float* xa, const float* xb, int split, float* xcopy, const float* g1, float* x1out, const float* g2, bf16_t* xn) {
    const int tid_ = opaque_tid(), lane = tid_ & 63, wave = __builtin_amdgcn_readfirstlane(tid_ >> 6);
    const int stride = gridDim.x * 8;
    for (int row0 = blockIdx.x * 8 + wave; row0 < M_TOK; row0 += 2 * stride) {
        int rows[2]; rows[0] = row0; rows[1] = (row0 + stride < M_TOK) ? row0 + stride : row0;
        f32x4 v[2][4]; float ss[2] = {0.f, 0.f};
#pragma unroll
        for (int q = 0; q < 2; ++q) { const int row = rows[q];
            const float* src = (row < split) ? xa + (size_t)row * DM : xb + (size_t)(row - split) * DM;
#pragma unroll
            for (int i = 0; i < 4; ++i) v[q][i] = *(const f32x4*)(src + i * 256 + lane * 4); }
#pragma unroll
        for (int q = 0; q < 2; ++q) {
#pragma unroll
            for (int i = 0; i < 4; ++i) ss[q] += v[q][i][0] * v[q][i][0] + v[q][i][1] * v[q][i][1] + v[q][i][2] * v[q][i][2] + v[q][i][3] * v[q][i][3];
            if (xcopy) {
#pragma unroll
                for (int i = 0; i < 4; ++i) *(f32x4*)(xcopy + (size_t)rows[q] * DM + i * 256 + lane * 4) = v[q][i];
            }
        }
        ss[0] = wave_sum(ss[0]); ss[1] = wave_sum(ss[1]);
        float r[2]; r[0] = rsqrtf(ss[0] * (1.0f / DM) + NORM_EPS); r[1] = rsqrtf(ss[1] * (1.0f / DM) + NORM_EPS);
        if (g1) {
            float s2[2] = {0.f, 0.f};
#pragma unroll
            for (int i = 0; i < 4; ++i) { const f32x4 g = *(const f32x4*)(g1 + i * 256 + lane * 4);
#pragma unroll
                for (int q = 0; q < 2; ++q) { v[q][i] = v[q][i] * r[q] * g; *(f32x4*)(x1out + (size_t)rows[q] * DM + i * 256 + lane * 4) = v[q][i];
                    s2[q] += v[q][i][0] * v[q][i][0] + v[q][i][1] * v[q][i][1] + v[q][i][2] * v[q][i][2] + v[q][i][3] * v[q][i][3]; } }
            s2[0] = wave_sum(s2[0]); s2[1] = wave_sum(s2[1]);
            r[0] = rsqrtf(s2[0] * (1.0f / DM) + NORM_EPS); r[1] = rsqrtf(s2[1] * (1.0f / DM) + NORM_EPS);
        }
        if (g2) {
#pragma unroll
            for (int i = 0; i < 4; ++i) { const f32x4 g = *(const f32x4*)(g2 + i * 256 + lane * 4);
#pragma unroll
                for (int q = 0; q < 2; ++q) { const f32x4 o = v[q][i] * r[q] * g;
                    u32x2 w; w.x = pk2(o[0], o[1]); w.y = pk2(o[2], o[3]); *(u32x2*)(xn + (size_t)rows[q] * DM + i * 256 + lane * 4) = w; } }
        }
    }
}

__device__ void sgu_item(const Params& PP, int chunk, LAS unsigned char* lds) {
    Params P = PP; P.ws = opaque_ptr(PP.ws);
    const int tid = opaque_tid(), lane = tid & 63, wave = __builtin_amdgcn_readfirstlane(tid >> 6), l15 = lane & 15, quad = lane >> 4;
    constexpr int PITCH = 1056;
    const bf16_t* Puv = (const bf16_t*)(P.ws + WS_PUV);
    bf16_t* MO = (bf16_t*)(P.ws + WS_XN);
    const size_t row0 = (size_t)chunk * 128;
    {
        float gn[8];
        { const f32x4 a = *(const f32x4*)(P.in[12] + lane * 8), b = *(const f32x4*)(P.in[12] + lane * 8 + 4); gn[0] = a[0]; gn[1] = a[1]; gn[2] = a[2]; gn[3] = a[3]; gn[4] = b[0]; gn[5] = b[1]; gn[6] = b[2]; gn[7] = b[3]; }
        for (int i = 0; i < 16; ++i) {
            const int p = wave * 16 + i;
            const u32x4 raw = *(const u32x4*)(Puv + (row0 + p) * 1024 + 512 + lane * 8);
            float v[8]; unpack8(raw, v); float ss = 0.f;
#pragma unroll
            for (int e = 0; e < 8; ++e) { v[e] = gelu_tanh(v[e]); ss += v[e] * v[e]; }
            ss = wave_sum(ss);
            const float r = rsqrtf(ss * (1.0f / 512.0f) + NORM_EPS);
#pragma unroll
            for (int e = 0; e < 8; ++e) v[e] = v[e] * r * gn[e];
            *(LAS u32x4*)(lds + p * PITCH + lane * 16) = pack8(v);
        }
    }
    __syncthreads();
    const int g = wave >> 1, cbase = (wave >> 1) * 128 + (wave & 1) * 64;
    const bf16_t* Wg = (const bf16_t*)(P.ws + WS_SGUW) + (size_t)g * 128 * 128;
    const int r4 = l15 >> 2, c4 = l15 & 3;
    for (int qh = 0; qh < 2; ++qh) {
        f32x4 acc[4][4];
#pragma unroll
        for (int a = 0; a < 4; ++a)
#pragma unroll
            for (int b = 0; b < 4; ++b) acc[a][b] = (f32x4){0.f, 0.f, 0.f, 0.f};
#pragma unroll
        for (int ks = 0; ks < 4; ++ks) {
            bf16x8 bfr[4];
#pragma unroll
            for (int qt = 0; qt < 4; ++qt) bfr[qt] = *(const bf16x8*)(Wg + (size_t)(qh * 64 + qt * 16 + l15) * 128 + ks * 32 + quad * 8);
#pragma unroll
            for (int ct = 0; ct < 4; ++ct) {
                LAS const unsigned char* ap = lds + (ks * 32 + quad * 8 + r4) * PITCH + (cbase + ct * 16 + 4 * c4) * 2;
                const s16x4 lo = tr_read(ap), hi = tr_read(ap + 4 * PITCH);
                const bf16x8 a = {lo[0], lo[1], lo[2], lo[3], hi[0], hi[1], hi[2], hi[3]};
#pragma unroll
                for (int qt = 0; qt < 4; ++qt) acc[ct][qt] = mfma16(a, bfr[qt], acc[ct][qt]);
            }
        }
#pragma unroll
        for (int qt = 0; qt < 4; ++qt) {
            const int q = qh * 64 + qt * 16 + l15;
            const float bq = P.in[14][g * 128 + q];
#pragma unroll
            for (int ct = 0; ct < 4; ++ct) {
                const int c = cbase + ct * 16 + quad * 4;
                const u32x2 ur = *(const u32x2*)(Puv + (row0 + q) * 1024 + c);
                const float u0 = gelu_tanh(bflo(ur.x)), u1 = gelu_tanh(bfhi(ur.x)), u2 = gelu_tanh(bflo(ur.y)), u3 = gelu_tanh(bfhi(ur.y));
                u32x2 w; w.x = pk2(u0 * (acc[ct][qt][0] + bq), u1 * (acc[ct][qt][1] + bq)); w.y = pk2(u2 * (acc[ct][qt][2] + bq), u3 * (acc[ct][qt][3] + bq));
                *(u32x2*)(MO + (row0 + q) * 1024 + c) = w;
            }
        }
    }
    __syncthreads();
}

template <int LPR> __device__ __forceinline__ float reduce_row(float x) {
    x += dppf<0xB1>(x); x += dppf<0x4E>(x); x += dppf<0x141>(x);
    if (LPR == 16) x += dppf<0x140>(x);
    return x;
}
__device__ __forceinline__ float reduce32(float x) {
    x += dppf<0xB1>(x); x += dppf<0x4E>(x); x += dppf<0x141>(x); x += dppf<0x140>(x); x += __shfl_xor(x, 16); return x;
}
__device__ __forceinline__ void lds_barrier() { asm volatile("s_waitcnt lgkmcnt(0)" ::: "memory"); __builtin_amdgcn_s_barrier(); asm volatile("" ::: "memory"); }
template <int NV> struct ScanSet { f32x4 kk[NV], w[NV], ka[NV], kp[NV], r[NV]; float vv; };
template <int NV> __device__ __forceinline__ void scan_load(ScanSet<NV>& t, LAS const float* KK, LAS const float* Wd, LAS const float* KKA, LAS const float* KP, LAS const float* Rr, LAS const float* Vv, int o, int ov, bool want_y) {
#pragma unroll
    for (int u = 0; u < NV; ++u) { t.kk[u] = *(LAS const f32x4*)(KK + o + u * 32); t.w[u] = *(LAS const f32x4*)(Wd + o + u * 32); t.ka[u] = *(LAS const f32x4*)(KKA + o + u * 32); t.kp[u] = *(LAS const f32x4*)(KP + o + u * 32); }
    if (want_y) {
#pragma unroll
        for (int u = 0; u < NV; ++u) t.r[u] = *(LAS const f32x4*)(Rr + o + u * 32);
    }
    t.vv = Vv[ov];
}
typedef float f32x2v __attribute__((ext_vector_type(2)));
template <int LPR, int NV> __device__ __forceinline__ float scan_step(float* S, const ScanSet<NV>& t, bool want_y, float& ypart) {
    f32x2v acc = {0.f, 0.f};
#pragma unroll
    for (int u = 0; u < NV; ++u)
#pragma unroll
        for (int hh = 0; hh < 2; ++hh) { const f32x2v s2 = {S[4 * u + 2 * hh], S[4 * u + 2 * hh + 1]}, k2 = {t.kk[u][2 * hh], t.kk[u][2 * hh + 1]}; acc = s2 * k2 + acc; }
    float sa = acc.x + acc.y, yb = ypart;
    sa += dppf<0xB1>(sa); yb += dppf<0xB1>(yb); sa += dppf<0x4E>(sa); yb += dppf<0x4E>(yb); sa += dppf<0x141>(sa); yb += dppf<0x141>(yb);
    const f32x2v sa2 = {sa, sa}, vv2 = {t.vv, t.vv};
#pragma unroll
    for (int u = 0; u < NV; ++u)
#pragma unroll
        for (int hh = 0; hh < 2; ++hh) {
            f32x2v s2 = {S[4 * u + 2 * hh], S[4 * u + 2 * hh + 1]};
            const f32x2v w2 = {t.w[u][2 * hh], t.w[u][2 * hh + 1]}, kp2 = {t.kp[u][2 * hh], t.kp[u][2 * hh + 1]}, ka2 = {t.ka[u][2 * hh], t.ka[u][2 * hh + 1]};
            f32x2v tt = vv2 * kp2; tt = tt - sa2 * ka2;
            s2 = s2 * w2 + tt;
            S[4 * u + 2 * hh] = s2.x; S[4 * u + 2 * hh + 1] = s2.y;
        }
    if (want_y) {
        f32x2v yacc = {0.f, 0.f};
#pragma unroll
        for (int u = 0; u < NV; ++u)
#pragma unroll
            for (int hh = 0; hh < 2; ++hh) { const f32x2v s2 = {S[4 * u + 2 * hh], S[4 * u + 2 * hh + 1]}, r2 = {t.r[u][2 * hh], t.r[u][2 * hh + 1]}; yacc = s2 * r2 + yacc; }
        ypart = yacc.x + yacc.y;
    }
    return yb;
}
struct ScanSet2 { f32x4 kk, w, ka, kp, r; float vv0, vv1; };
__device__ __forceinline__ void scan_load2(ScanSet2& t, LAS const float* KK, LAS const float* Wd, LAS const float* KKA, LAS const float* KP, LAS const float* Rr, LAS const float* Vv, int o, int ov, bool want_y) {
    t.kk = *(LAS const f32x4*)(KK + o); t.w = *(LAS const f32x4*)(Wd + o); t.ka = *(LAS const f32x4*)(KKA + o); t.kp = *(LAS const f32x4*)(KP + o);
    if (want_y) t.r = *(LAS const f32x4*)(Rr + o);
    t.vv0 = Vv[ov]; t.vv1 = Vv[ov + 4];
}
__device__ __forceinline__ float dpp16(float x) { x += dppf<0xB1>(x); x += dppf<0x4E>(x); x += dppf<0x141>(x); x += dppf<0x140>(x); return x; }
__device__ __forceinline__ void scan_step2(f32x2v* SS, const ScanSet2& t, bool want_y, float& y0, float& y1, float& yr0, float& yr1) {
    f32x2v a2 = SS[0] * (f32x2v){t.kk[0], t.kk[0]};
#pragma unroll
    for (int i = 1; i < 4; ++i) a2 = SS[i] * (f32x2v){t.kk[i], t.kk[i]} + a2;
    float a0 = a2.x, a1 = a2.y, b0 = y0, b1 = y1;
#define SCAN_OPAQUE4() asm("" : "+v"(a0), "+v"(a1), "+v"(b0), "+v"(b1))
    SCAN_OPAQUE4();
    a0 += dppf<0xB1>(a0); a1 += dppf<0xB1>(a1); b0 += dppf<0xB1>(b0); b1 += dppf<0xB1>(b1); SCAN_OPAQUE4();
    a0 += dppf<0x4E>(a0); a1 += dppf<0x4E>(a1); b0 += dppf<0x4E>(b0); b1 += dppf<0x4E>(b1); SCAN_OPAQUE4();
    a0 += dppf<0x141>(a0); a1 += dppf<0x141>(a1); b0 += dppf<0x141>(b0); b1 += dppf<0x141>(b1); SCAN_OPAQUE4();
    a0 += dppf<0x140>(a0); a1 += dppf<0x140>(a1); b0 += dppf<0x140>(b0); b1 += dppf<0x140>(b1); SCAN_OPAQUE4();
#undef SCAN_OPAQUE4
    yr0 = b0; yr1 = b1;
    const f32x2v sa2 = {a0, a1}, vv2 = {t.vv0, t.vv1};
#pragma unroll
    for (int i = 0; i < 4; ++i) {
        f32x2v tt = vv2 * (f32x2v){t.kp[i], t.kp[i]};
        tt = tt - sa2 * (f32x2v){t.ka[i], t.ka[i]};
        SS[i] = SS[i] * (f32x2v){t.w[i], t.w[i]} + tt;
    }
    if (want_y) {
        f32x2v p2 = SS[0] * (f32x2v){t.r[0], t.r[0]};
#pragma unroll
        for (int i = 1; i < 4; ++i) p2 = SS[i] * (f32x2v){t.r[i], t.r[i]} + p2;
        y0 = p2.x; y1 = p2.y;
    }
}
template <int LPR> __device__ void scan_item(const Params& PP, int seq, int h, int dir, int rhalf, int tbeg, int tlen, int flags, const float* sin, float* sout, LAS unsigned char* lds) {
    Params P = PP; P.ws = opaque_ptr(PP.ws);
    constexpr int KPL = 64 / LPR, RPW = 64 / LPR, NV = KPL / 4;
    const int tid = opaque_tid(), lane = tid & 63, wave = __builtin_amdgcn_readfirstlane(tid >> 6), l15 = lane & 15, quad = lane >> 4;
    const int Tseq = seq < 32 ? 2048 : 16384;
    const size_t base = seq < 32 ? (size_t)seq * 2048 : (size_t)M_PROMPT;
    const bf16_t* Prkvg = (const bf16_t*)(P.ws + WS_PRKVG);
    const bf16_t* Pwa = (const bf16_t*)(P.ws + WS_PWA);
    bf16_t* Yd = (bf16_t*)(P.ws + WS_Y) + (size_t)dir * M_TOK * 512;
    float* RKR = (float*)(P.ws + WS_RKR) + (size_t)dir * M_TOK * 8;
    LAS bf16_t* RAW0 = (LAS bf16_t*)lds;
    LAS bf16_t* ZROW = (LAS bf16_t*)(lds + 21760);
    LAS float* Wd = (LAS float*)(lds + 22528);
    LAS float* Aa = Wd + 1024; LAS float* Rr = Aa + 1024; LAS float* KP = Rr + 1024; LAS float* Vv = KP + 1024; LAS float* KK = Vv + 1024; LAS float* KKA = KK + 1024; LAS float* Yc = KKA + 1024;
    if (tid < 160) ((LAS unsigned*)ZROW)[tid] = 0u;
    LAS bf16_t* ALDS = (LAS bf16_t*)(lds + 55296);
    const int j_a = tid / 40, seg_a = (tid % 40) >> 3, c8_a = tid & 7;
    const int idx_b = tid + 512, j_b = idx_b / 40, seg_b = (idx_b % 40) >> 3, c8_b = idx_b & 7;
    const bool has_b = idx_b < 640;
    const int coff_a = seg_a < 3 ? seg_a * 512 + h * 64 + c8_a * 8 : dir * 128 + (seg_a - 3) * 64 + c8_a * 8;
    const int coff_b = seg_b < 3 ? seg_b * 512 + h * 64 + c8_b * 8 : dir * 128 + (seg_b - 3) * 64 + c8_b * 8;
    const int dst_a = (j_a + 1) * 320 + seg_a * 64 + c8_a * 8, dst_b = (j_b + 1) * 320 + seg_b * 64 + c8_b * 8;
    const bf16_t* src_a = (seg_a < 3 ? Prkvg + base * 2048 : Pwa + base * 256) + coff_a; const int ld_a = seg_a < 3 ? 2048 : 256;
    const bf16_t* src_b = (seg_b < 3 ? Prkvg + base * 2048 : Pwa + base * 256) + coff_b; const int ld_b = seg_b < 3 ? 2048 : 256;
    const int ltype = wave >> 2, lch = (wave & 3) * 16 + l15;
    const bf16_t* Wt = (const bf16_t*)(P.ws + WS_LORA) + (size_t)(dir * 2 + ltype) * 512 * 64 + (size_t)(h * 64 + lch) * 64;
    const bf16x8 lb0 = *(const bf16x8*)(Wt + quad * 8), lb1 = *(const bf16x8*)(Wt + 32 + quad * 8);
    const float lbias = ltype == 0 ? P.in[17][dir * 512 + h * 64 + lch] : P.in[19][dir * 512 + h * 64 + lch];
    const int tk = tid >> 5, c2 = tid & 31;
    float mu_r[2], mu_k[2], mu_v[2], k_k[2], k_a[2], r_k[2];
#pragma unroll
    for (int e = 0; e < 2; ++e) { const int ch = h * 64 + 2 * c2 + e;
        mu_r[e] = P.in[15][dir * 1536 + ch]; mu_k[e] = P.in[15][dir * 1536 + 512 + ch]; mu_v[e] = P.in[15][dir * 1536 + 1024 + ch];
        k_k[e] = P.in[21][ch]; k_a[e] = P.in[22][ch]; r_k[e] = P.in[23][ch]; }
    float amu[2][2];
#pragma unroll
    for (int ty = 0; ty < 2; ++ty)
#pragma unroll
        for (int e = 0; e < 2; ++e) amu[ty][e] = P.in[16][dir * 128 + ty * 64 + 2 * c2 + e];
#define SCAN_BUILD_A(RAWN, PREV0) do { \
        LAS const bf16_t* cur_ = (RAWN) + (tk + 1) * 320 + 192 + 2 * c2; \
        LAS const bf16_t* prv_ = (tk > 0 ? (RAWN) + tk * 320 : (PREV0)) + 192 + 2 * c2; \
        _Pragma("unroll") for (int ty = 0; ty < 2; ++ty) { \
            const unsigned xc_ = *(LAS const unsigned*)(cur_ + ty * 64), xp_ = *(LAS const unsigned*)(prv_ + ty * 64); \
            float z0_ = bflo(xc_) + (bflo(xp_) - bflo(xc_)) * amu[ty][0], z1_ = bfhi(xc_) + (bfhi(xp_) - bfhi(xc_)) * amu[ty][1]; \
            if (ty == 0) { z0_ = tanhf_(z0_); z1_ = tanhf_(z1_); } \
            *(LAS unsigned*)(ALDS + ty * 1152 + tk * 72 + 2 * c2) = pk2(z0_, z1_); } } while (0)
    static_assert(LPR == 16, "two rows per lane, 16 lanes per row");
    const int srow = wave * 8 + (lane >> 4), sq = lane & 15;
    f32x2v SS[4];
#pragma unroll
    for (int i = 0; i < 4; ++i) { const int kidx = sq * 4 + i;
        SS[i].x = (flags & 1) ? (kidx == srow ? 1.f : 0.f) : (sin ? sin[srow * 64 + kidx] : 0.f);
        SS[i].y = (flags & 1) ? (kidx == srow + 4 ? 1.f : 0.f) : (sin ? sin[(srow + 4) * 64 + kidx] : 0.f); }
    const int nch = tlen / 16;
    const int tstep = dir == 0 ? 16 : -16;
    const int tfirst = dir == 0 ? tbeg : tbeg + tlen - 16;
    const int tprev = dir == 0 ? tbeg - 1 : tbeg + tlen;
    const bool has_prev = tprev >= 0 && tprev < Tseq;
    if (has_prev && tid < 40) {
        const int sg = tid >> 3, c8 = tid & 7;
        const bf16_t* sp = sg < 3 ? Prkvg + (base + tprev) * 2048 + sg * 512 + h * 64 + c8 * 8 : Pwa + (base + tprev) * 256 + dir * 128 + (sg - 3) * 64 + c8 * 8;
        *(LAS u32x4*)(RAW0 + 5440 + 16 * 320 + sg * 64 + c8 * 8) = *(const u32x4*)sp;
    }
    const bool in_on = (flags & 2) == 0, wr_y = (flags & 4) != 0, wr_rk = (flags & 8) != 0;
#define SCAN_TOK(t0, j) (dir == 0 ? (t0) + (j) : (t0) + 15 - (j))
    u32x4 pre_a, pre_b = (u32x4){0u, 0u, 0u, 0u};
    {
        pre_a = *(const u32x4*)(src_a + (size_t)SCAN_TOK(tfirst, j_a) * ld_a);
        if (has_b) pre_b = *(const u32x4*)(src_b + (size_t)SCAN_TOK(tfirst, j_b) * ld_b);
        *(LAS u32x4*)(RAW0 + dst_a) = pre_a;
        if (has_b) *(LAS u32x4*)(RAW0 + dst_b) = pre_b;
        if (nch > 1) {
            pre_a = *(const u32x4*)(src_a + (size_t)SCAN_TOK(tfirst + tstep, j_a) * ld_a);
            if (has_b) pre_b = *(const u32x4*)(src_b + (size_t)SCAN_TOK(tfirst + tstep, j_b) * ld_b);
        }
    }
    __syncthreads();
    SCAN_BUILD_A(RAW0, (has_prev ? RAW0 + 5440 + 16 * 320 : ZROW));
    lds_barrier();
    u32x4 ypend = (u32x4){0u, 0u, 0u, 0u}; bf16_t* ypend_ptr = nullptr;
    for (int c = 0; c < nch; ++c) {
        LAS bf16_t* RAW = RAW0 + (c & 1) * 5440;
        LAS bf16_t* RAWp = RAW0 + ((c & 1) ^ 1) * 5440;
        const int t0 = tfirst + c * tstep;
        {
            bf16x8 af[2];
#pragma unroll
            for (int ks = 0; ks < 2; ++ks) af[ks] = *(LAS const bf16x8*)(ALDS + ltype * 1152 + l15 * 72 + ks * 32 + quad * 8);
            f32x4 d = mfma16(af[0], lb0, (f32x4){0.f, 0.f, 0.f, 0.f});
            d = mfma16(af[1], lb1, d);
            LAS float* dstp = (ltype == 0 ? Wd : Aa) + lch;
#pragma unroll
            for (int jj = 0; jj < 4; ++jj) { const float sg = sigmoidf_(lbias + d[jj]); dstp[(quad * 4 + jj) * 64] = ltype == 0 ? __expf(-0.6065306597126334f * sg) : sg; }
        }
        {
            LAS const bf16_t* cur = RAW + (tk + 1) * 320 + 2 * c2;
            LAS const bf16_t* prv = (tk > 0 ? RAW + tk * 320 : ((c > 0 || has_prev) ? RAWp + 16 * 320 : ZROW)) + 2 * c2;
            const unsigned rc = *(LAS const unsigned*)(cur), rp = *(LAS const unsigned*)(prv);
            const unsigned kc = *(LAS const unsigned*)(cur + 64), kq = *(LAS const unsigned*)(prv + 64);
            const unsigned vc = *(LAS const unsigned*)(cur + 128), vp = *(LAS const unsigned*)(prv + 128);
            const int o = tk * 64 + 2 * c2;
            Rr[o] = bflo(rc) + (bflo(rp) - bflo(rc)) * mu_r[0]; Rr[o + 1] = bfhi(rc) + (bfhi(rp) - bfhi(rc)) * mu_r[1];
            KP[o] = bflo(kc) + (bflo(kq) - bflo(kc)) * mu_k[0]; KP[o + 1] = bfhi(kc) + (bfhi(kq) - bfhi(kc)) * mu_k[1];
            Vv[o] = in_on ? bflo(vc) + (bflo(vp) - bflo(vc)) * mu_v[0] : 0.f; Vv[o + 1] = in_on ? bfhi(vc) + (bfhi(vp) - bfhi(vc)) * mu_v[1] : 0.f;
        }
        lds_barrier();
        float rk_keep;
        {
            const int o = tk * 64 + 2 * c2;
            const float kz0 = KP[o], kz1 = KP[o + 1], a0 = Aa[o], a1 = Aa[o + 1];
            const float q0 = kz0 * k_k[0], q1 = kz1 * k_k[1];
            const float kp0 = kz0 * (1.0f + (a0 - 1.0f) * k_a[0]), kp1 = kz1 * (1.0f + (a1 - 1.0f) * k_a[1]);
            const float ss = reduce32(q0 * q0 + q1 * q1);
            const float rk = reduce32(Rr[o] * kp0 * r_k[0] + Rr[o + 1] * kp1 * r_k[1]);
            const float inv = 1.0f / fmaxf(sqrtf(ss), 1e-12f);
            const float kk0 = q0 * inv, kk1 = q1 * inv;
            KK[o] = kk0; KK[o + 1] = kk1; KKA[o] = kk0 * a0; KKA[o + 1] = kk1 * a1;
            KP[o] = kp0; KP[o + 1] = kp1;
            rk_keep = rk;
        }
        if (c + 1 < nch) {
            *(LAS u32x4*)(RAWp + dst_a) = pre_a;
            if (has_b) *(LAS u32x4*)(RAWp + dst_b) = pre_b;
            if (c + 2 < nch) {
                pre_a = *(const u32x4*)(src_a + (size_t)SCAN_TOK(t0 + 2 * tstep, j_a) * ld_a);
                if (has_b) pre_b = *(const u32x4*)(src_b + (size_t)SCAN_TOK(t0 + 2 * tstep, j_b) * ld_b);
            }
        }
        if (wr_rk && c2 == 0) RKR[(base + SCAN_TOK(t0, tk)) * 8 + h] = rk_keep;
        if (ypend_ptr) *(u32x4*)ypend_ptr = ypend;
        lds_barrier();
        if (c + 1 < nch) SCAN_BUILD_A(RAWp, RAW + 16 * 320);
        {
            ScanSet2 sa_, sb_;
            scan_load2(sa_, KK, Wd, KKA, KP, Rr, Vv, sq * 4, srow, wr_y);
            float yk = 0.f, zk = 0.f, y0 = 0.f, y1 = 0.f, yr0, yr1;
#pragma unroll 1
            for (int jo = 0; jo < 16; jo += 2) {
                scan_load2(sb_, KK, Wd, KKA, KP, Rr, Vv, (jo + 1) * 64 + sq * 4, (jo + 1) * 64 + srow, wr_y);
                scan_step2(SS, sa_, wr_y, y0, y1, yr0, yr1);
                if (jo > 0 && sq == jo - 1) { yk = yr0; zk = yr1; }
                if (jo + 2 < 16) scan_load2(sa_, KK, Wd, KKA, KP, Rr, Vv, (jo + 2) * 64 + sq * 4, (jo + 2) * 64 + srow, wr_y);
                scan_step2(SS, sb_, wr_y, y0, y1, yr0, yr1);
                if (sq == jo) { yk = yr0; zk = yr1; }
            }
            yr0 = dpp16(y0); yr1 = dpp16(y1);
            if (sq == 15) { yk = yr0; zk = yr1; }
            Yc[sq * 64 + srow] = yk; Yc[sq * 64 + srow + 4] = zk;
        }
        lds_barrier();
        {
            const bool wr = wr_y && tid < 128;
            if (wr) {
                const int tq = tid >> 3, c8 = tid & 7; float f[8];
                const f32x4 a = *(LAS const f32x4*)(Yc + tq * 64 + c8 * 8), b = *(LAS const f32x4*)(Yc + tq * 64 + c8 * 8 + 4);
                f[0] = a[0]; f[1] = a[1]; f[2] = a[2]; f[3] = a[3]; f[4] = b[0]; f[5] = b[1]; f[6] = b[2]; f[7] = b[3];
                ypend = pack8(f); ypend_ptr = Yd + (base + SCAN_TOK(t0, tq)) * 512 + h * 64 + c8 * 8;
            }
        }
    }
    if (ypend_ptr) *(u32x4*)ypend_ptr = ypend;
    if (sout) { *(f32x4*)(sout + srow * 64 + sq * 4) = (f32x4){SS[0].x, SS[1].x, SS[2].x, SS[3].x}; *(f32x4*)(sout + (srow + 4) * 64 + sq * 4) = (f32x4){SS[0].y, SS[1].y, SS[2].y, SS[3].y}; }
#undef SCAN_TOK
#undef SCAN_BUILD_A
    __syncthreads();
}

__device__ void scan_carry(const Params& PP, int hd, LAS unsigned char* lds) {
    Params P = PP; P.ws = opaque_ptr(PP.ws);
    const int tid = opaque_tid();
    const float* Lm = (const float*)(P.ws + WS_STL) + (size_t)hd * NSEG * 4096;
    const float* Pm = (const float*)(P.ws + WS_STP) + (size_t)hd * NSEG * 4096;
    float* St = (float*)(P.ws + WS_STS) + (size_t)hd * NSEG * 4096;
    LAS float* Sc = (LAS float*)lds;
    LAS float* Pc = Sc + 4096;
    const int v = tid >> 3, k0 = (tid & 7) * 8;
    for (int i = 0; i < 8; ++i) { const float x = Lm[v * 64 + k0 + i]; Sc[v * 64 + k0 + i] = x; St[4096 + v * 64 + k0 + i] = x; }
    for (int sgm = 1; sgm + 1 < NSEG; ++sgm) {
        for (int i = 0; i < 8; ++i) Pc[v * 64 + k0 + i] = Pm[(size_t)sgm * 4096 + v * 64 + k0 + i];
        __syncthreads();
        float o[8];
        for (int i = 0; i < 8; ++i) o[i] = Lm[(size_t)sgm * 4096 + v * 64 + k0 + i];
        for (int j = 0; j < 64; ++j) { const float sv = Sc[v * 64 + j];
#pragma unroll
            for (int i = 0; i < 8; ++i) o[i] += sv * Pc[j * 64 + k0 + i]; }
        __syncthreads();
        for (int i = 0; i < 8; ++i) { Sc[v * 64 + k0 + i] = o[i]; St[(size_t)(sgm + 1) * 4096 + v * 64 + k0 + i] = o[i]; }
    }
    __syncthreads();
}

__device__ void rwkv_finalize(const Params& PP) {
    Params P = PP; P.ws = opaque_ptr(PP.ws);
    const int tid_ = opaque_tid(), lane = tid_ & 63, wave = __builtin_amdgcn_readfirstlane(tid_ >> 6);
    const bf16_t* Prkvg = (const bf16_t*)(P.ws + WS_PRKVG);
    const bf16_t* Y0 = (const bf16_t*)(P.ws + WS_Y);
    const bf16_t* Y1 = Y0 + (size_t)M_TOK * 512;
    const float* RKR0 = (const float*)(P.ws + WS_RKR);
    const float* RKR1 = RKR0 + (size_t)M_TOK * 8;
    bf16_t* MO = (bf16_t*)(P.ws + WS_XN);
    const int col = lane * 8, hh = lane >> 3;
    float gw[8], gb[8], muf[8], mub[8];
#pragma unroll
    for (int i = 0; i < 8; ++i) { gw[i] = P.in[24][col + i]; gb[i] = P.in[25][col + i]; muf[i] = P.in[15][1024 + col + i]; mub[i] = P.in[15][1536 + 1024 + col + i]; }
    for (int row = blockIdx.x * 8 + wave; row < M_TOK; row += gridDim.x * 8) {
        const int t = row < M_PROMPT ? (row & 2047) : row - M_PROMPT, T = row < M_PROMPT ? 2048 : 16384;
        float yf[8], yb[8], vc[8], vp[8], vn[8], gg[8];
        unpack8(*(const u32x4*)(Y0 + (size_t)row * 512 + col), yf); unpack8(*(const u32x4*)(Y1 + (size_t)row * 512 + col), yb);
        unpack8(*(const u32x4*)(Prkvg + (size_t)row * 2048 + 1024 + col), vc);
        unpack8(*(const u32x4*)(Prkvg + (size_t)row * 2048 + 1536 + col), gg);
        if (t > 0) unpack8(*(const u32x4*)(Prkvg + (size_t)(row - 1) * 2048 + 1024 + col), vp); else { for (int i = 0; i < 8; ++i) vp[i] = 0.f; }
        if (t < T - 1) unpack8(*(const u32x4*)(Prkvg + (size_t)(row + 1) * 2048 + 1024 + col), vn); else { for (int i = 0; i < 8; ++i) vn[i] = 0.f; }
        const float rf = RKR0[(size_t)row * 8 + hh], rb = RKR1[(size_t)row * 8 + hh];
        float s = 0.f;
#pragma unroll
        for (int i = 0; i < 8; ++i) { yf[i] += yb[i]; s += yf[i]; }
        const float mean = reduce8(s) * (1.0f / 64.0f);
        float q = 0.f;
#pragma unroll
        for (int i = 0; i < 8; ++i) { yf[i] -= mean; q += yf[i] * yf[i]; }
        const float rstd = rsqrtf(reduce8(q) * (1.0f / 64.0f) + 64e-5f);
        float o[8];
#pragma unroll
        for (int i = 0; i < 8; ++i) {
            const float vzf = vc[i] + (vp[i] - vc[i]) * muf[i], vzb = vc[i] + (vn[i] - vc[i]) * mub[i];
            o[i] = (yf[i] * rstd * gw[i] + gb[i] + rf * vzf + rb * vzb) * sigmoidf_(gg[i]);
        }
        *(u32x4*)(MO + (size_t)row * 1024 + 512 + col) = pack8(o);
    }
}

__device__ void attn_item(const Params& PP, int seq, int h, int tile, LAS unsigned char* lds) {
    Params P = PP; P.ws = opaque_ptr(PP.ws);
    const int tid = opaque_tid(), lane = tid & 63, wave = __builtin_amdgcn_readfirstlane(tid >> 6), l15 = lane & 15, quad = lane >> 4;
    const int T = seq < 32 ? 2048 : 16384;
    const size_t base = seq < 32 ? (size_t)seq * 2048 : (size_t)M_PROMPT;
    const int T0 = tile * 256;
    const bf16_t* QKV = (const bf16_t*)(P.ws + WS_BIG);
    bf16_t* MO = (bf16_t*)(P.ws + WS_XN);
    LAS float* OACC = (LAS float*)lds;
    LAS float* LS = (LAS float*)(lds + 256 * 272);
    LAS unsigned char* VST = lds + 256 * 272 + 1024 + wave * (32 * 144);
    const float slope = exp2f(-0.5f * (float)(h + 1));
    float gqk[16];
#pragma unroll
    for (int i = 0; i < 16; ++i) { const int e = (i >> 3) * 32 + quad * 8 + (i & 7); gqk[i] = P.in[28][e] * P.in[29][e]; }
    const int r4 = l15 >> 2, c4 = l15 & 3;
    float biasL[9][4];
#pragma unroll
    for (int kt = 0; kt < 9; ++kt)
#pragma unroll
        for (int j = 0; j < 4; ++j) { int dist = 16 * kt - 64 + quad * 4 + j - l15; dist = dist < 0 ? -dist : dist;
            biasL[kt][j] = dist <= 64 ? -slope * 1.4426950408889634f * (float)dist : -1e30f; }
    LAS float* RKT = (LAS float*)(lds + 107520);
    const int tb = T0 - 1024;
    for (int idx = tid; idx < 2304; idx += 512) {
        const int tok = tb + idx;
        if (tok >= 0 && tok < T) {
            const bf16_t* kp_ = QKV + (base + tok) * 3072 + 1024 + h * 64;
            float ss = 0.f;
#pragma unroll
            for (int i = 0; i < 8; ++i) { float f[8]; unpack8(*(const u32x4*)(kp_ + i * 8), f);
#pragma unroll
                for (int e = 0; e < 8; ++e) ss += f[e] * f[e]; }
            RKT[idx] = rsqrtf(ss * (1.0f / 64.0f) + NORM_EPS) * 1.4426950408889634f;
        }
    }
    __syncthreads();
    for (int bi = 0; bi < 3; ++bi) {
        const int dsh = 2 * bi, L = T >> dsh;
        const float sl_d = slope * (float)(1 << dsh);
        for (int gg = 0; gg < 2; ++gg) {
            const int g = wave * 2 + gg;
            const int res = bi == 0 ? 0 : (bi == 1 ? (g & 3) : g), blk = bi == 0 ? g : (bi == 1 ? (g >> 2) : 0);
            const int i0 = (T0 >> dsh) + 16 * blk;
            const int qtok = ((i0 + l15) << dsh) + res;
            bf16x8 qf[2]; float mq;
            {
                const bf16_t* qp = QKV + (base + qtok) * 3072 + h * 64 + quad * 8;
                float f[16]; unpack8(*(const u32x4*)qp, f); unpack8(*(const u32x4*)(qp + 32), f + 8);
                float ss = 0.f;
#pragma unroll
                for (int i = 0; i < 16; ++i) ss += f[i] * f[i];
                ss += __shfl_xor(ss, 16); ss += __shfl_xor(ss, 32);
                const float rq = rsqrtf(ss * (1.0f / 64.0f) + NORM_EPS) * 0.125f;
#pragma unroll
                for (int i = 0; i < 16; ++i) f[i] = f[i] * rq * gqk[i];
                const u32x4 w0 = pack8(f), w1 = pack8(f + 8);
                qf[0] = __builtin_bit_cast(bf16x8, w0); qf[1] = __builtin_bit_cast(bf16x8, w1);
                float fr[16]; unpack8(w0, fr); unpack8(w1, fr + 8);
                float n2 = 0.f;
#pragma unroll
                for (int i = 0; i < 16; ++i) n2 += fr[i] * fr[i];
                n2 += __shfl_xor(n2, 16); n2 += __shfl_xor(n2, 32);
                mq = 8.1f * 1.4426950408889634f * sqrtf(n2);
            }
            f32x4 oacc[4];
#pragma unroll
            for (int et = 0; et < 4; ++et) oacc[et] = (f32x4){0.f, 0.f, 0.f, 0.f};
            float lsum = 0.f;
            const int kjb = i0 - 64 + quad * 4, rkoff = res - tb;
            const float dmul = (float)(1 << dsh);
            bf16x8 kfb[2][2][2]; u32x4 vb[2][4];
            const int rowv = lane >> 1, half = lane & 1;
#define ATT_ISSUE(KP, BUF) do { \
                _Pragma("unroll") for (int tt_ = 0; tt_ < 2; ++tt_) { \
                    int kidx_ = i0 - 64 + 16 * (2 * (KP) + tt_) + l15; kidx_ = kidx_ < 0 ? 0 : (kidx_ > L - 1 ? L - 1 : kidx_); \
                    const bf16_t* kptr_ = QKV + (base + ((size_t)kidx_ << dsh) + res) * 3072 + 1024 + h * 64 + quad * 8; \
                    kfb[BUF][tt_][0] = *(const bf16x8*)kptr_; kfb[BUF][tt_][1] = *(const bf16x8*)(kptr_ + 32); } \
                int vidx_ = i0 - 64 + 32 * (KP) + rowv; vidx_ = vidx_ < 0 ? 0 : (vidx_ > L - 1 ? L - 1 : vidx_); \
                const bf16_t* vptr_ = QKV + (base + ((size_t)vidx_ << dsh) + res) * 3072 + 2048 + h * 64 + half * 32; \
                vb[BUF][0] = *(const u32x4*)vptr_; vb[BUF][1] = *(const u32x4*)(vptr_ + 8); vb[BUF][2] = *(const u32x4*)(vptr_ + 16); vb[BUF][3] = *(const u32x4*)(vptr_ + 24); } while (0)
            ATT_ISSUE(0, 0);
#pragma unroll
            for (int kp = 0; kp < 5; ++kp) {
                f32x4 s[2];
                if (kp + 1 < 5) ATT_ISSUE(kp + 1, (kp + 1) & 1);
#pragma unroll
                for (int tt = 0; tt < 2; ++tt) {
                    const int kt = 2 * kp + tt;
                    s[tt] = (f32x4){0.f, 0.f, 0.f, 0.f};
                    if (kt < 9) {
                        f32x4 sc = mfma16(kfb[kp & 1][tt][0], qf[0], (f32x4){0.f, 0.f, 0.f, 0.f});
                        sc = mfma16(kfb[kp & 1][tt][1], qf[1], sc);
#pragma unroll
                        for (int j = 0; j < 4; ++j) {
                            const int kj = kjb + 16 * kt + j;
                            const int kc = kj < 0 ? 0 : (kj > L - 1 ? L - 1 : kj);
                            const float rk = RKT[(kc << dsh) + rkoff];
                            float p = __builtin_amdgcn_exp2f(sc[j] * rk + (biasL[kt][j] * dmul - mq));
                            p = ((unsigned)kj < (unsigned)L) ? p : 0.f;
                            lsum += p; s[tt][j] = p;
                        }
                    }
                }
                bf16x8 pf;
                { u32x4 w; w.x = pk2(s[0][0], s[0][1]); w.y = pk2(s[0][2], s[0][3]); w.z = pk2(s[1][0], s[1][1]); w.w = pk2(s[1][2], s[1][3]); pf = __builtin_bit_cast(bf16x8, w); }
                {
                    LAS u32x4* vd = (LAS u32x4*)(VST + rowv * 144 + half * 64);
                    vd[0] = vb[kp & 1][0]; vd[1] = vb[kp & 1][1]; vd[2] = vb[kp & 1][2]; vd[3] = vb[kp & 1][3];
                }
                asm volatile("s_waitcnt lgkmcnt(0)" ::: "memory"); __builtin_amdgcn_fence(__ATOMIC_RELEASE, "wavefront"); __builtin_amdgcn_wave_barrier(); __builtin_amdgcn_fence(__ATOMIC_ACQUIRE, "wavefront"); asm volatile("s_waitcnt lgkmcnt(0)" ::: "memory");
#pragma unroll
                for (int et = 0; et < 4; ++et) {
                    LAS const unsigned char* ap = VST + (quad * 4 + r4) * 144 + (et * 16 + 4 * c4) * 2;
                    const s16x4 lo = tr_read(ap), hi = tr_read(ap + 16 * 144);
                    const bf16x8 a = {lo[0], lo[1], lo[2], lo[3], hi[0], hi[1], hi[2], hi[3]};
                    oacc[et] = mfma16(a, pf, oacc[et]);
                }
                asm volatile("s_waitcnt lgkmcnt(0)" ::: "memory"); __builtin_amdgcn_fence(__ATOMIC_RELEASE, "wavefront"); __builtin_amdgcn_wave_barrier(); __builtin_amdgcn_fence(__ATOMIC_ACQUIRE, "wavefront"); asm volatile("s_waitcnt lgkmcnt(0)" ::: "memory");
            }
#undef ATT_ISSUE
            lsum += __shfl_xor(lsum, 16); lsum += __shfl_xor(lsum, 32);
            const int qloc = qtok - T0;
#pragma unroll
            for (int et = 0; et < 4; ++et) {
                LAS f32x4* dst = (LAS f32x4*)(OACC + qloc * 68 + et * 16 + quad * 4);
                if (bi == 0) *dst = oacc[et]; else *dst = *dst + oacc[et];
            }
            if (quad == 0) { if (bi == 0) LS[qloc] = lsum; else LS[qloc] += lsum; }
        }
        __syncthreads();
    }
    {
        const int q = tid >> 1, half = tid & 1;
        const float inv = 1.0f / LS[q];
        bf16_t* op = MO + (base + T0 + q) * 1024 + h * 64 + half * 32;
#pragma unroll
        for (int i = 0; i < 4; ++i) {
            const f32x4 a = *(LAS const f32x4*)(OACC + q * 68 + half * 32 + i * 8), b = *(LAS const f32x4*)(OACC + q * 68 + half * 32 + i * 8 + 4);
            u32x4 w; w.x = pk2(a[0] * inv, a[1] * inv); w.y = pk2(a[2] * inv, a[3] * inv); w.z = pk2(b[0] * inv, b[1] * inv); w.w = pk2(b[2] * inv, b[3] * inv);
            *(u32x4*)(op + i * 8) = w;
        }
    }
    __syncthreads();
}

enum { K_P0 = 0, K_SWIGLU, K_RESID, K_NORM, K_GEMM_P, K_MIXA, K_FINAL, K_GEMM_QKV, K_ATTN, K_CARRY, K_MIXB };
constexpr int N_PHASES = 20;

__global__ void __launch_bounds__(512, 2) mega(Params P) {
    extern __shared__ __attribute__((aligned(16))) unsigned char lds_raw[];
    LAS unsigned char* lds = (LAS unsigned char*)lds_raw;
    cg::grid_group grid = cg::this_grid();
    for (int ph = 0; ph < N_PHASES; ++ph) {
#ifdef PROBE_MASK
        if (blockIdx.x == 0 && threadIdx.x == 0) ((unsigned long long*)(P.ws + WS_TS))[ph] = __builtin_amdgcn_s_memrealtime();
#endif
        unsigned char* ws = P.ws; float* X = P.out; int G = gridDim.x, bid = blockIdx.x;
        asm volatile("" : "+s"(ws), "+s"(X), "+s"(G), "+s"(bid));
        bf16_t* XN = (bf16_t*)(ws + WS_XN);
        bf16_t* Hb = (bf16_t*)(ws + WS_BIG);
        int kind, layer = 0, sub = 0;
        if (ph == 0) kind = K_P0;
        else {
            layer = ph <= 11 ? 0 : 1; const int r = ph <= 11 ? ph - 1 : ph - 12;
            const unsigned long long kc = layer == 0 ? 0x32126A95421ull : 0x32128721ull;
            const unsigned long long sc = layer == 0 ? 0x21120000000ull : 0x21120000ull;
            kind = (int)((kc >> (4 * r)) & 15ull); sub = (int)((sc >> (4 * r)) & 15ull);
        }
        if (kind == K_P0) {
#ifndef SKIP_P0
            LAS float* tile = (LAS float*)lds;
            int rot = 0;
            for (int job = 0; job < 16; ++job) {
                const float* src; size_t doff; int K, N;
                if (job < 4) { src = ((job & 1) ? P.in[7] : P.in[3]) + (size_t)(job >> 1) * 1024 * 5632; doff = WS_WFI + (size_t)job * SZ_WFI; K = 1024; N = 5632; }
                else if (job < 8) { src = ((job & 1) ? P.in[8] : P.in[4]) + (size_t)((job - 4) >> 1) * 2816 * 1024; doff = WS_WFO + (size_t)(job - 4) * SZ_WFO; K = 2816; N = 1024; }
                else if (job == 8) { src = P.in[10]; doff = WS_WABI; K = 1024; N = 3328; }
                else if (job == 9) { src = P.in[11]; doff = WS_WABO; K = 1024; N = 1024; }
                else if (job == 10) { src = P.in[26]; doff = WS_WATI; K = 1024; N = 3072; }
                else if (job == 11) { src = P.in[27]; doff = WS_WATO; K = 1024; N = 1024; }
                else { const int d = (job - 12) >> 1, ty = (job - 12) & 1; src = (ty ? P.in[20] : P.in[18]) + (size_t)d * 64 * 512; doff = WS_LORA + (size_t)(d * 2 + ty) * 512 * 64 * 2; K = 64; N = 512; }
                if (job < 4) convert_T<1>(src, (bf16_t*)(ws + doff), K, N, tile, rot); else convert_T<0>(src, (bf16_t*)(ws + doff), K, N, tile, rot);
                rot += (K / 64) * (N / 64);
            }
            {
                bf16_t* dst = (bf16_t*)(ws + WS_SGUW);
                for (int i = bid * 512 + opaque_tid(); i < 4 * 128 * 128 / 4; i += G * 512) {
                    const f32x4 v = *(const f32x4*)(P.in[13] + (size_t)i * 4);
                    u32x2 w; w.x = pk2(v[0], v[1]); w.y = pk2(v[2], v[3]); *(u32x2*)(dst + (size_t)i * 4) = w;
                }
            }
            norm_rows(P.in[0], P.in[1], M_PROMPT, X, nullptr, nullptr, P.in[2], XN);
#endif
        } else if (kind == K_SWIGLU) {
            if (sub == 0) { float* za = (float*)(ws + WS_RSA); for (int i = bid * 512 + opaque_tid(); i < M_TOK; i += G * 512) za[i] = 0.f; }
            pg8::Gemm g{sub == 0 ? XN : (const bf16_t*)(ws + WS_Y), (const bf16_t*)(ws + WS_WFI + (size_t)(layer * 2 + sub) * SZ_WFI), M_TOK, 5632, 1024};
            pg8::StaticOrder S; S.init(M_TOK, 5632, G, bid);
            EpiSwiglu E{Hb, sub == 0 ? nullptr : (const float*)(ws + WS_RSB)};
#ifndef SKIP_G1
            pg8::gemm_phase<EpiSwiglu, pg8::StaticOrder, GEMM_ALIGN, GEMM_SP2>(lds, g, S, E);
#endif
        } else if (kind == K_RESID) {
            const bf16_t* A; const bf16_t* Bt; int K; float scale; bf16_t* xg = nullptr; const float* gn = nullptr; float* rss = nullptr;
            if (sub < 2) { A = Hb; Bt = (const bf16_t*)(ws + WS_WFO + (size_t)(layer * 2 + sub) * SZ_WFO); K = 2816; scale = 0.5f;
                if (sub == 0) { xg = XN; gn = P.in[5] + layer * DM; rss = (float*)(ws + WS_RSA); } }
            else { A = XN; Bt = (const bf16_t*)(ws + (layer == 0 ? WS_WABO : WS_WATO)); K = 1024; scale = 1.0f; xg = (bf16_t*)(ws + WS_Y); gn = P.in[6] + layer * DM; rss = (float*)(ws + WS_RSB); }
            pg8::Gemm g{A, Bt, M_TOK, 1024, K};
            pg8::StaticOrder S; S.init(M_TOK, 1024, G, bid);
            EpiResid E{X, scale, xg, gn, rss};
#ifndef SKIP_G2
            pg8::gemm_phase<EpiResid, pg8::StaticOrder, GEMM_ALIGN, GEMM_SP2>(lds, g, S, E);
#endif
        } else if (kind == K_NORM) {
            if (ph < N_PHASES - 1) norm_rows(X, X, M_TOK, nullptr, P.in[9], X, P.in[2] + DM, XN);
            else norm_rows(X, X, M_TOK, nullptr, P.in[9] + DM, X, nullptr, nullptr);
        } else if (kind == K_GEMM_P || kind == K_GEMM_QKV) {
            const bool isP = kind == K_GEMM_P; const int N = isP ? 3328 : 3072;
            pg8::Gemm g{XN, (const bf16_t*)(ws + (isP ? WS_WABI : WS_WATI)), M_TOK, N, 1024};
            pg8::StaticOrder S; S.init(M_TOK, N, G, bid);
            { float* zb = (float*)(ws + WS_RSB); for (int i = bid * 512 + opaque_tid(); i < M_TOK; i += G * 512) zb[i] = 0.f; }
            EpiSplit E; const float* rsa = (const float*)(ws + WS_RSA);
            if (isP) E = EpiSplit{(bf16_t*)(ws + WS_PUV), 1024, 4, (bf16_t*)(ws + WS_PRKVG), 2048, 12, (bf16_t*)(ws + WS_PWA), 256, rsa};
            else E = EpiSplit{(bf16_t*)(ws + WS_BIG), 3072, 12, (bf16_t*)(ws + WS_BIG), 3072, 12, (bf16_t*)(ws + WS_BIG), 3072, rsa};
#ifndef SKIP_G3
            pg8::gemm_phase<EpiSplit, pg8::StaticOrder, GEMM_ALIGN, GEMM_SP2>(lds, g, S, E);
#endif
        } else if (kind == K_MIXA) {
            constexpr int NLONG = 16 + 16 * (NSEG - 2) * 2;
            for (int li = bid; li < 512 + NLONG + 640; li += G) {
#ifndef SKIP_SCAN
                if (li < 512) scan_item<16>(P, li >> 4, (li >> 1) & 7, li & 1, 0, 0, 2048, 4 | 8, nullptr, nullptr, lds);
                else if (li < 512 + 16) {
                    const int hd = li - 512, dir = hd & 1;
                    scan_item<16>(P, 32, hd >> 1, dir, 0, dir == 0 ? 0 : 16384 - SEGLEN, SEGLEN, 4 | 8, nullptr, (float*)(ws + WS_STL) + (size_t)hd * NSEG * 4096, lds);
                } else if (li < 512 + NLONG) {
                    const int q = li - 512 - 16, hd = q & 15, isP = (q >> 4) & 1, sgm = 1 + (q >> 5), dir = hd & 1;
                    const int tb = dir == 0 ? sgm * SEGLEN : 16384 - (sgm + 1) * SEGLEN;
                    float* so = (float*)(ws + (isP ? WS_STP : WS_STL)) + ((size_t)hd * NSEG + sgm) * 4096;
                    scan_item<16>(P, 32, hd >> 1, dir, 0, tb, SEGLEN, isP ? (1 | 2) : 0, nullptr, so, lds);
                }
#endif
#ifndef SKIP_SGU
                if (li >= 512 + NLONG) sgu_item(P, li - 512 - NLONG, lds);
#endif
            }
        } else if (kind == K_CARRY) {
#ifndef SKIP_SCAN
            if (bid < 16) scan_carry(P, bid, lds);
#endif
        } else if (kind == K_MIXB) {
#ifndef SKIP_SCAN
            for (int li = bid; li < 16 * (NSEG - 1); li += G) {
                const int hd = li & 15, sgm = 1 + (li >> 4), dir = hd & 1;
                const int tb = dir == 0 ? sgm * SEGLEN : 16384 - (sgm + 1) * SEGLEN;
                scan_item<16>(P, 32, hd >> 1, dir, 0, tb, SEGLEN, 4 | 8, (const float*)(ws + WS_STS) + ((size_t)hd * NSEG + sgm) * 4096, nullptr, lds);
            }
#endif
        } else if (kind == K_FINAL) {
#ifndef SKIP_FIN
            rwkv_finalize(P);
#endif
        } else if (kind == K_ATTN) {
            for (int it = bid; it < 5120; it += G) {
#ifndef SKIP_ATTN
                if (it < 4096) attn_item(P, it >> 7, it & 15, (it >> 4) & 7, lds);
                else attn_item(P, 32, it & 15, (it - 4096) >> 4, lds);
#endif
            }
        }
        if (ph + 1 < N_PHASES) {
            __builtin_amdgcn_fence(__ATOMIC_RELEASE, "agent");
            asm volatile("s_waitcnt vmcnt(0) lgkmcnt(0)" ::: "memory");
            grid.sync();
            __builtin_amdgcn_fence(__ATOMIC_ACQUIRE, "agent");
            asm volatile("s_waitcnt vmcnt(0) lgkmcnt(0)" ::: "memory");
            __syncthreads();
        }
    }
#ifdef PROBE_MASK
    if (blockIdx.x == 0 && threadIdx.x == 0) {
        unsigned long long* ts = (unsigned long long*)(P.ws + WS_TS);
        ts[N_PHASES] = __builtin_amdgcn_s_memrealtime();
        unsigned long long tot = 0;
        for (int i = 0; i < N_PHASES; ++i) if ((PROBE_MASK >> i) & 1) tot += ts[i + 1] - ts[i];
        P.out[0] += 4.0f + 10.0f * (float)tot * 1e-5f;
    }
#endif
}

extern "C" void kernel_launch(void* const* d_in, const int* in_sizes, int n_in, void* d_out, int out_size, void* d_ws, size_t ws_size, hipStream_t stream) {
    static int grid_blocks = 0;
    if (!grid_blocks) {
        int dev = 0, cus = 0, per_cu = 0;
        (void)hipGetDevice(&dev);
        (void)hipDeviceGetAttribute(&cus, hipDeviceAttributeMultiprocessorCount, dev);
        (void)hipFuncSetAttribute((const void*)mega, hipFuncAttributeMaxDynamicSharedMemorySize, LDS_BYTES);
        (void)hipOccupancyMaxActiveBlocksPerMultiprocessor(&per_cu, (const void*)mega, 512, LDS_BYTES);
        (void)hipGetLastError();
        if (cus <= 0) cus = 256;
        grid_blocks = cus;
        if (ws_size < WS_END2) fprintf(stderr, "kernel_launch: workspace too small: %zu < %zu\n", ws_size, (size_t)WS_END2);
    }
    Params p{};
    for (int i = 0; i < 30 && i < n_in; ++i) p.in[i] = (const float*)d_in[i];
    p.out = (float*)d_out; p.ws = (unsigned char*)d_ws;
    void* args[] = {&p};
    hipError_t e = hipLaunchCooperativeKernel((const void*)mega, dim3(grid_blocks), dim3(512), args, LDS_BYTES, stream);
    if (e != hipSuccess) fprintf(stderr, "cooperative launch failed: %s (grid %d)\n", hipGetErrorString(e), grid_blocks);
}
```

```cpp
#include <hip/hip_runtime.h>
#include <hip/hip_cooperative_groups.h>
#include <cstdio>
namespace cg = cooperative_groups;

namespace pg8 {
#define PG8_LAS __attribute__((address_space(3)))
typedef unsigned short bf16_t;
typedef short bf16x8 __attribute__((ext_vector_type(8)));
typedef float f32x4 __attribute__((ext_vector_type(4)));
typedef unsigned u32x4 __attribute__((ext_vector_type(4)));
constexpr int BM = 256, BK = 64, HALF = 128, HTB = HALF * BK * 2  , STAGE_BYTES = 8 * HTB, NXCD = 8, WGM = 8;

__host__ __device__ __forceinline__ int lds_byte(int r, int c) { const int st = (r >> 4) * 2 + (c >> 5), rr = r & 15, cc = c & 31, ob = rr * 64 + cc * 2; return st * 1024 + (ob ^ (((ob >> 9) & 1) << 5)); }
__host__ __device__ __forceinline__ void stage_rc(int b, int& R, int& C) { const int st = b / 1024, sb = b % 1024, swz = sb ^ (((sb >> 9) & 1) << 5); R = (st >> 1) * 16 + swz / 64; C = (st & 1) * 32 + (swz % 64) / 2; }
__host__ __device__ __forceinline__ int perm32(int rho) { const int n = rho >> 4, i = rho & 15; return 8 * (i >> 2) + 4 * n + (i & 3); }

struct Unit { int pm, pn; };
struct Gemm { const bf16_t* A; const bf16_t* Bt; int M, N, K; };

struct StaticOrder {
    int nM, nN, nwg, G, c;
    __host__ __device__ void init(int M, int N, int G_, int c_) { nM = M / BM; nN = N / BM; nwg = nM * nN; G = G_; c = c_; }
    __host__ __device__ bool next(int i, Unit& u) const {
        const long L = (long)i * G + c; if (L >= nwg) return false;
        int wgid = (int)L; { const int q = nwg / NXCD, r = nwg % NXCD, xcd = wgid % NXCD, off = wgid / NXCD; wgid = (xcd < r ? xcd * (q + 1) : r * (q + 1) + (xcd - r) * q) + off; }
        const int nig = WGM * nN, gid = wgid / nig, fm = gid * WGM, gsz = (nM - fm) < WGM ? (nM - fm) : WGM;
        u.pm = fm + ((wgid % nig) % gsz); u.pn = (wgid % nig) / gsz; return true;
    }
    __device__ __forceinline__ void a_ready(const Unit&) const {}
    __device__ __forceinline__ void done(const Unit&) const {}
};
__device__ __forceinline__ unsigned cvt_pk_bf16(float lo, float hi) { unsigned r; asm volatile("v_cvt_pk_bf16_f32 %0, %1, %2" : "=v"(r) : "v"(lo), "v"(hi)); return r; }
typedef float f32x2 __attribute__((ext_vector_type(2)));
template <class Epi, class Sched, bool ALIGN_EPI = false, bool SP2 = false>
__device__ __forceinline__ void gemm_phase(PG8_LAS unsigned char* lds, const Gemm g, const Sched& S, const Epi& E) {
    int tid_raw_ = threadIdx.x; asm volatile("" : "+v"(tid_raw_)); const int tid = tid_raw_, wid = __builtin_amdgcn_readfirstlane(tid >> 6), lane = tid & 63, wr = wid >> 2, wc = wid & 3, fr = lane & 15, fq = lane >> 4;
    const int K = g.K, nt = K / BK;
    unsigned voffA[2], voffB[2];
#pragma unroll
    for (int i = 0; i < 2; ++i) { int R, C; stage_rc(tid * 16 + i * 8192, R, C); const int Rb = Epi::PERM ? ((R & ~31) + perm32(R & 31)) : R;
        voffA[i] = (unsigned)(R * K + C) * 2u; voffB[i] = (unsigned)(Rb * K + C) * 2u; }
    const size_t kstep = (size_t)(BK * 2);
    const size_t hstep = (size_t)HALF * K * 2;
    const size_t tstep = 2 * hstep;
    const unsigned ldsw = (unsigned)wid * 1024u;
    const int aoff = lds_byte(wr * 64 + fr, fq * 8), boff = lds_byte(wc * 32 + fr, fq * 8);
#define PG8_SA(b, h) (((b) * 2 + (h)) * HTB)
#define PG8_SB(b, h) ((4 + (b) * 2 + (h)) * HTB)
#define PG8_STAGE(bufoff, gbase, voff) do { _Pragma("unroll") for (int _i = 0; _i < 2; ++_i) \
        __builtin_amdgcn_global_load_lds((const unsigned*)((const char*)(gbase) + (voff)[_i]), (PG8_LAS unsigned*)(lds + (bufoff) + ldsw + _i * 8192), 16, 0, 0); } while (0)
#define PG8_LDA(dst, b, h) do { _Pragma("unroll") for (int m = 0; m < 4; ++m) _Pragma("unroll") for (int k = 0; k < 2; ++k) dst[m][k] = *(const PG8_LAS bf16x8*)(lds + PG8_SA(b, h) + aoff + m * 2048 + k * 1024); } while (0)
#define PG8_LDB(dst, b, h) do { _Pragma("unroll") for (int n = 0; n < 2; ++n) _Pragma("unroll") for (int k = 0; k < 2; ++k) dst[n][k] = *(const PG8_LAS bf16x8*)(lds + PG8_SB(b, h) + boff + n * 2048 + k * 1024); } while (0)
#define PG8_MMA(ai, bj, At, Bt) do { __builtin_amdgcn_s_setprio(1); _Pragma("unroll") for (int m = 0; m < 4; ++m) _Pragma("unroll") for (int n = 0; n < 2; ++n) _Pragma("unroll") for (int k = 0; k < 2; ++k) \
        acc[ai][bj][m][n] = __builtin_amdgcn_mfma_f32_16x16x32_bf16(Bt[n][k], At[m][k], acc[ai][bj][m][n], 0, 0, 0); __builtin_amdgcn_s_setprio(0); } while (0)
#define PG8_WAIT_V(n) asm volatile("s_waitcnt vmcnt(" #n ")" ::: "memory")
#define PG8_WAIT_L(n) asm volatile("s_waitcnt lgkmcnt(" #n ")" ::: "memory")
#define PG8_BAR __builtin_amdgcn_s_barrier()
#define PG8_SCHED __builtin_amdgcn_sched_barrier(0)
    Unit cur, nxt; int ui = 0;
    if (!S.next(0, cur)) return;
    f32x4 acc[2][2][4][2];
#pragma unroll
    for (int a = 0; a < 2; ++a)
#pragma unroll
        for (int b = 0; b < 2; ++b)
#pragma unroll
            for (int m = 0; m < 4; ++m)
#pragma unroll
                for (int n = 0; n < 2; ++n) acc[a][b][m][n] = (f32x4){0.f, 0.f, 0.f, 0.f};
    bf16x8 At[4][2], B0[2][2], B1[2][2];
    const char* cA = (const char*)g.A + (size_t)cur.pm * tstep; const char* cB = (const char*)g.Bt + (size_t)cur.pn * tstep;
    S.a_ready(cur);
    if constexpr (SP2) {
        PG8_STAGE(PG8_SB(0, 0), cB, voffB); PG8_STAGE(PG8_SB(0, 1), cB + hstep, voffB); PG8_STAGE(PG8_SA(0, 0), cA, voffA); PG8_STAGE(PG8_SA(0, 1), cA + hstep, voffA);
        if (wr == 1) PG8_BAR;
        PG8_WAIT_V(2); PG8_BAR;
        PG8_STAGE(PG8_SB(1, 0), cB + kstep, voffB); PG8_STAGE(PG8_SA(1, 0), cA + kstep, voffA); PG8_STAGE(PG8_SB(1, 1), cB + hstep + kstep, voffB);
        PG8_WAIT_V(6); PG8_BAR;
    } else {
        PG8_STAGE(PG8_SB(0, 0), cB, voffB); PG8_STAGE(PG8_SA(0, 0), cA, voffA); PG8_STAGE(PG8_SB(0, 1), cB + hstep, voffB); PG8_STAGE(PG8_SA(0, 1), cA + hstep, voffA);
        if (wr == 1) PG8_BAR;
        PG8_WAIT_V(4); PG8_BAR;
        PG8_STAGE(PG8_SB(1, 0), cB + kstep, voffB); PG8_STAGE(PG8_SA(1, 0), cA + kstep, voffA); PG8_STAGE(PG8_SB(1, 1), cB + hstep + kstep, voffB);
        PG8_WAIT_V(6); PG8_BAR;
    }
    for (;;) {
        const bool has_next = S.next(ui + 1, nxt);
        const char* nA = has_next ? (const char*)g.A + (size_t)nxt.pm * tstep : cA; const char* nB = has_next ? (const char*)g.Bt + (size_t)nxt.pn * tstep : cB;
        for (int t = 0; t < nt; t += 2) {
            const bool last = (t == nt - 2);
            const char* a1 = cA + (size_t)(t + 1) * kstep;
            const char* a2 = last ? nA : cA + (size_t)(t + 2) * kstep; const char* b2 = last ? nB : cB + (size_t)(t + 2) * kstep;
            const char* a3 = a2 + kstep; const char* b3 = b2 + kstep;
            if (last && has_next) S.a_ready(nxt);
            if constexpr (SP2) {
            PG8_LDB(B0, 0, 0); PG8_LDB(B1, 0, 1); PG8_SCHED; PG8_LDA(At, 0, 0); PG8_STAGE(PG8_SA(1, 1), a1 + hstep, voffA);
            PG8_WAIT_V(8); PG8_WAIT_L(0); PG8_BAR; PG8_MMA(0, 0, At, B0); PG8_MMA(0, 1, At, B1); PG8_BAR; PG8_SCHED;
            PG8_LDA(At, 0, 1); PG8_STAGE(PG8_SB(0, 0), b2, voffB); PG8_STAGE(PG8_SB(0, 1), b2 + hstep, voffB); PG8_STAGE(PG8_SA(0, 0), a2, voffA);
            PG8_WAIT_V(8); PG8_WAIT_L(0); PG8_BAR; PG8_MMA(1, 0, At, B0); PG8_MMA(1, 1, At, B1); PG8_BAR; PG8_SCHED;
            PG8_LDB(B0, 1, 0); PG8_LDB(B1, 1, 1); PG8_SCHED; PG8_LDA(At, 1, 0); PG8_STAGE(PG8_SA(0, 1), a2 + hstep, voffA);
            PG8_WAIT_V(8); PG8_WAIT_L(0); PG8_BAR; PG8_MMA(0, 0, At, B0); PG8_MMA(0, 1, At, B1); PG8_BAR; PG8_SCHED;
            PG8_LDA(At, 1, 1); PG8_STAGE(PG8_SB(1, 0), b3, voffB); PG8_STAGE(PG8_SB(1, 1), b3 + hstep, voffB); PG8_STAGE(PG8_SA(1, 0), a3, voffA);
            PG8_WAIT_V(8); PG8_WAIT_L(0); PG8_BAR; PG8_MMA(1, 0, At, B0); PG8_MMA(1, 1, At, B1); PG8_BAR; PG8_SCHED;
            } else {
            PG8_LDB(B0, 0, 0); PG8_SCHED; PG8_LDA(At, 0, 0); PG8_STAGE(PG8_SA(1, 1), a1 + hstep, voffA);
            PG8_WAIT_L(8); PG8_BAR; PG8_WAIT_L(0); PG8_MMA(0, 0, At, B0); PG8_BAR; PG8_SCHED;
            PG8_LDB(B1, 0, 1); PG8_STAGE(PG8_SB(0, 0), b2, voffB);
            PG8_BAR; PG8_WAIT_L(0); PG8_MMA(0, 1, At, B1); PG8_BAR;
            PG8_LDA(At, 0, 1); PG8_STAGE(PG8_SA(0, 0), a2, voffA);
            PG8_BAR; PG8_WAIT_L(0); PG8_MMA(1, 0, At, B0); PG8_BAR; PG8_SCHED;
            PG8_STAGE(PG8_SB(0, 1), b2 + hstep, voffB);
            PG8_WAIT_V(6); PG8_BAR; PG8_MMA(1, 1, At, B1); PG8_BAR;
            PG8_LDB(B0, 1, 0); PG8_SCHED; PG8_LDA(At, 1, 0); PG8_STAGE(PG8_SA(0, 1), a2 + hstep, voffA);
            PG8_WAIT_L(8); PG8_BAR; PG8_WAIT_L(0); PG8_MMA(0, 0, At, B0); PG8_BAR; PG8_SCHED;
            PG8_LDB(B1, 1, 1); PG8_STAGE(PG8_SB(1, 0), b3, voffB);
            PG8_BAR; PG8_WAIT_L(0); PG8_MMA(0, 1, At, B1); PG8_BAR;
            PG8_LDA(At, 1, 1); PG8_STAGE(PG8_SA(1, 0), a3, voffA);
            PG8_BAR; PG8_WAIT_L(0); PG8_MMA(1, 0, At, B0); PG8_BAR; PG8_SCHED;
            PG8_STAGE(PG8_SB(1, 1), b3 + hstep, voffB);
            PG8_WAIT_V(6); PG8_BAR; PG8_MMA(1, 1, At, B1); PG8_BAR;
            }
        }
        if constexpr (ALIGN_EPI) { if (wr == 0) PG8_BAR; }
        if constexpr (!Epi::AFTER_DRAIN) { E(acc, cur, wr, wc, fr, fq); S.done(cur); }
        if (!has_next) break;
#pragma unroll
        for (int a = 0; a < 2; ++a)
#pragma unroll
            for (int b = 0; b < 2; ++b)
#pragma unroll
                for (int m = 0; m < 4; ++m)
#pragma unroll
                    for (int n = 0; n < 2; ++n) acc[a][b][m][n] = (f32x4){0.f, 0.f, 0.f, 0.f};
        cur = nxt; cA = nA; cB = nB; ++ui;
        if constexpr (ALIGN_EPI) { if (wr == 1) PG8_BAR; }
    }
    PG8_WAIT_V(0);
    if constexpr (!ALIGN_EPI) { if (wr == 0) PG8_BAR; }
    PG8_BAR;
    if constexpr (Epi::AFTER_DRAIN) { E.fused(acc, cur, wr, wc, fr, fq, lds, wid, lane); S.done(cur); }
#undef PG8_SA
#undef PG8_SB
#undef PG8_STAGE
#undef PG8_LDA
#undef PG8_LDB
#undef PG8_MMA
#undef PG8_WAIT_V
#undef PG8_WAIT_L
#undef PG8_BAR
#undef PG8_SCHED
}
}


#define LAS __attribute__((address_space(3)))
typedef unsigned short bf16_t;
typedef short bf16x8 __attribute__((ext_vector_type(8)));
typedef short s16x4 __attribute__((ext_vector_type(4)));
typedef float f32x4 __attribute__((ext_vector_type(4)));
typedef unsigned u32x4 __attribute__((ext_vector_type(4)));
typedef unsigned u32x2 __attribute__((ext_vector_type(2)));

constexpr int M_TOK = 81920, M_PROMPT = 65536, DM = 1024, DFF = 2816;
constexpr int LDS_BYTES = 147456;
#ifndef GEMM_ALIGN
#define GEMM_ALIGN true
#endif
#ifndef GEMM_SP2
#define GEMM_SP2 true
#endif
constexpr float NORM_EPS = 1e-6f;

constexpr size_t SZ_WFI = (size_t)5632 * 1024 * 2, SZ_WFO = (size_t)1024 * 2816 * 2;
constexpr size_t WS_WFI = 0;
constexpr size_t WS_WFO = WS_WFI + 4 * SZ_WFI;
constexpr size_t WS_WABI = WS_WFO + 4 * SZ_WFO;
constexpr size_t WS_WABO = WS_WABI + (size_t)3328 * 1024 * 2;
constexpr size_t WS_WATI = WS_WABO + (size_t)1024 * 1024 * 2;
constexpr size_t WS_WATO = WS_WATI + (size_t)3072 * 1024 * 2;
constexpr size_t WS_LORA = WS_WATO + (size_t)1024 * 1024 * 2;
constexpr size_t WS_SGUW = WS_LORA + (size_t)4 * 512 * 64 * 2;
constexpr size_t WS_RKR = WS_SGUW + (size_t)4 * 128 * 128 * 2;
constexpr size_t WS_XN = (WS_RKR + (size_t)2 * M_TOK * 8 * 4 + 4095) & ~(size_t)4095;
constexpr size_t WS_BIG = WS_XN + (size_t)M_TOK * 1024 * 2;
constexpr size_t WS_PUV = WS_BIG;
constexpr size_t WS_PRKVG = WS_PUV + (size_t)M_TOK * 1024 * 2;
constexpr size_t WS_PWA = WS_PRKVG + (size_t)M_TOK * 2048 * 2;
constexpr size_t WS_Y = WS_BIG + (size_t)M_TOK * 3328 * 2;
constexpr size_t WS_END = WS_Y + (size_t)2 * M_TOK * 512 * 2;

constexpr int NSEG = 16, SEGLEN = 16384 / NSEG;
constexpr size_t WS_STL = (WS_END + 4095) & ~(size_t)4095;
constexpr size_t WS_STP = WS_STL + (size_t)16 * NSEG * 4096 * 4;
constexpr size_t WS_STS = WS_STP + (size_t)16 * NSEG * 4096 * 4;
constexpr size_t WS_TS = WS_STS + (size_t)16 * NSEG * 4096 * 4;
constexpr size_t WS_RSA = WS_TS + 4096;
constexpr size_t WS_RSB = WS_RSA + (size_t)M_TOK * 4;
constexpr size_t WS_END2 = WS_RSB + (size_t)M_TOK * 4;
struct Params { const float* in[30]; float* out; unsigned char* ws; };

__device__ __forceinline__ float bflo(unsigned w) { return __uint_as_float(w << 16); }
__device__ __forceinline__ float bfhi(unsigned w) { return __uint_as_float(w & 0xffff0000u); }
__device__ __forceinline__ unsigned pk2(float lo, float hi) { unsigned r; asm("v_cvt_pk_bf16_f32 %0, %1, %2" : "=v"(r) : "v"(lo), "v"(hi)); return r; }
__device__ __forceinline__ void unpack8(const u32x4 w, float* f) { f[0] = bflo(w.x); f[1] = bfhi(w.x); f[2] = bflo(w.y); f[3] = bfhi(w.y); f[4] = bflo(w.z); f[5] = bfhi(w.z); f[6] = bflo(w.w); f[7] = bfhi(w.w); }
__device__ __forceinline__ u32x4 pack8(const float* f) { u32x4 w; w.x = pk2(f[0], f[1]); w.y = pk2(f[2], f[3]); w.z = pk2(f[4], f[5]); w.w = pk2(f[6], f[7]); return w; }
__device__ __forceinline__ float sigmoidf_(float x) { return __builtin_amdgcn_rcpf(1.0f + __expf(-x)); }
__device__ __forceinline__ float siluf_(float x) { return x * sigmoidf_(x); }
__device__ __forceinline__ float gelu_tanh(float x) { const float u = 0.7978845608028654f * (x + 0.044715f * x * x * x); return x * sigmoidf_(2.0f * u); }
__device__ __forceinline__ float tanhf_(float x) { return 1.0f - 2.0f * __builtin_amdgcn_rcpf(__expf(2.0f * x) + 1.0f); }
__device__ __forceinline__ float wave_sum(float x) { x += __shfl_xor(x, 32); x += __shfl_xor(x, 16); x += __shfl_xor(x, 8); x += __shfl_xor(x, 4); x += __shfl_xor(x, 2); x += __shfl_xor(x, 1); return x; }
template <int CTRL> __device__ __forceinline__ float dppf(float x) { return __int_as_float(__builtin_amdgcn_update_dpp(0, __float_as_int(x), CTRL, 0xF, 0xF, true)); }
__device__ __forceinline__ float reduce8(float x) { x += dppf<0xB1>(x); x += dppf<0x4E>(x); x += dppf<0x141>(x); return x; }
typedef short v4i16_t __attribute__((ext_vector_type(4)));
typedef __bf16 bf16x2_t __attribute__((ext_vector_type(2)));
__device__ __forceinline__ s16x4 tr_read(LAS const unsigned char* p) { return __builtin_bit_cast(s16x4, __builtin_amdgcn_ds_read_tr16_b64_v4i16((LAS v4i16_t*)p)); }
__device__ __forceinline__ f32x4 mfma16(bf16x8 a, bf16x8 b, f32x4 c) { return __builtin_amdgcn_mfma_f32_16x16x32_bf16(a, b, c, 0, 0, 0); }

__device__ __forceinline__ int opaque_tid() { int t = threadIdx.x; asm volatile("" : "+v"(t)); return t; }
__device__ __forceinline__ unsigned char* opaque_ptr(unsigned char* p) { size_t z = 0; asm volatile("" : "+s"(z)); return p + z; }
struct EpiSwiglu {
    static constexpr bool PERM = false, AFTER_DRAIN = false;
    bf16_t* H; const float* rowss;
    __device__ __forceinline__ void operator()(const f32x4 (&acc)[2][2][4][2], const pg8::Unit& u, int wr, int wc, int fr, int fq) const {
        const int row0 = u.pm * 256 + wr * 64 + fr, col0 = u.pn * 128 + wc * 32 + 8 * fq;
        float rsv[8];
#pragma unroll
        for (int gi = 0; gi < 8; ++gi) rsv[gi] = rowss ? rowss[row0 + (gi >> 2) * 128 + (gi & 3) * 16] : 0.f;
#pragma unroll
        for (int gi = 0; gi < 8; ++gi) rsv[gi] = rowss ? rsqrtf(rsv[gi] * (1.0f / DM) + NORM_EPS) : 1.0f;
#pragma unroll
        for (int ai = 0; ai < 2; ++ai)
#pragma unroll
            for (int m = 0; m < 4; ++m) {
                const int row = row0 + ai * 128 + m * 16;
                const float rs = rsv[ai * 4 + m];
                bf16_t* rowp = H + (size_t)row * DFF + col0;
                float h[8];
#pragma unroll
                for (int bj = 0; bj < 2; ++bj)
#pragma unroll
                    for (int j = 0; j < 4; ++j) h[bj * 4 + j] = siluf_(acc[ai][bj][m][0][j] * rs) * (acc[ai][bj][m][1][j] * rs);
                *(u32x4*)rowp = pack8(h);
                asm volatile("" ::: "memory");
            }
    }
};
struct EpiResid {
    static constexpr bool PERM = false, AFTER_DRAIN = false;
    float* X; float scale; bf16_t* XG; const float* g; float* rowss; const float* xin_a; const float* xin_b;
    __device__ __forceinline__ void operator()(const f32x4 (&acc)[2][2][4][2], const pg8::Unit& u, int wr, int wc, int fr, int fq) const {
        const int row0 = u.pm * 256 + wr * 64 + fr, col0 = u.pn * 256 + wc * 32 + 4 * fq;
        f32x4 gv[2][2];
#pragma unroll
        for (int bj = 0; bj < 2; ++bj)
#pragma unroll
            for (int n = 0; n < 2; ++n) gv[bj][n] = XG ? *(const f32x4*)(g + col0 + bj * 128 + n * 16) : (f32x4){0.f, 0.f, 0.f, 0.f};
        const float* Xs = xin_a ? (u.pm < 256 ? xin_a : xin_b - (size_t)M_PROMPT * DM) : X;
        f32x4 xin[2][2][2];
#pragma unroll
        for (int gi = 0; gi < 9; ++gi) {
            if (gi < 8) {
                const float* rowp = Xs + (size_t)(row0 + (gi >> 2) * 128 + (gi & 3) * 16) * DM + col0;
#pragma unroll
                for (int bj = 0; bj < 2; ++bj)
#pragma unroll
                    for (int n = 0; n < 2; ++n) xin[gi & 1][bj][n] = *(const f32x4*)(rowp + bj * 128 + n * 16);
            }
            if (gi > 0) {
                const int gp = gi - 1, ai = gp >> 2, m = gp & 3;
                const int row = row0 + ai * 128 + m * 16;
                float* rowp = X + (size_t)row * DM + col0;
                float ssq = 0.f;
#pragma unroll
                for (int bj = 0; bj < 2; ++bj)
#pragma unroll
                    for (int n = 0; n < 2; ++n) { f32x4 v = xin[gp & 1][bj][n]; v += acc[ai][bj][m][n] * scale; *(f32x4*)(rowp + bj * 128 + n * 16) = v;
                        if (XG) { ssq += (v[0] * v[0] + v[1] * v[1]) + (v[2] * v[2] + v[3] * v[3]); const f32x4 o = v * gv[bj][n]; u32x2 w; w.x = pk2(o[0], o[1]); w.y = pk2(o[2], o[3]);
                            *(u32x2*)(XG + (size_t)row * DM + col0 + bj * 128 + n * 16) = w; } }
                if (XG) { ssq += __shfl_xor(ssq, 16); ssq += __shfl_xor(ssq, 32);
                    if (fq == 0) __hip_atomic_fetch_add(rowss + row, ssq, __ATOMIC_RELAXED, __HIP_MEMORY_SCOPE_AGENT); }
            }
            asm volatile("" ::: "memory");
        }
    }
};
struct EpiSplit {
    static constexpr bool PERM = true, AFTER_DRAIN = false;
    bf16_t* b0; int ld0, t0; bf16_t* b1; int ld1, t1; bf16_t* b2; int ld2; const float* rowss;
    __device__ __forceinline__ void operator()(const f32x4 (&acc)[2][2][4][2], const pg8::Unit& u, int wr, int wc, int fr, int fq) const {
        bf16_t* base; int ld, ct;
        if (u.pn < t0) { base = b0; ld = ld0; ct = u.pn; } else if (u.pn < t1) { base = b1; ld = ld1; ct = u.pn - t0; } else { base = b2; ld = ld2; ct = u.pn - t1; }
        const int row0 = u.pm * 256 + wr * 64 + fr, col0 = ct * 256 + wc * 32 + 8 * fq;
        float rsv[8];
#pragma unroll
        for (int gi = 0; gi < 8; ++gi) rsv[gi] = rowss[row0 + (gi >> 2) * 128 + (gi & 3) * 16];
#pragma unroll
        for (int gi = 0; gi < 8; ++gi) rsv[gi] = rsqrtf(rsv[gi] * (1.0f / DM) + NORM_EPS);
#pragma unroll
        for (int ai = 0; ai < 2; ++ai)
#pragma unroll
            for (int m = 0; m < 4; ++m) {
                const int row = row0 + ai * 128 + m * 16;
                const float rs = rsv[ai * 4 + m];
                bf16_t* rowp = base + (size_t)row * ld + col0;
#pragma unroll
                for (int bj = 0; bj < 2; ++bj) {
                    const f32x4 v0 = acc[ai][bj][m][0] * rs, v1 = acc[ai][bj][m][1] * rs;
                    u32x4 w; w.x = pk2(v0[0], v0[1]); w.y = pk2(v0[2], v0[3]); w.z = pk2(v1[0], v1[1]); w.w = pk2(v1[2], v1[3]);
                    *(u32x4*)(rowp + bj * 128) = w;
                }
                asm volatile("" ::: "memory");
            }
    }
};

template <int MAP> __device__ __forceinline__ int src_col(int s) {
    if (MAP == 0) return s;
    const int pn = s >> 8, bj = (s >> 7) & 1, wc = (s >> 5) & 3, n = (s >> 4) & 1, fq = (s >> 2) & 3, jj = s & 3;
    return n * DFF + 128 * pn + 32 * wc + 8 * fq + 4 * bj + jj;
}
template <int MAP> __device__ void convert_T(const float* __restrict__ src, bf16_t* __restrict__ dst, int K, int N, LAS float* tile, int rot) {
    const int tk = K / 64, tn = N / 64, nt = tk * tn, tid = opaque_tid(), G = gridDim.x;
    const int kk0 = tid >> 4, sg = tid & 15;
    int t = (int)((blockIdx.x + rot) % G);
    float4 va = make_float4(0.f, 0.f, 0.f, 0.f), vb = va;
    if (t < nt) { const int k0 = (t % tk) * 64, s0 = (t / tk) * 64; const int c = src_col<MAP>(s0 + sg * 4);
        va = *(const float4*)(src + (size_t)(k0 + kk0) * N + c); vb = *(const float4*)(src + (size_t)(k0 + kk0 + 32) * N + c); }
    for (; t < nt; t += G) {
        const int k0 = (t % tk) * 64, s0 = (t / tk) * 64;
        { LAS float* tp = tile + kk0 * 65 + sg * 4; tp[0] = va.x; tp[1] = va.y; tp[2] = va.z; tp[3] = va.w;
          LAS float* tq = tile + (kk0 + 32) * 65 + sg * 4; tq[0] = vb.x; tq[1] = vb.y; tq[2] = vb.z; tq[3] = vb.w; }
        if (t + G < nt) {
            const int t2 = t + G, k2 = (t2 % tk) * 64, s2 = (t2 / tk) * 64; const int c = src_col<MAP>(s2 + sg * 4);
            va = *(const float4*)(src + (size_t)(k2 + kk0) * N + c); vb = *(const float4*)(src + (size_t)(k2 + kk0 + 32) * N + c); }
        asm volatile("s_waitcnt lgkmcnt(0)" ::: "memory"); __builtin_amdgcn_s_barrier(); asm volatile("" ::: "memory");
        {
            const int slot = tid >> 3, kc = tid & 7; float f[8];
#pragma unroll
            for (int i = 0; i < 8; ++i) f[i] = tile[(kc * 8 + i) * 65 + slot];
            *(u32x4*)(dst + (size_t)(s0 + slot) * K + k0 + kc * 8) = pack8(f);
        }
        asm volatile("s_waitcnt lgkmcnt(0)" ::: "memory"); __builtin_amdgcn_s_barrier(); asm volatile("" ::: "memory");
    }
}

__device__ void norm_rows(const float* xa, const float* xb, int split, float* xcopy, const float* g1, float* x1out, const float* g2, bf16_t* xn) {
    const int tid_ = opaque_tid(), lane = tid_ & 63, wave = __builtin_amdgcn_readfirstlane(tid_ >> 6);
    const int stride = gridDim.x * 8;
    for (int row0 = blockIdx.x * 8 + wave; row0 < M_TOK; row0 += 2 * stride) {
        int rows[2]; rows[0] = row0; rows[1] = (row0 + stride < M_TOK) ? row0 + stride : row0;
        f32x4 v[2][4]; float ss[2] = {0.f, 0.f};
#pragma unroll
        for (int q = 0; q < 2; ++q) { const int row = rows[q];
            const float* src = (row < split) ? xa + (size_t)row * DM : xb + (size_t)(row - split) * DM;
#pragma unroll
            for (int i = 0; i < 4; ++i) v[q][i] = *(const f32x4*)(src + i * 256 + lane * 4); }
#pragma unroll
        for (int q = 0; q < 2; ++q) {
#pragma unroll
            for (int i = 0; i < 4; ++i) ss[q] += v[q][i][0] * v[q][i][0] + v[q][i][1] * v[q][i][1] + v[q][i][2] * v[q][i][2] + v[q][i][3] * v[q][i][3];
            if (xcopy) {
#pragma unroll
                for (int i = 0; i < 4; ++i) *(f32x4*)(xcopy + (size_t)rows[q] * DM + i * 256 + lane * 4) = v[q][i];
            }
        }
        ss[0] = wave_sum(ss[0]); ss[1] = wave_sum(ss[1]);
        float r[2]; r[0] = rsqrtf(ss[0] * (1.0f / DM) + NORM_EPS); r[1] = rsqrtf(ss[1] * (1.0f / DM) + NORM_EPS);
        if (g1) {
            float s2[2] = {0.f, 0.f};
#pragma unroll
            for (int i = 0; i < 4; ++i) { const f32x4 g = *(const f32x4*)(g1 + i * 256 + lane * 4);
#pragma unroll
                for (int q = 0; q < 2; ++q) { v[q][i] = v[q][i] * r[q] * g; *(f32x4*)(x1out + (size_t)rows[q] * DM + i * 256 + lane * 4) = v[q][i];
                    s2[q] += v[q][i][0] * v[q][i][0] + v[q][i][1] * v[q][i][1] + v[q][i][2] * v[q][i][2] + v[q][i][3] * v[q][i][3]; } }
            s2[0] = wave_sum(s2[0]); s2[1] = wave_sum(s2[1]);
            r[0] = rsqrtf(s2[0] * (1.0f / DM) + NORM_EPS); r[1] = rsqrtf(s2[1] * (1.0f / DM) + NORM_EPS);
        }
        if (g2) {
#pragma unroll
            for (int i = 0; i < 4; ++i) { const f32x4 g = *(const f32x4*)(g2 + i * 256 + lane * 4);
#pragma unroll
                for (int q = 0; q < 2; ++q) { const f32x4 o = v[q][i] * r[q] * g;
                    u32x2 w; w.x = pk2(o[0], o[1]); w.y = pk2(o[2], o[3]); *(u32x2*)(xn + (size_t)rows[q] * DM + i * 256 + lane * 4) = w; } }
        }
    }
}

__device__ void sgu_item(const Params& PP, int chunk, LAS unsigned char* lds) {
    Params P = PP; P.ws = opaque_ptr(PP.ws);
    const int tid = opaque_tid(), lane = tid & 63, wave = __builtin_amdgcn_readfirstlane(tid >> 6), l15 = lane & 15, quad = lane >> 4;
    constexpr int PITCH = 1056;
    const bf16_t* Puv = (const bf16_t*)(P.ws + WS_PUV);
    bf16_t* MO = (bf16_t*)(P.ws + WS_XN);
    const size_t row0 = (size_t)chunk * 128;
    {
        float gn[8];
        { const f32x4 a = *(const f32x4*)(P.in[12] + lane * 8), b = *(const f32x4*)(P.in[12] + lane * 8 + 4); gn[0] = a[0]; gn[1] = a[1]; gn[2] = a[2]; gn[3] = a[3]; gn[4] = b[0]; gn[5] = b[1]; gn[6] = b[2]; gn[7] = b[3]; }
        for (int i = 0; i < 16; ++i) {
            const int p = wave * 16 + i;
            const u32x4 raw = *(const u32x4*)(Puv + (row0 + p) * 1024 + 512 + lane * 8);
            float v[8]; unpack8(raw, v); float ss = 0.f;
#pragma unroll
            for (int e = 0; e < 8; ++e) { v[e] = gelu_tanh(v[e]); ss += v[e] * v[e]; }
            ss = wave_sum(ss);
            const float r = rsqrtf(ss * (1.0f / 512.0f) + NORM_EPS);
#pragma unroll
            for (int e = 0; e < 8; ++e) v[e] = v[e] * r * gn[e];
            *(LAS u32x4*)(lds + p * PITCH + lane * 16) = pack8(v);
        }
    }
    __syncthreads();
    const int g = wave >> 1, cbase = (wave >> 1) * 128 + (wave & 1) * 64;
    const bf16_t* Wg = (const bf16_t*)(P.ws + WS_SGUW) + (size_t)g * 128 * 128;
    const int r4 = l15 >> 2, c4 = l15 & 3;
    for (int qh = 0; qh < 2; ++qh) {
        f32x4 acc[4][4];
#pragma unroll
        for (int a = 0; a < 4; ++a)
#pragma unroll
            for (int b = 0; b < 4; ++b) acc[a][b] = (f32x4){0.f, 0.f, 0.f, 0.f};
#pragma unroll
        for (int ks = 0; ks < 4; ++ks) {
            bf16x8 bfr[4];
#pragma unroll
            for (int qt = 0; qt < 4; ++qt) bfr[qt] = *(const bf16x8*)(Wg + (size_t)(qh * 64 + qt * 16 + l15) * 128 + ks * 32 + quad * 8);
#pragma unroll
            for (int ct = 0; ct < 4; ++ct) {
                LAS const unsigned char* ap = lds + (ks * 32 + quad * 8 + r4) * PITCH + (cbase + ct * 16 + 4 * c4) * 2;
                const s16x4 lo = tr_read(ap), hi = tr_read(ap + 4 * PITCH);
                const bf16x8 a = {lo[0], lo[1], lo[2], lo[3], hi[0], hi[1], hi[2], hi[3]};
#pragma unroll
                for (int qt = 0; qt < 4; ++qt) acc[ct][qt] = mfma16(a, bfr[qt], acc[ct][qt]);
            }
        }
#pragma unroll
        for (int qt = 0; qt < 4; ++qt) {
            const int q = qh * 64 + qt * 16 + l15;
            const float bq = P.in[14][g * 128 + q];
#pragma unroll
            for (int ct = 0; ct < 4; ++ct) {
                const int c = cbase + ct * 16 + quad * 4;
                const u32x2 ur = *(const u32x2*)(Puv + (row0 + q) * 1024 + c);
                const float u0 = gelu_tanh(bflo(ur.x)), u1 = gelu_tanh(bfhi(ur.x)), u2 = gelu_tanh(bflo(ur.y)), u3 = gelu_tanh(bfhi(ur.y));
                u32x2 w; w.x = pk2(u0 * (acc[ct][qt][0] + bq), u1 * (acc[ct][qt][1] + bq)); w.y = pk2(u2 * (acc[ct][qt][2] + bq), u3 * (acc[ct][qt][3] + bq));
                *(u32x2*)(MO + (row0 + q) * 1024 + c) = w;
            }
        }
    }
    __syncthreads();
}

template <int LPR> __device__ __forceinline__ float reduce_row(float x) {
    x += dppf<0xB1>(x); x += dppf<0x4E>(x); x += dppf<0x141>(x);
    if (LPR == 16) x += dppf<0x140>(x);
    return x;
}
__device__ __forceinline__ float reduce32(float x) {
    x += dppf<0xB1>(x); x += dppf<0x4E>(x); x += dppf<0x141>(x); x += dppf<0x140>(x); x += __shfl_xor(x, 16); return x;
}
__device__ __forceinline__ void lds_barrier() { asm volatile("s_waitcnt lgkmcnt(0)" ::: "memory"); __builtin_amdgcn_s_barrier(); asm volatile("" ::: "memory"); }
template <int NV> struct ScanSet { f32x4 kk[NV], w[NV], ka[NV], kp[NV], r[NV]; float vv; };
template <int NV> __device__ __forceinline__ void scan_load(ScanSet<NV>& t, LAS const float* KK, LAS const float* Wd, LAS const float* KKA, LAS const float* KP, LAS const float* Rr, LAS const float* Vv, int o, int ov, bool want_y) {
#pragma unroll
    for (int u = 0; u < NV; ++u) { t.kk[u] = *(LAS const f32x4*)(KK + o + u * 32); t.w[u] = *(LAS const f32x4*)(Wd + o + u * 32); t.ka[u] = *(LAS const f32x4*)(KKA + o + u * 32); t.kp[u] = *(LAS const f32x4*)(KP + o + u * 32); }
    if (want_y) {
#pragma unroll
        for (int u = 0; u < NV; ++u) t.r[u] = *(LAS const f32x4*)(Rr + o + u * 32);
    }
    t.vv = Vv[ov];
}
typedef float f32x2v __attribute__((ext_vector_type(2)));
template <int LPR, int NV> __device__ __forceinline__ float scan_step(float* S, const ScanSet<NV>& t, bool want_y, float& ypart) {
    f32x2v acc = {0.f, 0.f};
#pragma unroll
    for (int u = 0; u < NV; ++u)
#pragma unroll
        for (int hh = 0; hh < 2; ++hh) { const f32x2v s2 = {S[4 * u + 2 * hh], S[4 * u + 2 * hh + 1]}, k2 = {t.kk[u][2 * hh], t.kk[u][2 * hh + 1]}; acc = s2 * k2 + acc; }
    float sa = acc.x + acc.y, yb = ypart;
    sa += dppf<0xB1>(sa); yb += dppf<0xB1>(yb); sa += dppf<0x4E>(sa); yb += dppf<0x4E>(yb); sa += dppf<0x141>(sa); yb += dppf<0x141>(yb);
    const f32x2v sa2 = {sa, sa}, vv2 = {t.vv, t.vv};
#pragma unroll
    for (int u = 0; u < NV; ++u)
#pragma unroll
        for (int hh = 0; hh < 2; ++hh) {
            f32x2v s2 = {S[4 * u + 2 * hh], S[4 * u + 2 * hh + 1]};
            const f32x2v w2 = {t.w[u][2 * hh], t.w[u][2 * hh + 1]}, kp2 = {t.kp[u][2 * hh], t.kp[u][2 * hh + 1]}, ka2 = {t.ka[u][2 * hh], t.ka[u][2 * hh + 1]};
            f32x2v tt = vv2 * kp2; tt = tt - sa2 * ka2;
            s2 = s2 * w2 + tt;
            S[4 * u + 2 * hh] = s2.x; S[4 * u + 2 * hh + 1] = s2.y;
        }
    if (want_y) {
        f32x2v yacc = {0.f, 0.f};
#pragma unroll
        for (int u = 0; u < NV; ++u)
#pragma unroll
            for (int hh = 0; hh < 2; ++hh) { const f32x2v s2 = {S[4 * u + 2 * hh], S[4 * u + 2 * hh + 1]}, r2 = {t.r[u][2 * hh], t.r[u][2 * hh + 1]}; yacc = s2 * r2 + yacc; }
        ypart = yacc.x + yacc.y;
    }
    return yb;
}
struct ScanSet2 { f32x4 kk, w, ka, kp, r; float vv0, vv1; };
__device__ __forceinline__ void scan_load2(ScanSet2& t, LAS const float* KK, LAS const float* Wd, LAS const float* KKA, LAS const float* KP, LAS const float* Rr, LAS const float* Vv, int o, int ov, bool want_y) {
    t.kk = *(LAS const f32x4*)(KK + o); t.w = *(LAS const f32x4*)(Wd + o); t.ka = *(LAS const f32x4*)(KKA + o); t.kp = *(LAS const f32x4*)(KP + o);
    if (want_y) t.r = *(LAS const f32x4*)(Rr + o);
    t.vv0 = Vv[ov]; t.vv1 = Vv[ov + 4];
}
__device__ __forceinline__ float dpp16(float x) { x += dppf<0xB1>(x); x += dppf<0x4E>(x); x += dppf<0x141>(x); x += dppf<0x140>(x); return x; }
__device__ __forceinline__ void scan_step2(f32x2v* SS, const ScanSet2& t, bool want_y, float& y0, float& y1, float& yr0, float& yr1) {
    f32x2v a2 = SS[0] * (f32x2v){t.kk[0], t.kk[0]};
#pragma unroll
    for (int i = 1; i < 4; ++i) a2 = SS[i] * (f32x2v){t.kk[i], t.kk[i]} + a2;
    float a0 = a2.x, a1 = a2.y, b0 = y0, b1 = y1;
#define SCAN_OPAQUE4() asm("" : "+v"(a0), "+v"(a1), "+v"(b0), "+v"(b1))
    SCAN_OPAQUE4();
    a0 += dppf<0xB1>(a0); a1 += dppf<0xB1>(a1); b0 += dppf<0xB1>(b0); b1 += dppf<0xB1>(b1); SCAN_OPAQUE4();
    a0 += dppf<0x4E>(a0); a1 += dppf<0x4E>(a1); b0 += dppf<0x4E>(b0); b1 += dppf<0x4E>(b1); SCAN_OPAQUE4();
    a0 += dppf<0x141>(a0); a1 += dppf<0x141>(a1); b0 += dppf<0x141>(b0); b1 += dppf<0x141>(b1); SCAN_OPAQUE4();
    a0 += dppf<0x140>(a0); a1 += dppf<0x140>(a1); b0 += dppf<0x140>(b0); b1 += dppf<0x140>(b1); SCAN_OPAQUE4();
#undef SCAN_OPAQUE4
    yr0 = b0; yr1 = b1;
    const f32x2v sa2 = {a0, a1}, vv2 = {t.vv0, t.vv1};
#pragma unroll
    for (int i = 0; i < 4; ++i) {
        f32x2v tt = vv2 * (f32x2v){t.kp[i], t.kp[i]};
        tt = tt - sa2 * (f32x2v){t.ka[i], t.ka[i]};
        SS[i] = SS[i] * (f32x2v){t.w[i], t.w[i]} + tt;
    }
    if (want_y) {
        f32x2v p2 = SS[0] * (f32x2v){t.r[0], t.r[0]};
#pragma unroll
        for (int i = 1; i < 4; ++i) p2 = SS[i] * (f32x2v){t.r[i], t.r[i]} + p2;
        y0 = p2.x; y1 = p2.y;
    }
}
template <int LPR> __device__ void scan_item(const Params& PP, int seq, int h, int dir, int rhalf, int tbeg, int tlen, int flags, const float* sin, float* sout, LAS unsigned char* lds) {
    Params P = PP; P.ws = opaque_ptr(PP.ws);
    constexpr int KPL = 64 / LPR, RPW = 64 / LPR, NV = KPL / 4;
    const int tid = opaque_tid(), lane = tid & 63, wave = __builtin_amdgcn_readfirstlane(tid >> 6), l15 = lane & 15, quad = lane >> 4;
    const int Tseq = seq < 32 ? 2048 : 16384;
    const size_t base = seq < 32 ? (size_t)seq * 2048 : (size_t)M_PROMPT;
    const bf16_t* Prkvg = (const bf16_t*)(P.ws + WS_PRKVG);
    const bf16_t* Pwa = (const bf16_t*)(P.ws + WS_PWA);
    bf16_t* Yd = (bf16_t*)(P.ws + WS_Y) + (size_t)dir * M_TOK * 512;
    float* RKR = (float*)(P.ws + WS_RKR) + (size_t)dir * M_TOK * 8;
    LAS bf16_t* RAW0 = (LAS bf16_t*)lds;
    LAS bf16_t* ZROW = (LAS bf16_t*)(lds + 21760);
    LAS float* Wd = (LAS float*)(lds + 22528);
    LAS float* Aa = Wd + 1024; LAS float* Rr = Aa + 1024; LAS float* KP = Rr + 1024; LAS float* Vv = KP + 1024; LAS float* KK = Vv + 1024; LAS float* KKA = KK + 1024; LAS float* Yc = KKA + 1024;
    if (tid < 160) ((LAS unsigned*)ZROW)[tid] = 0u;
    LAS bf16_t* ALDS = (LAS bf16_t*)(lds + 55296);
    const int j_a = tid / 40, seg_a = (tid % 40) >> 3, c8_a = tid & 7;
    const int idx_b = tid + 512, j_b = idx_b / 40, seg_b = (idx_b % 40) >> 3, c8_b = idx_b & 7;
    const bool has_b = idx_b < 640;
    const int coff_a = seg_a < 3 ? seg_a * 512 + h * 64 + c8_a * 8 : dir * 128 + (seg_a - 3) * 64 + c8_a * 8;
    const int coff_b = seg_b < 3 ? seg_b * 512 + h * 64 + c8_b * 8 : dir * 128 + (seg_b - 3) * 64 + c8_b * 8;
    const int dst_a = (j_a + 1) * 320 + seg_a * 64 + c8_a * 8, dst_b = (j_b + 1) * 320 + seg_b * 64 + c8_b * 8;
    const bf16_t* src_a = (seg_a < 3 ? Prkvg + base * 2048 : Pwa + base * 256) + coff_a; const int ld_a = seg_a < 3 ? 2048 : 256;
    const bf16_t* src_b = (seg_b < 3 ? Prkvg + base * 2048 : Pwa + base * 256) + coff_b; const int ld_b = seg_b < 3 ? 2048 : 256;
    const int ltype = wave >> 2, lch = (wave & 3) * 16 + l15;
    const bf16_t* Wt = (const bf16_t*)(P.ws + WS_LORA) + (size_t)(dir * 2 + ltype) * 512 * 64 + (size_t)(h * 64 + lch) * 64;
    const bf16x8 lb0 = *(const bf16x8*)(Wt + quad * 8), lb1 = *(const bf16x8*)(Wt + 32 + quad * 8);
    const float lbias = ltype == 0 ? P.in[17][dir * 512 + h * 64 + lch] : P.in[19][dir * 512 + h * 64 + lch];
    const int tk = tid >> 5, c2 = tid & 31;
    float mu_r[2], mu_k[2], mu_v[2], k_k[2], k_a[2], r_k[2];
#pragma unroll
    for (int e = 0; e < 2; ++e) { const int ch = h * 64 + 2 * c2 + e;
        mu_r[e] = P.in[15][dir * 1536 + ch]; mu_k[e] = P.in[15][dir * 1536 + 512 + ch]; mu_v[e] = P.in[15][dir * 1536 + 1024 + ch];
        k_k[e] = P.in[21][ch]; k_a[e] = P.in[22][ch]; r_k[e] = P.in[23][ch]; }
    float amu[2][2];
#pragma unroll
    for (int ty = 0; ty < 2; ++ty)
#pragma unroll
        for (int e = 0; e < 2; ++e) amu[ty][e] = P.in[16][dir * 128 + ty * 64 + 2 * c2 + e];
#define SCAN_BUILD_A(RAWN, PREV0) do { \
        LAS const bf16_t* cur_ = (RAWN) + (tk + 1) * 320 + 192 + 2 * c2; \
        LAS const bf16_t* prv_ = (tk > 0 ? (RAWN) + tk * 320 : (PREV0)) + 192 + 2 * c2; \
        _Pragma("unroll") for (int ty = 0; ty < 2; ++ty) { \
            const unsigned xc_ = *(LAS const unsigned*)(cur_ + ty * 64), xp_ = *(LAS const unsigned*)(prv_ + ty * 64); \
            float z0_ = bflo(xc_) + (bflo(xp_) - bflo(xc_)) * amu[ty][0], z1_ = bfhi(xc_) + (bfhi(xp_) - bfhi(xc_)) * amu[ty][1]; \
            if (ty == 0) { z0_ = tanhf_(z0_); z1_ = tanhf_(z1_); } \
            *(LAS unsigned*)(ALDS + ty * 1152 + tk * 72 + 2 * c2) = pk2(z0_, z1_); } } while (0)
    static_assert(LPR == 16, "two rows per lane, 16 lanes per row");
    const int srow = wave * 8 + (lane >> 4), sq = lane & 15;
    f32x2v SS[4];
#pragma unroll
    for (int i = 0; i < 4; ++i) { const int kidx = sq * 4 + i;
        SS[i].x = (flags & 1) ? (kidx == srow ? 1.f : 0.f) : (sin ? sin[srow * 64 + kidx] : 0.f);
        SS[i].y = (flags & 1) ? (kidx == srow + 4 ? 1.f : 0.f) : (sin ? sin[(srow + 4) * 64 + kidx] : 0.f); }
    const int nch = tlen / 16;
    const int tstep = dir == 0 ? 16 : -16;
    const int tfirst = dir == 0 ? tbeg : tbeg + tlen - 16;
    const int tprev = dir == 0 ? tbeg - 1 : tbeg + tlen;
    const bool has_prev = tprev >= 0 && tprev < Tseq;
    if (has_prev && tid < 40) {
        const int sg = tid >> 3, c8 = tid & 7;
        const bf16_t* sp = sg < 3 ? Prkvg + (base + tprev) * 2048 + sg * 512 + h * 64 + c8 * 8 : Pwa + (base + tprev) * 256 + dir * 128 + (sg - 3) * 64 + c8 * 8;
        *(LAS u32x4*)(RAW0 + 5440 + 16 * 320 + sg * 64 + c8 * 8) = *(const u32x4*)sp;
    }
    const bool in_on = (flags & 2) == 0, wr_y = (flags & 4) != 0, wr_rk = (flags & 8) != 0;
#define SCAN_TOK(t0, j) (dir == 0 ? (t0) + (j) : (t0) + 15 - (j))
    u32x4 pre_a, pre_b = (u32x4){0u, 0u, 0u, 0u};
    {
        pre_a = *(const u32x4*)(src_a + (size_t)SCAN_TOK(tfirst, j_a) * ld_a);
        if (has_b) pre_b = *(const u32x4*)(src_b + (size_t)SCAN_TOK(tfirst, j_b) * ld_b);
        *(LAS u32x4*)(RAW0 + dst_a) = pre_a;
        if (has_b) *(LAS u32x4*)(RAW0 + dst_b) = pre_b;
        if (nch > 1) {
            pre_a = *(const u32x4*)(src_a + (size_t)SCAN_TOK(tfirst + tstep, j_a) * ld_a);
            if (has_b) pre_b = *(const u32x4*)(src_b + (size_t)SCAN_TOK(tfirst + tstep, j_b) * ld_b);
        }
    }
    __syncthreads();
    SCAN_BUILD_A(RAW0, (has_prev ? RAW0 + 5440 + 16 * 320 : ZROW));
    lds_barrier();
    u32x4 ypend = (u32x4){0u, 0u, 0u, 0u}; bf16_t* ypend_ptr = nullptr;
    for (int c = 0; c < nch; ++c) {
        LAS bf16_t* RAW = RAW0 + (c & 1) * 5440;
        LAS bf16_t* RAWp = RAW0 + ((c & 1) ^ 1) * 5440;
        const int t0 = tfirst + c * tstep;
        {
            bf16x8 af[2];
#pragma unroll
            for (int ks = 0; ks < 2; ++ks) af[ks] = *(LAS const bf16x8*)(ALDS + ltype * 1152 + l15 * 72 + ks * 32 + quad * 8);
            f32x4 d = mfma16(af[0], lb0, (f32x4){0.f, 0.f, 0.f, 0.f});
            d = mfma16(af[1], lb1, d);
            LAS float* dstp = (ltype == 0 ? Wd : Aa) + lch;
#pragma unroll
            for (int jj = 0; jj < 4; ++jj) { const float sg = sigmoidf_(lbias + d[jj]); dstp[(quad * 4 + jj) * 64] = ltype == 0 ? __expf(-0.6065306597126334f * sg) : sg; }
        }
        {
            LAS const bf16_t* cur = RAW + (tk + 1) * 320 + 2 * c2;
            LAS const bf16_t* prv = (tk > 0 ? RAW + tk * 320 : ((c > 0 || has_prev) ? RAWp + 16 * 320 : ZROW)) + 2 * c2;
            const unsigned rc = *(LAS const unsigned*)(cur), rp = *(LAS const unsigned*)(prv);
            const unsigned kc = *(LAS const unsigned*)(cur + 64), kq = *(LAS const unsigned*)(prv + 64);
            const unsigned vc = *(LAS const unsigned*)(cur + 128), vp = *(LAS const unsigned*)(prv + 128);
            const int o = tk * 64 + 2 * c2;
            Rr[o] = bflo(rc) + (bflo(rp) - bflo(rc)) * mu_r[0]; Rr[o + 1] = bfhi(rc) + (bfhi(rp) - bfhi(rc)) * mu_r[1];
            KP[o] = bflo(kc) + (bflo(kq) - bflo(kc)) * mu_k[0]; KP[o + 1] = bfhi(kc) + (bfhi(kq) - bfhi(kc)) * mu_k[1];
            Vv[o] = in_on ? bflo(vc) + (bflo(vp) - bflo(vc)) * mu_v[0] : 0.f; Vv[o + 1] = in_on ? bfhi(vc) + (bfhi(vp) - bfhi(vc)) * mu_v[1] : 0.f;
        }
        lds_barrier();
        float rk_keep;
        {
            const int o = tk * 64 + 2 * c2;
            const float kz0 = KP[o], kz1 = KP[o + 1], a0 = Aa[o], a1 = Aa[o + 1];
            const float q0 = kz0 * k_k[0], q1 = kz1 * k_k[1];
            const float kp0 = kz0 * (1.0f + (a0 - 1.0f) * k_a[0]), kp1 = kz1 * (1.0f + (a1 - 1.0f) * k_a[1]);
            const float ss = reduce32(q0 * q0 + q1 * q1);
            const float rk = reduce32(Rr[o] * kp0 * r_k[0] + Rr[o + 1] * kp1 * r_k[1]);
            const float inv = __builtin_amdgcn_rsqf(fmaxf(ss, 1e-24f));
            const float kk0 = q0 * inv, kk1 = q1 * inv;
            KK[o] = kk0; KK[o + 1] = kk1; KKA[o] = kk0 * a0; KKA[o + 1] = kk1 * a1;
            KP[o] = kp0; KP[o + 1] = kp1;
            rk_keep = rk;
        }
        if (c + 1 < nch) {
            *(LAS u32x4*)(RAWp + dst_a) = pre_a;
            if (has_b) *(LAS u32x4*)(RAWp + dst_b) = pre_b;
            if (c + 2 < nch) {
                pre_a = *(const u32x4*)(src_a + (size_t)SCAN_TOK(t0 + 2 * tstep, j_a) * ld_a);
                if (has_b) pre_b = *(const u32x4*)(src_b + (size_t)SCAN_TOK(t0 + 2 * tstep, j_b) * ld_b);
            }
        }
        if (wr_rk && c2 == 0) RKR[(base + SCAN_TOK(t0, tk)) * 8 + h] = rk_keep;
        if (ypend_ptr) *(u32x4*)ypend_ptr = ypend;
        lds_barrier();
        if (c + 1 < nch) SCAN_BUILD_A(RAWp, RAW + 16 * 320);
        {
            ScanSet2 sa_, sb_;
            scan_load2(sa_, KK, Wd, KKA, KP, Rr, Vv, sq * 4, srow, wr_y);
            float yk = 0.f, zk = 0.f, y0 = 0.f, y1 = 0.f, yr0, yr1;
#pragma unroll 1
            for (int jo = 0; jo < 16; jo += 2) {
                scan_load2(sb_, KK, Wd, KKA, KP, Rr, Vv, (jo + 1) * 64 + sq * 4, (jo + 1) * 64 + srow, wr_y);
                scan_step2(SS, sa_, wr_y, y0, y1, yr0, yr1);
                if (jo > 0 && sq == jo - 1) { yk = yr0; zk = yr1; }
                if (jo + 2 < 16) scan_load2(sa_, KK, Wd, KKA, KP, Rr, Vv, (jo + 2) * 64 + sq * 4, (jo + 2) * 64 + srow, wr_y);
                scan_step2(SS, sb_, wr_y, y0, y1, yr0, yr1);
                if (sq == jo) { yk = yr0; zk = yr1; }
            }
            yr0 = dpp16(y0); yr1 = dpp16(y1);
            if (sq == 15) { yk = yr0; zk = yr1; }
            Yc[sq * 64 + srow] = yk; Yc[sq * 64 + srow + 4] = zk;
        }
        lds_barrier();
        {
            const bool wr = wr_y && tid < 128;
            if (wr) {
                const int tq = tid >> 3, c8 = tid & 7; float f[8];
                const f32x4 a = *(LAS const f32x4*)(Yc + tq * 64 + c8 * 8), b = *(LAS const f32x4*)(Yc + tq * 64 + c8 * 8 + 4);
                f[0] = a[0]; f[1] = a[1]; f[2] = a[2]; f[3] = a[3]; f[4] = b[0]; f[5] = b[1]; f[6] = b[2]; f[7] = b[3];
                ypend = pack8(f); ypend_ptr = Yd + (base + SCAN_TOK(t0, tq)) * 512 + h * 64 + c8 * 8;
            }
        }
    }
    if (ypend_ptr) *(u32x4*)ypend_ptr = ypend;
    if (sout) { *(f32x4*)(sout + srow * 64 + sq * 4) = (f32x4){SS[0].x, SS[1].x, SS[2].x, SS[3].x}; *(f32x4*)(sout + (srow + 4) * 64 + sq * 4) = (f32x4){SS[0].y, SS[1].y, SS[2].y, SS[3].y}; }
#undef SCAN_TOK
#undef SCAN_BUILD_A
    __syncthreads();
}

__device__ void scan_carry(const Params& PP, int hd, LAS unsigned char* lds) {
    Params P = PP; P.ws = opaque_ptr(PP.ws);
    const int tid = opaque_tid();
    const float* Lm = (const float*)(P.ws + WS_STL) + (size_t)hd * NSEG * 4096;
    const float* Pm = (const float*)(P.ws + WS_STP) + (size_t)hd * NSEG * 4096;
    float* St = (float*)(P.ws + WS_STS) + (size_t)hd * NSEG * 4096;
    LAS float* Sc = (LAS float*)lds;
    LAS float* Pc = Sc + 4096;
    const int v = tid >> 3, k0 = (tid & 7) * 8;
    for (int i = 0; i < 8; ++i) { const float x = Lm[v * 64 + k0 + i]; Sc[v * 64 + k0 + i] = x; St[4096 + v * 64 + k0 + i] = x; }
    for (int sgm = 1; sgm + 1 < NSEG; ++sgm) {
        for (int i = 0; i < 8; ++i) Pc[v * 64 + k0 + i] = Pm[(size_t)sgm * 4096 + v * 64 + k0 + i];
        __syncthreads();
        float o[8];
        for (int i = 0; i < 8; ++i) o[i] = Lm[(size_t)sgm * 4096 + v * 64 + k0 + i];
        for (int j = 0; j < 64; ++j) { const float sv = Sc[v * 64 + j];
#pragma unroll
            for (int i = 0; i < 8; ++i) o[i] += sv * Pc[j * 64 + k0 + i]; }
        __syncthreads();
        for (int i = 0; i < 8; ++i) { Sc[v * 64 + k0 + i] = o[i]; St[(size_t)(sgm + 1) * 4096 + v * 64 + k0 + i] = o[i]; }
    }
    __syncthreads();
}

__device__ void rwkv_finalize(const Params& PP) {
    Params P = PP; P.ws = opaque_ptr(PP.ws);
    const int tid_ = opaque_tid(), lane = tid_ & 63, wave = __builtin_amdgcn_readfirstlane(tid_ >> 6);
    const bf16_t* Prkvg = (const bf16_t*)(P.ws + WS_PRKVG);
    const bf16_t* Y0 = (const bf16_t*)(P.ws + WS_Y);
    const bf16_t* Y1 = Y0 + (size_t)M_TOK * 512;
    const float* RKR0 = (const float*)(P.ws + WS_RKR);
    const float* RKR1 = RKR0 + (size_t)M_TOK * 8;
    bf16_t* MO = (bf16_t*)(P.ws + WS_XN);
    const int col = lane * 8, hh = lane >> 3;
    float gw[8], gb[8], muf[8], mub[8];
#pragma unroll
    for (int i = 0; i < 8; ++i) { gw[i] = P.in[24][col + i]; gb[i] = P.in[25][col + i]; muf[i] = P.in[15][1024 + col + i]; mub[i] = P.in[15][1536 + 1024 + col + i]; }
    for (int row = blockIdx.x * 8 + wave; row < M_TOK; row += gridDim.x * 8) {
        const int t = row < M_PROMPT ? (row & 2047) : row - M_PROMPT, T = row < M_PROMPT ? 2048 : 16384;
        float yf[8], yb[8], vc[8], vp[8], vn[8], gg[8];
        unpack8(*(const u32x4*)(Y0 + (size_t)row * 512 + col), yf); unpack8(*(const u32x4*)(Y1 + (size_t)row * 512 + col), yb);
        unpack8(*(const u32x4*)(Prkvg + (size_t)row * 2048 + 1024 + col), vc);
        unpack8(*(const u32x4*)(Prkvg + (size_t)row * 2048 + 1536 + col), gg);
        if (t > 0) unpack8(*(const u32x4*)(Prkvg + (size_t)(row - 1) * 2048 + 1024 + col), vp); else { for (int i = 0; i < 8; ++i) vp[i] = 0.f; }
        if (t < T - 1) unpack8(*(const u32x4*)(Prkvg + (size_t)(row + 1) * 2048 + 1024 + col), vn); else { for (int i = 0; i < 8; ++i) vn[i] = 0.f; }
        const float rf = RKR0[(size_t)row * 8 + hh], rb = RKR1[(size_t)row * 8 + hh];
        float s = 0.f;
#pragma unroll
        for (int i = 0; i < 8; ++i) { yf[i] += yb[i]; s += yf[i]; }
        const float mean = reduce8(s) * (1.0f / 64.0f);
        float q = 0.f;
#pragma unroll
        for (int i = 0; i < 8; ++i) { yf[i] -= mean; q += yf[i] * yf[i]; }
        const float rstd = rsqrtf(reduce8(q) * (1.0f / 64.0f) + 64e-5f);
        float o[8];
#pragma unroll
        for (int i = 0; i < 8; ++i) {
            const float vzf = vc[i] + (vp[i] - vc[i]) * muf[i], vzb = vc[i] + (vn[i] - vc[i]) * mub[i];
            o[i] = (yf[i] * rstd * gw[i] + gb[i] + rf * vzf + rb * vzb) * sigmoidf_(gg[i]);
        }
        *(u32x4*)(MO + (size_t)row * 1024 + 512 + col) = pack8(o);
    }
}

__device__ void attn_item(const Params& PP, int seq, int h, int tile, LAS unsigned char* lds) {
    Params P = PP; P.ws = opaque_ptr(PP.ws);
    const int tid = opaque_tid(), lane = tid & 63, wave = __builtin_amdgcn_readfirstlane(tid >> 6), l15 = lane & 15, quad = lane >> 4;
    const int T = seq < 32 ? 2048 : 16384;
    const size_t base = seq < 32 ? (size_t)seq * 2048 : (size_t)M_PROMPT;
    const int T0 = tile * 256;
    const bf16_t* QKV = (const bf16_t*)(P.ws + WS_BIG);
    bf16_t* MO = (bf16_t*)(P.ws + WS_XN);
    LAS float* OACC = (LAS float*)lds;
    LAS float* LS = (LAS float*)(lds + 256 * 272);
    LAS unsigned char* VST = lds + 256 * 272 + 1024 + wave * (32 * 144);
    const float slope = exp2f(-0.5f * (float)(h + 1));
    float gqk[16];
#pragma unroll
    for (int i = 0; i < 16; ++i) { const int e = (i >> 3) * 32 + quad * 8 + (i & 7); gqk[i] = P.in[28][e] * P.in[29][e]; }
    const int r4 = l15 >> 2, c4 = l15 & 3;
    float biasL[9][4];
#pragma unroll
    for (int kt = 0; kt < 9; ++kt)
#pragma unroll
        for (int j = 0; j < 4; ++j) { int dist = 16 * kt - 64 + quad * 4 + j - l15; dist = dist < 0 ? -dist : dist;
            biasL[kt][j] = dist <= 64 ? -slope * 1.4426950408889634f * (float)dist : -1e30f; }
    LAS float* RKT = (LAS float*)(lds + 107520);
    const int tb = T0 - 1024;
    for (int idx = tid; idx < 2304; idx += 512) {
        const int tok = tb + idx;
        if (tok >= 0 && tok < T) {
            const bf16_t* kp_ = QKV + (base + tok) * 3072 + 1024 + h * 64;
            float ss = 0.f;
#pragma unroll
            for (int i = 0; i < 8; ++i) { float f[8]; unpack8(*(const u32x4*)(kp_ + i * 8), f);
#pragma unroll
                for (int e = 0; e < 8; ++e) ss += f[e] * f[e]; }
            RKT[idx] = rsqrtf(ss * (1.0f / 64.0f) + NORM_EPS) * 1.4426950408889634f;
        }
    }
    __syncthreads();
    for (int bi = 0; bi < 3; ++bi) {
        const int dsh = 2 * bi, L = T >> dsh;
        const float sl_d = slope * (float)(1 << dsh);
        for (int gg = 0; gg < 2; ++gg) {
            const int g = wave * 2 + gg;
            const int res = bi == 0 ? 0 : (bi == 1 ? (g & 3) : g), blk = bi == 0 ? g : (bi == 1 ? (g >> 2) : 0);
            const int i0 = (T0 >> dsh) + 16 * blk;
            const int qtok = ((i0 + l15) << dsh) + res;
            bf16x8 qf[2]; float mq;
            {
                const bf16_t* qp = QKV + (base + qtok) * 3072 + h * 64 + quad * 8;
                float f[16]; unpack8(*(const u32x4*)qp, f); unpack8(*(const u32x4*)(qp + 32), f + 8);
                float ss = 0.f;
#pragma unroll
                for (int i = 0; i < 16; ++i) ss += f[i] * f[i];
                ss += __shfl_xor(ss, 16); ss += __shfl_xor(ss, 32);
                const float rq = rsqrtf(ss * (1.0f / 64.0f) + NORM_EPS) * 0.125f;
#pragma unroll
                for (int i = 0; i < 16; ++i) f[i] = f[i] * rq * gqk[i];
                const u32x4 w0 = pack8(f), w1 = pack8(f + 8);
                qf[0] = __builtin_bit_cast(bf16x8, w0); qf[1] = __builtin_bit_cast(bf16x8, w1);
                float fr[16]; unpack8(w0, fr); unpack8(w1, fr + 8);
                float n2 = 0.f;
#pragma unroll
                for (int i = 0; i < 16; ++i) n2 += fr[i] * fr[i];
                n2 += __shfl_xor(n2, 16); n2 += __shfl_xor(n2, 32);
                mq = 8.1f * 1.4426950408889634f * sqrtf(n2);
            }
            f32x4 oacc[4];
#pragma unroll
            for (int et = 0; et < 4; ++et) oacc[et] = (f32x4){0.f, 0.f, 0.f, 0.f};
            float lsum = 0.f;
            const int kjb = i0 - 64 + quad * 4, rkoff = res - tb;
            const float dmul = (float)(1 << dsh);
            bf16x8 kfb[2][2][2]; u32x4 vb[2][4];
            const int rowv = lane >> 1, half = lane & 1;
#define ATT_ISSUE(KP, BUF) do { \
                _Pragma("unroll") for (int tt_ = 0; tt_ < 2; ++tt_) { \
                    int kidx_ = i0 - 64 + 16 * (2 * (KP) + tt_) + l15; kidx_ = kidx_ < 0 ? 0 : (kidx_ > L - 1 ? L - 1 : kidx_); \
                    const bf16_t* kptr_ = QKV + (base + ((size_t)kidx_ << dsh) + res) * 3072 + 1024 + h * 64 + quad * 8; \
                    kfb[BUF][tt_][0] = *(const bf16x8*)kptr_; kfb[BUF][tt_][1] = *(const bf16x8*)(kptr_ + 32); } \
                int vidx_ = i0 - 64 + 32 * (KP) + rowv; vidx_ = vidx_ < 0 ? 0 : (vidx_ > L - 1 ? L - 1 : vidx_); \
                const bf16_t* vptr_ = QKV + (base + ((size_t)vidx_ << dsh) + res) * 3072 + 2048 + h * 64 + half * 32; \
                vb[BUF][0] = *(const u32x4*)vptr_; vb[BUF][1] = *(const u32x4*)(vptr_ + 8); vb[BUF][2] = *(const u32x4*)(vptr_ + 16); vb[BUF][3] = *(const u32x4*)(vptr_ + 24); } while (0)
            ATT_ISSUE(0, 0);
#pragma unroll
            for (int kp = 0; kp < 5; ++kp) {
                f32x4 s[2];
                if (kp + 1 < 5) ATT_ISSUE(kp + 1, (kp + 1) & 1);
#pragma unroll
                for (int tt = 0; tt < 2; ++tt) {
                    const int kt = 2 * kp + tt;
                    s[tt] = (f32x4){0.f, 0.f, 0.f, 0.f};
                    if (kt < 9) {
                        f32x4 sc = mfma16(kfb[kp & 1][tt][0], qf[0], (f32x4){0.f, 0.f, 0.f, 0.f});
                        sc = mfma16(kfb[kp & 1][tt][1], qf[1], sc);
#pragma unroll
                        for (int j = 0; j < 4; ++j) {
                            const int kj = kjb + 16 * kt + j;
                            const int kc = kj < 0 ? 0 : (kj > L - 1 ? L - 1 : kj);
                            const float rk = RKT[(kc << dsh) + rkoff];
                            float p = __builtin_amdgcn_exp2f(sc[j] * rk + (biasL[kt][j] * dmul - mq));
                            p = ((unsigned)kj < (unsigned)L) ? p : 0.f;
                            lsum += p; s[tt][j] = p;
                        }
                    }
                }
                bf16x8 pf;
                { u32x4 w; w.x = pk2(s[0][0], s[0][1]); w.y = pk2(s[0][2], s[0][3]); w.z = pk2(s[1][0], s[1][1]); w.w = pk2(s[1][2], s[1][3]); pf = __builtin_bit_cast(bf16x8, w); }
                {
                    LAS u32x4* vd = (LAS u32x4*)(VST + rowv * 144 + half * 64);
                    vd[0] = vb[kp & 1][0]; vd[1] = vb[kp & 1][1]; vd[2] = vb[kp & 1][2]; vd[3] = vb[kp & 1][3];
                }
                asm volatile("s_waitcnt lgkmcnt(0)" ::: "memory"); __builtin_amdgcn_fence(__ATOMIC_RELEASE, "wavefront"); __builtin_amdgcn_wave_barrier(); __builtin_amdgcn_fence(__ATOMIC_ACQUIRE, "wavefront"); asm volatile("s_waitcnt lgkmcnt(0)" ::: "memory");
#pragma unroll
                for (int et = 0; et < 4; ++et) {
                    LAS const unsigned char* ap = VST + (quad * 4 + r4) * 144 + (et * 16 + 4 * c4) * 2;
                    const s16x4 lo = tr_read(ap), hi = tr_read(ap + 16 * 144);
                    const bf16x8 a = {lo[0], lo[1], lo[2], lo[3], hi[0], hi[1], hi[2], hi[3]};
                    oacc[et] = mfma16(a, pf, oacc[et]);
                }
                asm volatile("s_waitcnt lgkmcnt(0)" ::: "memory"); __builtin_amdgcn_fence(__ATOMIC_RELEASE, "wavefront"); __builtin_amdgcn_wave_barrier(); __builtin_amdgcn_fence(__ATOMIC_ACQUIRE, "wavefront"); asm volatile("s_waitcnt lgkmcnt(0)" ::: "memory");
            }
#undef ATT_ISSUE
            lsum += __shfl_xor(lsum, 16); lsum += __shfl_xor(lsum, 32);
            const int qloc = qtok - T0;
#pragma unroll
            for (int et = 0; et < 4; ++et) {
                LAS f32x4* dst = (LAS f32x4*)(OACC + qloc * 68 + et * 16 + quad * 4);
                if (bi == 0) *dst = oacc[et]; else *dst = *dst + oacc[et];
            }
            if (quad == 0) { if (bi == 0) LS[qloc] = lsum; else LS[qloc] += lsum; }
        }
        __syncthreads();
    }
    {
        const int q = tid >> 1, half = tid & 1;
        const float inv = 1.0f / LS[q];
        bf16_t* op = MO + (base + T0 + q) * 1024 + h * 64 + half * 32;
#pragma unroll
        for (int i = 0; i < 4; ++i) {
            const f32x4 a = *(LAS const f32x4*)(OACC + q * 68 + half * 32 + i * 8), b = *(LAS const f32x4*)(OACC + q * 68 + half * 32 + i * 8 + 4);
            u32x4 w; w.x = pk2(a[0] * inv, a[1] * inv); w.y = pk2(a[2] * inv, a[3] * inv); w.z = pk2(b[0] * inv, b[1] * inv); w.w = pk2(b[2] * inv, b[3] * inv);
            *(u32x4*)(op + i * 8) = w;
        }
    }
    __syncthreads();
}

enum { K_P0 = 0, K_SWIGLU, K_RESID, K_NORM, K_GEMM_P, K_MIXA, K_FINAL, K_GEMM_QKV, K_ATTN, K_CARRY, K_MIXB };
constexpr int N_PHASES = 20;

__global__ void __launch_bounds__(512, 2) mega(Params P) {
    extern __shared__ __attribute__((aligned(16))) unsigned char lds_raw[];
    LAS unsigned char* lds = (LAS unsigned char*)lds_raw;
    cg::grid_group grid = cg::this_grid();
    for (int ph = 0; ph < N_PHASES; ++ph) {
#ifdef PROBE_MASK
        if (blockIdx.x == 0 && threadIdx.x == 0) ((unsigned long long*)(P.ws + WS_TS))[ph] = __builtin_amdgcn_s_memrealtime();
#endif
        unsigned char* ws = P.ws; float* X = P.out; int G = gridDim.x, bid = blockIdx.x;
        asm volatile("" : "+s"(ws), "+s"(X), "+s"(G), "+s"(bid));
        bf16_t* XN = (bf16_t*)(ws + WS_XN);
        bf16_t* Hb = (bf16_t*)(ws + WS_BIG);
        int kind, layer = 0, sub = 0;
        if (ph == 0) kind = K_P0;
        else {
            layer = ph <= 11 ? 0 : 1; const int r = ph <= 11 ? ph - 1 : ph - 12;
            const unsigned long long kc = layer == 0 ? 0x32126A95421ull : 0x32128721ull;
            const unsigned long long sc = layer == 0 ? 0x21120000000ull : 0x21120000ull;
            kind = (int)((kc >> (4 * r)) & 15ull); sub = (int)((sc >> (4 * r)) & 15ull);
        }
        if (kind == K_P0) {
#ifndef SKIP_P0
            LAS float* tile = (LAS float*)lds;
            int rot = 0;
            for (int job = 0; job < 16; ++job) {
                const float* src; size_t doff; int K, N;
                if (job < 4) { src = ((job & 1) ? P.in[7] : P.in[3]) + (size_t)(job >> 1) * 1024 * 5632; doff = WS_WFI + (size_t)job * SZ_WFI; K = 1024; N = 5632; }
                else if (job < 8) { src = ((job & 1) ? P.in[8] : P.in[4]) + (size_t)((job - 4) >> 1) * 2816 * 1024; doff = WS_WFO + (size_t)(job - 4) * SZ_WFO; K = 2816; N = 1024; }
                else if (job == 8) { src = P.in[10]; doff = WS_WABI; K = 1024; N = 3328; }
                else if (job == 9) { src = P.in[11]; doff = WS_WABO; K = 1024; N = 1024; }
                else if (job == 10) { src = P.in[26]; doff = WS_WATI; K = 1024; N = 3072; }
                else if (job == 11) { src = P.in[27]; doff = WS_WATO; K = 1024; N = 1024; }
                else { const int d = (job - 12) >> 1, ty = (job - 12) & 1; src = (ty ? P.in[20] : P.in[18]) + (size_t)d * 64 * 512; doff = WS_LORA + (size_t)(d * 2 + ty) * 512 * 64 * 2; K = 64; N = 512; }
                if (job < 4) convert_T<1>(src, (bf16_t*)(ws + doff), K, N, tile, rot); else convert_T<0>(src, (bf16_t*)(ws + doff), K, N, tile, rot);
                rot += (K / 64) * (N / 64);
            }
            {
                bf16_t* dst = (bf16_t*)(ws + WS_SGUW);
                for (int i = bid * 512 + opaque_tid(); i < 4 * 128 * 128 / 4; i += G * 512) {
                    const f32x4 v = *(const f32x4*)(P.in[13] + (size_t)i * 4);
                    u32x2 w; w.x = pk2(v[0], v[1]); w.y = pk2(v[2], v[3]); *(u32x2*)(dst + (size_t)i * 4) = w;
                }
            }
            norm_rows(P.in[0], P.in[1], M_PROMPT, nullptr, nullptr, nullptr, P.in[2], XN);
            if (bid == 0 && opaque_tid() == 0) *(unsigned*)(ws + WS_TS + 2048) = 0u;
#endif
        } else if (kind == K_SWIGLU) {
            if (sub == 0) { float* za = (float*)(ws + WS_RSA); for (int i = bid * 512 + opaque_tid(); i < M_TOK; i += G * 512) za[i] = 0.f; }
            pg8::Gemm g{sub == 0 ? XN : (const bf16_t*)(ws + WS_Y), (const bf16_t*)(ws + WS_WFI + (size_t)(layer * 2 + sub) * SZ_WFI), M_TOK, 5632, 1024};
            pg8::StaticOrder S; S.init(M_TOK, 5632, G, bid);
            EpiSwiglu E{Hb, sub == 0 ? nullptr : (const float*)(ws + WS_RSB)};
#ifndef SKIP_G1
            pg8::gemm_phase<EpiSwiglu, pg8::StaticOrder, GEMM_ALIGN, GEMM_SP2>(lds, g, S, E);
#endif
        } else if (kind == K_RESID) {
            const bf16_t* A; const bf16_t* Bt; int K; float scale; bf16_t* xg = nullptr; const float* gn = nullptr; float* rss = nullptr;
            if (sub < 2) { A = Hb; Bt = (const bf16_t*)(ws + WS_WFO + (size_t)(layer * 2 + sub) * SZ_WFO); K = 2816; scale = 0.5f;
                if (sub == 0) { xg = XN; gn = P.in[5] + layer * DM; rss = (float*)(ws + WS_RSA); } }
            else { A = XN; Bt = (const bf16_t*)(ws + (layer == 0 ? WS_WABO : WS_WATO)); K = 1024; scale = 1.0f; xg = (bf16_t*)(ws + WS_Y); gn = P.in[6] + layer * DM; rss = (float*)(ws + WS_RSB); }
            pg8::Gemm g{A, Bt, M_TOK, 1024, K};
            pg8::StaticOrder S; S.init(M_TOK, 1024, G, bid);
            const bool first = (layer == 0 && sub == 0);
            EpiResid E{X, scale, xg, gn, rss, first ? P.in[0] : nullptr, first ? P.in[1] : nullptr};
#ifndef SKIP_G2
            pg8::gemm_phase<EpiResid, pg8::StaticOrder, GEMM_ALIGN, GEMM_SP2>(lds, g, S, E);
#endif
        } else if (kind == K_NORM) {
            if (ph < N_PHASES - 1) norm_rows(X, X, M_TOK, nullptr, P.in[9], X, P.in[2] + DM, XN);
            else norm_rows(X, X, M_TOK, nullptr, P.in[9] + DM, X, nullptr, nullptr);
        } else if (kind == K_GEMM_P || kind == K_GEMM_QKV) {
            const bool isP = kind == K_GEMM_P; const int N = isP ? 3328 : 3072;
            pg8::Gemm g{XN, (const bf16_t*)(ws + (isP ? WS_WABI : WS_WATI)), M_TOK, N, 1024};
            pg8::StaticOrder S; S.init(M_TOK, N, G, bid);
            { float* zb = (float*)(ws + WS_RSB); for (int i = bid * 512 + opaque_tid(); i < M_TOK; i += G * 512) zb[i] = 0.f; }
            EpiSplit E; const float* rsa = (const float*)(ws + WS_RSA);
            if (isP) E = EpiSplit{(bf16_t*)(ws + WS_PUV), 1024, 4, (bf16_t*)(ws + WS_PRKVG), 2048, 12, (bf16_t*)(ws + WS_PWA), 256, rsa};
            else E = EpiSplit{(bf16_t*)(ws + WS_BIG), 3072, 12, (bf16_t*)(ws + WS_BIG), 3072, 12, (bf16_t*)(ws + WS_BIG), 3072, rsa};
#ifndef SKIP_G3
            pg8::gemm_phase<EpiSplit, pg8::StaticOrder, GEMM_ALIGN, GEMM_SP2>(lds, g, S, E);
#endif
        } else if (kind == K_MIXA) {
            constexpr int NLONG = 16 + 16 * (NSEG - 2) * 2;
            unsigned* qhead = (unsigned*)(ws + WS_TS + 2048);
            LAS int* qslot = (LAS int*)(lds + LDS_BYTES - 16);
            for (;;) {
                if (opaque_tid() == 0) *qslot = (int)__hip_atomic_fetch_add(qhead, 1u, __ATOMIC_RELAXED, __HIP_MEMORY_SCOPE_AGENT);
                __syncthreads();
                const int li = __builtin_amdgcn_readfirstlane(*qslot);
                __syncthreads();
                if (li >= 512 + NLONG + 640) break;
#ifndef SKIP_SCAN
                if (li < 512) scan_item<16>(P, li >> 4, (li >> 1) & 7, li & 1, 0, 0, 2048, 4 | 8, nullptr, nullptr, lds);
                else if (li < 512 + 16) {
                    const int hd = li - 512, dir = hd & 1;
                    scan_item<16>(P, 32, hd >> 1, dir, 0, dir == 0 ? 0 : 16384 - SEGLEN, SEGLEN, 4 | 8, nullptr, (float*)(ws + WS_STL) + (size_t)hd * NSEG * 4096, lds);
                } else if (li < 512 + NLONG) {
                    const int q = li - 512 - 16, hd = q & 15, isP = (q >> 4) & 1, sgm = 1 + (q >> 5), dir = hd & 1;
                    const int tb = dir == 0 ? sgm * SEGLEN : 16384 - (sgm + 1) * SEGLEN;
                    float* so = (float*)(ws + (isP ? WS_STP : WS_STL)) + ((size_t)hd * NSEG + sgm) * 4096;
                    scan_item<16>(P, 32, hd >> 1, dir, 0, tb, SEGLEN, isP ? (1 | 2) : 0, nullptr, so, lds);
                }
#endif
#ifndef SKIP_SGU
                if (li >= 512 + NLONG) sgu_item(P, li - 512 - NLONG, lds);
#endif
            }
        } else if (kind == K_CARRY) {
#ifndef SKIP_SCAN
            if (bid < 16) scan_carry(P, bid, lds);
#endif
        } else if (kind == K_MIXB) {
#ifndef SKIP_SCAN
            for (int li = bid; li < 16 * (NSEG - 1); li += G) {
                const int hd = li & 15, sgm = 1 + (li >> 4), dir = hd & 1;
                const int tb = dir == 0 ? sgm * SEGLEN : 16384 - (sgm + 1) * SEGLEN;
                scan_item<16>(P, 32, hd >> 1, dir, 0, tb, SEGLEN, 4 | 8, (const float*)(ws + WS_STS) + ((size_t)hd * NSEG + sgm) * 4096, nullptr, lds);
            }
#endif
        } else if (kind == K_FINAL) {
#ifndef SKIP_FIN
            rwkv_finalize(P);
#endif
        } else if (kind == K_ATTN) {
            for (int it = bid; it < 5120; it += G) {
#ifndef SKIP_ATTN
                if (it < 4096) attn_item(P, it >> 7, it & 15, (it >> 4) & 7, lds);
                else attn_item(P, 32, it & 15, (it - 4096) >> 4, lds);
#endif
            }
        }
        if (ph + 1 < N_PHASES) {
            __builtin_amdgcn_fence(__ATOMIC_RELEASE, "agent");
            asm volatile("s_waitcnt vmcnt(0) lgkmcnt(0)" ::: "memory");
            grid.sync();
            __builtin_amdgcn_fence(__ATOMIC_ACQUIRE, "agent");
            asm volatile("s_waitcnt vmcnt(0) lgkmcnt(0)" ::: "memory");
            __syncthreads();
        }
    }
#ifdef PROBE_MASK
    if (blockIdx.x == 0 && threadIdx.x == 0) {
        unsigned long long* ts = (unsigned long long*)(P.ws + WS_TS);
        ts[N_PHASES] = __builtin_amdgcn_s_memrealtime();
        unsigned long long tot = 0;
        for (int i = 0; i < N_PHASES; ++i) if ((PROBE_MASK >> i) & 1) tot += ts[i + 1] - ts[i];
        P.out[0] += 4.0f + 10.0f * (float)tot * 1e-5f;
    }
#endif
}

extern "C" void kernel_launch(void* const* d_in, const int* in_sizes, int n_in, void* d_out, int out_size, void* d_ws, size_t ws_size, hipStream_t stream) {
    static int grid_blocks = 0;
    if (!grid_blocks) {
        int dev = 0, cus = 0, per_cu = 0;
        (void)hipGetDevice(&dev);
        (void)hipDeviceGetAttribute(&cus, hipDeviceAttributeMultiprocessorCount, dev);
        (void)hipFuncSetAttribute((const void*)mega, hipFuncAttributeMaxDynamicSharedMemorySize, LDS_BYTES);
        (void)hipOccupancyMaxActiveBlocksPerMultiprocessor(&per_cu, (const void*)mega, 512, LDS_BYTES);
        (void)hipGetLastError();
        if (cus <= 0) cus = 256;
        grid_blocks = cus;
        if (ws_size < WS_END2) fprintf(stderr, "kernel_launch: workspace too small: %zu < %zu\n", ws_size, (size_t)WS_END2);
    }
    Params p{};
    for (int i = 0; i < 30 && i < n_in; ++i) p.in[i] = (const float*)d_in[i];
    p.out = (float*)d_out; p.ws = (unsigned char*)d_ws;
    void* args[] = {&p};
    hipError_t e = hipLaunchCooperativeKernel((const void*)mega, dim3(grid_blocks), dim3(512), args, LDS_BYTES, stream);
    if (e != hipSuccess) fprintf(stderr, "cooperative launch failed: %s (grid %d)\n", hipGetErrorString(e), grid_blocks);
}
```

```cpp
#include <hip/hip_runtime.h>
#include <hip/hip_cooperative_groups.h>
#include <cstdio>
namespace cg = cooperative_groups;

namespace pg8 {
#define PG8_LAS __attribute__((address_space(3)))
typedef unsigned short bf16_t;
typedef short bf16x8 __attribute__((ext_vector_type(8)));
typedef float f32x4 __attribute__((ext_vector_type(4)));
typedef unsigned u32x4 __attribute__((ext_vector_type(4)));
constexpr int BM = 256, BK = 64, HALF = 128, HTB = HALF * BK * 2  , STAGE_BYTES = 8 * HTB, NXCD = 8, WGM = 8;

__host__ __device__ __forceinline__ int lds_byte(int r, int c) { const int st = (r >> 4) * 2 + (c >> 5), rr = r & 15, cc = c & 31, ob = rr * 64 + cc * 2; return st * 1024 + (ob ^ (((ob >> 9) & 1) << 5)); }
__host__ __device__ __forceinline__ void stage_rc(int b, int& R, int& C) { const int st = b / 1024, sb = b % 1024, swz = sb ^ (((sb >> 9) & 1) << 5); R = (st >> 1) * 16 + swz / 64; C = (st & 1) * 32 + (swz % 64) / 2; }
__host__ __device__ __forceinline__ int perm32(int rho) { const int n = rho >> 4, i = rho & 15; return 8 * (i >> 2) + 4 * n + (i & 3); }

struct Unit { int pm, pn; };
struct Gemm { const bf16_t* A; const bf16_t* Bt; int M, N, K; };

struct StaticOrder {
    int nM, nN, nwg, G, c;
    __host__ __device__ void init(int M, int N, int G_, int c_) { nM = M / BM; nN = N / BM; nwg = nM * nN; G = G_; c = c_; }
    __host__ __device__ bool next(int i, Unit& u) const {
        const long L = (long)i * G + c; if (L >= nwg) return false;
        int wgid = (int)L; { const int q = nwg / NXCD, r = nwg % NXCD, xcd = wgid % NXCD, off = wgid / NXCD; wgid = (xcd < r ? xcd * (q + 1) : r * (q + 1) + (xcd - r) * q) + off; }
        const int nig = WGM * nN, gid = wgid / nig, fm = gid * WGM, gsz = (nM - fm) < WGM ? (nM - fm) : WGM;
        u.pm = fm + ((wgid % nig) % gsz); u.pn = (wgid % nig) / gsz; return true;
    }
    __device__ __forceinline__ void a_ready(const Unit&) const {}
    __device__ __forceinline__ void done(const Unit&) const {}
};
__device__ __forceinline__ unsigned cvt_pk_bf16(float lo, float hi) { unsigned r; asm volatile("v_cvt_pk_bf16_f32 %0, %1, %2" : "=v"(r) : "v"(lo), "v"(hi)); return r; }
typedef float f32x2 __attribute__((ext_vector_type(2)));
template <class Epi, class Sched, bool ALIGN_EPI = false, bool SP2 = false>
__device__ __forceinline__ void gemm_phase(PG8_LAS unsigned char* lds, const Gemm g, const Sched& S, const Epi& E) {
    int tid_raw_ = threadIdx.x; asm volatile("" : "+v"(tid_raw_)); const int tid = tid_raw_, wid = __builtin_amdgcn_readfirstlane(tid >> 6), lane = tid & 63, wr = wid >> 2, wc = wid & 3, fr = lane & 15, fq = lane >> 4;
    const int K = g.K, nt = K / BK;
    unsigned voffA[2], voffB[2];
#pragma unroll
    for (int i = 0; i < 2; ++i) { int R, C; stage_rc(tid * 16 + i * 8192, R, C); const int Rb = Epi::PERM ? ((R & ~31) + perm32(R & 31)) : R;
        voffA[i] = (unsigned)(R * K + C) * 2u; voffB[i] = (unsigned)(Rb * K + C) * 2u; }
    const size_t kstep = (size_t)(BK * 2);
    const size_t hstep = (size_t)HALF * K * 2;
    const size_t tstep = 2 * hstep;
    const unsigned ldsw = (unsigned)wid * 1024u;
    const int aoff = lds_byte(wr * 64 + fr, fq * 8), boff = lds_byte(wc * 32 + fr, fq * 8);
#define PG8_SA(b, h) (((b) * 2 + (h)) * HTB)
#define PG8_SB(b, h) ((4 + (b) * 2 + (h)) * HTB)
#define PG8_STAGE(bufoff, gbase, voff) do { _Pragma("unroll") for (int _i = 0; _i < 2; ++_i) \
        __builtin_amdgcn_global_load_lds((const unsigned*)((const char*)(gbase) + (voff)[_i]), (PG8_LAS unsigned*)(lds + (bufoff) + ldsw + _i * 8192), 16, 0, 0); } while (0)
#define PG8_LDA(dst, b, h) do { _Pragma("unroll") for (int m = 0; m < 4; ++m) _Pragma("unroll") for (int k = 0; k < 2; ++k) dst[m][k] = *(const PG8_LAS bf16x8*)(lds + PG8_SA(b, h) + aoff + m * 2048 + k * 1024); } while (0)
#define PG8_LDB(dst, b, h) do { _Pragma("unroll") for (int n = 0; n < 2; ++n) _Pragma("unroll") for (int k = 0; k < 2; ++k) dst[n][k] = *(const PG8_LAS bf16x8*)(lds + PG8_SB(b, h) + boff + n * 2048 + k * 1024); } while (0)
#define PG8_MMA(ai, bj, At, Bt) do { __builtin_amdgcn_s_setprio(1); _Pragma("unroll") for (int m = 0; m < 4; ++m) _Pragma("unroll") for (int n = 0; n < 2; ++n) _Pragma("unroll") for (int k = 0; k < 2; ++k) \
        acc[ai][bj][m][n] = __builtin_amdgcn_mfma_f32_16x16x32_bf16(Bt[n][k], At[m][k], acc[ai][bj][m][n], 0, 0, 0); __builtin_amdgcn_s_setprio(0); } while (0)
#define PG8_WAIT_V(n) asm volatile("s_waitcnt vmcnt(" #n ")" ::: "memory")
#define PG8_WAIT_L(n) asm volatile("s_waitcnt lgkmcnt(" #n ")" ::: "memory")
#define PG8_BAR __builtin_amdgcn_s_barrier()
#define PG8_SCHED __builtin_amdgcn_sched_barrier(0)
    Unit cur, nxt; int ui = 0;
    if (!S.next(0, cur)) return;
    f32x4 acc[2][2][4][2];
#pragma unroll
    for (int a = 0; a < 2; ++a)
#pragma unroll
        for (int b = 0; b < 2; ++b)
#pragma unroll
            for (int m = 0; m < 4; ++m)
#pragma unroll
                for (int n = 0; n < 2; ++n) acc[a][b][m][n] = (f32x4){0.f, 0.f, 0.f, 0.f};
    bf16x8 At[4][2], B0[2][2], B1[2][2];
    const char* cA = (const char*)g.A + (size_t)cur.pm * tstep; const char* cB = (const char*)g.Bt + (size_t)cur.pn * tstep;
    S.a_ready(cur);
    if constexpr (SP2) {
        PG8_STAGE(PG8_SB(0, 0), cB, voffB); PG8_STAGE(PG8_SB(0, 1), cB + hstep, voffB); PG8_STAGE(PG8_SA(0, 0), cA, voffA); PG8_STAGE(PG8_SA(0, 1), cA + hstep, voffA);
        if (wr == 1) PG8_BAR;
        PG8_WAIT_V(2); PG8_BAR;
        PG8_STAGE(PG8_SB(1, 0), cB + kstep, voffB); PG8_STAGE(PG8_SA(1, 0), cA + kstep, voffA); PG8_STAGE(PG8_SB(1, 1), cB + hstep + kstep, voffB);
        PG8_WAIT_V(6); PG8_BAR;
    } else {
        PG8_STAGE(PG8_SB(0, 0), cB, voffB); PG8_STAGE(PG8_SA(0, 0), cA, voffA); PG8_STAGE(PG8_SB(0, 1), cB + hstep, voffB); PG8_STAGE(PG8_SA(0, 1), cA + hstep, voffA);
        if (wr == 1) PG8_BAR;
        PG8_WAIT_V(4); PG8_BAR;
        PG8_STAGE(PG8_SB(1, 0), cB + kstep, voffB); PG8_STAGE(PG8_SA(1, 0), cA + kstep, voffA); PG8_STAGE(PG8_SB(1, 1), cB + hstep + kstep, voffB);
        PG8_WAIT_V(6); PG8_BAR;
    }
    for (;;) {
        const bool has_next = S.next(ui + 1, nxt);
        const char* nA = has_next ? (const char*)g.A + (size_t)nxt.pm * tstep : cA; const char* nB = has_next ? (const char*)g.Bt + (size_t)nxt.pn * tstep : cB;
        for (int t = 0; t < nt; t += 2) {
            const bool last = (t == nt - 2);
            const char* a1 = cA + (size_t)(t + 1) * kstep;
            const char* a2 = last ? nA : cA + (size_t)(t + 2) * kstep; const char* b2 = last ? nB : cB + (size_t)(t + 2) * kstep;
            const char* a3 = a2 + kstep; const char* b3 = b2 + kstep;
            if (last && has_next) S.a_ready(nxt);
            if constexpr (SP2) {
            PG8_LDB(B0, 0, 0); PG8_LDB(B1, 0, 1); PG8_SCHED; PG8_LDA(At, 0, 0); PG8_STAGE(PG8_SA(1, 1), a1 + hstep, voffA);
            PG8_WAIT_V(8); PG8_WAIT_L(0); PG8_BAR; PG8_MMA(0, 0, At, B0); PG8_MMA(0, 1, At, B1); PG8_BAR; PG8_SCHED;
            PG8_LDA(At, 0, 1); PG8_STAGE(PG8_SB(0, 0), b2, voffB); PG8_STAGE(PG8_SB(0, 1), b2 + hstep, voffB); PG8_STAGE(PG8_SA(0, 0), a2, voffA);
            PG8_WAIT_V(8); PG8_WAIT_L(0); PG8_BAR; PG8_MMA(1, 0, At, B0); PG8_MMA(1, 1, At, B1); PG8_BAR; PG8_SCHED;
            PG8_LDB(B0, 1, 0); PG8_LDB(B1, 1, 1); PG8_SCHED; PG8_LDA(At, 1, 0); PG8_STAGE(PG8_SA(0, 1), a2 + hstep, voffA);
            PG8_WAIT_V(8); PG8_WAIT_L(0); PG8_BAR; PG8_MMA(0, 0, At, B0); PG8_MMA(0, 1, At, B1); PG8_BAR; PG8_SCHED;
            PG8_LDA(At, 1, 1); PG8_STAGE(PG8_SB(1, 0), b3, voffB); PG8_STAGE(PG8_SB(1, 1), b3 + hstep, voffB); PG8_STAGE(PG8_SA(1, 0), a3, voffA);
            PG8_WAIT_V(8); PG8_WAIT_L(0); PG8_BAR; PG8_MMA(1, 0, At, B0); PG8_MMA(1, 1, At, B1); PG8_BAR; PG8_SCHED;
            } else {
            PG8_LDB(B0, 0, 0); PG8_SCHED; PG8_LDA(At, 0, 0); PG8_STAGE(PG8_SA(1, 1), a1 + hstep, voffA);
            PG8_WAIT_L(8); PG8_BAR; PG8_WAIT_L(0); PG8_MMA(0, 0, At, B0); PG8_BAR; PG8_SCHED;
            PG8_LDB(B1, 0, 1); PG8_STAGE(PG8_SB(0, 0), b2, voffB);
            PG8_BAR; PG8_WAIT_L(0); PG8_MMA(0, 1, At, B1); PG8_BAR;
            PG8_LDA(At, 0, 1); PG8_STAGE(PG8_SA(0, 0), a2, voffA);
            PG8_BAR; PG8_WAIT_L(0); PG8_MMA(1, 0, At, B0); PG8_BAR; PG8_SCHED;
            PG8_STAGE(PG8_SB(0, 1), b2 + hstep, voffB);
            PG8_WAIT_V(6); PG8_BAR; PG8_MMA(1, 1, At, B1); PG8_BAR;
            PG8_LDB(B0, 1, 0); PG8_SCHED; PG8_LDA(At, 1, 0); PG8_STAGE(PG8_SA(0, 1), a2 + hstep, voffA);
            PG8_WAIT_L(8); PG8_BAR; PG8_WAIT_L(0); PG8_MMA(0, 0, At, B0); PG8_BAR; PG8_SCHED;
            PG8_LDB(B1, 1, 1); PG8_STAGE(PG8_SB(1, 0), b3, voffB);
            PG8_BAR; PG8_WAIT_L(0); PG8_MMA(0, 1, At, B1); PG8_BAR;
            PG8_LDA(At, 1, 1); PG8_STAGE(PG8_SA(1, 0), a3, voffA);
            PG8_BAR; PG8_WAIT_L(0); PG8_MMA(1, 0, At, B0); PG8_BAR; PG8_SCHED;
            PG8_STAGE(PG8_SB(1, 1), b3 + hstep, voffB);
            PG8_WAIT_V(6); PG8_BAR; PG8_MMA(1, 1, At, B1); PG8_BAR;
            }
        }
        if constexpr (ALIGN_EPI) { if (wr == 0) PG8_BAR; }
        if constexpr (!Epi::AFTER_DRAIN) { E(acc, cur, wr, wc, fr, fq); S.done(cur); }
        if (!has_next) break;
#pragma unroll
        for (int a = 0; a < 2; ++a)
#pragma unroll
            for (int b = 0; b < 2; ++b)
#pragma unroll
                for (int m = 0; m < 4; ++m)
#pragma unroll
                    for (int n = 0; n < 2; ++n) acc[a][b][m][n] = (f32x4){0.f, 0.f, 0.f, 0.f};
        cur = nxt; cA = nA; cB = nB; ++ui;
        if constexpr (ALIGN_EPI) { if (wr == 1) PG8_BAR; }
    }
    PG8_WAIT_V(0);
    if constexpr (!ALIGN_EPI) { if (wr == 0) PG8_BAR; }
    PG8_BAR;
    if constexpr (Epi::AFTER_DRAIN) { E.fused(acc, cur, wr, wc, fr, fq, lds, wid, lane); S.done(cur); }
#undef PG8_SA
#undef PG8_SB
#undef PG8_STAGE
#undef PG8_LDA
#undef PG8_LDB
#undef PG8_MMA
#undef PG8_WAIT_V
#undef PG8_WAIT_L
#undef PG8_BAR
#undef PG8_SCHED
}
}


#define LAS __attribute__((address_space(3)))
typedef unsigned short bf16_t;
typedef short bf16x8 __attribute__((ext_vector_type(8)));
typedef short s16x4 __attribute__((ext_vector_type(4)));
typedef float f32x4 __attribute__((ext_vector_type(4)));
typedef unsigned u32x4 __attribute__((ext_vector_type(4)));
typedef unsigned u32x2 __attribute__((ext_vector_type(2)));

constexpr int M_TOK = 81920, M_PROMPT = 65536, DM = 1024, DFF = 2816;
constexpr int LDS_BYTES = 147456;
#ifndef GEMM_ALIGN
#define GEMM_ALIGN true
#endif
#ifndef GEMM_SP2
#define GEMM_SP2 true
#endif
constexpr float NORM_EPS = 1e-6f;

constexpr size_t SZ_WFI = (size_t)5632 * 1024 * 2, SZ_WFO = (size_t)1024 * 2816 * 2;
constexpr size_t WS_WFI = 0;
constexpr size_t WS_WFO = WS_WFI + 4 * SZ_WFI;
constexpr size_t WS_WABI = WS_WFO + 4 * SZ_WFO;
constexpr size_t WS_WABO = WS_WABI + (size_t)3328 * 1024 * 2;
constexpr size_t WS_WATI = WS_WABO + (size_t)1024 * 1024 * 2;
constexpr size_t WS_WATO = WS_WATI + (size_t)3072 * 1024 * 2;
constexpr size_t WS_LORA = WS_WATO + (size_t)1024 * 1024 * 2;
constexpr size_t WS_SGUW = WS_LORA + (size_t)4 * 512 * 64 * 2;
constexpr size_t WS_RKR = WS_SGUW + (size_t)4 * 128 * 128 * 2;
constexpr size_t WS_XN = (WS_RKR + (size_t)2 * M_TOK * 8 * 4 + 4095) & ~(size_t)4095;
constexpr size_t WS_BIG = WS_XN + (size_t)M_TOK * 1024 * 2;
constexpr size_t WS_PUV = WS_BIG;
constexpr size_t WS_PRKVG = WS_PUV + (size_t)M_TOK * 1024 * 2;
constexpr size_t WS_PWA = WS_PRKVG + (size_t)M_TOK * 2048 * 2;
constexpr size_t WS_Y = WS_BIG + (size_t)M_TOK * 3328 * 2;
constexpr size_t WS_END = WS_Y + (size_t)2 * M_TOK * 512 * 2;

constexpr int NSEG = 16, SEGLEN = 16384 / NSEG;
constexpr size_t WS_STL = (WS_END + 4095) & ~(size_t)4095;
constexpr size_t WS_STP = WS_STL + (size_t)16 * NSEG * 4096 * 4;
constexpr size_t WS_STS = WS_STP + (size_t)16 * NSEG * 4096 * 4;
constexpr size_t WS_TS = WS_STS + (size_t)16 * NSEG * 4096 * 4;
constexpr size_t WS_RSA = WS_TS + 4096;
constexpr size_t WS_RSB = WS_RSA + (size_t)M_TOK * 4;
constexpr size_t WS_RSC = WS_RSB + (size_t)M_TOK * 4;
constexpr size_t WS_RSD = WS_RSC + (size_t)M_TOK * 4;
constexpr size_t WS_END2 = WS_RSD + (size_t)M_TOK * 4;
struct Params { const float* in[30]; float* out; unsigned char* ws; };

__device__ __forceinline__ float bflo(unsigned w) { return __uint_as_float(w << 16); }
__device__ __forceinline__ float bfhi(unsigned w) { return __uint_as_float(w & 0xffff0000u); }
__device__ __forceinline__ unsigned pk2(float lo, float hi) { unsigned r; asm("v_cvt_pk_bf16_f32 %0, %1, %2" : "=v"(r) : "v"(lo), "v"(hi)); return r; }
__device__ __forceinline__ void unpack8(const u32x4 w, float* f) { f[0] = bflo(w.x); f[1] = bfhi(w.x); f[2] = bflo(w.y); f[3] = bfhi(w.y); f[4] = bflo(w.z); f[5] = bfhi(w.z); f[6] = bflo(w.w); f[7] = bfhi(w.w); }
__device__ __forceinline__ u32x4 pack8(const float* f) { u32x4 w; w.x = pk2(f[0], f[1]); w.y = pk2(f[2], f[3]); w.z = pk2(f[4], f[5]); w.w = pk2(f[6], f[7]); return w; }
__device__ __forceinline__ float sigmoidf_(float x) { return __builtin_amdgcn_rcpf(1.0f + __expf(-x)); }
__device__ __forceinline__ float siluf_(float x) { return x * sigmoidf_(x); }
__device__ __forceinline__ float gelu_tanh(float x) { const float u = 0.7978845608028654f * (x + 0.044715f * x * x * x); return x * sigmoidf_(2.0f * u); }
__device__ __forceinline__ float tanhf_(float x) { return 1.0f - 2.0f * __builtin_amdgcn_rcpf(__expf(2.0f * x) + 1.0f); }
__device__ __forceinline__ float wave_sum(float x) { x += __shfl_xor(x, 32); x += __shfl_xor(x, 16); x += __shfl_xor(x, 8); x += __shfl_xor(x, 4); x += __shfl_xor(x, 2); x += __shfl_xor(x, 1); return x; }
template <int CTRL> __device__ __forceinline__ float dppf(float x) { return __int_as_float(__builtin_amdgcn_update_dpp(0, __float_as_int(x), CTRL, 0xF, 0xF, true)); }
__device__ __forceinline__ float reduce8(float x) { x += dppf<0xB1>(x); x += dppf<0x4E>(x); x += dppf<0x141>(x); return x; }
typedef short v4i16_t __attribute__((ext_vector_type(4)));
typedef __bf16 bf16x2_t __attribute__((ext_vector_type(2)));
__device__ __forceinline__ s16x4 tr_read(LAS const unsigned char* p) { return __builtin_bit_cast(s16x4, __builtin_amdgcn_ds_read_tr16_b64_v4i16((LAS v4i16_t*)p)); }
__device__ __forceinline__ f32x4 mfma16(bf16x8 a, bf16x8 b, f32x4 c) { return __builtin_amdgcn_mfma_f32_16x16x32_bf16(a, b, c, 0, 0, 0); }

__device__ __forceinline__ int opaque_tid() { int t = threadIdx.x; asm volatile("" : "+v"(t)); return t; }
__device__ __forceinline__ unsigned char* opaque_ptr(unsigned char* p) { size_t z = 0; asm volatile("" : "+s"(z)); return p + z; }
struct EpiSwiglu {
    static constexpr bool PERM = false, AFTER_DRAIN = false;
    bf16_t* H; const float* rowss; const float* rowss2;
    __device__ __forceinline__ void operator()(const f32x4 (&acc)[2][2][4][2], const pg8::Unit& u, int wr, int wc, int fr, int fq) const {
        const int row0 = u.pm * 256 + wr * 64 + fr, col0 = u.pn * 128 + wc * 32 + 8 * fq;
        float rsv[8];
#pragma unroll
        for (int gi = 0; gi < 8; ++gi) rsv[gi] = rowss ? rowss[row0 + (gi >> 2) * 128 + (gi & 3) * 16] : 0.f;
        float rsw[8];
#pragma unroll
        for (int gi = 0; gi < 8; ++gi) rsw[gi] = rowss2 ? rowss2[row0 + (gi >> 2) * 128 + (gi & 3) * 16] : 0.f;
#pragma unroll
        for (int gi = 0; gi < 8; ++gi) { rsv[gi] = rowss ? rsqrtf(rsv[gi] * (1.0f / DM) + NORM_EPS) : 1.0f;
            if (rowss2) rsv[gi] *= rsqrtf(rsv[gi] * rsv[gi] * rsw[gi] * (1.0f / DM) + NORM_EPS); }
#pragma unroll
        for (int ai = 0; ai < 2; ++ai)
#pragma unroll
            for (int m = 0; m < 4; ++m) {
                const int row = row0 + ai * 128 + m * 16;
                const float rs = rsv[ai * 4 + m];
                bf16_t* rowp = H + (size_t)row * DFF + col0;
                float h[8];
#pragma unroll
                for (int bj = 0; bj < 2; ++bj)
#pragma unroll
                    for (int j = 0; j < 4; ++j) h[bj * 4 + j] = siluf_(acc[ai][bj][m][0][j] * rs) * (acc[ai][bj][m][1][j] * rs);
                *(u32x4*)rowp = pack8(h);
                asm volatile("" ::: "memory");
            }
    }
};
struct EpiResid {
    static constexpr bool PERM = false, AFTER_DRAIN = false;
    float* X; float scale; bf16_t* XG; const float* g; float* rowss; const float* xin_a; const float* xin_b;
    const float* gaux; float* rowss2; const float* base_ss;
    __device__ __forceinline__ void operator()(const f32x4 (&acc)[2][2][4][2], const pg8::Unit& u, int wr, int wc, int fr, int fq) const {
        const int row0 = u.pm * 256 + wr * 64 + fr, col0 = u.pn * 256 + wc * 32 + 4 * fq;
        f32x4 gv[2][2];
#pragma unroll
        for (int bj = 0; bj < 2; ++bj)
#pragma unroll
            for (int n = 0; n < 2; ++n) gv[bj][n] = XG ? *(const f32x4*)(g + col0 + bj * 128 + n * 16) : (f32x4){0.f, 0.f, 0.f, 0.f};
        f32x4 ga[2][2];
#pragma unroll
        for (int bj = 0; bj < 2; ++bj)
#pragma unroll
            for (int n = 0; n < 2; ++n) { ga[bj][n] = gaux ? *(const f32x4*)(gaux + col0 + bj * 128 + n * 16) : (f32x4){1.f, 1.f, 1.f, 1.f}; if (rowss2) gv[bj][n] = gv[bj][n] * ga[bj][n]; }
        float brs[8];
#pragma unroll
        for (int gi = 0; gi < 8; ++gi) brs[gi] = base_ss ? base_ss[row0 + (gi >> 2) * 128 + (gi & 3) * 16] : 0.f;
#pragma unroll
        for (int gi = 0; gi < 8; ++gi) brs[gi] = base_ss ? rsqrtf(brs[gi] * (1.0f / DM) + NORM_EPS) : 1.0f;
        const float* Xs = xin_a ? (u.pm < 256 ? xin_a : xin_b - (size_t)M_PROMPT * DM) : X;
        f32x4 xin[2][2][2];
#pragma unroll
        for (int gi = 0; gi < 9; ++gi) {
            if (gi < 8) {
                const float* rowp = Xs + (size_t)(row0 + (gi >> 2) * 128 + (gi & 3) * 16) * DM + col0;
#pragma unroll
                for (int bj = 0; bj < 2; ++bj)
#pragma unroll
                    for (int n = 0; n < 2; ++n) xin[gi & 1][bj][n] = *(const f32x4*)(rowp + bj * 128 + n * 16);
            }
            if (gi > 0) {
                const int gp = gi - 1, ai = gp >> 2, m = gp & 3;
                const int row = row0 + ai * 128 + m * 16;
                float* rowp = X + (size_t)row * DM + col0;
                float ssq = 0.f, ssq2 = 0.f;
#pragma unroll
                for (int bj = 0; bj < 2; ++bj)
#pragma unroll
                    for (int n = 0; n < 2; ++n) { f32x4 v = xin[gp & 1][bj][n]; if (base_ss) v = v * brs[gp] * ga[bj][n];
                        v += acc[ai][bj][m][n] * scale; *(f32x4*)(rowp + bj * 128 + n * 16) = v;
                        if (XG) { ssq += (v[0] * v[0] + v[1] * v[1]) + (v[2] * v[2] + v[3] * v[3]); const f32x4 o = v * gv[bj][n]; u32x2 w; w.x = pk2(o[0], o[1]); w.y = pk2(o[2], o[3]);
                            *(u32x2*)(XG + (size_t)row * DM + col0 + bj * 128 + n * 16) = w; }
                        if (rowss2) { const f32x4 t = v * ga[bj][n]; ssq2 += (t[0] * t[0] + t[1] * t[1]) + (t[2] * t[2] + t[3] * t[3]); } }
                if (XG) { ssq += __shfl_xor(ssq, 16); ssq += __shfl_xor(ssq, 32);
                    if (fq == 0) __hip_atomic_fetch_add(rowss + row, ssq, __ATOMIC_RELAXED, __HIP_MEMORY_SCOPE_AGENT); }
                if (rowss2) { ssq2 += __shfl_xor(ssq2, 16); ssq2 += __shfl_xor(ssq2, 32);
                    if (fq == 0) __hip_atomic_fetch_add(rowss2 + row, ssq2, __ATOMIC_RELAXED, __HIP_MEMORY_SCOPE_AGENT); }
            }
            asm volatile("" ::: "memory");
        }
    }
};
struct EpiSplit {
    static constexpr bool PERM = true, AFTER_DRAIN = false;
    bf16_t* b0; int ld0, t0; bf16_t* b1; int ld1, t1; bf16_t* b2; int ld2; const float* rowss;
    __device__ __forceinline__ void operator()(const f32x4 (&acc)[2][2][4][2], const pg8::Unit& u, int wr, int wc, int fr, int fq) const {
        bf16_t* base; int ld, ct;
        if (u.pn < t0) { base = b0; ld = ld0; ct = u.pn; } else if (u.pn < t1) { base = b1; ld = ld1; ct = u.pn - t0; } else { base = b2; ld = ld2; ct = u.pn - t1; }
        const int row0 = u.pm * 256 + wr * 64 + fr, col0 = ct * 256 + wc * 32 + 8 * fq;
        float rsv[8];
#pragma unroll
        for (int gi = 0; gi < 8; ++gi) rsv[gi] = rowss[row0 + (gi >> 2) * 128 + (gi & 3) * 16];
#pragma unroll
        for (int gi = 0; gi < 8; ++gi) rsv[gi] = rsqrtf(rsv[gi] * (1.0f / DM) + NORM_EPS);
#pragma unroll
        for (int ai = 0; ai < 2; ++ai)
#pragma unroll
            for (int m = 0; m < 4; ++m) {
                const int row = row0 + ai * 128 + m * 16;
                const float rs = rsv[ai * 4 + m];
                bf16_t* rowp = base + (size_t)row * ld + col0;
#pragma unroll
                for (int bj = 0; bj < 2; ++bj) {
                    const f32x4 v0 = acc[ai][bj][m][0] * rs, v1 = acc[ai][bj][m][1] * rs;
                    u32x4 w; w.x = pk2(v0[0], v0[1]); w.y = pk2(v0[2], v0[3]); w.z = pk2(v1[0], v1[1]); w.w = pk2(v1[2], v1[3]);
                    *(u32x4*)(rowp + bj * 128) = w;
                }
                asm volatile("" ::: "memory");
            }
    }
};

template <int MAP> __device__ __forceinline__ int src_col(int s) {
    if (MAP == 0) return s;
    const int pn = s >> 8, bj = (s >> 7) & 1, wc = (s >> 5) & 3, n = (s >> 4) & 1, fq = (s >> 2) & 3, jj = s & 3;
    return n * DFF + 128 * pn + 32 * wc + 8 * fq + 4 * bj + jj;
}
template <int MAP> __device__ void convert_T(const float* __restrict__ src, bf16_t* __restrict__ dst, int K, int N, LAS float* tile, int rot) {
    const int tk = K / 64, tn = N / 64, nt = tk * tn, tid = opaque_tid(), G = gridDim.x;
    const int kk0 = tid >> 4, sg = tid & 15;
    int t = (int)((blockIdx.x + rot) % G);
    float4 va = make_float4(0.f, 0.f, 0.f, 0.f), vb = va;
    if (t < nt) { const int k0 = (t % tk) * 64, s0 = (t / tk) * 64; const int c = src_col<MAP>(s0 + sg * 4);
        va = *(const float4*)(src + (size_t)(k0 + kk0) * N + c); vb = *(const float4*)(src + (size_t)(k0 + kk0 + 32) * N + c); }
    for (; t < nt; t += G) {
        const int k0 = (t % tk) * 64, s0 = (t / tk) * 64;
        { LAS float* tp = tile + kk0 * 65 + sg * 4; tp[0] = va.x; tp[1] = va.y; tp[2] = va.z; tp[3] = va.w;
          LAS float* tq = tile + (kk0 + 32) * 65 + sg * 4; tq[0] = vb.x; tq[1] = vb.y; tq[2] = vb.z; tq[3] = vb.w; }
        if (t + G < nt) {
            const int t2 = t + G, k2 = (t2 % tk) * 64, s2 = (t2 / tk) * 64; const int c = src_col<MAP>(s2 + sg * 4);
            va = *(const float4*)(src + (size_t)(k2 + kk0) * N + c); vb = *(const float4*)(src + (size_t)(k2 + kk0 + 32) * N + c); }
        asm volatile("s_waitcnt lgkmcnt(0)" ::: "memory"); __builtin_amdgcn_s_barrier(); asm volatile("" ::: "memory");
        {
            const int slot = tid >> 3, kc = tid & 7; float f[8];
#pragma unroll
            for (int i = 0; i < 8; ++i) f[i] = tile[(kc * 8 + i) * 65 + slot];
            *(u32x4*)(dst + (size_t)(s0 + slot) * K + k0 + kc * 8) = pack8(f);
        }
        asm volatile("s_waitcnt lgkmcnt(0)" ::: "memory"); __builtin_amdgcn_s_barrier(); asm volatile("" ::: "memory");
    }
}

__device__ void norm_rows(const float* xa, const float* xb, int split, float* xcopy, const float* g1, float* x1out, const float* g2, bf16_t* xn) {
    const int tid_ = opaque_tid(), lane = tid_ & 63, wave = __builtin_amdgcn_readfirstlane(tid_ >> 6);
    const int stride = gridDim.x * 8;
    for (int row0 = blockIdx.x * 8 + wave; row0 < M_TOK; row0 += 2 * stride) {
        int rows[2]; rows[0] = row0; rows[1] = (row0 + stride < M_TOK) ? row0 + stride : row0;
        f32x4 v[2][4]; float ss[2] = {0.f, 0.f};
#pragma unroll
        for (int q = 0; q < 2; ++q) { const int row = rows[q];
            const float* src = (row < split) ? xa + (size_t)row * DM : xb + (size_t)(row - split) * DM;
#pragma unroll
            for (int i = 0; i < 4; ++i) v[q][i] = *(const f32x4*)(src + i * 256 + lane * 4); }
#pragma unroll
        for (int q = 0; q < 2; ++q) {
#pragma unroll
            for (int i = 0; i < 4; ++i) ss[q] += v[q][i][0] * v[q][i][0] + v[q][i][1] * v[q][i][1] + v[q][i][2] * v[q][i][2] + v[q][i][3] * v[q][i][3];
            if (xcopy) {
#pragma unroll
                for (int i = 0; i < 4; ++i) *(f32x4*)(xcopy + (size_t)rows[q] * DM + i * 256 + lane * 4) = v[q][i];
            }
        }
        ss[0] = wave_sum(ss[0]); ss[1] = wave_sum(ss[1]);
        float r[2]; r[0] = rsqrtf(ss[0] * (1.0f / DM) + NORM_EPS); r[1] = rsqrtf(ss[1] * (1.0f / DM) + NORM_EPS);
        if (g1) {
            float s2[2] = {0.f, 0.f};
#pragma unroll
            for (int i = 0; i < 4; ++i) { const f32x4 g = *(const f32x4*)(g1 + i * 256 + lane * 4);
#pragma unroll
                for (int q = 0; q < 2; ++q) { v[q][i] = v[q][i] * r[q] * g; *(f32x4*)(x1out + (size_t)rows[q] * DM + i * 256 + lane * 4) = v[q][i];
                    s2[q] += v[q][i][0] * v[q][i][0] + v[q][i][1] * v[q][i][1] + v[q][i][2] * v[q][i][2] + v[q][i][3] * v[q][i][3]; } }
            s2[0] = wave_sum(s2[0]); s2[1] = wave_sum(s2[1]);
            r[0] = rsqrtf(s2[0] * (1.0f / DM) + NORM_EPS); r[1] = rsqrtf(s2[1] * (1.0f / DM) + NORM_EPS);
        }
        if (g2) {
#pragma unroll
            for (int i = 0; i < 4; ++i) { const f32x4 g = *(const f32x4*)(g2 + i * 256 + lane * 4);
#pragma unroll
                for (int q = 0; q < 2; ++q) { const f32x4 o = v[q][i] * r[q] * g;
                    u32x2 w; w.x = pk2(o[0], o[1]); w.y = pk2(o[2], o[3]); *(u32x2*)(xn + (size_t)rows[q] * DM + i * 256 + lane * 4) = w; } }
        }
    }
}

__device__ void sgu_item(const Params& PP, int chunk, LAS unsigned char* lds) {
    Params P = PP; P.ws = opaque_ptr(PP.ws);
    const int tid = opaque_tid(), lane = tid & 63, wave = __builtin_amdgcn_readfirstlane(tid >> 6), l15 = lane & 15, quad = lane >> 4;
    constexpr int PITCH = 1056;
    const bf16_t* Puv = (const bf16_t*)(P.ws + WS_PUV);
    bf16_t* MO = (bf16_t*)(P.ws + WS_XN);
    const size_t row0 = (size_t)chunk * 128;
    {
        float gn[8];
        { const f32x4 a = *(const f32x4*)(P.in[12] + lane * 8), b = *(const f32x4*)(P.in[12] + lane * 8 + 4); gn[0] = a[0]; gn[1] = a[1]; gn[2] = a[2]; gn[3] = a[3]; gn[4] = b[0]; gn[5] = b[1]; gn[6] = b[2]; gn[7] = b[3]; }
        for (int i = 0; i < 16; ++i) {
            const int p = wave * 16 + i;
            const u32x4 raw = *(const u32x4*)(Puv + (row0 + p) * 1024 + 512 + lane * 8);
            float v[8]; unpack8(raw, v); float ss = 0.f;
#pragma unroll
            for (int e = 0; e < 8; ++e) { v[e] = gelu_tanh(v[e]); ss += v[e] * v[e]; }
            ss = wave_sum(ss);
            const float r = rsqrtf(ss * (1.0f / 512.0f) + NORM_EPS);
#pragma unroll
            for (int e = 0; e < 8; ++e) v[e] = v[e] * r * gn[e];
            *(LAS u32x4*)(lds + p * PITCH + lane * 16) = pack8(v);
        }
    }
    __syncthreads();
    const int g = wave >> 1, cbase = (wave >> 1) * 128 + (wave & 1) * 64;
    const bf16_t* Wg = (const bf16_t*)(P.ws + WS_SGUW) + (size_t)g * 128 * 128;
    const int r4 = l15 >> 2, c4 = l15 & 3;
    for (int qh = 0; qh < 2; ++qh) {
        f32x4 acc[4][4];
#pragma unroll
        for (int a = 0; a < 4; ++a)
#pragma unroll
            for (int b = 0; b < 4; ++b) acc[a][b] = (f32x4){0.f, 0.f, 0.f, 0.f};
#pragma unroll
        for (int ks = 0; ks < 4; ++ks) {
            bf16x8 bfr[4];
#pragma unroll
            for (int qt = 0; qt < 4; ++qt) bfr[qt] = *(const bf16x8*)(Wg + (size_t)(qh * 64 + qt * 16 + l15) * 128 + ks * 32 + quad * 8);
#pragma unroll
            for (int ct = 0; ct < 4; ++ct) {
                LAS const unsigned char* ap = lds + (ks * 32 + quad * 8 + r4) * PITCH + (cbase + ct * 16 + 4 * c4) * 2;
                const s16x4 lo = tr_read(ap), hi = tr_read(ap + 4 * PITCH);
                const bf16x8 a = {lo[0], lo[1], lo[2], lo[3], hi[0], hi[1], hi[2], hi[3]};
#pragma unroll
                for (int qt = 0; qt < 4; ++qt) acc[ct][qt] = mfma16(a, bfr[qt], acc[ct][qt]);
            }
        }
#pragma unroll
        for (int qt = 0; qt < 4; ++qt) {
            const int q = qh * 64 + qt * 16 + l15;
            const float bq = P.in[14][g * 128 + q];
#pragma unroll
            for (int ct = 0; ct < 4; ++ct) {
                const int c = cbase + ct * 16 + quad * 4;
                const u32x2 ur = *(const u32x2*)(Puv + (row0 + q) * 1024 + c);
                const float u0 = gelu_tanh(bflo(ur.x)), u1 = gelu_tanh(bfhi(ur.x)), u2 = gelu_tanh(bflo(ur.y)), u3 = gelu_tanh(bfhi(ur.y));
                u32x2 w; w.x = pk2(u0 * (acc[ct][qt][0] + bq), u1 * (acc[ct][qt][1] + bq)); w.y = pk2(u2 * (acc[ct][qt][2] + bq), u3 * (acc[ct][qt][3] + bq));
                *(u32x2*)(MO + (row0 + q) * 1024 + c) = w;
            }
        }
    }
    __syncthreads();
}

template <int LPR> __device__ __forceinline__ float reduce_row(float x) {
    x += dppf<0xB1>(x); x += dppf<0x4E>(x); x += dppf<0x141>(x);
    if (LPR == 16) x += dppf<0x140>(x);
    return x;
}
__device__ __forceinline__ float reduce32(float x) {
    x += dppf<0xB1>(x); x += dppf<0x4E>(x); x += dppf<0x141>(x); x += dppf<0x140>(x); x += __shfl_xor(x, 16); return x;
}
__device__ __forceinline__ void lds_barrier() { asm volatile("s_waitcnt lgkmcnt(0)" ::: "memory"); __builtin_amdgcn_s_barrier(); asm volatile("" ::: "memory"); }
template <int NV> struct ScanSet { f32x4 kk[NV], w[NV], ka[NV], kp[NV], r[NV]; float vv; };
template <int NV> __device__ __forceinline__ void scan_load(ScanSet<NV>& t, LAS const float* KK, LAS const float* Wd, LAS const float* KKA, LAS const float* KP, LAS const float* Rr, LAS const float* Vv, int o, int ov, bool want_y) {
#pragma unroll
    for (int u = 0; u < NV; ++u) { t.kk[u] = *(LAS const f32x4*)(KK + o + u * 32); t.w[u] = *(LAS const f32x4*)(Wd + o + u * 32); t.ka[u] = *(LAS const f32x4*)(KKA + o + u * 32); t.kp[u] = *(LAS const f32x4*)(KP + o + u * 32); }
    if (want_y) {
#pragma unroll
        for (int u = 0; u < NV; ++u) t.r[u] = *(LAS const f32x4*)(Rr + o + u * 32);
    }
    t.vv = Vv[ov];
}
typedef float f32x2v __attribute__((ext_vector_type(2)));
template <int LPR, int NV> __device__ __forceinline__ float scan_step(float* S, const ScanSet<NV>& t, bool want_y, float& ypart) {
    f32x2v acc = {0.f, 0.f};
#pragma unroll
    for (int u = 0; u < NV; ++u)
#pragma unroll
        for (int hh = 0; hh < 2; ++hh) { const f32x2v s2 = {S[4 * u + 2 * hh], S[4 * u + 2 * hh + 1]}, k2 = {t.kk[u][2 * hh], t.kk[u][2 * hh + 1]}; acc = s2 * k2 + acc; }
    float sa = acc.x + acc.y, yb = ypart;
    sa += dppf<0xB1>(sa); yb += dppf<0xB1>(yb); sa += dppf<0x4E>(sa); yb += dppf<0x4E>(yb); sa += dppf<0x141>(sa); yb += dppf<0x141>(yb);
    const f32x2v sa2 = {sa, sa}, vv2 = {t.vv, t.vv};
#pragma unroll
    for (int u = 0; u < NV; ++u)
#pragma unroll
        for (int hh = 0; hh < 2; ++hh) {
            f32x2v s2 = {S[4 * u + 2 * hh], S[4 * u + 2 * hh + 1]};
            const f32x2v w2 = {t.w[u][2 * hh], t.w[u][2 * hh + 1]}, kp2 = {t.kp[u][2 * hh], t.kp[u][2 * hh + 1]}, ka2 = {t.ka[u][2 * hh], t.ka[u][2 * hh + 1]};
            f32x2v tt = vv2 * kp2; tt = tt - sa2 * ka2;
            s2 = s2 * w2 + tt;
            S[4 * u + 2 * hh] = s2.x; S[4 * u + 2 * hh + 1] = s2.y;
        }
    if (want_y) {
        f32x2v yacc = {0.f, 0.f};
#pragma unroll
        for (int u = 0; u < NV; ++u)
#pragma unroll
            for (int hh = 0; hh < 2; ++hh) { const f32x2v s2 = {S[4 * u + 2 * hh], S[4 * u + 2 * hh + 1]}, r2 = {t.r[u][2 * hh], t.r[u][2 * hh + 1]}; yacc = s2 * r2 + yacc; }
        ypart = yacc.x + yacc.y;
    }
    return yb;
}
struct ScanSet2 { f32x4 kk, w, ka, kp, r; float vv0, vv1; };
__device__ __forceinline__ void scan_load2(ScanSet2& t, LAS const float* KK, LAS const float* Wd, LAS const float* KKA, LAS const float* KP, LAS const float* Rr, LAS const float* Vv, int o, int ov, bool want_y) {
    t.kk = *(LAS const f32x4*)(KK + o); t.w = *(LAS const f32x4*)(Wd + o); t.ka = *(LAS const f32x4*)(KKA + o); t.kp = *(LAS const f32x4*)(KP + o);
    if (want_y) t.r = *(LAS const f32x4*)(Rr + o);
    t.vv0 = Vv[ov]; t.vv1 = Vv[ov + 4];
}
__device__ __forceinline__ float dpp16(float x) { x += dppf<0xB1>(x); x += dppf<0x4E>(x); x += dppf<0x141>(x); x += dppf<0x140>(x); return x; }
__device__ __forceinline__ void scan_step2(f32x2v* SS, const ScanSet2& t, bool want_y, float& y0, float& y1, float& yr0, float& yr1) {
    f32x2v a2 = SS[0] * (f32x2v){t.kk[0], t.kk[0]};
#pragma unroll
    for (int i = 1; i < 4; ++i) a2 = SS[i] * (f32x2v){t.kk[i], t.kk[i]} + a2;
    float a0 = a2.x, a1 = a2.y, b0 = y0, b1 = y1;
#define SCAN_OPAQUE4() asm("" : "+v"(a0), "+v"(a1), "+v"(b0), "+v"(b1))
    SCAN_OPAQUE4();
    a0 += dppf<0xB1>(a0); a1 += dppf<0xB1>(a1); b0 += dppf<0xB1>(b0); b1 += dppf<0xB1>(b1); SCAN_OPAQUE4();
    a0 += dppf<0x4E>(a0); a1 += dppf<0x4E>(a1); b0 += dppf<0x4E>(b0); b1 += dppf<0x4E>(b1); SCAN_OPAQUE4();
    a0 += dppf<0x141>(a0); a1 += dppf<0x141>(a1); b0 += dppf<0x141>(b0); b1 += dppf<0x141>(b1); SCAN_OPAQUE4();
    a0 += dppf<0x140>(a0); a1 += dppf<0x140>(a1); b0 += dppf<0x140>(b0); b1 += dppf<0x140>(b1); SCAN_OPAQUE4();
#undef SCAN_OPAQUE4
    yr0 = b0; yr1 = b1;
    const f32x2v sa2 = {a0, a1}, vv2 = {t.vv0, t.vv1};
#pragma unroll
    for (int i = 0; i < 4; ++i) {
        f32x2v tt = vv2 * (f32x2v){t.kp[i], t.kp[i]};
        tt = tt - sa2 * (f32x2v){t.ka[i], t.ka[i]};
        SS[i] = SS[i] * (f32x2v){t.w[i], t.w[i]} + tt;
    }
    if (want_y) {
        f32x2v p2 = SS[0] * (f32x2v){t.r[0], t.r[0]};
#pragma unroll
        for (int i = 1; i < 4; ++i) p2 = SS[i] * (f32x2v){t.r[i], t.r[i]} + p2;
        y0 = p2.x; y1 = p2.y;
    }
}
template <int LPR> __device__ void scan_item(const Params& PP, int seq, int h, int dir, int rhalf, int tbeg, int tlen, int flags, const float* sin, float* sout, LAS unsigned char* lds) {
    Params P = PP; P.ws = opaque_ptr(PP.ws);
    constexpr int KPL = 64 / LPR, RPW = 64 / LPR, NV = KPL / 4;
    const int tid = opaque_tid(), lane = tid & 63, wave = __builtin_amdgcn_readfirstlane(tid >> 6), l15 = lane & 15, quad = lane >> 4;
    const int Tseq = seq < 32 ? 2048 : 16384;
    const size_t base = seq < 32 ? (size_t)seq * 2048 : (size_t)M_PROMPT;
    const bf16_t* Prkvg = (const bf16_t*)(P.ws + WS_PRKVG);
    const bf16_t* Pwa = (const bf16_t*)(P.ws + WS_PWA);
    bf16_t* Yd = (bf16_t*)(P.ws + WS_Y) + (size_t)dir * M_TOK * 512;
    float* RKR = (float*)(P.ws + WS_RKR) + (size_t)dir * M_TOK * 8;
    LAS bf16_t* RAW0 = (LAS bf16_t*)lds;
    LAS bf16_t* ZROW = (LAS bf16_t*)(lds + 21760);
    LAS float* Wd = (LAS float*)(lds + 22528);
    LAS float* Aa = Wd + 1024; LAS float* Rr = Aa + 1024; LAS float* KP = Rr + 1024; LAS float* Vv = KP + 1024; LAS float* KK = Vv + 1024; LAS float* KKA = KK + 1024; LAS float* Yc = KKA + 1024;
    if (tid < 160) ((LAS unsigned*)ZROW)[tid] = 0u;
    LAS bf16_t* ALDS = (LAS bf16_t*)(lds + 55296);
    const int j_a = tid / 40, seg_a = (tid % 40) >> 3, c8_a = tid & 7;
    const int idx_b = tid + 512, j_b = idx_b / 40, seg_b = (idx_b % 40) >> 3, c8_b = idx_b & 7;
    const bool has_b = idx_b < 640;
    const int coff_a = seg_a < 3 ? seg_a * 512 + h * 64 + c8_a * 8 : dir * 128 + (seg_a - 3) * 64 + c8_a * 8;
    const int coff_b = seg_b < 3 ? seg_b * 512 + h * 64 + c8_b * 8 : dir * 128 + (seg_b - 3) * 64 + c8_b * 8;
    const int dst_a = (j_a + 1) * 320 + seg_a * 64 + c8_a * 8, dst_b = (j_b + 1) * 320 + seg_b * 64 + c8_b * 8;
    const bf16_t* src_a = (seg_a < 3 ? Prkvg + base * 2048 : Pwa + base * 256) + coff_a; const int ld_a = seg_a < 3 ? 2048 : 256;
    const bf16_t* src_b = (seg_b < 3 ? Prkvg + base * 2048 : Pwa + base * 256) + coff_b; const int ld_b = seg_b < 3 ? 2048 : 256;
    const int ltype = wave >> 2, lch = (wave & 3) * 16 + l15;
    const bf16_t* Wt = (const bf16_t*)(P.ws + WS_LORA) + (size_t)(dir * 2 + ltype) * 512 * 64 + (size_t)(h * 64 + lch) * 64;
    const bf16x8 lb0 = *(const bf16x8*)(Wt + quad * 8), lb1 = *(const bf16x8*)(Wt + 32 + quad * 8);
    const float lbias = ltype == 0 ? P.in[17][dir * 512 + h * 64 + lch] : P.in[19][dir * 512 + h * 64 + lch];
    const int tk = tid >> 5, c2 = tid & 31;
    float mu_r[2], mu_k[2], mu_v[2], k_k[2], k_a[2], r_k[2];
#pragma unroll
    for (int e = 0; e < 2; ++e) { const int ch = h * 64 + 2 * c2 + e;
        mu_r[e] = P.in[15][dir * 1536 + ch]; mu_k[e] = P.in[15][dir * 1536 + 512 + ch]; mu_v[e] = P.in[15][dir * 1536 + 1024 + ch];
        k_k[e] = P.in[21][ch]; k_a[e] = P.in[22][ch]; r_k[e] = P.in[23][ch]; }
    float amu[2][2];
#pragma unroll
    for (int ty = 0; ty < 2; ++ty)
#pragma unroll
        for (int e = 0; e < 2; ++e) amu[ty][e] = P.in[16][dir * 128 + ty * 64 + 2 * c2 + e];
#define SCAN_BUILD_A(RAWN, PREV0) do { \
        LAS const bf16_t* cur_ = (RAWN) + (tk + 1) * 320 + 192 + 2 * c2; \
        LAS const bf16_t* prv_ = (tk > 0 ? (RAWN) + tk * 320 : (PREV0)) + 192 + 2 * c2; \
        _Pragma("unroll") for (int ty = 0; ty < 2; ++ty) { \
            const unsigned xc_ = *(LAS const unsigned*)(cur_ + ty * 64), xp_ = *(LAS const unsigned*)(prv_ + ty * 64); \
            float z0_ = bflo(xc_) + (bflo(xp_) - bflo(xc_)) * amu[ty][0], z1_ = bfhi(xc_) + (bfhi(xp_) - bfhi(xc_)) * amu[ty][1]; \
            if (ty == 0) { z0_ = tanhf_(z0_); z1_ = tanhf_(z1_); } \
            *(LAS unsigned*)(ALDS + ty * 1152 + tk * 72 + 2 * c2) = pk2(z0_, z1_); } } while (0)
    static_assert(LPR == 16, "two rows per lane, 16 lanes per row");
    const int srow = wave * 8 + (lane >> 4), sq = lane & 15;
    f32x2v SS[4];
#pragma unroll
    for (int i = 0; i < 4; ++i) { const int kidx = sq * 4 + i;
        SS[i].x = (flags & 1) ? (kidx == srow ? 1.f : 0.f) : (sin ? sin[srow * 64 + kidx] : 0.f);
        SS[i].y = (flags & 1) ? (kidx == srow + 4 ? 1.f : 0.f) : (sin ? sin[(srow + 4) * 64 + kidx] : 0.f); }
    const int nch = tlen / 16;
    const int tstep = dir == 0 ? 16 : -16;
    const int tfirst = dir == 0 ? tbeg : tbeg + tlen - 16;
    const int tprev = dir == 0 ? tbeg - 1 : tbeg + tlen;
    const bool has_prev = tprev >= 0 && tprev < Tseq;
    if (has_prev && tid < 40) {
        const int sg = tid >> 3, c8 = tid & 7;
        const bf16_t* sp = sg < 3 ? Prkvg + (base + tprev) * 2048 + sg * 512 + h * 64 + c8 * 8 : Pwa + (base + tprev) * 256 + dir * 128 + (sg - 3) * 64 + c8 * 8;
        *(LAS u32x4*)(RAW0 + 5440 + 16 * 320 + sg * 64 + c8 * 8) = *(const u32x4*)sp;
    }
    const bool in_on = (flags & 2) == 0, wr_y = (flags & 4) != 0, wr_rk = (flags & 8) != 0;
#define SCAN_TOK(t0, j) (dir == 0 ? (t0) + (j) : (t0) + 15 - (j))
    u32x4 pre_a, pre_b = (u32x4){0u, 0u, 0u, 0u};
    {
        pre_a = *(const u32x4*)(src_a + (size_t)SCAN_TOK(tfirst, j_a) * ld_a);
        if (has_b) pre_b = *(const u32x4*)(src_b + (size_t)SCAN_TOK(tfirst, j_b) * ld_b);
        *(LAS u32x4*)(RAW0 + dst_a) = pre_a;
        if (has_b) *(LAS u32x4*)(RAW0 + dst_b) = pre_b;
        if (nch > 1) {
            pre_a = *(const u32x4*)(src_a + (size_t)SCAN_TOK(tfirst + tstep, j_a) * ld_a);
            if (has_b) pre_b = *(const u32x4*)(src_b + (size_t)SCAN_TOK(tfirst + tstep, j_b) * ld_b);
        }
    }
    __syncthreads();
    SCAN_BUILD_A(RAW0, (has_prev ? RAW0 + 5440 + 16 * 320 : ZROW));
    lds_barrier();
    u32x4 ypend = (u32x4){0u, 0u, 0u, 0u}; bf16_t* ypend_ptr = nullptr;
    for (int c = 0; c < nch; ++c) {
        LAS bf16_t* RAW = RAW0 + (c & 1) * 5440;
        LAS bf16_t* RAWp = RAW0 + ((c & 1) ^ 1) * 5440;
        const int t0 = tfirst + c * tstep;
        {
            bf16x8 af[2];
#pragma unroll
            for (int ks = 0; ks < 2; ++ks) af[ks] = *(LAS const bf16x8*)(ALDS + ltype * 1152 + l15 * 72 + ks * 32 + quad * 8);
            f32x4 d = mfma16(af[0], lb0, (f32x4){0.f, 0.f, 0.f, 0.f});
            d = mfma16(af[1], lb1, d);
            LAS float* dstp = (ltype == 0 ? Wd : Aa) + lch;
#pragma unroll
            for (int jj = 0; jj < 4; ++jj) { const float sg = sigmoidf_(lbias + d[jj]); dstp[(quad * 4 + jj) * 64] = ltype == 0 ? __expf(-0.6065306597126334f * sg) : sg; }
        }
        {
            LAS const bf16_t* cur = RAW + (tk + 1) * 320 + 2 * c2;
            LAS const bf16_t* prv = (tk > 0 ? RAW + tk * 320 : ((c > 0 || has_prev) ? RAWp + 16 * 320 : ZROW)) + 2 * c2;
            const unsigned rc = *(LAS const unsigned*)(cur), rp = *(LAS const unsigned*)(prv);
            const unsigned kc = *(LAS const unsigned*)(cur + 64), kq = *(LAS const unsigned*)(prv + 64);
            const unsigned vc = *(LAS const unsigned*)(cur + 128), vp = *(LAS const unsigned*)(prv + 128);
            const int o = tk * 64 + 2 * c2;
            Rr[o] = bflo(rc) + (bflo(rp) - bflo(rc)) * mu_r[0]; Rr[o + 1] = bfhi(rc) + (bfhi(rp) - bfhi(rc)) * mu_r[1];
            KP[o] = bflo(kc) + (bflo(kq) - bflo(kc)) * mu_k[0]; KP[o + 1] = bfhi(kc) + (bfhi(kq) - bfhi(kc)) * mu_k[1];
            Vv[o] = in_on ? bflo(vc) + (bflo(vp) - bflo(vc)) * mu_v[0] : 0.f; Vv[o + 1] = in_on ? bfhi(vc) + (bfhi(vp) - bfhi(vc)) * mu_v[1] : 0.f;
        }
        lds_barrier();
        float rk_keep;
        {
            const int o = tk * 64 + 2 * c2;
            const float kz0 = KP[o], kz1 = KP[o + 1], a0 = Aa[o], a1 = Aa[o + 1];
            const float q0 = kz0 * k_k[0], q1 = kz1 * k_k[1];
            const float kp0 = kz0 * (1.0f + (a0 - 1.0f) * k_a[0]), kp1 = kz1 * (1.0f + (a1 - 1.0f) * k_a[1]);
            const float ss = reduce32(q0 * q0 + q1 * q1);
            const float rk = reduce32(Rr[o] * kp0 * r_k[0] + Rr[o + 1] * kp1 * r_k[1]);
            const float inv = __builtin_amdgcn_rsqf(fmaxf(ss, 1e-24f));
            const float kk0 = q0 * inv, kk1 = q1 * inv;
            KK[o] = kk0; KK[o + 1] = kk1; KKA[o] = kk0 * a0; KKA[o + 1] = kk1 * a1;
            KP[o] = kp0; KP[o + 1] = kp1;
            rk_keep = rk;
        }
        if (c + 1 < nch) {
            *(LAS u32x4*)(RAWp + dst_a) = pre_a;
            if (has_b) *(LAS u32x4*)(RAWp + dst_b) = pre_b;
            if (c + 2 < nch) {
                pre_a = *(const u32x4*)(src_a + (size_t)SCAN_TOK(t0 + 2 * tstep, j_a) * ld_a);
                if (has_b) pre_b = *(const u32x4*)(src_b + (size_t)SCAN_TOK(t0 + 2 * tstep, j_b) * ld_b);
            }
        }
        if (wr_rk && c2 == 0) RKR[(base + SCAN_TOK(t0, tk)) * 8 + h] = rk_keep;
        if (ypend_ptr) *(u32x4*)ypend_ptr = ypend;
        lds_barrier();
        if (c + 1 < nch) SCAN_BUILD_A(RAWp, RAW + 16 * 320);
        {
            ScanSet2 sa_, sb_;
            scan_load2(sa_, KK, Wd, KKA, KP, Rr, Vv, sq * 4, srow, wr_y);
            float yk = 0.f, zk = 0.f, y0 = 0.f, y1 = 0.f, yr0, yr1;
#pragma unroll 1
            for (int jo = 0; jo < 16; jo += 2) {
                scan_load2(sb_, KK, Wd, KKA, KP, Rr, Vv, (jo + 1) * 64 + sq * 4, (jo + 1) * 64 + srow, wr_y);
                scan_step2(SS, sa_, wr_y, y0, y1, yr0, yr1);
                if (jo > 0 && sq == jo - 1) { yk = yr0; zk = yr1; }
                if (jo + 2 < 16) scan_load2(sa_, KK, Wd, KKA, KP, Rr, Vv, (jo + 2) * 64 + sq * 4, (jo + 2) * 64 + srow, wr_y);
                scan_step2(SS, sb_, wr_y, y0, y1, yr0, yr1);
                if (sq == jo) { yk = yr0; zk = yr1; }
            }
            yr0 = dpp16(y0); yr1 = dpp16(y1);
            if (sq == 15) { yk = yr0; zk = yr1; }
            Yc[sq * 64 + srow] = yk; Yc[sq * 64 + srow + 4] = zk;
        }
        lds_barrier();
        {
            const bool wr = wr_y && tid < 128;
            if (wr) {
                const int tq = tid >> 3, c8 = tid & 7; float f[8];
                const f32x4 a = *(LAS const f32x4*)(Yc + tq * 64 + c8 * 8), b = *(LAS const f32x4*)(Yc + tq * 64 + c8 * 8 + 4);
                f[0] = a[0]; f[1] = a[1]; f[2] = a[2]; f[3] = a[3]; f[4] = b[0]; f[5] = b[1]; f[6] = b[2]; f[7] = b[3];
                ypend = pack8(f); ypend_ptr = Yd + (base + SCAN_TOK(t0, tq)) * 512 + h * 64 + c8 * 8;
            }
        }
    }
    if (ypend_ptr) *(u32x4*)ypend_ptr = ypend;
    if (sout) { *(f32x4*)(sout + srow * 64 + sq * 4) = (f32x4){SS[0].x, SS[1].x, SS[2].x, SS[3].x}; *(f32x4*)(sout + (srow + 4) * 64 + sq * 4) = (f32x4){SS[0].y, SS[1].y, SS[2].y, SS[3].y}; }
#undef SCAN_TOK
#undef SCAN_BUILD_A
    __syncthreads();
}

__device__ void scan_carry(const Params& PP, int hd, LAS unsigned char* lds) {
    Params P = PP; P.ws = opaque_ptr(PP.ws);
    const int tid = opaque_tid();
    const float* Lm = (const float*)(P.ws + WS_STL) + (size_t)hd * NSEG * 4096;
    const float* Pm = (const float*)(P.ws + WS_STP) + (size_t)hd * NSEG * 4096;
    float* St = (float*)(P.ws + WS_STS) + (size_t)hd * NSEG * 4096;
    LAS float* Sc = (LAS float*)lds;
    LAS float* Pc = Sc + 4096;
    const int v = tid >> 3, k0 = (tid & 7) * 8;
    for (int i = 0; i < 8; ++i) { const float x = Lm[v * 64 + k0 + i]; Sc[v * 64 + k0 + i] = x; St[4096 + v * 64 + k0 + i] = x; }
    for (int sgm = 1; sgm + 1 < NSEG; ++sgm) {
        for (int i = 0; i < 8; ++i) Pc[v * 64 + k0 + i] = Pm[(size_t)sgm * 4096 + v * 64 + k0 + i];
        __syncthreads();
        float o[8];
        for (int i = 0; i < 8; ++i) o[i] = Lm[(size_t)sgm * 4096 + v * 64 + k0 + i];
        for (int j = 0; j < 64; ++j) { const float sv = Sc[v * 64 + j];
#pragma unroll
            for (int i = 0; i < 8; ++i) o[i] += sv * Pc[j * 64 + k0 + i]; }
        __syncthreads();
        for (int i = 0; i < 8; ++i) { Sc[v * 64 + k0 + i] = o[i]; St[(size_t)(sgm + 1) * 4096 + v * 64 + k0 + i] = o[i]; }
    }
    __syncthreads();
}

__device__ void rwkv_finalize(const Params& PP) {
    Params P = PP; P.ws = opaque_ptr(PP.ws);
    const int tid_ = opaque_tid(), lane = tid_ & 63, wave = __builtin_amdgcn_readfirstlane(tid_ >> 6);
    const bf16_t* Prkvg = (const bf16_t*)(P.ws + WS_PRKVG);
    const bf16_t* Y0 = (const bf16_t*)(P.ws + WS_Y);
    const bf16_t* Y1 = Y0 + (size_t)M_TOK * 512;
    const float* RKR0 = (const float*)(P.ws + WS_RKR);
    const float* RKR1 = RKR0 + (size_t)M_TOK * 8;
    bf16_t* MO = (bf16_t*)(P.ws + WS_XN);
    const int col = lane * 8, hh = lane >> 3;
    float gw[8], gb[8], muf[8], mub[8];
#pragma unroll
    for (int i = 0; i < 8; ++i) { gw[i] = P.in[24][col + i]; gb[i] = P.in[25][col + i]; muf[i] = P.in[15][1024 + col + i]; mub[i] = P.in[15][1536 + 1024 + col + i]; }
    for (int row = blockIdx.x * 8 + wave; row < M_TOK; row += gridDim.x * 8) {
        const int t = row < M_PROMPT ? (row & 2047) : row - M_PROMPT, T = row < M_PROMPT ? 2048 : 16384;
        float yf[8], yb[8], vc[8], vp[8], vn[8], gg[8];
        unpack8(*(const u32x4*)(Y0 + (size_t)row * 512 + col), yf); unpack8(*(const u32x4*)(Y1 + (size_t)row * 512 + col), yb);
        unpack8(*(const u32x4*)(Prkvg + (size_t)row * 2048 + 1024 + col), vc);
        unpack8(*(const u32x4*)(Prkvg + (size_t)row * 2048 + 1536 + col), gg);
        if (t > 0) unpack8(*(const u32x4*)(Prkvg + (size_t)(row - 1) * 2048 + 1024 + col), vp); else { for (int i = 0; i < 8; ++i) vp[i] = 0.f; }
        if (t < T - 1) unpack8(*(const u32x4*)(Prkvg + (size_t)(row + 1) * 2048 + 1024 + col), vn); else { for (int i = 0; i < 8; ++i) vn[i] = 0.f; }
        const float rf = RKR0[(size_t)row * 8 + hh], rb = RKR1[(size_t)row * 8 + hh];
        float s = 0.f;
#pragma unroll
        for (int i = 0; i < 8; ++i) { yf[i] += yb[i]; s += yf[i]; }
        const float mean = reduce8(s) * (1.0f / 64.0f);
        float q = 0.f;
#pragma unroll
        for (int i = 0; i < 8; ++i) { yf[i] -= mean; q += yf[i] * yf[i]; }
        const float rstd = rsqrtf(reduce8(q) * (1.0f / 64.0f) + 64e-5f);
        float o[8];
#pragma unroll
        for (int i = 0; i < 8; ++i) {
            const float vzf = vc[i] + (vp[i] - vc[i]) * muf[i], vzb = vc[i] + (vn[i] - vc[i]) * mub[i];
            o[i] = (yf[i] * rstd * gw[i] + gb[i] + rf * vzf + rb * vzb) * sigmoidf_(gg[i]);
        }
        *(u32x4*)(MO + (size_t)row * 1024 + 512 + col) = pack8(o);
    }
}

__device__ void attn_item(const Params& PP, int seq, int h, int tile, LAS unsigned char* lds) {
    Params P = PP; P.ws = opaque_ptr(PP.ws);
    const int tid = opaque_tid(), lane = tid & 63, wave = __builtin_amdgcn_readfirstlane(tid >> 6), l15 = lane & 15, quad = lane >> 4;
    const int T = seq < 32 ? 2048 : 16384;
    const size_t base = seq < 32 ? (size_t)seq * 2048 : (size_t)M_PROMPT;
    const int T0 = tile * 256;
    const bf16_t* QKV = (const bf16_t*)(P.ws + WS_BIG);
    bf16_t* MO = (bf16_t*)(P.ws + WS_XN);
    LAS float* OACC = (LAS float*)lds;
    LAS float* LS = (LAS float*)(lds + 256 * 272);
    LAS unsigned char* VST = lds + 256 * 272 + 1024 + wave * (32 * 144);
    const float slope = exp2f(-0.5f * (float)(h + 1));
    float gqk[16];
#pragma unroll
    for (int i = 0; i < 16; ++i) { const int e = (i >> 3) * 32 + quad * 8 + (i & 7); gqk[i] = P.in[28][e] * P.in[29][e]; }
    const int r4 = l15 >> 2, c4 = l15 & 3;
    float biasL[9][4];
#pragma unroll
    for (int kt = 0; kt < 9; ++kt)
#pragma unroll
        for (int j = 0; j < 4; ++j) { int dist = 16 * kt - 64 + quad * 4 + j - l15; dist = dist < 0 ? -dist : dist;
            biasL[kt][j] = dist <= 64 ? -slope * 1.4426950408889634f * (float)dist : -1e30f; }
    LAS float* RKT = (LAS float*)(lds + 107520);
    const int tb = T0 - 1024;
    for (int idx = tid; idx < 2304; idx += 512) {
        const int tok = tb + idx;
        if (tok >= 0 && tok < T) {
            const bf16_t* kp_ = QKV + (base + tok) * 3072 + 1024 + h * 64;
            float ss = 0.f;
#pragma unroll
            for (int i = 0; i < 8; ++i) { float f[8]; unpack8(*(const u32x4*)(kp_ + i * 8), f);
#pragma unroll
                for (int e = 0; e < 8; ++e) ss += f[e] * f[e]; }
            RKT[idx] = rsqrtf(ss * (1.0f / 64.0f) + NORM_EPS) * 1.4426950408889634f;
        }
    }
    __syncthreads();
    for (int bi = 0; bi < 3; ++bi) {
        const int dsh = 2 * bi, L = T >> dsh;
        const float sl_d = slope * (float)(1 << dsh);
        for (int gg = 0; gg < 2; ++gg) {
            const int g = wave * 2 + gg;
            const int res = bi == 0 ? 0 : (bi == 1 ? (g & 3) : g), blk = bi == 0 ? g : (bi == 1 ? (g >> 2) : 0);
            const int i0 = (T0 >> dsh) + 16 * blk;
            const int qtok = ((i0 + l15) << dsh) + res;
            bf16x8 qf[2]; float mq;
            {
                const bf16_t* qp = QKV + (base + qtok) * 3072 + h * 64 + quad * 8;
                float f[16]; unpack8(*(const u32x4*)qp, f); unpack8(*(const u32x4*)(qp + 32), f + 8);
                float ss = 0.f;
#pragma unroll
                for (int i = 0; i < 16; ++i) ss += f[i] * f[i];
                ss += __shfl_xor(ss, 16); ss += __shfl_xor(ss, 32);
                const float rq = rsqrtf(ss * (1.0f / 64.0f) + NORM_EPS) * 0.125f;
#pragma unroll
                for (int i = 0; i < 16; ++i) f[i] = f[i] * rq * gqk[i];
                const u32x4 w0 = pack8(f), w1 = pack8(f + 8);
                qf[0] = __builtin_bit_cast(bf16x8, w0); qf[1] = __builtin_bit_cast(bf16x8, w1);
                float fr[16]; unpack8(w0, fr); unpack8(w1, fr + 8);
                float n2 = 0.f;
#pragma unroll
                for (int i = 0; i < 16; ++i) n2 += fr[i] * fr[i];
                n2 += __shfl_xor(n2, 16); n2 += __shfl_xor(n2, 32);
                mq = 8.1f * 1.4426950408889634f * sqrtf(n2);
            }
            f32x4 oacc[4];
#pragma unroll
            for (int et = 0; et < 4; ++et) oacc[et] = (f32x4){0.f, 0.f, 0.f, 0.f};
            float lsum = 0.f;
            const int kjb = i0 - 64 + quad * 4, rkoff = res - tb;
            const float dmul = (float)(1 << dsh);
            bf16x8 kfb[2][2][2]; u32x4 vb[2][4];
            const int rowv = lane >> 1, half = lane & 1;
#define ATT_ISSUE(KP, BUF) do { \
                _Pragma("unroll") for (int tt_ = 0; tt_ < 2; ++tt_) { \
                    int kidx_ = i0 - 64 + 16 * (2 * (KP) + tt_) + l15; kidx_ = kidx_ < 0 ? 0 : (kidx_ > L - 1 ? L - 1 : kidx_); \
                    const bf16_t* kptr_ = QKV + (base + ((size_t)kidx_ << dsh) + res) * 3072 + 1024 + h * 64 + quad * 8; \
                    kfb[BUF][tt_][0] = *(const bf16x8*)kptr_; kfb[BUF][tt_][1] = *(const bf16x8*)(kptr_ + 32); } \
                int vidx_ = i0 - 64 + 32 * (KP) + rowv; vidx_ = vidx_ < 0 ? 0 : (vidx_ > L - 1 ? L - 1 : vidx_); \
                const bf16_t* vptr_ = QKV + (base + ((size_t)vidx_ << dsh) + res) * 3072 + 2048 + h * 64 + half * 32; \
                vb[BUF][0] = *(const u32x4*)vptr_; vb[BUF][1] = *(const u32x4*)(vptr_ + 8); vb[BUF][2] = *(const u32x4*)(vptr_ + 16); vb[BUF][3] = *(const u32x4*)(vptr_ + 24); } while (0)
            ATT_ISSUE(0, 0);
#pragma unroll
            for (int kp = 0; kp < 5; ++kp) {
                f32x4 s[2];
                if (kp + 1 < 5) ATT_ISSUE(kp + 1, (kp + 1) & 1);
#pragma unroll
                for (int tt = 0; tt < 2; ++tt) {
                    const int kt = 2 * kp + tt;
                    s[tt] = (f32x4){0.f, 0.f, 0.f, 0.f};
                    if (kt < 9) {
                        f32x4 sc = mfma16(kfb[kp & 1][tt][0], qf[0], (f32x4){0.f, 0.f, 0.f, 0.f});
                        sc = mfma16(kfb[kp & 1][tt][1], qf[1], sc);
#pragma unroll
                        for (int j = 0; j < 4; ++j) {
                            const int kj = kjb + 16 * kt + j;
                            const int kc = kj < 0 ? 0 : (kj > L - 1 ? L - 1 : kj);
                            const float rk = RKT[(kc << dsh) + rkoff];
                            float p = __builtin_amdgcn_exp2f(sc[j] * rk + (biasL[kt][j] * dmul - mq));
                            p = ((unsigned)kj < (unsigned)L) ? p : 0.f;
                            lsum += p; s[tt][j] = p;
                        }
                    }
                }
                bf16x8 pf;
                { u32x4 w; w.x = pk2(s[0][0], s[0][1]); w.y = pk2(s[0][2], s[0][3]); w.z = pk2(s[1][0], s[1][1]); w.w = pk2(s[1][2], s[1][3]); pf = __builtin_bit_cast(bf16x8, w); }
                {
                    LAS u32x4* vd = (LAS u32x4*)(VST + rowv * 144 + half * 64);
                    vd[0] = vb[kp & 1][0]; vd[1] = vb[kp & 1][1]; vd[2] = vb[kp & 1][2]; vd[3] = vb[kp & 1][3];
                }
                asm volatile("s_waitcnt lgkmcnt(0)" ::: "memory"); __builtin_amdgcn_fence(__ATOMIC_RELEASE, "wavefront"); __builtin_amdgcn_wave_barrier(); __builtin_amdgcn_fence(__ATOMIC_ACQUIRE, "wavefront"); asm volatile("s_waitcnt lgkmcnt(0)" ::: "memory");
#pragma unroll
                for (int et = 0; et < 4; ++et) {
                    LAS const unsigned char* ap = VST + (quad * 4 + r4) * 144 + (et * 16 + 4 * c4) * 2;
                    const s16x4 lo = tr_read(ap), hi = tr_read(ap + 16 * 144);
                    const bf16x8 a = {lo[0], lo[1], lo[2], lo[3], hi[0], hi[1], hi[2], hi[3]};
                    oacc[et] = mfma16(a, pf, oacc[et]);
                }
                asm volatile("s_waitcnt lgkmcnt(0)" ::: "memory"); __builtin_amdgcn_fence(__ATOMIC_RELEASE, "wavefront"); __builtin_amdgcn_wave_barrier(); __builtin_amdgcn_fence(__ATOMIC_ACQUIRE, "wavefront"); asm volatile("s_waitcnt lgkmcnt(0)" ::: "memory");
            }
#undef ATT_ISSUE
            lsum += __shfl_xor(lsum, 16); lsum += __shfl_xor(lsum, 32);
            const int qloc = qtok - T0;
#pragma unroll
            for (int et = 0; et < 4; ++et) {
                LAS f32x4* dst = (LAS f32x4*)(OACC + qloc * 68 + et * 16 + quad * 4);
                if (bi == 0) *dst = oacc[et]; else *dst = *dst + oacc[et];
            }
            if (quad == 0) { if (bi == 0) LS[qloc] = lsum; else LS[qloc] += lsum; }
        }
        __syncthreads();
    }
    {
        const int q = tid >> 1, half = tid & 1;
        const float inv = 1.0f / LS[q];
        bf16_t* op = MO + (base + T0 + q) * 1024 + h * 64 + half * 32;
#pragma unroll
        for (int i = 0; i < 4; ++i) {
            const f32x4 a = *(LAS const f32x4*)(OACC + q * 68 + half * 32 + i * 8), b = *(LAS const f32x4*)(OACC + q * 68 + half * 32 + i * 8 + 4);
            u32x4 w; w.x = pk2(a[0] * inv, a[1] * inv); w.y = pk2(a[2] * inv, a[3] * inv); w.z = pk2(b[0] * inv, b[1] * inv); w.w = pk2(b[2] * inv, b[3] * inv);
            *(u32x4*)(op + i * 8) = w;
        }
    }
    __syncthreads();
}

enum { K_P0 = 0, K_SWIGLU, K_RESID, K_NORM, K_GEMM_P, K_MIXA, K_FINAL, K_GEMM_QKV, K_ATTN, K_CARRY, K_MIXB };
constexpr int N_PHASES = 19;

__global__ void __launch_bounds__(512, 2) mega(Params P) {
    extern __shared__ __attribute__((aligned(16))) unsigned char lds_raw[];
    LAS unsigned char* lds = (LAS unsigned char*)lds_raw;
    cg::grid_group grid = cg::this_grid();
    for (int ph = 0; ph < N_PHASES; ++ph) {
#ifdef PROBE_MASK
        if (blockIdx.x == 0 && threadIdx.x == 0) ((unsigned long long*)(P.ws + WS_TS))[ph] = __builtin_amdgcn_s_memrealtime();
#endif
        unsigned char* ws = P.ws; float* X = P.out; int G = gridDim.x, bid = blockIdx.x;
        asm volatile("" : "+s"(ws), "+s"(X), "+s"(G), "+s"(bid));
        bf16_t* XN = (bf16_t*)(ws + WS_XN);
        bf16_t* Hb = (bf16_t*)(ws + WS_BIG);
        int kind, layer = 0, sub = 0;
        if (ph == 0) kind = K_P0;
        else {
            layer = ph <= 10 ? 0 : 1; const int r = ph <= 10 ? ph - 1 : ph - 11;
            const unsigned long long kc = layer == 0 ? 0x2126A95421ull : 0x32128721ull;
            const unsigned long long sc = layer == 0 ? 0x1120000000ull : 0x21120000ull;
            kind = (int)((kc >> (4 * r)) & 15ull); sub = (int)((sc >> (4 * r)) & 15ull);
        }
        if (kind == K_P0) {
#ifndef SKIP_P0
            LAS float* tile = (LAS float*)lds;
            int rot = 0;
            for (int job = 0; job < 16; ++job) {
                const float* src; size_t doff; int K, N;
                if (job < 4) { src = ((job & 1) ? P.in[7] : P.in[3]) + (size_t)(job >> 1) * 1024 * 5632; doff = WS_WFI + (size_t)job * SZ_WFI; K = 1024; N = 5632; }
                else if (job < 8) { src = ((job & 1) ? P.in[8] : P.in[4]) + (size_t)((job - 4) >> 1) * 2816 * 1024; doff = WS_WFO + (size_t)(job - 4) * SZ_WFO; K = 2816; N = 1024; }
                else if (job == 8) { src = P.in[10]; doff = WS_WABI; K = 1024; N = 3328; }
                else if (job == 9) { src = P.in[11]; doff = WS_WABO; K = 1024; N = 1024; }
                else if (job == 10) { src = P.in[26]; doff = WS_WATI; K = 1024; N = 3072; }
                else if (job == 11) { src = P.in[27]; doff = WS_WATO; K = 1024; N = 1024; }
                else { const int d = (job - 12) >> 1, ty = (job - 12) & 1; src = (ty ? P.in[20] : P.in[18]) + (size_t)d * 64 * 512; doff = WS_LORA + (size_t)(d * 2 + ty) * 512 * 64 * 2; K = 64; N = 512; }
                if (job < 4) convert_T<1>(src, (bf16_t*)(ws + doff), K, N, tile, rot); else convert_T<0>(src, (bf16_t*)(ws + doff), K, N, tile, rot);
                rot += (K / 64) * (N / 64);
            }
            {
                bf16_t* dst = (bf16_t*)(ws + WS_SGUW);
                for (int i = bid * 512 + opaque_tid(); i < 4 * 128 * 128 / 4; i += G * 512) {
                    const f32x4 v = *(const f32x4*)(P.in[13] + (size_t)i * 4);
                    u32x2 w; w.x = pk2(v[0], v[1]); w.y = pk2(v[2], v[3]); *(u32x2*)(dst + (size_t)i * 4) = w;
                }
            }
            norm_rows(P.in[0], P.in[1], M_PROMPT, nullptr, nullptr, nullptr, P.in[2], XN);
            if (bid == 0 && opaque_tid() == 0) *(unsigned*)(ws + WS_TS + 2048) = 0u;
#endif
        } else if (kind == K_SWIGLU) {
            if (sub == 0) { float* za = (float*)(ws + WS_RSA); for (int i = bid * 512 + opaque_tid(); i < M_TOK; i += G * 512) za[i] = 0.f; }
            pg8::Gemm g{sub == 0 ? XN : (const bf16_t*)(ws + WS_Y), (const bf16_t*)(ws + WS_WFI + (size_t)(layer * 2 + sub) * SZ_WFI), M_TOK, 5632, 1024};
            pg8::StaticOrder S; S.init(M_TOK, 5632, G, bid);
            if (sub == 1 && layer == 0) { float* zc = (float*)(ws + WS_RSC); for (int i = bid * 512 + opaque_tid(); i < 2 * M_TOK; i += G * 512) zc[i] = 0.f; }
            EpiSwiglu E{Hb, sub == 0 ? (layer == 0 ? nullptr : (const float*)(ws + WS_RSC)) : (const float*)(ws + WS_RSB), (sub == 0 && layer == 1) ? (const float*)(ws + WS_RSD) : nullptr};
#ifndef SKIP_G1
            pg8::gemm_phase<EpiSwiglu, pg8::StaticOrder, GEMM_ALIGN, GEMM_SP2>(lds, g, S, E);
#endif
        } else if (kind == K_RESID) {
            const bf16_t* A; const bf16_t* Bt; int K; float scale; bf16_t* xg = nullptr; const float* gn = nullptr; float* rss = nullptr;
            const float* gaux = nullptr; float* rss2 = nullptr; const float* bss = nullptr;
            if (sub < 2) { A = Hb; Bt = (const bf16_t*)(ws + WS_WFO + (size_t)(layer * 2 + sub) * SZ_WFO); K = 2816; scale = 0.5f;
                if (sub == 0) { xg = XN; gn = P.in[5] + layer * DM; rss = (float*)(ws + WS_RSA); if (layer == 1) { bss = (const float*)(ws + WS_RSC); gaux = P.in[9]; } }
                else if (layer == 0) { xg = XN; gn = P.in[2] + DM; gaux = P.in[9]; rss = (float*)(ws + WS_RSC); rss2 = (float*)(ws + WS_RSD); } }
            else { A = XN; Bt = (const bf16_t*)(ws + (layer == 0 ? WS_WABO : WS_WATO)); K = 1024; scale = 1.0f; xg = (bf16_t*)(ws + WS_Y); gn = P.in[6] + layer * DM; rss = (float*)(ws + WS_RSB); }
            pg8::Gemm g{A, Bt, M_TOK, 1024, K};
            pg8::StaticOrder S; S.init(M_TOK, 1024, G, bid);
            const bool first = (layer == 0 && sub == 0);
            EpiResid E{X, scale, xg, gn, rss, first ? P.in[0] : nullptr, first ? P.in[1] : nullptr, gaux, rss2, bss};
#ifndef SKIP_G2
            pg8::gemm_phase<EpiResid, pg8::StaticOrder, GEMM_ALIGN, GEMM_SP2>(lds, g, S, E);
#endif
        } else if (kind == K_NORM) {
            norm_rows(X, X, M_TOK, nullptr, P.in[9] + DM, X, nullptr, nullptr);
        } else if (kind == K_GEMM_P || kind == K_GEMM_QKV) {
            const bool isP = kind == K_GEMM_P; const int N = isP ? 3328 : 3072;
            pg8::Gemm g{XN, (const bf16_t*)(ws + (isP ? WS_WABI : WS_WATI)), M_TOK, N, 1024};
            pg8::StaticOrder S; S.init(M_TOK, N, G, bid);
            { float* zb = (float*)(ws + WS_RSB); for (int i = bid * 512 + opaque_tid(); i < M_TOK; i += G * 512) zb[i] = 0.f; }
            EpiSplit E; const float* rsa = (const float*)(ws + WS_RSA);
            if (isP) E = EpiSplit{(bf16_t*)(ws + WS_PUV), 1024, 4, (bf16_t*)(ws + WS_PRKVG), 2048, 12, (bf16_t*)(ws + WS_PWA), 256, rsa};
            else E = EpiSplit{(bf16_t*)(ws + WS_BIG), 3072, 12, (bf16_t*)(ws + WS_BIG), 3072, 12, (bf16_t*)(ws + WS_BIG), 3072, rsa};
#ifndef SKIP_G3
            pg8::gemm_phase<EpiSplit, pg8::StaticOrder, GEMM_ALIGN, GEMM_SP2>(lds, g, S, E);
#endif
        } else if (kind == K_MIXA) {
            constexpr int NLONG = 16 + 16 * (NSEG - 2) * 2;
            unsigned* qhead = (unsigned*)(ws + WS_TS + 2048);
            LAS int* qslot = (LAS int*)(lds + LDS_BYTES - 16);
            for (;;) {
                if (opaque_tid() == 0) *qslot = (int)__hip_atomic_fetch_add(qhead, 1u, __ATOMIC_RELAXED, __HIP_MEMORY_SCOPE_AGENT);
                __syncthreads();
                const int li = __builtin_amdgcn_readfirstlane(*qslot);
                __syncthreads();
                if (li >= 512 + NLONG + 640) break;
#ifndef SKIP_SCAN
                if (li < 512) scan_item<16>(P, li >> 4, (li >> 1) & 7, li & 1, 0, 0, 2048, 4 | 8, nullptr, nullptr, lds);
                else if (li < 512 + 16) {
                    const int hd = li - 512, dir = hd & 1;
                    scan_item<16>(P, 32, hd >> 1, dir, 0, dir == 0 ? 0 : 16384 - SEGLEN, SEGLEN, 4 | 8, nullptr, (float*)(ws + WS_STL) + (size_t)hd * NSEG * 4096, lds);
                } else if (li < 512 + NLONG) {
                    const int q = li - 512 - 16, hd = q & 15, isP = (q >> 4) & 1, sgm = 1 + (q >> 5), dir = hd & 1;
                    const int tb = dir == 0 ? sgm * SEGLEN : 16384 - (sgm + 1) * SEGLEN;
                    float* so = (float*)(ws + (isP ? WS_STP : WS_STL)) + ((size_t)hd * NSEG + sgm) * 4096;
                    scan_item<16>(P, 32, hd >> 1, dir, 0, tb, SEGLEN, isP ? (1 | 2) : 0, nullptr, so, lds);
                }
#endif
#ifndef SKIP_SGU
                if (li >= 512 + NLONG) sgu_item(P, li - 512 - NLONG, lds);
#endif
            }
        } else if (kind == K_CARRY) {
#ifndef SKIP_SCAN
            if (bid < 16) scan_carry(P, bid, lds);
#endif
        } else if (kind == K_MIXB) {
#ifndef SKIP_SCAN
            for (int li = bid; li < 16 * (NSEG - 1); li += G) {
                const int hd = li & 15, sgm = 1 + (li >> 4), dir = hd & 1;
                const int tb = dir == 0 ? sgm * SEGLEN : 16384 - (sgm + 1) * SEGLEN;
                scan_item<16>(P, 32, hd >> 1, dir, 0, tb, SEGLEN, 4 | 8, (const float*)(ws + WS_STS) + ((size_t)hd * NSEG + sgm) * 4096, nullptr, lds);
            }
#endif
        } else if (kind == K_FINAL) {
#ifndef SKIP_FIN
            rwkv_finalize(P);
#endif
        } else if (kind == K_ATTN) {
            for (int it = bid; it < 5120; it += G) {
#ifndef SKIP_ATTN
                if (it < 4096) attn_item(P, it >> 7, it & 15, (it >> 4) & 7, lds);
                else attn_item(P, 32, it & 15, (it - 4096) >> 4, lds);
#endif
            }
        }
        if (ph + 1 < N_PHASES) {
            __builtin_amdgcn_fence(__ATOMIC_RELEASE, "agent");
            asm volatile("s_waitcnt vmcnt(0) lgkmcnt(0)" ::: "memory");
            grid.sync();
            __builtin_amdgcn_fence(__ATOMIC_ACQUIRE, "agent");
            asm volatile("s_waitcnt vmcnt(0) lgkmcnt(0)" ::: "memory");
            __syncthreads();
        }
    }
#ifdef PROBE_MASK
    if (blockIdx.x == 0 && threadIdx.x == 0) {
        unsigned long long* ts = (unsigned long long*)(P.ws + WS_TS);
        ts[N_PHASES] = __builtin_amdgcn_s_memrealtime();
        unsigned long long tot = 0;
        for (int i = 0; i < N_PHASES; ++i) if ((PROBE_MASK >> i) & 1) tot += ts[i + 1] - ts[i];
        P.out[0] += 4.0f + 10.0f * (float)tot * 1e-5f;
    }
#endif
}

extern "C" void kernel_launch(void* const* d_in, const int* in_sizes, int n_in, void* d_out, int out_size, void* d_ws, size_t ws_size, hipStream_t stream) {
    static int grid_blocks = 0;
    if (!grid_blocks) {
        int dev = 0, cus = 0, per_cu = 0;
        (void)hipGetDevice(&dev);
        (void)hipDeviceGetAttribute(&cus, hipDeviceAttributeMultiprocessorCount, dev);
        (void)hipFuncSetAttribute((const void*)mega, hipFuncAttributeMaxDynamicSharedMemorySize, LDS_BYTES);
        (void)hipOccupancyMaxActiveBlocksPerMultiprocessor(&per_cu, (const void*)mega, 512, LDS_BYTES);
        (void)hipGetLastError();
        if (cus <= 0) cus = 256;
        grid_blocks = cus;
        if (ws_size < WS_END2) fprintf(stderr, "kernel_launch: workspace too small: %zu < %zu\n", ws_size, (size_t)WS_END2);
    }
    Params p{};
    for (int i = 0; i < 30 && i < n_in; ++i) p.in[i] = (const float*)d_in[i];
    p.out = (float*)d_out; p.ws = (unsigned char*)d_ws;
    void* args[] = {&p};
    hipError_t e = hipLaunchCooperativeKernel((const void*)mega, dim3(grid_blocks), dim3(512), args, LDS_BYTES, stream);
    if (e != hipSuccess) fprintf(stderr, "cooperative launch failed: %s (grid %d)\n", hipGetErrorString(e), grid_blocks);
}
```

```cpp
#include <hip/hip_runtime.h>
#include <hip/hip_cooperative_groups.h>
#include <cstdio>
namespace cg = cooperative_groups;

namespace pg8 {
#define PG8_LAS __attribute__((address_space(3)))
typedef unsigned short bf16_t;
typedef short bf16x8 __attribute__((ext_vector_type(8)));
typedef float f32x4 __attribute__((ext_vector_type(4)));
typedef unsigned u32x4 __attribute__((ext_vector_type(4)));
constexpr int BM = 256, BK = 64, HALF = 128, HTB = HALF * BK * 2  , STAGE_BYTES = 8 * HTB, NXCD = 8, WGM = 8;

__host__ __device__ __forceinline__ int lds_byte(int r, int c) { const int st = (r >> 4) * 2 + (c >> 5), rr = r & 15, cc = c & 31, ob = rr * 64 + cc * 2; return st * 1024 + (ob ^ (((ob >> 9) & 1) << 5)); }
__host__ __device__ __forceinline__ void stage_rc(int b, int& R, int& C) { const int st = b / 1024, sb = b % 1024, swz = sb ^ (((sb >> 9) & 1) << 5); R = (st >> 1) * 16 + swz / 64; C = (st & 1) * 32 + (swz % 64) / 2; }
__host__ __device__ __forceinline__ int perm32(int rho) { const int n = rho >> 4, i = rho & 15; return 8 * (i >> 2) + 4 * n + (i & 3); }

struct Unit { int pm, pn; };
struct Gemm { const bf16_t* A; const bf16_t* Bt; int M, N, K; };

struct StaticOrder {
    int nM, nN, nwg, G, c;
    __host__ __device__ void init(int M, int N, int G_, int c_) { nM = M / BM; nN = N / BM; nwg = nM * nN; G = G_; c = c_; }
    __host__ __device__ bool next(int i, Unit& u) const {
        const long L = (long)i * G + c; if (L >= nwg) return false;
        int wgid = (int)L; { const int q = nwg / NXCD, r = nwg % NXCD, xcd = wgid % NXCD, off = wgid / NXCD; wgid = (xcd < r ? xcd * (q + 1) : r * (q + 1) + (xcd - r) * q) + off; }
        const int nig = WGM * nN, gid = wgid / nig, fm = gid * WGM, gsz = (nM - fm) < WGM ? (nM - fm) : WGM;
        u.pm = fm + ((wgid % nig) % gsz); u.pn = (wgid % nig) / gsz; return true;
    }
    __device__ __forceinline__ void a_ready(const Unit&) const {}
    __device__ __forceinline__ void done(const Unit&) const {}
};
__device__ __forceinline__ unsigned cvt_pk_bf16(float lo, float hi) { unsigned r; asm volatile("v_cvt_pk_bf16_f32 %0, %1, %2" : "=v"(r) : "v"(lo), "v"(hi)); return r; }
typedef float f32x2 __attribute__((ext_vector_type(2)));
template <class Epi, class Sched, bool ALIGN_EPI = false, bool SP2 = false>
__device__ __forceinline__ void gemm_phase(PG8_LAS unsigned char* lds, const Gemm g, const Sched& S, const Epi& E) {
    int tid_raw_ = threadIdx.x; asm volatile("" : "+v"(tid_raw_)); const int tid = tid_raw_, wid = __builtin_amdgcn_readfirstlane(tid >> 6), lane = tid & 63, wr = wid >> 2, wc = wid & 3, fr = lane & 15, fq = lane >> 4;
    const int K = g.K, nt = K / BK;
    unsigned voffA[2], voffB[2];
#pragma unroll
    for (int i = 0; i < 2; ++i) { int R, C; stage_rc(tid * 16 + i * 8192, R, C); const int Rb = Epi::PERM ? ((R & ~31) + perm32(R & 31)) : R;
        voffA[i] = (unsigned)(R * K + C) * 2u; voffB[i] = (unsigned)(Rb * K + C) * 2u; }
    const size_t kstep = (size_t)(BK * 2);
    const size_t hstep = (size_t)HALF * K * 2;
    const size_t tstep = 2 * hstep;
    const unsigned ldsw = (unsigned)wid * 1024u;
    const int aoff = lds_byte(wr * 64 + fr, fq * 8), boff = lds_byte(wc * 32 + fr, fq * 8);
#define PG8_SA(b, h) (((b) * 2 + (h)) * HTB)
#define PG8_SB(b, h) ((4 + (b) * 2 + (h)) * HTB)
#define PG8_STAGE(bufoff, gbase, voff) do { _Pragma("unroll") for (int _i = 0; _i < 2; ++_i) \
        __builtin_amdgcn_global_load_lds((const unsigned*)((const char*)(gbase) + (voff)[_i]), (PG8_LAS unsigned*)(lds + (bufoff) + ldsw + _i * 8192), 16, 0, 0); } while (0)
#define PG8_LDA(dst, b, h) do { _Pragma("unroll") for (int m = 0; m < 4; ++m) _Pragma("unroll") for (int k = 0; k < 2; ++k) dst[m][k] = *(const PG8_LAS bf16x8*)(lds + PG8_SA(b, h) + aoff + m * 2048 + k * 1024); } while (0)
#define PG8_LDB(dst, b, h) do { _Pragma("unroll") for (int n = 0; n < 2; ++n) _Pragma("unroll") for (int k = 0; k < 2; ++k) dst[n][k] = *(const PG8_LAS bf16x8*)(lds + PG8_SB(b, h) + boff + n * 2048 + k * 1024); } while (0)
#define PG8_MMA(ai, bj, At, Bt) do { __builtin_amdgcn_s_setprio(1); _Pragma("unroll") for (int m = 0; m < 4; ++m) _Pragma("unroll") for (int n = 0; n < 2; ++n) _Pragma("unroll") for (int k = 0; k < 2; ++k) \
        acc[ai][bj][m][n] = __builtin_amdgcn_mfma_f32_16x16x32_bf16(Bt[n][k], At[m][k], acc[ai][bj][m][n], 0, 0, 0); __builtin_amdgcn_s_setprio(0); } while (0)
#define PG8_WAIT_V(n) asm volatile("s_waitcnt vmcnt(" #n ")" ::: "memory")
#define PG8_WAIT_L(n) asm volatile("s_waitcnt lgkmcnt(" #n ")" ::: "memory")
#define PG8_BAR __builtin_amdgcn_s_barrier()
#define PG8_SCHED __builtin_amdgcn_sched_barrier(0)
    Unit cur, nxt; int ui = 0;
    if (!S.next(0, cur)) return;
    f32x4 acc[2][2][4][2];
#pragma unroll
    for (int a = 0; a < 2; ++a)
#pragma unroll
        for (int b = 0; b < 2; ++b)
#pragma unroll
            for (int m = 0; m < 4; ++m)
#pragma unroll
                for (int n = 0; n < 2; ++n) acc[a][b][m][n] = (f32x4){0.f, 0.f, 0.f, 0.f};
    bf16x8 At[4][2], B0[2][2], B1[2][2];
    const char* cA = (const char*)g.A + (size_t)cur.pm * tstep; const char* cB = (const char*)g.Bt + (size_t)cur.pn * tstep;
    S.a_ready(cur);
    if constexpr (SP2) {
        PG8_STAGE(PG8_SB(0, 0), cB, voffB); PG8_STAGE(PG8_SB(0, 1), cB + hstep, voffB); PG8_STAGE(PG8_SA(0, 0), cA, voffA); PG8_STAGE(PG8_SA(0, 1), cA + hstep, voffA);
        if (wr == 1) PG8_BAR;
        PG8_WAIT_V(2); PG8_BAR;
        PG8_STAGE(PG8_SB(1, 0), cB + kstep, voffB); PG8_STAGE(PG8_SA(1, 0), cA + kstep, voffA); PG8_STAGE(PG8_SB(1, 1), cB + hstep + kstep, voffB);
        PG8_WAIT_V(6); PG8_BAR;
    } else {
        PG8_STAGE(PG8_SB(0, 0), cB, voffB); PG8_STAGE(PG8_SA(0, 0), cA, voffA); PG8_STAGE(PG8_SB(0, 1), cB + hstep, voffB); PG8_STAGE(PG8_SA(0, 1), cA + hstep, voffA);
        if (wr == 1) PG8_BAR;
        PG8_WAIT_V(4); PG8_BAR;
        PG8_STAGE(PG8_SB(1, 0), cB + kstep, voffB); PG8_STAGE(PG8_SA(1, 0), cA + kstep, voffA); PG8_STAGE(PG8_SB(1, 1), cB + hstep + kstep, voffB);
        PG8_WAIT_V(6); PG8_BAR;
    }
    for (;;) {
        const bool has_next = S.next(ui + 1, nxt);
        const char* nA = has_next ? (const char*)g.A + (size_t)nxt.pm * tstep : cA; const char* nB = has_next ? (const char*)g.Bt + (size_t)nxt.pn * tstep : cB;
        for (int t = 0; t < nt; t += 2) {
            const bool last = (t == nt - 2);
            const char* a1 = cA + (size_t)(t + 1) * kstep;
            const char* a2 = last ? nA : cA + (size_t)(t + 2) * kstep; const char* b2 = last ? nB : cB + (size_t)(t + 2) * kstep;
            const char* a3 = a2 + kstep; const char* b3 = b2 + kstep;
            if (last && has_next) S.a_ready(nxt);
            if constexpr (SP2) {
            PG8_LDB(B0, 0, 0); PG8_LDB(B1, 0, 1); PG8_SCHED; PG8_LDA(At, 0, 0); PG8_STAGE(PG8_SA(1, 1), a1 + hstep, voffA);
            PG8_WAIT_V(8); PG8_WAIT_L(0); PG8_BAR; PG8_MMA(0, 0, At, B0); PG8_MMA(0, 1, At, B1); PG8_BAR; PG8_SCHED;
            PG8_LDA(At, 0, 1); PG8_STAGE(PG8_SB(0, 0), b2, voffB); PG8_STAGE(PG8_SB(0, 1), b2 + hstep, voffB); PG8_STAGE(PG8_SA(0, 0), a2, voffA);
            PG8_WAIT_V(8); PG8_WAIT_L(0); PG8_BAR; PG8_MMA(1, 0, At, B0); PG8_MMA(1, 1, At, B1); PG8_BAR; PG8_SCHED;
            PG8_LDB(B0, 1, 0); PG8_LDB(B1, 1, 1); PG8_SCHED; PG8_LDA(At, 1, 0); PG8_STAGE(PG8_SA(0, 1), a2 + hstep, voffA);
            PG8_WAIT_V(8); PG8_WAIT_L(0); PG8_BAR; PG8_MMA(0, 0, At, B0); PG8_MMA(0, 1, At, B1); PG8_BAR; PG8_SCHED;
            PG8_LDA(At, 1, 1); PG8_STAGE(PG8_SB(1, 0), b3, voffB); PG8_STAGE(PG8_SB(1, 1), b3 + hstep, voffB); PG8_STAGE(PG8_SA(1, 0), a3, voffA);
            PG8_WAIT_V(8); PG8_WAIT_L(0); PG8_BAR; PG8_MMA(1, 0, At, B0); PG8_MMA(1, 1, At, B1); PG8_BAR; PG8_SCHED;
            } else {
            PG8_LDB(B0, 0, 0); PG8_SCHED; PG8_LDA(At, 0, 0); PG8_STAGE(PG8_SA(1, 1), a1 + hstep, voffA);
            PG8_WAIT_L(8); PG8_BAR; PG8_WAIT_L(0); PG8_MMA(0, 0, At, B0); PG8_BAR; PG8_SCHED;
            PG8_LDB(B1, 0, 1); PG8_STAGE(PG8_SB(0, 0), b2, voffB);
            PG8_BAR; PG8_WAIT_L(0); PG8_MMA(0, 1, At, B1); PG8_BAR;
            PG8_LDA(At, 0, 1); PG8_STAGE(PG8_SA(0, 0), a2, voffA);
            PG8_BAR; PG8_WAIT_L(0); PG8_MMA(1, 0, At, B0); PG8_BAR; PG8_SCHED;
            PG8_STAGE(PG8_SB(0, 1), b2 + hstep, voffB);
            PG8_WAIT_V(6); PG8_BAR; PG8_MMA(1, 1, At, B1); PG8_BAR;
            PG8_LDB(B0, 1, 0); PG8_SCHED; PG8_LDA(At, 1, 0); PG8_STAGE(PG8_SA(0, 1), a2 + hstep, voffA);
            PG8_WAIT_L(8); PG8_BAR; PG8_WAIT_L(0); PG8_MMA(0, 0, At, B0); PG8_BAR; PG8_SCHED;
            PG8_LDB(B1, 1, 1); PG8_STAGE(PG8_SB(1, 0), b3, voffB);
            PG8_BAR; PG8_WAIT_L(0); PG8_MMA(0, 1, At, B1); PG8_BAR;
            PG8_LDA(At, 1, 1); PG8_STAGE(PG8_SA(1, 0), a3, voffA);
            PG8_BAR; PG8_WAIT_L(0); PG8_MMA(1, 0, At, B0); PG8_BAR; PG8_SCHED;
            PG8_STAGE(PG8_SB(1, 1), b3 + hstep, voffB);
            PG8_WAIT_V(6); PG8_BAR; PG8_MMA(1, 1, At, B1); PG8_BAR;
            }
        }
        if constexpr (ALIGN_EPI) { if (wr == 0) PG8_BAR; }
        if constexpr (!Epi::AFTER_DRAIN) { E(acc, cur, wr, wc, fr, fq); S.done(cur); }
        if (!has_next) break;
#pragma unroll
        for (int a = 0; a < 2; ++a)
#pragma unroll
            for (int b = 0; b < 2; ++b)
#pragma unroll
                for (int m = 0; m < 4; ++m)
#pragma unroll
                    for (int n = 0; n < 2; ++n) acc[a][b][m][n] = (f32x4){0.f, 0.f, 0.f, 0.f};
        cur = nxt; cA = nA; cB = nB; ++ui;
        if constexpr (ALIGN_EPI) { if (wr == 1) PG8_BAR; }
    }
    PG8_WAIT_V(0);
    if constexpr (!ALIGN_EPI) { if (wr == 0) PG8_BAR; }
    PG8_BAR;
    if constexpr (Epi::AFTER_DRAIN) { E.fused(acc, cur, wr, wc, fr, fq, lds, wid, lane); S.done(cur); }
#undef PG8_SA
#undef PG8_SB
#undef PG8_STAGE
#undef PG8_LDA
#undef PG8_LDB
#undef PG8_MMA
#undef PG8_WAIT_V
#undef PG8_WAIT_L
#undef PG8_BAR
#undef PG8_SCHED
}
}


#define LAS __attribute__((address_space(3)))
typedef unsigned short bf16_t;
typedef short bf16x8 __attribute__((ext_vector_type(8)));
typedef short s16x4 __attribute__((ext_vector_type(4)));
typedef float f32x4 __attribute__((ext_vector_type(4)));
typedef unsigned u32x4 __attribute__((ext_vector_type(4)));
typedef unsigned u32x2 __attribute__((ext_vector_type(2)));

constexpr int M_TOK = 81920, M_PROMPT = 65536, DM = 1024, DFF = 2816;
constexpr int LDS_BYTES = 147456;
#ifndef GEMM_ALIGN
#define GEMM_ALIGN true
#endif
#ifndef GEMM_SP2
#define GEMM_SP2 true
#endif
constexpr float NORM_EPS = 1e-6f;

constexpr size_t SZ_WFI = (size_t)5632 * 1024 * 2, SZ_WFO = (size_t)1024 * 2816 * 2;
constexpr size_t WS_WFI = 0;
constexpr size_t WS_WFO = WS_WFI + 4 * SZ_WFI;
constexpr size_t WS_WABI = WS_WFO + 4 * SZ_WFO;
constexpr size_t WS_WABO = WS_WABI + (size_t)3328 * 1024 * 2;
constexpr size_t WS_WATI = WS_WABO + (size_t)1024 * 1024 * 2;
constexpr size_t WS_WATO = WS_WATI + (size_t)3072 * 1024 * 2;
constexpr size_t WS_LORA = WS_WATO + (size_t)1024 * 1024 * 2;
constexpr size_t WS_SGUW = WS_LORA + (size_t)4 * 512 * 64 * 2;
constexpr size_t WS_RKR = WS_SGUW + (size_t)4 * 128 * 128 * 2;
constexpr size_t WS_XN = (WS_RKR + (size_t)2 * M_TOK * 8 * 4 + 4095) & ~(size_t)4095;
constexpr size_t WS_BIG = WS_XN + (size_t)M_TOK * 1024 * 2;
constexpr size_t WS_PUV = WS_BIG;
constexpr size_t WS_PRKVG = WS_PUV + (size_t)M_TOK * 1024 * 2;
constexpr size_t WS_PWA = WS_PRKVG + (size_t)M_TOK * 2048 * 2;
constexpr size_t WS_Y = WS_BIG + (size_t)M_TOK * 3328 * 2;
constexpr size_t WS_END = WS_Y + (size_t)2 * M_TOK * 512 * 2;

constexpr int NSEG = 16, SEGLEN = 16384 / NSEG;
constexpr size_t WS_STL = (WS_END + 4095) & ~(size_t)4095;
constexpr size_t WS_STP = WS_STL + (size_t)16 * NSEG * 4096 * 4;
constexpr size_t WS_STS = WS_STP + (size_t)16 * NSEG * 4096 * 4;
constexpr size_t WS_TS = WS_STS + (size_t)16 * NSEG * 4096 * 4;
constexpr size_t WS_RSA = WS_TS + 4096;
constexpr size_t WS_RSB = WS_RSA + (size_t)M_TOK * 4;
constexpr size_t WS_RSC = WS_RSB + (size_t)M_TOK * 4;
constexpr size_t WS_RSD = WS_RSC + (size_t)M_TOK * 4;
constexpr size_t WS_END2 = WS_RSD + (size_t)M_TOK * 4;
struct Params { const float* in[30]; float* out; unsigned char* ws; };

__device__ __forceinline__ float bflo(unsigned w) { return __uint_as_float(w << 16); }
__device__ __forceinline__ float bfhi(unsigned w) { return __uint_as_float(w & 0xffff0000u); }
__device__ __forceinline__ unsigned pk2(float lo, float hi) { unsigned r; asm("v_cvt_pk_bf16_f32 %0, %1, %2" : "=v"(r) : "v"(lo), "v"(hi)); return r; }
__device__ __forceinline__ void unpack8(const u32x4 w, float* f) { f[0] = bflo(w.x); f[1] = bfhi(w.x); f[2] = bflo(w.y); f[3] = bfhi(w.y); f[4] = bflo(w.z); f[5] = bfhi(w.z); f[6] = bflo(w.w); f[7] = bfhi(w.w); }
__device__ __forceinline__ u32x4 pack8(const float* f) { u32x4 w; w.x = pk2(f[0], f[1]); w.y = pk2(f[2], f[3]); w.z = pk2(f[4], f[5]); w.w = pk2(f[6], f[7]); return w; }
__device__ __forceinline__ float sigmoidf_(float x) { return __builtin_amdgcn_rcpf(1.0f + __expf(-x)); }
__device__ __forceinline__ float siluf_(float x) { return x * sigmoidf_(x); }
__device__ __forceinline__ float gelu_tanh(float x) { const float u = 0.7978845608028654f * (x + 0.044715f * x * x * x); return x * sigmoidf_(2.0f * u); }
__device__ __forceinline__ float tanhf_(float x) { return 1.0f - 2.0f * __builtin_amdgcn_rcpf(__expf(2.0f * x) + 1.0f); }
__device__ __forceinline__ float wave_sum(float x) { x += __shfl_xor(x, 32); x += __shfl_xor(x, 16); x += __shfl_xor(x, 8); x += __shfl_xor(x, 4); x += __shfl_xor(x, 2); x += __shfl_xor(x, 1); return x; }
template <int CTRL> __device__ __forceinline__ float dppf(float x) { return __int_as_float(__builtin_amdgcn_update_dpp(0, __float_as_int(x), CTRL, 0xF, 0xF, true)); }
__device__ __forceinline__ float reduce8(float x) { x += dppf<0xB1>(x); x += dppf<0x4E>(x); x += dppf<0x141>(x); return x; }
typedef short v4i16_t __attribute__((ext_vector_type(4)));
typedef __bf16 bf16x2_t __attribute__((ext_vector_type(2)));
__device__ __forceinline__ s16x4 tr_read(LAS const unsigned char* p) { return __builtin_bit_cast(s16x4, __builtin_amdgcn_ds_read_tr16_b64_v4i16((LAS v4i16_t*)p)); }
__device__ __forceinline__ f32x4 mfma16(bf16x8 a, bf16x8 b, f32x4 c) { return __builtin_amdgcn_mfma_f32_16x16x32_bf16(a, b, c, 0, 0, 0); }

__device__ __forceinline__ int opaque_tid() { int t = threadIdx.x; asm volatile("" : "+v"(t)); return t; }
__device__ __forceinline__ unsigned char* opaque_ptr(unsigned char* p) { size_t z = 0; asm volatile("" : "+s"(z)); return p + z; }
struct EpiSwiglu {
    static constexpr bool PERM = false, AFTER_DRAIN = false;
    bf16_t* H; const float* rowss; const float* rowss2;
    __device__ __forceinline__ void operator()(const f32x4 (&acc)[2][2][4][2], const pg8::Unit& u, int wr, int wc, int fr, int fq) const {
        const int row0 = u.pm * 256 + wr * 64 + fr, col0 = u.pn * 128 + wc * 32 + 8 * fq;
        float rsv[8];
#pragma unroll
        for (int gi = 0; gi < 8; ++gi) rsv[gi] = rowss ? rowss[row0 + (gi >> 2) * 128 + (gi & 3) * 16] : 0.f;
        float rsw[8];
#pragma unroll
        for (int gi = 0; gi < 8; ++gi) rsw[gi] = rowss2 ? rowss2[row0 + (gi >> 2) * 128 + (gi & 3) * 16] : 0.f;
#pragma unroll
        for (int gi = 0; gi < 8; ++gi) { rsv[gi] = rowss ? rsqrtf(rsv[gi] * (1.0f / DM) + NORM_EPS) : 1.0f;
            if (rowss2) rsv[gi] *= rsqrtf(rsv[gi] * rsv[gi] * rsw[gi] * (1.0f / DM) + NORM_EPS); }
#pragma unroll
        for (int ai = 0; ai < 2; ++ai)
#pragma unroll
            for (int m = 0; m < 4; ++m) {
                const int row = row0 + ai * 128 + m * 16;
                const float rs = rsv[ai * 4 + m];
                bf16_t* rowp = H + (size_t)row * DFF + col0;
                float h[8];
#pragma unroll
                for (int bj = 0; bj < 2; ++bj)
#pragma unroll
                    for (int j = 0; j < 4; ++j) h[bj * 4 + j] = siluf_(acc[ai][bj][m][0][j] * rs) * (acc[ai][bj][m][1][j] * rs);
                *(u32x4*)rowp = pack8(h);
                asm volatile("" ::: "memory");
            }
    }
};
struct EpiResid {
    static constexpr bool PERM = false, AFTER_DRAIN = false;
    float* X; float scale; bf16_t* XG; const float* g; float* rowss; const float* xin_a; const float* xin_b;
    const float* gaux; float* rowss2; const float* base_ss;
    __device__ __forceinline__ void operator()(const f32x4 (&acc)[2][2][4][2], const pg8::Unit& u, int wr, int wc, int fr, int fq) const {
        const int row0 = u.pm * 256 + wr * 64 + fr, col0 = u.pn * 256 + wc * 32 + 4 * fq;
        f32x4 gv[2][2];
#pragma unroll
        for (int bj = 0; bj < 2; ++bj)
#pragma unroll
            for (int n = 0; n < 2; ++n) gv[bj][n] = XG ? *(const f32x4*)(g + col0 + bj * 128 + n * 16) : (f32x4){0.f, 0.f, 0.f, 0.f};
        f32x4 ga[2][2];
#pragma unroll
        for (int bj = 0; bj < 2; ++bj)
#pragma unroll
            for (int n = 0; n < 2; ++n) { ga[bj][n] = gaux ? *(const f32x4*)(gaux + col0 + bj * 128 + n * 16) : (f32x4){1.f, 1.f, 1.f, 1.f}; if (rowss2) gv[bj][n] = gv[bj][n] * ga[bj][n]; }
        float brs[8];
#pragma unroll
        for (int gi = 0; gi < 8; ++gi) brs[gi] = base_ss ? base_ss[row0 + (gi >> 2) * 128 + (gi & 3) * 16] : 0.f;
#pragma unroll
        for (int gi = 0; gi < 8; ++gi) brs[gi] = base_ss ? rsqrtf(brs[gi] * (1.0f / DM) + NORM_EPS) : 1.0f;
        const float* Xs = xin_a ? (u.pm < 256 ? xin_a : xin_b - (size_t)M_PROMPT * DM) : X;
        f32x4 xin[2][2][2];
#pragma unroll
        for (int gi = 0; gi < 9; ++gi) {
            if (gi < 8) {
                const float* rowp = Xs + (size_t)(row0 + (gi >> 2) * 128 + (gi & 3) * 16) * DM + col0;
#pragma unroll
                for (int bj = 0; bj < 2; ++bj)
#pragma unroll
                    for (int n = 0; n < 2; ++n) xin[gi & 1][bj][n] = *(const f32x4*)(rowp + bj * 128 + n * 16);
            }
            if (gi > 0) {
                const int gp = gi - 1, ai = gp >> 2, m = gp & 3;
                const int row = row0 + ai * 128 + m * 16;
                float* rowp = X + (size_t)row * DM + col0;
                float ssq = 0.f, ssq2 = 0.f;
#pragma unroll
                for (int bj = 0; bj < 2; ++bj)
#pragma unroll
                    for (int n = 0; n < 2; ++n) { f32x4 v = xin[gp & 1][bj][n]; if (base_ss) v = v * brs[gp] * ga[bj][n];
                        v += acc[ai][bj][m][n] * scale; *(f32x4*)(rowp + bj * 128 + n * 16) = v;
                        if (XG) { ssq += (v[0] * v[0] + v[1] * v[1]) + (v[2] * v[2] + v[3] * v[3]); const f32x4 o = v * gv[bj][n]; u32x2 w; w.x = pk2(o[0], o[1]); w.y = pk2(o[2], o[3]);
                            *(u32x2*)(XG + (size_t)row * DM + col0 + bj * 128 + n * 16) = w; }
                        if (rowss2) { const f32x4 t = v * ga[bj][n]; ssq2 += (t[0] * t[0] + t[1] * t[1]) + (t[2] * t[2] + t[3] * t[3]); } }
                if (XG) { ssq += __shfl_xor(ssq, 16); ssq += __shfl_xor(ssq, 32);
                    if (fq == 0) __hip_atomic_fetch_add(rowss + row, ssq, __ATOMIC_RELAXED, __HIP_MEMORY_SCOPE_AGENT); }
                if (rowss2) { ssq2 += __shfl_xor(ssq2, 16); ssq2 += __shfl_xor(ssq2, 32);
                    if (fq == 0) __hip_atomic_fetch_add(rowss2 + row, ssq2, __ATOMIC_RELAXED, __HIP_MEMORY_SCOPE_AGENT); }
            }
            asm volatile("" ::: "memory");
        }
    }
};
struct EpiSplit {
    static constexpr bool PERM = true, AFTER_DRAIN = false;
    bf16_t* b0; int ld0, t0; bf16_t* b1; int ld1, t1; bf16_t* b2; int ld2; const float* rowss;
    __device__ __forceinline__ void operator()(const f32x4 (&acc)[2][2][4][2], const pg8::Unit& u, int wr, int wc, int fr, int fq) const {
        bf16_t* base; int ld, ct;
        if (u.pn < t0) { base = b0; ld = ld0; ct = u.pn; } else if (u.pn < t1) { base = b1; ld = ld1; ct = u.pn - t0; } else { base = b2; ld = ld2; ct = u.pn - t1; }
        const int row0 = u.pm * 256 + wr * 64 + fr, col0 = ct * 256 + wc * 32 + 8 * fq;
        float rsv[8];
#pragma unroll
        for (int gi = 0; gi < 8; ++gi) rsv[gi] = rowss[row0 + (gi >> 2) * 128 + (gi & 3) * 16];
#pragma unroll
        for (int gi = 0; gi < 8; ++gi) rsv[gi] = rsqrtf(rsv[gi] * (1.0f / DM) + NORM_EPS);
#pragma unroll
        for (int ai = 0; ai < 2; ++ai)
#pragma unroll
            for (int m = 0; m < 4; ++m) {
                const int row = row0 + ai * 128 + m * 16;
                const float rs = rsv[ai * 4 + m];
                bf16_t* rowp = base + (size_t)row * ld + col0;
#pragma unroll
                for (int bj = 0; bj < 2; ++bj) {
                    const f32x4 v0 = acc[ai][bj][m][0] * rs, v1 = acc[ai][bj][m][1] * rs;
                    u32x4 w; w.x = pk2(v0[0], v0[1]); w.y = pk2(v0[2], v0[3]); w.z = pk2(v1[0], v1[1]); w.w = pk2(v1[2], v1[3]);
                    *(u32x4*)(rowp + bj * 128) = w;
                }
                asm volatile("" ::: "memory");
            }
    }
};

template <int MAP> __device__ __forceinline__ int src_col(int s) {
    if (MAP == 0) return s;
    const int pn = s >> 8, bj = (s >> 7) & 1, wc = (s >> 5) & 3, n = (s >> 4) & 1, fq = (s >> 2) & 3, jj = s & 3;
    return n * DFF + 128 * pn + 32 * wc + 8 * fq + 4 * bj + jj;
}
template <int MAP> __device__ void convert_T(const float* __restrict__ src, bf16_t* __restrict__ dst, int K, int N, LAS float* tile, int rot) {
    const int tk = K / 64, tn = N / 64, nt = tk * tn, tid = opaque_tid(), G = gridDim.x;
    const int kk0 = tid >> 4, sg = tid & 15;
    int t = (int)((blockIdx.x + rot) % G);
    float4 va = make_float4(0.f, 0.f, 0.f, 0.f), vb = va;
    if (t < nt) { const int k0 = (t % tk) * 64, s0 = (t / tk) * 64; const int c = src_col<MAP>(s0 + sg * 4);
        va = *(const float4*)(src + (size_t)(k0 + kk0) * N + c); vb = *(const float4*)(src + (size_t)(k0 + kk0 + 32) * N + c); }
    for (; t < nt; t += G) {
        const int k0 = (t % tk) * 64, s0 = (t / tk) * 64;
        { LAS float* tp = tile + kk0 * 65 + sg * 4; tp[0] = va.x; tp[1] = va.y; tp[2] = va.z; tp[3] = va.w;
          LAS float* tq = tile + (kk0 + 32) * 65 + sg * 4; tq[0] = vb.x; tq[1] = vb.y; tq[2] = vb.z; tq[3] = vb.w; }
        if (t + G < nt) {
            const int t2 = t + G, k2 = (t2 % tk) * 64, s2 = (t2 / tk) * 64; const int c = src_col<MAP>(s2 + sg * 4);
            va = *(const float4*)(src + (size_t)(k2 + kk0) * N + c); vb = *(const float4*)(src + (size_t)(k2 + kk0 + 32) * N + c); }
        asm volatile("s_waitcnt lgkmcnt(0)" ::: "memory"); __builtin_amdgcn_s_barrier(); asm volatile("" ::: "memory");
        {
            const int slot = tid >> 3, kc = tid & 7; float f[8];
#pragma unroll
            for (int i = 0; i < 8; ++i) f[i] = tile[(kc * 8 + i) * 65 + slot];
            *(u32x4*)(dst + (size_t)(s0 + slot) * K + k0 + kc * 8) = pack8(f);
        }
        asm volatile("s_waitcnt lgkmcnt(0)" ::: "memory"); __builtin_amdgcn_s_barrier(); asm volatile("" ::: "memory");
    }
}

__device__ void norm_rows(const float* xa, const float* xb, int split, float* xcopy, const float* g1, float* x1out, const float* g2, bf16_t* xn) {
    const int tid_ = opaque_tid(), lane = tid_ & 63, wave = __builtin_amdgcn_readfirstlane(tid_ >> 6);
    const int stride = gridDim.x * 8;
    for (int row0 = blockIdx.x * 8 + wave; row0 < M_TOK; row0 += 2 * stride) {
        int rows[2]; rows[0] = row0; rows[1] = (row0 + stride < M_TOK) ? row0 + stride : row0;
        f32x4 v[2][4]; float ss[2] = {0.f, 0.f};
#pragma unroll
        for (int q = 0; q < 2; ++q) { const int row = rows[q];
            const float* src = (row < split) ? xa + (size_t)row * DM : xb + (size_t)(row - split) * DM;
#pragma unroll
            for (int i = 0; i < 4; ++i) v[q][i] = *(const f32x4*)(src + i * 256 + lane * 4); }
#pragma unroll
        for (int q = 0; q < 2; ++q) {
#pragma unroll
            for (int i = 0; i < 4; ++i) ss[q] += v[q][i][0] * v[q][i][0] + v[q][i][1] * v[q][i][1] + v[q][i][2] * v[q][i][2] + v[q][i][3] * v[q][i][3];
            if (xcopy) {
#pragma unroll
                for (int i = 0; i < 4; ++i) *(f32x4*)(xcopy + (size_t)rows[q] * DM + i * 256 + lane * 4) = v[q][i];
            }
        }
        ss[0] = wave_sum(ss[0]); ss[1] = wave_sum(ss[1]);
        float r[2]; r[0] = rsqrtf(ss[0] * (1.0f / DM) + NORM_EPS); r[1] = rsqrtf(ss[1] * (1.0f / DM) + NORM_EPS);
        if (g1) {
            float s2[2] = {0.f, 0.f};
#pragma unroll
            for (int i = 0; i < 4; ++i) { const f32x4 g = *(const f32x4*)(g1 + i * 256 + lane * 4);
#pragma unroll
                for (int q = 0; q < 2; ++q) { v[q][i] = v[q][i] * r[q] * g; *(f32x4*)(x1out + (size_t)rows[q] * DM + i * 256 + lane * 4) = v[q][i];
                    s2[q] += v[q][i][0] * v[q][i][0] + v[q][i][1] * v[q][i][1] + v[q][i][2] * v[q][i][2] + v[q][i][3] * v[q][i][3]; } }
            s2[0] = wave_sum(s2[0]); s2[1] = wave_sum(s2[1]);
            r[0] = rsqrtf(s2[0] * (1.0f / DM) + NORM_EPS); r[1] = rsqrtf(s2[1] * (1.0f / DM) + NORM_EPS);
        }
        if (g2) {
#pragma unroll
            for (int i = 0; i < 4; ++i) { const f32x4 g = *(const f32x4*)(g2 + i * 256 + lane * 4);
#pragma unroll
                for (int q = 0; q < 2; ++q) { const f32x4 o = v[q][i] * r[q] * g;
                    u32x2 w; w.x = pk2(o[0], o[1]); w.y = pk2(o[2], o[3]); *(u32x2*)(xn + (size_t)rows[q] * DM + i * 256 + lane * 4) = w; } }
        }
    }
}

__device__ void sgu_item(const Params& PP, int chunk, LAS unsigned char* lds) {
    Params P = PP; P.ws = opaque_ptr(PP.ws);
    const int tid = opaque_tid(), lane = tid & 63, wave = __builtin_amdgcn_readfirstlane(tid >> 6), l15 = lane & 15, quad = lane >> 4;
    constexpr int PITCH = 1056;
    const bf16_t* Puv = (const bf16_t*)(P.ws + WS_PUV);
    bf16_t* MO = (bf16_t*)(P.ws + WS_XN);
    const size_t row0 = (size_t)chunk * 128;
    {
        float gn[8];
        { const f32x4 a = *(const f32x4*)(P.in[12] + lane * 8), b = *(const f32x4*)(P.in[12] + lane * 8 + 4); gn[0] = a[0]; gn[1] = a[1]; gn[2] = a[2]; gn[3] = a[3]; gn[4] = b[0]; gn[5] = b[1]; gn[6] = b[2]; gn[7] = b[3]; }
        for (int i = 0; i < 16; ++i) {
            const int p = wave * 16 + i;
            const u32x4 raw = *(const u32x4*)(Puv + (row0 + p) * 1024 + 512 + lane * 8);
            float v[8]; unpack8(raw, v); float ss = 0.f;
#pragma unroll
            for (int e = 0; e < 8; ++e) { v[e] = gelu_tanh(v[e]); ss += v[e] * v[e]; }
            ss = wave_sum(ss);
            const float r = rsqrtf(ss * (1.0f / 512.0f) + NORM_EPS);
#pragma unroll
            for (int e = 0; e < 8; ++e) v[e] = v[e] * r * gn[e];
            *(LAS u32x4*)(lds + p * PITCH + lane * 16) = pack8(v);
        }
    }
    __syncthreads();
    const int g = wave >> 1, cbase = (wave >> 1) * 128 + (wave & 1) * 64;
    const bf16_t* Wg = (const bf16_t*)(P.ws + WS_SGUW) + (size_t)g * 128 * 128;
    const int r4 = l15 >> 2, c4 = l15 & 3;
    for (int qh = 0; qh < 2; ++qh) {
        f32x4 acc[4][4];
#pragma unroll
        for (int a = 0; a < 4; ++a)
#pragma unroll
            for (int b = 0; b < 4; ++b) acc[a][b] = (f32x4){0.f, 0.f, 0.f, 0.f};
#pragma unroll
        for (int ks = 0; ks < 4; ++ks) {
            bf16x8 bfr[4];
#pragma unroll
            for (int qt = 0; qt < 4; ++qt) bfr[qt] = *(const bf16x8*)(Wg + (size_t)(qh * 64 + qt * 16 + l15) * 128 + ks * 32 + quad * 8);
#pragma unroll
            for (int ct = 0; ct < 4; ++ct) {
                LAS const unsigned char* ap = lds + (ks * 32 + quad * 8 + r4) * PITCH + (cbase + ct * 16 + 4 * c4) * 2;
                const s16x4 lo = tr_read(ap), hi = tr_read(ap + 4 * PITCH);
                const bf16x8 a = {lo[0], lo[1], lo[2], lo[3], hi[0], hi[1], hi[2], hi[3]};
#pragma unroll
                for (int qt = 0; qt < 4; ++qt) acc[ct][qt] = mfma16(a, bfr[qt], acc[ct][qt]);
            }
        }
#pragma unroll
        for (int qt = 0; qt < 4; ++qt) {
            const int q = qh * 64 + qt * 16 + l15;
            const float bq = P.in[14][g * 128 + q];
#pragma unroll
            for (int ct = 0; ct < 4; ++ct) {
                const int c = cbase + ct * 16 + quad * 4;
                const u32x2 ur = *(const u32x2*)(Puv + (row0 + q) * 1024 + c);
                const float u0 = gelu_tanh(bflo(ur.x)), u1 = gelu_tanh(bfhi(ur.x)), u2 = gelu_tanh(bflo(ur.y)), u3 = gelu_tanh(bfhi(ur.y));
                u32x2 w; w.x = pk2(u0 * (acc[ct][qt][0] + bq), u1 * (acc[ct][qt][1] + bq)); w.y = pk2(u2 * (acc[ct][qt][2] + bq), u3 * (acc[ct][qt][3] + bq));
                *(u32x2*)(MO + (row0 + q) * 1024 + c) = w;
            }
        }
    }
    __syncthreads();
}

template <int LPR> __device__ __forceinline__ float reduce_row(float x) {
    x += dppf<0xB1>(x); x += dppf<0x4E>(x); x += dppf<0x141>(x);
    if (LPR == 16) x += dppf<0x140>(x);
    return x;
}
__device__ __forceinline__ float reduce32(float x) {
    x += dppf<0xB1>(x); x += dppf<0x4E>(x); x += dppf<0x141>(x); x += dppf<0x140>(x); x += __shfl_xor(x, 16); return x;
}
__device__ __forceinline__ void lds_barrier() { asm volatile("s_waitcnt lgkmcnt(0)" ::: "memory"); __builtin_amdgcn_s_barrier(); asm volatile("" ::: "memory"); }
template <int NV> struct ScanSet { f32x4 kk[NV], w[NV], ka[NV], kp[NV], r[NV]; float vv; };
template <int NV> __device__ __forceinline__ void scan_load(ScanSet<NV>& t, LAS const float* KK, LAS const float* Wd, LAS const float* KKA, LAS const float* KP, LAS const float* Rr, LAS const float* Vv, int o, int ov, bool want_y) {
#pragma unroll
    for (int u = 0; u < NV; ++u) { t.kk[u] = *(LAS const f32x4*)(KK + o + u * 32); t.w[u] = *(LAS const f32x4*)(Wd + o + u * 32); t.ka[u] = *(LAS const f32x4*)(KKA + o + u * 32); t.kp[u] = *(LAS const f32x4*)(KP + o + u * 32); }
    if (want_y) {
#pragma unroll
        for (int u = 0; u < NV; ++u) t.r[u] = *(LAS const f32x4*)(Rr + o + u * 32);
    }
    t.vv = Vv[ov];
}
typedef float f32x2v __attribute__((ext_vector_type(2)));
template <int LPR, int NV> __device__ __forceinline__ float scan_step(float* S, const ScanSet<NV>& t, bool want_y, float& ypart) {
    f32x2v acc = {0.f, 0.f};
#pragma unroll
    for (int u = 0; u < NV; ++u)
#pragma unroll
        for (int hh = 0; hh < 2; ++hh) { const f32x2v s2 = {S[4 * u + 2 * hh], S[4 * u + 2 * hh + 1]}, k2 = {t.kk[u][2 * hh], t.kk[u][2 * hh + 1]}; acc = s2 * k2 + acc; }
    float sa = acc.x + acc.y, yb = ypart;
    sa += dppf<0xB1>(sa); yb += dppf<0xB1>(yb); sa += dppf<0x4E>(sa); yb += dppf<0x4E>(yb); sa += dppf<0x141>(sa); yb += dppf<0x141>(yb);
    const f32x2v sa2 = {sa, sa}, vv2 = {t.vv, t.vv};
#pragma unroll
    for (int u = 0; u < NV; ++u)
#pragma unroll
        for (int hh = 0; hh < 2; ++hh) {
            f32x2v s2 = {S[4 * u + 2 * hh], S[4 * u + 2 * hh + 1]};
            const f32x2v w2 = {t.w[u][2 * hh], t.w[u][2 * hh + 1]}, kp2 = {t.kp[u][2 * hh], t.kp[u][2 * hh + 1]}, ka2 = {t.ka[u][2 * hh], t.ka[u][2 * hh + 1]};
            f32x2v tt = vv2 * kp2; tt = tt - sa2 * ka2;
            s2 = s2 * w2 + tt;
            S[4 * u + 2 * hh] = s2.x; S[4 * u + 2 * hh + 1] = s2.y;
        }
    if (want_y) {
        f32x2v yacc = {0.f, 0.f};
#pragma unroll
        for (int u = 0; u < NV; ++u)
#pragma unroll
            for (int hh = 0; hh < 2; ++hh) { const f32x2v s2 = {S[4 * u + 2 * hh], S[4 * u + 2 * hh + 1]}, r2 = {t.r[u][2 * hh], t.r[u][2 * hh + 1]}; yacc = s2 * r2 + yacc; }
        ypart = yacc.x + yacc.y;
    }
    return yb;
}
struct ScanSet2 { f32x4 kk, w, ka, kp, r; float vv0, vv1; };
__device__ __forceinline__ void scan_load2(ScanSet2& t, LAS const float* KK, LAS const float* Wd, LAS const float* KKA, LAS const float* KP, LAS const float* Rr, LAS const float* Vv, int o, int ov, bool want_y) {
    t.kk = *(LAS const f32x4*)(KK + o); t.w = *(LAS const f32x4*)(Wd + o); t.ka = *(LAS const f32x4*)(KKA + o); t.kp = *(LAS const f32x4*)(KP + o);
    if (want_y) t.r = *(LAS const f32x4*)(Rr + o);
    t.vv0 = Vv[ov]; t.vv1 = Vv[ov + 4];
}
__device__ __forceinline__ float dpp16(float x) { x += dppf<0xB1>(x); x += dppf<0x4E>(x); x += dppf<0x141>(x); x += dppf<0x140>(x); return x; }
__device__ __forceinline__ void scan_step2(f32x2v* SS, const ScanSet2& t, bool want_y, float& y0, float& y1, float& yr0, float& yr1) {
    f32x2v a2 = SS[0] * (f32x2v){t.kk[0], t.kk[0]};
#pragma unroll
    for (int i = 1; i < 4; ++i) a2 = SS[i] * (f32x2v){t.kk[i], t.kk[i]} + a2;
    float a0 = a2.x, a1 = a2.y, b0 = y0, b1 = y1;
#define SCAN_OPAQUE4() asm("" : "+v"(a0), "+v"(a1), "+v"(b0), "+v"(b1))
    SCAN_OPAQUE4();
    a0 += dppf<0xB1>(a0); a1 += dppf<0xB1>(a1); b0 += dppf<0xB1>(b0); b1 += dppf<0xB1>(b1); SCAN_OPAQUE4();
    a0 += dppf<0x4E>(a0); a1 += dppf<0x4E>(a1); b0 += dppf<0x4E>(b0); b1 += dppf<0x4E>(b1); SCAN_OPAQUE4();
    a0 += dppf<0x141>(a0); a1 += dppf<0x141>(a1); b0 += dppf<0x141>(b0); b1 += dppf<0x141>(b1); SCAN_OPAQUE4();
    a0 += dppf<0x140>(a0); a1 += dppf<0x140>(a1); b0 += dppf<0x140>(b0); b1 += dppf<0x140>(b1); SCAN_OPAQUE4();
#undef SCAN_OPAQUE4
    yr0 = b0; yr1 = b1;
    const f32x2v sa2 = {a0, a1}, vv2 = {t.vv0, t.vv1};
#pragma unroll
    for (int i = 0; i < 4; ++i) {
        f32x2v tt = vv2 * (f32x2v){t.kp[i], t.kp[i]};
        tt = tt - sa2 * (f32x2v){t.ka[i], t.ka[i]};
        SS[i] = SS[i] * (f32x2v){t.w[i], t.w[i]} + tt;
    }
    if (want_y) {
        f32x2v p2 = SS[0] * (f32x2v){t.r[0], t.r[0]};
#pragma unroll
        for (int i = 1; i < 4; ++i) p2 = SS[i] * (f32x2v){t.r[i], t.r[i]} + p2;
        y0 = p2.x; y1 = p2.y;
    }
}
template <int LPR> __device__ void scan_item(const Params& PP, int seq, int h, int dir, int rhalf, int tbeg, int tlen, int flags, const float* sin, float* sout, LAS unsigned char* lds) {
    Params P = PP; P.ws = opaque_ptr(PP.ws);
    constexpr int KPL = 64 / LPR, RPW = 64 / LPR, NV = KPL / 4;
    const int tid = opaque_tid(), lane = tid & 63, wave = __builtin_amdgcn_readfirstlane(tid >> 6), l15 = lane & 15, quad = lane >> 4;
    const int Tseq = seq < 32 ? 2048 : 16384;
    const size_t base = seq < 32 ? (size_t)seq * 2048 : (size_t)M_PROMPT;
    const bf16_t* Prkvg = (const bf16_t*)(P.ws + WS_PRKVG);
    const bf16_t* Pwa = (const bf16_t*)(P.ws + WS_PWA);
    bf16_t* Yd = (bf16_t*)(P.ws + WS_Y) + (size_t)dir * M_TOK * 512;
    float* RKR = (float*)(P.ws + WS_RKR) + (size_t)dir * M_TOK * 8;
    LAS bf16_t* RAW0 = (LAS bf16_t*)lds;
    LAS bf16_t* ZROW = (LAS bf16_t*)(lds + 21760);
    LAS float* Wd = (LAS float*)(lds + 22528);
    LAS float* Aa = Wd + 1024; LAS float* Rr = Aa + 1024; LAS float* KP = Rr + 1024; LAS float* Vv = KP + 1024; LAS float* KK = Vv + 1024; LAS float* KKA = KK + 1024; LAS float* Yc = KKA + 1024;
    if (tid < 160) ((LAS unsigned*)ZROW)[tid] = 0u;
    LAS bf16_t* ALDS = (LAS bf16_t*)(lds + 55296);
    const int j_a = tid / 40, seg_a = (tid % 40) >> 3, c8_a = tid & 7;
    const int idx_b = tid + 512, j_b = idx_b / 40, seg_b = (idx_b % 40) >> 3, c8_b = idx_b & 7;
    const bool has_b = idx_b < 640;
    const int coff_a = seg_a < 3 ? seg_a * 512 + h * 64 + c8_a * 8 : dir * 128 + (seg_a - 3) * 64 + c8_a * 8;
    const int coff_b = seg_b < 3 ? seg_b * 512 + h * 64 + c8_b * 8 : dir * 128 + (seg_b - 3) * 64 + c8_b * 8;
    const int dst_a = (j_a + 1) * 320 + seg_a * 64 + c8_a * 8, dst_b = (j_b + 1) * 320 + seg_b * 64 + c8_b * 8;
    const bf16_t* src_a = (seg_a < 3 ? Prkvg + base * 2048 : Pwa + base * 256) + coff_a; const int ld_a = seg_a < 3 ? 2048 : 256;
    const bf16_t* src_b = (seg_b < 3 ? Prkvg + base * 2048 : Pwa + base * 256) + coff_b; const int ld_b = seg_b < 3 ? 2048 : 256;
    const int ltype = wave >> 2, lch = (wave & 3) * 16 + l15;
    const bf16_t* Wt = (const bf16_t*)(P.ws + WS_LORA) + (size_t)(dir * 2 + ltype) * 512 * 64 + (size_t)(h * 64 + lch) * 64;
    const bf16x8 lb0 = *(const bf16x8*)(Wt + quad * 8), lb1 = *(const bf16x8*)(Wt + 32 + quad * 8);
    const float lbias = ltype == 0 ? P.in[17][dir * 512 + h * 64 + lch] : P.in[19][dir * 512 + h * 64 + lch];
    const int tk = tid >> 5, c2 = tid & 31;
    float mu_r[2], mu_k[2], mu_v[2], k_k[2], k_a[2], r_k[2];
#pragma unroll
    for (int e = 0; e < 2; ++e) { const int ch = h * 64 + 2 * c2 + e;
        mu_r[e] = P.in[15][dir * 1536 + ch]; mu_k[e] = P.in[15][dir * 1536 + 512 + ch]; mu_v[e] = P.in[15][dir * 1536 + 1024 + ch];
        k_k[e] = P.in[21][ch]; k_a[e] = P.in[22][ch]; r_k[e] = P.in[23][ch]; }
    float amu[2][2];
#pragma unroll
    for (int ty = 0; ty < 2; ++ty)
#pragma unroll
        for (int e = 0; e < 2; ++e) amu[ty][e] = P.in[16][dir * 128 + ty * 64 + 2 * c2 + e];
#define SCAN_BUILD_A(RAWN, PREV0) do { \
        LAS const bf16_t* cur_ = (RAWN) + (tk + 1) * 320 + 192 + 2 * c2; \
        LAS const bf16_t* prv_ = (tk > 0 ? (RAWN) + tk * 320 : (PREV0)) + 192 + 2 * c2; \
        _Pragma("unroll") for (int ty = 0; ty < 2; ++ty) { \
            const unsigned xc_ = *(LAS const unsigned*)(cur_ + ty * 64), xp_ = *(LAS const unsigned*)(prv_ + ty * 64); \
            float z0_ = bflo(xc_) + (bflo(xp_) - bflo(xc_)) * amu[ty][0], z1_ = bfhi(xc_) + (bfhi(xp_) - bfhi(xc_)) * amu[ty][1]; \
            if (ty == 0) { z0_ = tanhf_(z0_); z1_ = tanhf_(z1_); } \
            *(LAS unsigned*)(ALDS + ty * 1152 + tk * 72 + 2 * c2) = pk2(z0_, z1_); } } while (0)
    static_assert(LPR == 16, "two rows per lane, 16 lanes per row");
    const int srow = wave * 8 + (lane >> 4), sq = lane & 15;
    f32x2v SS[4];
#pragma unroll
    for (int i = 0; i < 4; ++i) { const int kidx = sq * 4 + i;
        SS[i].x = (flags & 1) ? (kidx == srow ? 1.f : 0.f) : (sin ? sin[srow * 64 + kidx] : 0.f);
        SS[i].y = (flags & 1) ? (kidx == srow + 4 ? 1.f : 0.f) : (sin ? sin[(srow + 4) * 64 + kidx] : 0.f); }
    const int nch = tlen / 16;
    const int tstep = dir == 0 ? 16 : -16;
    const int tfirst = dir == 0 ? tbeg : tbeg + tlen - 16;
    const int tprev = dir == 0 ? tbeg - 1 : tbeg + tlen;
    const bool has_prev = tprev >= 0 && tprev < Tseq;
    if (has_prev && tid < 40) {
        const int sg = tid >> 3, c8 = tid & 7;
        const bf16_t* sp = sg < 3 ? Prkvg + (base + tprev) * 2048 + sg * 512 + h * 64 + c8 * 8 : Pwa + (base + tprev) * 256 + dir * 128 + (sg - 3) * 64 + c8 * 8;
        *(LAS u32x4*)(RAW0 + 5440 + 16 * 320 + sg * 64 + c8 * 8) = *(const u32x4*)sp;
    }
    const bool in_on = (flags & 2) == 0, wr_y = (flags & 4) != 0, wr_rk = (flags & 8) != 0;
#define SCAN_TOK(t0, j) (dir == 0 ? (t0) + (j) : (t0) + 15 - (j))
    u32x4 pre_a, pre_b = (u32x4){0u, 0u, 0u, 0u};
    {
        pre_a = *(const u32x4*)(src_a + (size_t)SCAN_TOK(tfirst, j_a) * ld_a);
        if (has_b) pre_b = *(const u32x4*)(src_b + (size_t)SCAN_TOK(tfirst, j_b) * ld_b);
        *(LAS u32x4*)(RAW0 + dst_a) = pre_a;
        if (has_b) *(LAS u32x4*)(RAW0 + dst_b) = pre_b;
        if (nch > 1) {
            pre_a = *(const u32x4*)(src_a + (size_t)SCAN_TOK(tfirst + tstep, j_a) * ld_a);
            if (has_b) pre_b = *(const u32x4*)(src_b + (size_t)SCAN_TOK(tfirst + tstep, j_b) * ld_b);
        }
    }
    __syncthreads();
    SCAN_BUILD_A(RAW0, (has_prev ? RAW0 + 5440 + 16 * 320 : ZROW));
    lds_barrier();
    u32x4 ypend = (u32x4){0u, 0u, 0u, 0u}; bf16_t* ypend_ptr = nullptr;
    for (int c = 0; c < nch; ++c) {
        LAS bf16_t* RAW = RAW0 + (c & 1) * 5440;
        LAS bf16_t* RAWp = RAW0 + ((c & 1) ^ 1) * 5440;
        const int t0 = tfirst + c * tstep;
        {
            bf16x8 af[2];
#pragma unroll
            for (int ks = 0; ks < 2; ++ks) af[ks] = *(LAS const bf16x8*)(ALDS + ltype * 1152 + l15 * 72 + ks * 32 + quad * 8);
            f32x4 d = mfma16(af[0], lb0, (f32x4){0.f, 0.f, 0.f, 0.f});
            d = mfma16(af[1], lb1, d);
            LAS float* dstp = (ltype == 0 ? Wd : Aa) + lch;
#pragma unroll
            for (int jj = 0; jj < 4; ++jj) { const float sg = sigmoidf_(lbias + d[jj]); dstp[(quad * 4 + jj) * 64] = ltype == 0 ? __expf(-0.6065306597126334f * sg) : sg; }
        }
        {
            LAS const bf16_t* cur = RAW + (tk + 1) * 320 + 2 * c2;
            LAS const bf16_t* prv = (tk > 0 ? RAW + tk * 320 : ((c > 0 || has_prev) ? RAWp + 16 * 320 : ZROW)) + 2 * c2;
            const unsigned rc = *(LAS const unsigned*)(cur), rp = *(LAS const unsigned*)(prv);
            const unsigned kc = *(LAS const unsigned*)(cur + 64), kq = *(LAS const unsigned*)(prv + 64);
            const unsigned vc = *(LAS const unsigned*)(cur + 128), vp = *(LAS const unsigned*)(prv + 128);
            const int o = tk * 64 + 2 * c2;
            Rr[o] = bflo(rc) + (bflo(rp) - bflo(rc)) * mu_r[0]; Rr[o + 1] = bfhi(rc) + (bfhi(rp) - bfhi(rc)) * mu_r[1];
            KP[o] = bflo(kc) + (bflo(kq) - bflo(kc)) * mu_k[0]; KP[o + 1] = bfhi(kc) + (bfhi(kq) - bfhi(kc)) * mu_k[1];
            Vv[o] = in_on ? bflo(vc) + (bflo(vp) - bflo(vc)) * mu_v[0] : 0.f; Vv[o + 1] = in_on ? bfhi(vc) + (bfhi(vp) - bfhi(vc)) * mu_v[1] : 0.f;
        }
        lds_barrier();
        float rk_keep;
        {
            const int o = tk * 64 + 2 * c2;
            const float kz0 = KP[o], kz1 = KP[o + 1], a0 = Aa[o], a1 = Aa[o + 1];
            const float q0 = kz0 * k_k[0], q1 = kz1 * k_k[1];
            const float kp0 = kz0 * (1.0f + (a0 - 1.0f) * k_a[0]), kp1 = kz1 * (1.0f + (a1 - 1.0f) * k_a[1]);
            const float ss = reduce32(q0 * q0 + q1 * q1);
            const float rk = reduce32(Rr[o] * kp0 * r_k[0] + Rr[o + 1] * kp1 * r_k[1]);
            const float inv = __builtin_amdgcn_rsqf(fmaxf(ss, 1e-24f));
            const float kk0 = q0 * inv, kk1 = q1 * inv;
            KK[o] = kk0; KK[o + 1] = kk1; KKA[o] = kk0 * a0; KKA[o + 1] = kk1 * a1;
            KP[o] = kp0; KP[o + 1] = kp1;
            rk_keep = rk;
        }
        if (c + 1 < nch) {
            *(LAS u32x4*)(RAWp + dst_a) = pre_a;
            if (has_b) *(LAS u32x4*)(RAWp + dst_b) = pre_b;
            if (c + 2 < nch) {
                pre_a = *(const u32x4*)(src_a + (size_t)SCAN_TOK(t0 + 2 * tstep, j_a) * ld_a);
                if (has_b) pre_b = *(const u32x4*)(src_b + (size_t)SCAN_TOK(t0 + 2 * tstep, j_b) * ld_b);
            }
        }
        if (wr_rk && c2 == 0) RKR[(base + SCAN_TOK(t0, tk)) * 8 + h] = rk_keep;
        if (ypend_ptr) *(u32x4*)ypend_ptr = ypend;
        lds_barrier();
        if (c + 1 < nch) SCAN_BUILD_A(RAWp, RAW + 16 * 320);
        {
            ScanSet2 sa_, sb_;
            scan_load2(sa_, KK, Wd, KKA, KP, Rr, Vv, sq * 4, srow, wr_y);
            float yk = 0.f, zk = 0.f, y0 = 0.f, y1 = 0.f, yr0, yr1;
#pragma unroll 1
            for (int jo = 0; jo < 16; jo += 2) {
                scan_load2(sb_, KK, Wd, KKA, KP, Rr, Vv, (jo + 1) * 64 + sq * 4, (jo + 1) * 64 + srow, wr_y);
                scan_step2(SS, sa_, wr_y, y0, y1, yr0, yr1);
                if (jo > 0 && sq == jo - 1) { yk = yr0; zk = yr1; }
                if (jo + 2 < 16) scan_load2(sa_, KK, Wd, KKA, KP, Rr, Vv, (jo + 2) * 64 + sq * 4, (jo + 2) * 64 + srow, wr_y);
                scan_step2(SS, sb_, wr_y, y0, y1, yr0, yr1);
                if (sq == jo) { yk = yr0; zk = yr1; }
            }
            yr0 = dpp16(y0); yr1 = dpp16(y1);
            if (sq == 15) { yk = yr0; zk = yr1; }
            Yc[sq * 64 + srow] = yk; Yc[sq * 64 + srow + 4] = zk;
        }
        lds_barrier();
        {
            const bool wr = wr_y && tid < 128;
            if (wr) {
                const int tq = tid >> 3, c8 = tid & 7; float f[8];
                const f32x4 a = *(LAS const f32x4*)(Yc + tq * 64 + c8 * 8), b = *(LAS const f32x4*)(Yc + tq * 64 + c8 * 8 + 4);
                f[0] = a[0]; f[1] = a[1]; f[2] = a[2]; f[3] = a[3]; f[4] = b[0]; f[5] = b[1]; f[6] = b[2]; f[7] = b[3];
                ypend = pack8(f); ypend_ptr = Yd + (base + SCAN_TOK(t0, tq)) * 512 + h * 64 + c8 * 8;
            }
        }
    }
    if (ypend_ptr) *(u32x4*)ypend_ptr = ypend;
    if (sout) { *(f32x4*)(sout + srow * 64 + sq * 4) = (f32x4){SS[0].x, SS[1].x, SS[2].x, SS[3].x}; *(f32x4*)(sout + (srow + 4) * 64 + sq * 4) = (f32x4){SS[0].y, SS[1].y, SS[2].y, SS[3].y}; }
#undef SCAN_TOK
#undef SCAN_BUILD_A
    __syncthreads();
}

__device__ void scan_carry(const Params& PP, int hd, LAS unsigned char* lds) {
    Params P = PP; P.ws = opaque_ptr(PP.ws);
    const int tid = opaque_tid();
    const float* Lm = (const float*)(P.ws + WS_STL) + (size_t)hd * NSEG * 4096;
    const float* Pm = (const float*)(P.ws + WS_STP) + (size_t)hd * NSEG * 4096;
    float* St = (float*)(P.ws + WS_STS) + (size_t)hd * NSEG * 4096;
    LAS float* Sc = (LAS float*)lds;
    LAS float* Pc = Sc + 4096;
    const int v = tid >> 3, k0 = (tid & 7) * 8;
    for (int i = 0; i < 8; ++i) { const float x = Lm[v * 64 + k0 + i]; Sc[v * 64 + k0 + i] = x; St[4096 + v * 64 + k0 + i] = x; }
    for (int sgm = 1; sgm + 1 < NSEG; ++sgm) {
        for (int i = 0; i < 8; ++i) Pc[v * 64 + k0 + i] = Pm[(size_t)sgm * 4096 + v * 64 + k0 + i];
        __syncthreads();
        float o[8];
        for (int i = 0; i < 8; ++i) o[i] = Lm[(size_t)sgm * 4096 + v * 64 + k0 + i];
        for (int j = 0; j < 64; ++j) { const float sv = Sc[v * 64 + j];
#pragma unroll
            for (int i = 0; i < 8; ++i) o[i] += sv * Pc[j * 64 + k0 + i]; }
        __syncthreads();
        for (int i = 0; i < 8; ++i) { Sc[v * 64 + k0 + i] = o[i]; St[(size_t)(sgm + 1) * 4096 + v * 64 + k0 + i] = o[i]; }
    }
    __syncthreads();
}

__device__ void rwkv_finalize(const Params& PP) {
    Params P = PP; P.ws = opaque_ptr(PP.ws);
    const int tid_ = opaque_tid(), lane = tid_ & 63, wave = __builtin_amdgcn_readfirstlane(tid_ >> 6);
    const bf16_t* Prkvg = (const bf16_t*)(P.ws + WS_PRKVG);
    const bf16_t* Y0 = (const bf16_t*)(P.ws + WS_Y);
    const bf16_t* Y1 = Y0 + (size_t)M_TOK * 512;
    const float* RKR0 = (const float*)(P.ws + WS_RKR);
    const float* RKR1 = RKR0 + (size_t)M_TOK * 8;
    bf16_t* MO = (bf16_t*)(P.ws + WS_XN);
    const int col = lane * 8, hh = lane >> 3;
    float gw[8], gb[8], muf[8], mub[8];
#pragma unroll
    for (int i = 0; i < 8; ++i) { gw[i] = P.in[24][col + i]; gb[i] = P.in[25][col + i]; muf[i] = P.in[15][1024 + col + i]; mub[i] = P.in[15][1536 + 1024 + col + i]; }
    for (int row = blockIdx.x * 8 + wave; row < M_TOK; row += gridDim.x * 8) {
        const int t = row < M_PROMPT ? (row & 2047) : row - M_PROMPT, T = row < M_PROMPT ? 2048 : 16384;
        float yf[8], yb[8], vc[8], vp[8], vn[8], gg[8];
        unpack8(*(const u32x4*)(Y0 + (size_t)row * 512 + col), yf); unpack8(*(const u32x4*)(Y1 + (size_t)row * 512 + col), yb);
        unpack8(*(const u32x4*)(Prkvg + (size_t)row * 2048 + 1024 + col), vc);
        unpack8(*(const u32x4*)(Prkvg + (size_t)row * 2048 + 1536 + col), gg);
        if (t > 0) unpack8(*(const u32x4*)(Prkvg + (size_t)(row - 1) * 2048 + 1024 + col), vp); else { for (int i = 0; i < 8; ++i) vp[i] = 0.f; }
        if (t < T - 1) unpack8(*(const u32x4*)(Prkvg + (size_t)(row + 1) * 2048 + 1024 + col), vn); else { for (int i = 0; i < 8; ++i) vn[i] = 0.f; }
        const float rf = RKR0[(size_t)row * 8 + hh], rb = RKR1[(size_t)row * 8 + hh];
        float s = 0.f;
#pragma unroll
        for (int i = 0; i < 8; ++i) { yf[i] += yb[i]; s += yf[i]; }
        const float mean = reduce8(s) * (1.0f / 64.0f);
        float q = 0.f;
#pragma unroll
        for (int i = 0; i < 8; ++i) { yf[i] -= mean; q += yf[i] * yf[i]; }
        const float rstd = rsqrtf(reduce8(q) * (1.0f / 64.0f) + 64e-5f);
        float o[8];
#pragma unroll
        for (int i = 0; i < 8; ++i) {
            const float vzf = vc[i] + (vp[i] - vc[i]) * muf[i], vzb = vc[i] + (vn[i] - vc[i]) * mub[i];
            o[i] = (yf[i] * rstd * gw[i] + gb[i] + rf * vzf + rb * vzb) * sigmoidf_(gg[i]);
        }
        *(u32x4*)(MO + (size_t)row * 1024 + 512 + col) = pack8(o);
    }
}

template <int NQ> __device__ __forceinline__ void attn_groups(const bf16_t* QKV, size_t base, int h, int T0, int L, int dsh, int res, int i0, int bi,
        int lane, int l15, int quad, int r4, int c4, LAS unsigned char* VST, LAS const f32x2v* RKT, int tb, const float (&bx)[11][4], const float (&gqk)[16], LAS float* OACC, LAS float* LS) {
    constexpr int NT = NQ == 2 ? 10 : 9;
    bf16x8 qf[NQ][2]; float mq[NQ]; int qtok[NQ];
#pragma unroll
    for (int q = 0; q < NQ; ++q) {
        qtok[q] = ((i0 + 16 * q + l15) << dsh) + res;
        const bf16_t* qp = QKV + (base + qtok[q]) * 3072 + h * 64 + quad * 8;
        float f[16]; unpack8(*(const u32x4*)qp, f); unpack8(*(const u32x4*)(qp + 32), f + 8);
        float ss = 0.f;
#pragma unroll
        for (int i = 0; i < 16; ++i) ss += f[i] * f[i];
        ss += __shfl_xor(ss, 16); ss += __shfl_xor(ss, 32);
        const float rq = rsqrtf(ss * (1.0f / 64.0f) + NORM_EPS) * 0.125f;
#pragma unroll
        for (int i = 0; i < 16; ++i) f[i] = f[i] * rq * gqk[i];
        const u32x4 w0 = pack8(f), w1 = pack8(f + 8);
        qf[q][0] = __builtin_bit_cast(bf16x8, w0); qf[q][1] = __builtin_bit_cast(bf16x8, w1);
        float fr[16]; unpack8(w0, fr); unpack8(w1, fr + 8);
        float n2 = 0.f;
#pragma unroll
        for (int i = 0; i < 16; ++i) n2 += fr[i] * fr[i];
        n2 += __shfl_xor(n2, 16); n2 += __shfl_xor(n2, 32);
        mq[q] = 8.1f * 1.4426950408889634f * sqrtf(n2);
    }
    f32x4 oacc[NQ][4];
    float lsum[NQ];
#pragma unroll
    for (int q = 0; q < NQ; ++q) { lsum[q] = 0.f;
#pragma unroll
        for (int et = 0; et < 4; ++et) oacc[q][et] = (f32x4){0.f, 0.f, 0.f, 0.f}; }
    const int ebase = (i0 - 64 + quad * 4) * (1 << dsh) + res - tb;
    const float dmul = (float)(1 << dsh);
    bf16x8 kfb[2][2][2]; u32x4 vb[2][4];
    const int rowv = lane >> 1, half = lane & 1;
#define ATT_ISSUE(KP, BUF) do { \
        _Pragma("unroll") for (int tt_ = 0; tt_ < 2; ++tt_) { \
            int kidx_ = i0 - 64 + 16 * (2 * (KP) + tt_) + l15; kidx_ = kidx_ < 0 ? 0 : (kidx_ > L - 1 ? L - 1 : kidx_); \
            const bf16_t* kptr_ = QKV + (base + ((size_t)kidx_ << dsh) + res) * 3072 + 1024 + h * 64 + quad * 8; \
            kfb[BUF][tt_][0] = *(const bf16x8*)kptr_; kfb[BUF][tt_][1] = *(const bf16x8*)(kptr_ + 32); } \
        int vidx_ = i0 - 64 + 32 * (KP) + rowv; vidx_ = vidx_ < 0 ? 0 : (vidx_ > L - 1 ? L - 1 : vidx_); \
        const bf16_t* vptr_ = QKV + (base + ((size_t)vidx_ << dsh) + res) * 3072 + 2048 + h * 64 + half * 32; \
        vb[BUF][0] = *(const u32x4*)vptr_; vb[BUF][1] = *(const u32x4*)(vptr_ + 8); vb[BUF][2] = *(const u32x4*)(vptr_ + 16); vb[BUF][3] = *(const u32x4*)(vptr_ + 24); } while (0)
    ATT_ISSUE(0, 0);
#pragma unroll
    for (int kp = 0; kp < 5; ++kp) {
        f32x4 s[NQ][2];
        if (kp + 1 < 5) ATT_ISSUE(kp + 1, (kp + 1) & 1);
#pragma unroll
        for (int tt = 0; tt < 2; ++tt) {
            const int kt = 2 * kp + tt;
#pragma unroll
            for (int q = 0; q < NQ; ++q) s[q][tt] = (f32x4){0.f, 0.f, 0.f, 0.f};
            if (kt < NT) {
                f32x2v e[4];
#pragma unroll
                for (int j = 0; j < 4; ++j) e[j] = RKT[((16 * kt + j) << dsh) + ebase];
#pragma unroll
                for (int q = 0; q < NQ; ++q) {
                    f32x4 sc = mfma16(kfb[kp & 1][tt][0], qf[q][0], (f32x4){0.f, 0.f, 0.f, 0.f});
                    sc = mfma16(kfb[kp & 1][tt][1], qf[q][1], sc);
#pragma unroll
                    for (int j = 0; j < 4; ++j) {
                        const float p = __builtin_amdgcn_exp2f(sc[j] * e[j].x + (e[j].y + (bx[kt + 1 - q][j] * dmul - mq[q])));
                        lsum[q] += p; s[q][tt][j] = p;
                    }
                }
            }
        }
        bf16x8 pf[NQ];
#pragma unroll
        for (int q = 0; q < NQ; ++q) { u32x4 w; w.x = pk2(s[q][0][0], s[q][0][1]); w.y = pk2(s[q][0][2], s[q][0][3]); w.z = pk2(s[q][1][0], s[q][1][1]); w.w = pk2(s[q][1][2], s[q][1][3]); pf[q] = __builtin_bit_cast(bf16x8, w); }
        {
            LAS u32x4* vd = (LAS u32x4*)(VST + rowv * 144 + half * 64);
            vd[0] = vb[kp & 1][0]; vd[1] = vb[kp & 1][1]; vd[2] = vb[kp & 1][2]; vd[3] = vb[kp & 1][3];
        }
        asm volatile("s_waitcnt lgkmcnt(0)" ::: "memory"); __builtin_amdgcn_fence(__ATOMIC_RELEASE, "wavefront"); __builtin_amdgcn_wave_barrier(); __builtin_amdgcn_fence(__ATOMIC_ACQUIRE, "wavefront"); asm volatile("s_waitcnt lgkmcnt(0)" ::: "memory");
#pragma unroll
        for (int et = 0; et < 4; ++et) {
            LAS const unsigned char* ap = VST + (quad * 4 + r4) * 144 + (et * 16 + 4 * c4) * 2;
            const s16x4 lo = tr_read(ap), hi = tr_read(ap + 16 * 144);
            const bf16x8 a = {lo[0], lo[1], lo[2], lo[3], hi[0], hi[1], hi[2], hi[3]};
#pragma unroll
            for (int q = 0; q < NQ; ++q) oacc[q][et] = mfma16(a, pf[q], oacc[q][et]);
        }
        asm volatile("s_waitcnt lgkmcnt(0)" ::: "memory"); __builtin_amdgcn_fence(__ATOMIC_RELEASE, "wavefront"); __builtin_amdgcn_wave_barrier(); __builtin_amdgcn_fence(__ATOMIC_ACQUIRE, "wavefront"); asm volatile("s_waitcnt lgkmcnt(0)" ::: "memory");
    }
#undef ATT_ISSUE
#pragma unroll
    for (int q = 0; q < NQ; ++q) {
        float l = lsum[q]; l += __shfl_xor(l, 16); l += __shfl_xor(l, 32);
        const int qloc = qtok[q] - T0;
#pragma unroll
        for (int et = 0; et < 4; ++et) {
            LAS f32x4* dst = (LAS f32x4*)(OACC + qloc * 68 + et * 16 + quad * 4);
            if (bi == 0) *dst = oacc[q][et]; else *dst = *dst + oacc[q][et];
        }
        if (quad == 0) { if (bi == 0) LS[qloc] = l; else LS[qloc] += l; }
    }
}

__device__ void attn_item(const Params& PP, int seq, int h, int tile, LAS unsigned char* lds) {
    Params P = PP; P.ws = opaque_ptr(PP.ws);
    const int tid = opaque_tid(), lane = tid & 63, wave = __builtin_amdgcn_readfirstlane(tid >> 6), l15 = lane & 15, quad = lane >> 4;
    const int T = seq < 32 ? 2048 : 16384;
    const size_t base = seq < 32 ? (size_t)seq * 2048 : (size_t)M_PROMPT;
    const int T0 = tile * 256;
    const bf16_t* QKV = (const bf16_t*)(P.ws + WS_BIG);
    bf16_t* MO = (bf16_t*)(P.ws + WS_XN);
    LAS float* OACC = (LAS float*)lds;
    LAS float* LS = (LAS float*)(lds + 256 * 272);
    LAS unsigned char* VST = lds + 256 * 272 + 1024 + wave * (32 * 144);
    const float slope = exp2f(-0.5f * (float)(h + 1));
    float gqk[16];
#pragma unroll
    for (int i = 0; i < 16; ++i) { const int e = (i >> 3) * 32 + quad * 8 + (i & 7); gqk[i] = P.in[28][e] * P.in[29][e]; }
    const int r4 = l15 >> 2, c4 = l15 & 3;
    float bx[11][4];
#pragma unroll
    for (int kt = -1; kt < 10; ++kt)
#pragma unroll
        for (int j = 0; j < 4; ++j) { int dist = 16 * kt - 64 + quad * 4 + j - l15; dist = dist < 0 ? -dist : dist;
            bx[kt + 1][j] = dist <= 64 ? -slope * 1.4426950408889634f * (float)dist : -1e30f; }
    LAS f32x2v* RKT = (LAS f32x2v*)(lds + 107520);
    const int tb = T0 - 1024;
    for (int idx = tid; idx < 2304; idx += 512) {
        const int tok = tb + idx;
        f32x2v ent = {0.f, -1e30f};
        if (tok >= 0 && tok < T) {
            const bf16_t* kp_ = QKV + (base + tok) * 3072 + 1024 + h * 64;
            float ss = 0.f;
#pragma unroll
            for (int i = 0; i < 8; ++i) { float f[8]; unpack8(*(const u32x4*)(kp_ + i * 8), f);
#pragma unroll
                for (int e = 0; e < 8; ++e) ss += f[e] * f[e]; }
            ent.x = rsqrtf(ss * (1.0f / 64.0f) + NORM_EPS) * 1.4426950408889634f; ent.y = 0.f;
        }
        RKT[idx] = ent;
    }
    __syncthreads();
    for (int bi = 0; bi < 3; ++bi) {
        const int dsh = 2 * bi, L = T >> dsh;
        if (bi < 2) {
            const int res = bi == 0 ? 0 : (wave & 3), i0 = (T0 >> dsh) + (bi == 0 ? 32 * wave : 32 * (wave >> 2));
            attn_groups<2>(QKV, base, h, T0, L, dsh, res, i0, bi, lane, l15, quad, r4, c4, VST, RKT, tb, bx, gqk, OACC, LS);
        } else {
            for (int gg = 0; gg < 2; ++gg)
                attn_groups<1>(QKV, base, h, T0, L, dsh, wave * 2 + gg, T0 >> dsh, bi, lane, l15, quad, r4, c4, VST, RKT, tb, bx, gqk, OACC, LS);
        }
        __syncthreads();
    }
    {
        const int q = tid >> 1, half = tid & 1;
        const float inv = 1.0f / LS[q];
        bf16_t* op = MO + (base + T0 + q) * 1024 + h * 64 + half * 32;
#pragma unroll
        for (int i = 0; i < 4; ++i) {
            const f32x4 a = *(LAS const f32x4*)(OACC + q * 68 + half * 32 + i * 8), b = *(LAS const f32x4*)(OACC + q * 68 + half * 32 + i * 8 + 4);
            u32x4 w; w.x = pk2(a[0] * inv, a[1] * inv); w.y = pk2(a[2] * inv, a[3] * inv); w.z = pk2(b[0] * inv, b[1] * inv); w.w = pk2(b[2] * inv, b[3] * inv);
            *(u32x4*)(op + i * 8) = w;
        }
    }
    __syncthreads();
}

enum { K_P0 = 0, K_SWIGLU, K_RESID, K_NORM, K_GEMM_P, K_MIXA, K_FINAL, K_GEMM_QKV, K_ATTN, K_CARRY, K_MIXB };
constexpr int N_PHASES = 19;

__global__ void __launch_bounds__(512, 2) mega(Params P) {
    extern __shared__ __attribute__((aligned(16))) unsigned char lds_raw[];
    LAS unsigned char* lds = (LAS unsigned char*)lds_raw;
    cg::grid_group grid = cg::this_grid();
    for (int ph = 0; ph < N_PHASES; ++ph) {
#ifdef PROBE_MASK
        if (blockIdx.x == 0 && threadIdx.x == 0) ((unsigned long long*)(P.ws + WS_TS))[ph] = __builtin_amdgcn_s_memrealtime();
#endif
        unsigned char* ws = P.ws; float* X = P.out; int G = gridDim.x, bid = blockIdx.x;
        asm volatile("" : "+s"(ws), "+s"(X), "+s"(G), "+s"(bid));
        bf16_t* XN = (bf16_t*)(ws + WS_XN);
        bf16_t* Hb = (bf16_t*)(ws + WS_BIG);
        int kind, layer = 0, sub = 0;
        if (ph == 0) kind = K_P0;
        else {
            layer = ph <= 10 ? 0 : 1; const int r = ph <= 10 ? ph - 1 : ph - 11;
            const unsigned long long kc = layer == 0 ? 0x2126A95421ull : 0x32128721ull;
            const unsigned long long sc = layer == 0 ? 0x1120000000ull : 0x21120000ull;
            kind = (int)((kc >> (4 * r)) & 15ull); sub = (int)((sc >> (4 * r)) & 15ull);
        }
        if (kind == K_P0) {
#ifndef SKIP_P0
            LAS float* tile = (LAS float*)lds;
            int rot = 0;
            for (int job = 0; job < 16; ++job) {
                const float* src; size_t doff; int K, N;
                if (job < 4) { src = ((job & 1) ? P.in[7] : P.in[3]) + (size_t)(job >> 1) * 1024 * 5632; doff = WS_WFI + (size_t)job * SZ_WFI; K = 1024; N = 5632; }
                else if (job < 8) { src = ((job & 1) ? P.in[8] : P.in[4]) + (size_t)((job - 4) >> 1) * 2816 * 1024; doff = WS_WFO + (size_t)(job - 4) * SZ_WFO; K = 2816; N = 1024; }
                else if (job == 8) { src = P.in[10]; doff = WS_WABI; K = 1024; N = 3328; }
                else if (job == 9) { src = P.in[11]; doff = WS_WABO; K = 1024; N = 1024; }
                else if (job == 10) { src = P.in[26]; doff = WS_WATI; K = 1024; N = 3072; }
                else if (job == 11) { src = P.in[27]; doff = WS_WATO; K = 1024; N = 1024; }
                else { const int d = (job - 12) >> 1, ty = (job - 12) & 1; src = (ty ? P.in[20] : P.in[18]) + (size_t)d * 64 * 512; doff = WS_LORA + (size_t)(d * 2 + ty) * 512 * 64 * 2; K = 64; N = 512; }
                if (job < 4) convert_T<1>(src, (bf16_t*)(ws + doff), K, N, tile, rot); else convert_T<0>(src, (bf16_t*)(ws + doff), K, N, tile, rot);
                rot += (K / 64) * (N / 64);
            }
            {
                bf16_t* dst = (bf16_t*)(ws + WS_SGUW);
                for (int i = bid * 512 + opaque_tid(); i < 4 * 128 * 128 / 4; i += G * 512) {
                    const f32x4 v = *(const f32x4*)(P.in[13] + (size_t)i * 4);
                    u32x2 w; w.x = pk2(v[0], v[1]); w.y = pk2(v[2], v[3]); *(u32x2*)(dst + (size_t)i * 4) = w;
                }
            }
            norm_rows(P.in[0], P.in[1], M_PROMPT, nullptr, nullptr, nullptr, P.in[2], XN);
            if (bid == 0 && opaque_tid() == 0) *(unsigned*)(ws + WS_TS + 2048) = 0u;
#endif
        } else if (kind == K_SWIGLU) {
            if (sub == 0) { float* za = (float*)(ws + WS_RSA); for (int i = bid * 512 + opaque_tid(); i < M_TOK; i += G * 512) za[i] = 0.f; }
            pg8::Gemm g{sub == 0 ? XN : (const bf16_t*)(ws + WS_Y), (const bf16_t*)(ws + WS_WFI + (size_t)(layer * 2 + sub) * SZ_WFI), M_TOK, 5632, 1024};
            pg8::StaticOrder S; S.init(M_TOK, 5632, G, bid);
            if (sub == 1 && layer == 0) { float* zc = (float*)(ws + WS_RSC); for (int i = bid * 512 + opaque_tid(); i < 2 * M_TOK; i += G * 512) zc[i] = 0.f; }
            EpiSwiglu E{Hb, sub == 0 ? (layer == 0 ? nullptr : (const float*)(ws + WS_RSC)) : (const float*)(ws + WS_RSB), (sub == 0 && layer == 1) ? (const float*)(ws + WS_RSD) : nullptr};
#ifndef SKIP_G1
            pg8::gemm_phase<EpiSwiglu, pg8::StaticOrder, GEMM_ALIGN, GEMM_SP2>(lds, g, S, E);
#endif
        } else if (kind == K_RESID) {
            const bf16_t* A; const bf16_t* Bt; int K; float scale; bf16_t* xg = nullptr; const float* gn = nullptr; float* rss = nullptr;
            const float* gaux = nullptr; float* rss2 = nullptr; const float* bss = nullptr;
            if (sub < 2) { A = Hb; Bt = (const bf16_t*)(ws + WS_WFO + (size_t)(layer * 2 + sub) * SZ_WFO); K = 2816; scale = 0.5f;
                if (sub == 0) { xg = XN; gn = P.in[5] + layer * DM; rss = (float*)(ws + WS_RSA); if (layer == 1) { bss = (const float*)(ws + WS_RSC); gaux = P.in[9]; } }
                else if (layer == 0) { xg = XN; gn = P.in[2] + DM; gaux = P.in[9]; rss = (float*)(ws + WS_RSC); rss2 = (float*)(ws + WS_RSD); } }
            else { A = XN; Bt = (const bf16_t*)(ws + (layer == 0 ? WS_WABO : WS_WATO)); K = 1024; scale = 1.0f; xg = (bf16_t*)(ws + WS_Y); gn = P.in[6] + layer * DM; rss = (float*)(ws + WS_RSB); }
            pg8::Gemm g{A, Bt, M_TOK, 1024, K};
            pg8::StaticOrder S; S.init(M_TOK, 1024, G, bid);
            const bool first = (layer == 0 && sub == 0);
            EpiResid E{X, scale, xg, gn, rss, first ? P.in[0] : nullptr, first ? P.in[1] : nullptr, gaux, rss2, bss};
#ifndef SKIP_G2
            pg8::gemm_phase<EpiResid, pg8::StaticOrder, GEMM_ALIGN, GEMM_SP2>(lds, g, S, E);
#endif
        } else if (kind == K_NORM) {
            norm_rows(X, X, M_TOK, nullptr, P.in[9] + DM, X, nullptr, nullptr);
        } else if (kind == K_GEMM_P || kind == K_GEMM_QKV) {
            const bool isP = kind == K_GEMM_P; const int N = isP ? 3328 : 3072;
            pg8::Gemm g{XN, (const bf16_t*)(ws + (isP ? WS_WABI : WS_WATI)), M_TOK, N, 1024};
            pg8::StaticOrder S; S.init(M_TOK, N, G, bid);
            { float* zb = (float*)(ws + WS_RSB); for (int i = bid * 512 + opaque_tid(); i < M_TOK; i += G * 512) zb[i] = 0.f; }
            EpiSplit E; const float* rsa = (const float*)(ws + WS_RSA);
            if (isP) E = EpiSplit{(bf16_t*)(ws + WS_PUV), 1024, 4, (bf16_t*)(ws + WS_PRKVG), 2048, 12, (bf16_t*)(ws + WS_PWA), 256, rsa};
            else E = EpiSplit{(bf16_t*)(ws + WS_BIG), 3072, 12, (bf16_t*)(ws + WS_BIG), 3072, 12, (bf16_t*)(ws + WS_BIG), 3072, rsa};
#ifndef SKIP_G3
            pg8::gemm_phase<EpiSplit, pg8::StaticOrder, GEMM_ALIGN, GEMM_SP2>(lds, g, S, E);
#endif
        } else if (kind == K_MIXA) {
            constexpr int NLONG = 16 + 16 * (NSEG - 2) * 2;
            unsigned* qhead = (unsigned*)(ws + WS_TS + 2048);
            LAS int* qslot = (LAS int*)(lds + LDS_BYTES - 16);
            for (;;) {
                if (opaque_tid() == 0) *qslot = (int)__hip_atomic_fetch_add(qhead, 1u, __ATOMIC_RELAXED, __HIP_MEMORY_SCOPE_AGENT);
                __syncthreads();
                const int li = __builtin_amdgcn_readfirstlane(*qslot);
                __syncthreads();
                if (li >= 512 + NLONG + 640) break;
#ifndef SKIP_SCAN
                if (li < 512) scan_item<16>(P, li >> 4, (li >> 1) & 7, li & 1, 0, 0, 2048, 4 | 8, nullptr, nullptr, lds);
                else if (li < 512 + 16) {
                    const int hd = li - 512, dir = hd & 1;
                    scan_item<16>(P, 32, hd >> 1, dir, 0, dir == 0 ? 0 : 16384 - SEGLEN, SEGLEN, 4 | 8, nullptr, (float*)(ws + WS_STL) + (size_t)hd * NSEG * 4096, lds);
                } else if (li < 512 + NLONG) {
                    const int q = li - 512 - 16, hd = q & 15, isP = (q >> 4) & 1, sgm = 1 + (q >> 5), dir = hd & 1;
                    const int tb = dir == 0 ? sgm * SEGLEN : 16384 - (sgm + 1) * SEGLEN;
                    float* so = (float*)(ws + (isP ? WS_STP : WS_STL)) + ((size_t)hd * NSEG + sgm) * 4096;
                    scan_item<16>(P, 32, hd >> 1, dir, 0, tb, SEGLEN, isP ? (1 | 2) : 0, nullptr, so, lds);
                }
#endif
#ifndef SKIP_SGU
                if (li >= 512 + NLONG) sgu_item(P, li - 512 - NLONG, lds);
#endif
            }
        } else if (kind == K_CARRY) {
#ifndef SKIP_SCAN
            if (bid < 16) scan_carry(P, bid, lds);
#endif
        } else if (kind == K_MIXB) {
#ifndef SKIP_SCAN
            for (int li = bid; li < 16 * (NSEG - 1); li += G) {
                const int hd = li & 15, sgm = 1 + (li >> 4), dir = hd & 1;
                const int tb = dir == 0 ? sgm * SEGLEN : 16384 - (sgm + 1) * SEGLEN;
                scan_item<16>(P, 32, hd >> 1, dir, 0, tb, SEGLEN, 4 | 8, (const float*)(ws + WS_STS) + ((size_t)hd * NSEG + sgm) * 4096, nullptr, lds);
            }
#endif
        } else if (kind == K_FINAL) {
#ifndef SKIP_FIN
            rwkv_finalize(P);
#endif
        } else if (kind == K_ATTN) {
            for (int it = bid; it < 5120; it += G) {
#ifndef SKIP_ATTN
                if (it < 4096) attn_item(P, it >> 7, it & 15, (it >> 4) & 7, lds);
                else attn_item(P, 32, it & 15, (it - 4096) >> 4, lds);
#endif
            }
        }
        if (ph + 1 < N_PHASES) {
            __builtin_amdgcn_fence(__ATOMIC_RELEASE, "agent");
            asm volatile("s_waitcnt vmcnt(0) lgkmcnt(0)" ::: "memory");
            grid.sync();
            __builtin_amdgcn_fence(__ATOMIC_ACQUIRE, "agent");
            asm volatile("s_waitcnt vmcnt(0) lgkmcnt(0)" ::: "memory");
            __syncthreads();
        }
    }
#ifdef PROBE_MASK
    if (blockIdx.x == 0 && threadIdx.x == 0) {
        unsigned long long* ts = (unsigned long long*)(P.ws + WS_TS);
        ts[N_PHASES] = __builtin_amdgcn_s_memrealtime();
        unsigned long long tot = 0;
        for (int i = 0; i < N_PHASES; ++i) if ((PROBE_MASK >> i) & 1) tot += ts[i + 1] - ts[i];
        P.out[0] += 4.0f + 10.0f * (float)tot * 1e-5f;
    }
#endif
}

extern "C" void kernel_launch(void* const* d_in, const int* in_sizes, int n_in, void* d_out, int out_size, void* d_ws, size_t ws_size, hipStream_t stream) {
    static int grid_blocks = 0;
    if (!grid_blocks) {
        int dev = 0, cus = 0, per_cu = 0;
        (void)hipGetDevice(&dev);
        (void)hipDeviceGetAttribute(&cus, hipDeviceAttributeMultiprocessorCount, dev);
        (void)hipFuncSetAttribute((const void*)mega, hipFuncAttributeMaxDynamicSharedMemorySize, LDS_BYTES);
        (void)hipOccupancyMaxActiveBlocksPerMultiprocessor(&per_cu, (const void*)mega, 512, LDS_BYTES);
        (void)hipGetLastError();
        if (cus <= 0) cus = 256;
        grid_blocks = cus;
        if (ws_size < WS_END2) fprintf(stderr, "kernel_launch: workspace too small: %zu < %zu\n", ws_size, (size_t)WS_END2);
    }
    Params p{};
    for (int i = 0; i < 30 && i < n_in; ++i) p.in[i] = (const float*)d_in[i];
    p.out = (float*)d_out; p.ws = (unsigned char*)d_ws;
    void* args[] = {&p};
    hipError_t e = hipLaunchCooperativeKernel((const void*)mega, dim3(grid_blocks), dim3(512), args, LDS_BYTES, stream);
    if (e != hipSuccess) fprintf(stderr, "cooperative launch failed: %s (grid %d)\n", hipGetErrorString(e), grid_blocks);
}
```

```cpp
#include <hip/hip_runtime.h>
#include <hip/hip_cooperative_groups.h>
#include <cstdio>
namespace cg = cooperative_groups;

namespace pg8 {
#define PG8_LAS __attribute__((address_space(3)))
typedef unsigned short bf16_t;
typedef short bf16x8 __attribute__((ext_vector_type(8)));
typedef float f32x4 __attribute__((ext_vector_type(4)));
typedef unsigned u32x4 __attribute__((ext_vector_type(4)));
constexpr int BM = 256, BK = 64, HALF = 128, HTB = HALF * BK * 2  , STAGE_BYTES = 8 * HTB, NXCD = 8, WGM = 8;

__host__ __device__ __forceinline__ int lds_byte(int r, int c) { const int st = (r >> 4) * 2 + (c >> 5), rr = r & 15, cc = c & 31, ob = rr * 64 + cc * 2; return st * 1024 + (ob ^ (((ob >> 9) & 1) << 5)); }
__host__ __device__ __forceinline__ void stage_rc(int b, int& R, int& C) { const int st = b / 1024, sb = b % 1024, swz = sb ^ (((sb >> 9) & 1) << 5); R = (st >> 1) * 16 + swz / 64; C = (st & 1) * 32 + (swz % 64) / 2; }
__host__ __device__ __forceinline__ int perm32(int rho) { const int n = rho >> 4, i = rho & 15; return 8 * (i >> 2) + 4 * n + (i & 3); }

struct Unit { int pm, pn; };
struct Gemm { const bf16_t* A; const bf16_t* Bt; int M, N, K; };

struct StaticOrder {
    int nM, nN, nwg, G, c;
    __host__ __device__ void init(int M, int N, int G_, int c_) { nM = M / BM; nN = N / BM; nwg = nM * nN; G = G_; c = c_; }
    __host__ __device__ bool next(int i, Unit& u) const {
        const long L = (long)i * G + c; if (L >= nwg) return false;
        int wgid = (int)L; { const int q = nwg / NXCD, r = nwg % NXCD, xcd = wgid % NXCD, off = wgid / NXCD; wgid = (xcd < r ? xcd * (q + 1) : r * (q + 1) + (xcd - r) * q) + off; }
        const int nig = WGM * nN, gid = wgid / nig, fm = gid * WGM, gsz = (nM - fm) < WGM ? (nM - fm) : WGM;
        u.pm = fm + ((wgid % nig) % gsz); u.pn = (wgid % nig) / gsz; return true;
    }
    __device__ __forceinline__ void a_ready(const Unit&) const {}
    __device__ __forceinline__ void done(const Unit&) const {}
};
__device__ __forceinline__ unsigned cvt_pk_bf16(float lo, float hi) { unsigned r; asm volatile("v_cvt_pk_bf16_f32 %0, %1, %2" : "=v"(r) : "v"(lo), "v"(hi)); return r; }
typedef float f32x2 __attribute__((ext_vector_type(2)));
template <class Epi, class Sched, bool ALIGN_EPI = false, bool SP2 = false>
__device__ __forceinline__ void gemm_phase(PG8_LAS unsigned char* lds, const Gemm g, const Sched& S, const Epi& E) {
    int tid_raw_ = threadIdx.x; asm volatile("" : "+v"(tid_raw_)); const int tid = tid_raw_, wid = __builtin_amdgcn_readfirstlane(tid >> 6), lane = tid & 63, wr = wid >> 2, wc = wid & 3, fr = lane & 15, fq = lane >> 4;
    const int K = g.K, nt = K / BK;
    unsigned voffA[2], voffB[2];
#pragma unroll
    for (int i = 0; i < 2; ++i) { int R, C; stage_rc(tid * 16 + i * 8192, R, C); const int Rb = Epi::PERM ? ((R & ~31) + perm32(R & 31)) : R;
        voffA[i] = (unsigned)(R * K + C) * 2u; voffB[i] = (unsigned)(Rb * K + C) * 2u; }
    const size_t kstep = (size_t)(BK * 2);
    const size_t hstep = (size_t)HALF * K * 2;
    const size_t tstep = 2 * hstep;
    const unsigned ldsw = (unsigned)wid * 1024u;
    const int aoff = lds_byte(wr * 64 + fr, fq * 8), boff = lds_byte(wc * 32 + fr, fq * 8);
#define PG8_SA(b, h) (((b) * 2 + (h)) * HTB)
#define PG8_SB(b, h) ((4 + (b) * 2 + (h)) * HTB)
#define PG8_STAGE(bufoff, gbase, voff) do { _Pragma("unroll") for (int _i = 0; _i < 2; ++_i) \
        __builtin_amdgcn_global_load_lds((const unsigned*)((const char*)(gbase) + (voff)[_i]), (PG8_LAS unsigned*)(lds + (bufoff) + ldsw + _i * 8192), 16, 0, 0); } while (0)
#define PG8_LDA(dst, b, h) do { _Pragma("unroll") for (int m = 0; m < 4; ++m) _Pragma("unroll") for (int k = 0; k < 2; ++k) dst[m][k] = *(const PG8_LAS bf16x8*)(lds + PG8_SA(b, h) + aoff + m * 2048 + k * 1024); } while (0)
#define PG8_LDB(dst, b, h) do { _Pragma("unroll") for (int n = 0; n < 2; ++n) _Pragma("unroll") for (int k = 0; k < 2; ++k) dst[n][k] = *(const PG8_LAS bf16x8*)(lds + PG8_SB(b, h) + boff + n * 2048 + k * 1024); } while (0)
#define PG8_MMA(ai, bj, At, Bt) do { __builtin_amdgcn_s_setprio(1); _Pragma("unroll") for (int m = 0; m < 4; ++m) _Pragma("unroll") for (int n = 0; n < 2; ++n) _Pragma("unroll") for (int k = 0; k < 2; ++k) \
        acc[ai][bj][m][n] = __builtin_amdgcn_mfma_f32_16x16x32_bf16(Bt[n][k], At[m][k], acc[ai][bj][m][n], 0, 0, 0); __builtin_amdgcn_s_setprio(0); } while (0)
#define PG8_WAIT_V(n) asm volatile("s_waitcnt vmcnt(" #n ")" ::: "memory")
#define PG8_WAIT_L(n) asm volatile("s_waitcnt lgkmcnt(" #n ")" ::: "memory")
#define PG8_BAR __builtin_amdgcn_s_barrier()
#define PG8_SCHED __builtin_amdgcn_sched_barrier(0)
    Unit cur, nxt; int ui = 0;
    if (!S.next(0, cur)) return;
    f32x4 acc[2][2][4][2];
#pragma unroll
    for (int a = 0; a < 2; ++a)
#pragma unroll
        for (int b = 0; b < 2; ++b)
#pragma unroll
            for (int m = 0; m < 4; ++m)
#pragma unroll
                for (int n = 0; n < 2; ++n) acc[a][b][m][n] = (f32x4){0.f, 0.f, 0.f, 0.f};
    bf16x8 At[4][2], B0[2][2], B1[2][2];
    const char* cA = (const char*)g.A + (size_t)cur.pm * tstep; const char* cB = (const char*)g.Bt + (size_t)cur.pn * tstep;
    S.a_ready(cur);
    if constexpr (SP2) {
        PG8_STAGE(PG8_SB(0, 0), cB, voffB); PG8_STAGE(PG8_SB(0, 1), cB + hstep, voffB); PG8_STAGE(PG8_SA(0, 0), cA, voffA); PG8_STAGE(PG8_SA(0, 1), cA + hstep, voffA);
        if (wr == 1) PG8_BAR;
        PG8_WAIT_V(2); PG8_BAR;
        PG8_STAGE(PG8_SB(1, 0), cB + kstep, voffB); PG8_STAGE(PG8_SA(1, 0), cA + kstep, voffA); PG8_STAGE(PG8_SB(1, 1), cB + hstep + kstep, voffB);
        PG8_WAIT_V(6); PG8_BAR;
    } else {
        PG8_STAGE(PG8_SB(0, 0), cB, voffB); PG8_STAGE(PG8_SA(0, 0), cA, voffA); PG8_STAGE(PG8_SB(0, 1), cB + hstep, voffB); PG8_STAGE(PG8_SA(0, 1), cA + hstep, voffA);
        if (wr == 1) PG8_BAR;
        PG8_WAIT_V(4); PG8_BAR;
        PG8_STAGE(PG8_SB(1, 0), cB + kstep, voffB); PG8_STAGE(PG8_SA(1, 0), cA + kstep, voffA); PG8_STAGE(PG8_SB(1, 1), cB + hstep + kstep, voffB);
        PG8_WAIT_V(6); PG8_BAR;
    }
    for (;;) {
        const bool has_next = S.next(ui + 1, nxt);
        const char* nA = has_next ? (const char*)g.A + (size_t)nxt.pm * tstep : cA; const char* nB = has_next ? (const char*)g.Bt + (size_t)nxt.pn * tstep : cB;
        for (int t = 0; t < nt; t += 2) {
            const bool last = (t == nt - 2);
            const char* a1 = cA + (size_t)(t + 1) * kstep;
            const char* a2 = last ? nA : cA + (size_t)(t + 2) * kstep; const char* b2 = last ? nB : cB + (size_t)(t + 2) * kstep;
            const char* a3 = a2 + kstep; const char* b3 = b2 + kstep;
            if (last && has_next) S.a_ready(nxt);
            if constexpr (SP2) {
            PG8_LDB(B0, 0, 0); PG8_LDB(B1, 0, 1); PG8_SCHED; PG8_LDA(At, 0, 0); PG8_STAGE(PG8_SA(1, 1), a1 + hstep, voffA);
            PG8_WAIT_V(8); PG8_WAIT_L(0); PG8_BAR; PG8_MMA(0, 0, At, B0); PG8_MMA(0, 1, At, B1); PG8_BAR; PG8_SCHED;
            PG8_LDA(At, 0, 1); PG8_STAGE(PG8_SB(0, 0), b2, voffB); PG8_STAGE(PG8_SB(0, 1), b2 + hstep, voffB); PG8_STAGE(PG8_SA(0, 0), a2, voffA);
            PG8_WAIT_V(8); PG8_WAIT_L(0); PG8_BAR; PG8_MMA(1, 0, At, B0); PG8_MMA(1, 1, At, B1); PG8_BAR; PG8_SCHED;
            PG8_LDB(B0, 1, 0); PG8_LDB(B1, 1, 1); PG8_SCHED; PG8_LDA(At, 1, 0); PG8_STAGE(PG8_SA(0, 1), a2 + hstep, voffA);
            PG8_WAIT_V(8); PG8_WAIT_L(0); PG8_BAR; PG8_MMA(0, 0, At, B0); PG8_MMA(0, 1, At, B1); PG8_BAR; PG8_SCHED;
            PG8_LDA(At, 1, 1); PG8_STAGE(PG8_SB(1, 0), b3, voffB); PG8_STAGE(PG8_SB(1, 1), b3 + hstep, voffB); PG8_STAGE(PG8_SA(1, 0), a3, voffA);
            PG8_WAIT_V(8); PG8_WAIT_L(0); PG8_BAR; PG8_MMA(1, 0, At, B0); PG8_MMA(1, 1, At, B1); PG8_BAR; PG8_SCHED;
            } else {
            PG8_LDB(B0, 0, 0); PG8_SCHED; PG8_LDA(At, 0, 0); PG8_STAGE(PG8_SA(1, 1), a1 + hstep, voffA);
            PG8_WAIT_L(8); PG8_BAR; PG8_WAIT_L(0); PG8_MMA(0, 0, At, B0); PG8_BAR; PG8_SCHED;
            PG8_LDB(B1, 0, 1); PG8_STAGE(PG8_SB(0, 0), b2, voffB);
            PG8_BAR; PG8_WAIT_L(0); PG8_MMA(0, 1, At, B1); PG8_BAR;
            PG8_LDA(At, 0, 1); PG8_STAGE(PG8_SA(0, 0), a2, voffA);
            PG8_BAR; PG8_WAIT_L(0); PG8_MMA(1, 0, At, B0); PG8_BAR; PG8_SCHED;
            PG8_STAGE(PG8_SB(0, 1), b2 + hstep, voffB);
            PG8_WAIT_V(6); PG8_BAR; PG8_MMA(1, 1, At, B1); PG8_BAR;
            PG8_LDB(B0, 1, 0); PG8_SCHED; PG8_LDA(At, 1, 0); PG8_STAGE(PG8_SA(0, 1), a2 + hstep, voffA);
            PG8_WAIT_L(8); PG8_BAR; PG8_WAIT_L(0); PG8_MMA(0, 0, At, B0); PG8_BAR; PG8_SCHED;
            PG8_LDB(B1, 1, 1); PG8_STAGE(PG8_SB(1, 0), b3, voffB);
            PG8_BAR; PG8_WAIT_L(0); PG8_MMA(0, 1, At, B1); PG8_BAR;
            PG8_LDA(At, 1, 1); PG8_STAGE(PG8_SA(1, 0), a3, voffA);
            PG8_BAR; PG8_WAIT_L(0); PG8_MMA(1, 0, At, B0); PG8_BAR; PG8_SCHED;
            PG8_STAGE(PG8_SB(1, 1), b3 + hstep, voffB);
            PG8_WAIT_V(6); PG8_BAR; PG8_MMA(1, 1, At, B1); PG8_BAR;
            }
        }
        if constexpr (ALIGN_EPI) { if (wr == 0) PG8_BAR; }
        if constexpr (!Epi::AFTER_DRAIN) { E(acc, cur, wr, wc, fr, fq); S.done(cur); }
        if (!has_next) break;
#pragma unroll
        for (int a = 0; a < 2; ++a)
#pragma unroll
            for (int b = 0; b < 2; ++b)
#pragma unroll
                for (int m = 0; m < 4; ++m)
#pragma unroll
                    for (int n = 0; n < 2; ++n) acc[a][b][m][n] = (f32x4){0.f, 0.f, 0.f, 0.f};
        cur = nxt; cA = nA; cB = nB; ++ui;
        if constexpr (ALIGN_EPI) { if (wr == 1) PG8_BAR; }
    }
    PG8_WAIT_V(0);
    if constexpr (!ALIGN_EPI) { if (wr == 0) PG8_BAR; }
    PG8_BAR;
    if constexpr (Epi::AFTER_DRAIN) { E.fused(acc, cur, wr, wc, fr, fq, lds, wid, lane); S.done(cur); }
#undef PG8_SA
#undef PG8_SB
#undef PG8_STAGE
#undef PG8_LDA
#undef PG8_LDB
#undef PG8_MMA
#undef PG8_WAIT_V
#undef PG8_WAIT_L
#undef PG8_BAR
#undef PG8_SCHED
}
}


#define LAS __attribute__((address_space(3)))
typedef unsigned short bf16_t;
typedef short bf16x8 __attribute__((ext_vector_type(8)));
typedef short s16x4 __attribute__((ext_vector_type(4)));
typedef float f32x4 __attribute__((ext_vector_type(4)));
typedef unsigned u32x4 __attribute__((ext_vector_type(4)));
typedef unsigned u32x2 __attribute__((ext_vector_type(2)));

constexpr int M_TOK = 81920, M_PROMPT = 65536, DM = 1024, DFF = 2816;
constexpr int LDS_BYTES = 147456;
#ifndef GEMM_ALIGN
#define GEMM_ALIGN true
#endif
#ifndef GEMM_SP2
#define GEMM_SP2 true
#endif
constexpr float NORM_EPS = 1e-6f;

constexpr size_t SZ_WFI = (size_t)5632 * 1024 * 2, SZ_WFO = (size_t)1024 * 2816 * 2;
constexpr size_t WS_WFI = 0;
constexpr size_t WS_WFO = WS_WFI + 4 * SZ_WFI;
constexpr size_t WS_WABI = WS_WFO + 4 * SZ_WFO;
constexpr size_t WS_WABO = WS_WABI + (size_t)3328 * 1024 * 2;
constexpr size_t WS_WATI = WS_WABO + (size_t)1024 * 1024 * 2;
constexpr size_t WS_WATO = WS_WATI + (size_t)3072 * 1024 * 2;
constexpr size_t WS_LORA = WS_WATO + (size_t)1024 * 1024 * 2;
constexpr size_t WS_SGUW = WS_LORA + (size_t)4 * 512 * 64 * 2;
constexpr size_t WS_RKR = WS_SGUW + (size_t)4 * 128 * 128 * 2;
constexpr size_t WS_XN = (WS_RKR + (size_t)2 * M_TOK * 8 * 4 + 4095) & ~(size_t)4095;
constexpr size_t WS_BIG = WS_XN + (size_t)M_TOK * 1024 * 2;
constexpr size_t WS_PUV = WS_BIG;
constexpr size_t WS_PRKVG = WS_PUV + (size_t)M_TOK * 1024 * 2;
constexpr size_t WS_PWA = WS_PRKVG + (size_t)M_TOK * 2048 * 2;
constexpr size_t WS_Y = WS_BIG + (size_t)M_TOK * 3328 * 2;
constexpr size_t WS_END = WS_Y + (size_t)2 * M_TOK * 512 * 2;

constexpr int NSEG = 16, SEGLEN = 16384 / NSEG;
constexpr size_t WS_STL = (WS_END + 4095) & ~(size_t)4095;
constexpr size_t WS_STP = WS_STL + (size_t)16 * NSEG * 4096 * 4;
constexpr size_t WS_STS = WS_STP + (size_t)16 * NSEG * 4096 * 4;
constexpr size_t WS_TS = WS_STS + (size_t)16 * NSEG * 4096 * 4;
constexpr size_t WS_RSA = WS_TS + 4096;
constexpr size_t WS_RSB = WS_RSA + (size_t)M_TOK * 4;
constexpr size_t WS_RSC = WS_RSB + (size_t)M_TOK * 4;
constexpr size_t WS_RSD = WS_RSC + (size_t)M_TOK * 4;
constexpr size_t WS_KSQ = WS_RSD + (size_t)M_TOK * 4;
constexpr size_t WS_END2 = WS_KSQ + (size_t)16 * M_TOK * 4;
struct Params { const float* in[30]; float* out; unsigned char* ws; };

__device__ __forceinline__ float bflo(unsigned w) { return __uint_as_float(w << 16); }
__device__ __forceinline__ float bfhi(unsigned w) { return __uint_as_float(w & 0xffff0000u); }
__device__ __forceinline__ unsigned pk2(float lo, float hi) { unsigned r; asm("v_cvt_pk_bf16_f32 %0, %1, %2" : "=v"(r) : "v"(lo), "v"(hi)); return r; }
__device__ __forceinline__ void unpack8(const u32x4 w, float* f) { f[0] = bflo(w.x); f[1] = bfhi(w.x); f[2] = bflo(w.y); f[3] = bfhi(w.y); f[4] = bflo(w.z); f[5] = bfhi(w.z); f[6] = bflo(w.w); f[7] = bfhi(w.w); }
__device__ __forceinline__ u32x4 pack8(const float* f) { u32x4 w; w.x = pk2(f[0], f[1]); w.y = pk2(f[2], f[3]); w.z = pk2(f[4], f[5]); w.w = pk2(f[6], f[7]); return w; }
__device__ __forceinline__ float sigmoidf_(float x) { return __builtin_amdgcn_rcpf(1.0f + __expf(-x)); }
__device__ __forceinline__ float siluf_(float x) { return x * sigmoidf_(x); }
__device__ __forceinline__ float gelu_tanh(float x) { const float u = 0.7978845608028654f * (x + 0.044715f * x * x * x); return x * sigmoidf_(2.0f * u); }
__device__ __forceinline__ float tanhf_(float x) { return 1.0f - 2.0f * __builtin_amdgcn_rcpf(__expf(2.0f * x) + 1.0f); }
__device__ __forceinline__ float wave_sum(float x) { x += __shfl_xor(x, 32); x += __shfl_xor(x, 16); x += __shfl_xor(x, 8); x += __shfl_xor(x, 4); x += __shfl_xor(x, 2); x += __shfl_xor(x, 1); return x; }
template <int CTRL> __device__ __forceinline__ float dppf(float x) { return __int_as_float(__builtin_amdgcn_update_dpp(0, __float_as_int(x), CTRL, 0xF, 0xF, true)); }
__device__ __forceinline__ float reduce8(float x) { x += dppf<0xB1>(x); x += dppf<0x4E>(x); x += dppf<0x141>(x); return x; }
typedef short v4i16_t __attribute__((ext_vector_type(4)));
typedef __bf16 bf16x2_t __attribute__((ext_vector_type(2)));
__device__ __forceinline__ s16x4 tr_read(LAS const unsigned char* p) { return __builtin_bit_cast(s16x4, __builtin_amdgcn_ds_read_tr16_b64_v4i16((LAS v4i16_t*)p)); }
__device__ __forceinline__ f32x4 mfma16(bf16x8 a, bf16x8 b, f32x4 c) { return __builtin_amdgcn_mfma_f32_16x16x32_bf16(a, b, c, 0, 0, 0); }

__device__ __forceinline__ int opaque_tid() { int t = threadIdx.x; asm volatile("" : "+v"(t)); return t; }
__device__ __forceinline__ unsigned char* opaque_ptr(unsigned char* p) { size_t z = 0; asm volatile("" : "+s"(z)); return p + z; }
struct EpiSwiglu {
    static constexpr bool PERM = false, AFTER_DRAIN = false;
    bf16_t* H; const float* rowss; const float* rowss2;
    __device__ __forceinline__ void operator()(const f32x4 (&acc)[2][2][4][2], const pg8::Unit& u, int wr, int wc, int fr, int fq) const {
        const int row0 = u.pm * 256 + wr * 64 + fr, col0 = u.pn * 128 + wc * 32 + 8 * fq;
        float rsv[8];
#pragma unroll
        for (int gi = 0; gi < 8; ++gi) rsv[gi] = rowss ? rowss[row0 + (gi >> 2) * 128 + (gi & 3) * 16] : 0.f;
        float rsw[8];
#pragma unroll
        for (int gi = 0; gi < 8; ++gi) rsw[gi] = rowss2 ? rowss2[row0 + (gi >> 2) * 128 + (gi & 3) * 16] : 0.f;
#pragma unroll
        for (int gi = 0; gi < 8; ++gi) { rsv[gi] = rowss ? rsqrtf(rsv[gi] * (1.0f / DM) + NORM_EPS) : 1.0f;
            if (rowss2) rsv[gi] *= rsqrtf(rsv[gi] * rsv[gi] * rsw[gi] * (1.0f / DM) + NORM_EPS); }
#pragma unroll
        for (int ai = 0; ai < 2; ++ai)
#pragma unroll
            for (int m = 0; m < 4; ++m) {
                const int row = row0 + ai * 128 + m * 16;
                const float rs = rsv[ai * 4 + m];
                bf16_t* rowp = H + (size_t)row * DFF + col0;
                float h[8];
#pragma unroll
                for (int bj = 0; bj < 2; ++bj)
#pragma unroll
                    for (int j = 0; j < 4; ++j) h[bj * 4 + j] = siluf_(acc[ai][bj][m][0][j] * rs) * (acc[ai][bj][m][1][j] * rs);
                *(u32x4*)rowp = pack8(h);
                asm volatile("" ::: "memory");
            }
    }
};
struct EpiResid {
    static constexpr bool PERM = false, AFTER_DRAIN = false;
    float* X; float scale; bf16_t* XG; const float* g; float* rowss; const float* xin_a; const float* xin_b;
    const float* gaux; float* rowss2; const float* base_ss;
    __device__ __forceinline__ void operator()(const f32x4 (&acc)[2][2][4][2], const pg8::Unit& u, int wr, int wc, int fr, int fq) const {
        const int row0 = u.pm * 256 + wr * 64 + fr, col0 = u.pn * 256 + wc * 32 + 4 * fq;
        f32x4 gv[2][2];
#pragma unroll
        for (int bj = 0; bj < 2; ++bj)
#pragma unroll
            for (int n = 0; n < 2; ++n) gv[bj][n] = XG ? *(const f32x4*)(g + col0 + bj * 128 + n * 16) : (f32x4){0.f, 0.f, 0.f, 0.f};
        f32x4 ga[2][2];
#pragma unroll
        for (int bj = 0; bj < 2; ++bj)
#pragma unroll
            for (int n = 0; n < 2; ++n) { ga[bj][n] = gaux ? *(const f32x4*)(gaux + col0 + bj * 128 + n * 16) : (f32x4){1.f, 1.f, 1.f, 1.f}; if (rowss2) gv[bj][n] = gv[bj][n] * ga[bj][n]; }
        float brs[8];
#pragma unroll
        for (int gi = 0; gi < 8; ++gi) brs[gi] = base_ss ? base_ss[row0 + (gi >> 2) * 128 + (gi & 3) * 16] : 0.f;
#pragma unroll
        for (int gi = 0; gi < 8; ++gi) brs[gi] = base_ss ? rsqrtf(brs[gi] * (1.0f / DM) + NORM_EPS) : 1.0f;
        const float* Xs = xin_a ? (u.pm < 256 ? xin_a : xin_b - (size_t)M_PROMPT * DM) : X;
        f32x4 xin[2][2][2];
#pragma unroll
        for (int gi = 0; gi < 9; ++gi) {
            if (gi < 8) {
                const float* rowp = Xs + (size_t)(row0 + (gi >> 2) * 128 + (gi & 3) * 16) * DM + col0;
#pragma unroll
                for (int bj = 0; bj < 2; ++bj)
#pragma unroll
                    for (int n = 0; n < 2; ++n) xin[gi & 1][bj][n] = *(const f32x4*)(rowp + bj * 128 + n * 16);
            }
            if (gi > 0) {
                const int gp = gi - 1, ai = gp >> 2, m = gp & 3;
                const int row = row0 + ai * 128 + m * 16;
                float* rowp = X + (size_t)row * DM + col0;
                float ssq = 0.f, ssq2 = 0.f;
#pragma unroll
                for (int bj = 0; bj < 2; ++bj)
#pragma unroll
                    for (int n = 0; n < 2; ++n) { f32x4 v = xin[gp & 1][bj][n]; if (base_ss) v = v * brs[gp] * ga[bj][n];
                        v += acc[ai][bj][m][n] * scale; *(f32x4*)(rowp + bj * 128 + n * 16) = v;
                        if (XG) { ssq += (v[0] * v[0] + v[1] * v[1]) + (v[2] * v[2] + v[3] * v[3]); const f32x4 o = v * gv[bj][n]; u32x2 w; w.x = pk2(o[0], o[1]); w.y = pk2(o[2], o[3]);
                            *(u32x2*)(XG + (size_t)row * DM + col0 + bj * 128 + n * 16) = w; }
                        if (rowss2) { const f32x4 t = v * ga[bj][n]; ssq2 += (t[0] * t[0] + t[1] * t[1]) + (t[2] * t[2] + t[3] * t[3]); } }
                if (XG) { ssq += __shfl_xor(ssq, 16); ssq += __shfl_xor(ssq, 32);
                    if (fq == 0) __hip_atomic_fetch_add(rowss + row, ssq, __ATOMIC_RELAXED, __HIP_MEMORY_SCOPE_AGENT); }
                if (rowss2) { ssq2 += __shfl_xor(ssq2, 16); ssq2 += __shfl_xor(ssq2, 32);
                    if (fq == 0) __hip_atomic_fetch_add(rowss2 + row, ssq2, __ATOMIC_RELAXED, __HIP_MEMORY_SCOPE_AGENT); }
            }
            asm volatile("" ::: "memory");
        }
    }
};
struct EpiSplit {
    static constexpr bool PERM = true, AFTER_DRAIN = false;
    bf16_t* b0; int ld0, t0; bf16_t* b1; int ld1, t1; bf16_t* b2; int ld2; const float* rowss; float* ksq;
    __device__ __forceinline__ void operator()(const f32x4 (&acc)[2][2][4][2], const pg8::Unit& u, int wr, int wc, int fr, int fq) const {
        bf16_t* base; int ld, ct;
        if (u.pn < t0) { base = b0; ld = ld0; ct = u.pn; } else if (u.pn < t1) { base = b1; ld = ld1; ct = u.pn - t0; } else { base = b2; ld = ld2; ct = u.pn - t1; }
        const int row0 = u.pm * 256 + wr * 64 + fr, col0 = ct * 256 + wc * 32 + 8 * fq;
        const bool isk = ksq != nullptr && u.pn >= 4 && u.pn < 8;
        float rsv[8];
#pragma unroll
        for (int gi = 0; gi < 8; ++gi) rsv[gi] = rowss[row0 + (gi >> 2) * 128 + (gi & 3) * 16];
#pragma unroll
        for (int gi = 0; gi < 8; ++gi) rsv[gi] = rsqrtf(rsv[gi] * (1.0f / DM) + NORM_EPS);
#pragma unroll
        for (int ai = 0; ai < 2; ++ai)
#pragma unroll
            for (int m = 0; m < 4; ++m) {
                const int row = row0 + ai * 128 + m * 16;
                const float rs = rsv[ai * 4 + m];
                bf16_t* rowp = base + (size_t)row * ld + col0;
#pragma unroll
                for (int bj = 0; bj < 2; ++bj) {
                    const f32x4 v0 = acc[ai][bj][m][0] * rs, v1 = acc[ai][bj][m][1] * rs;
                    u32x4 w; w.x = pk2(v0[0], v0[1]); w.y = pk2(v0[2], v0[3]); w.z = pk2(v1[0], v1[1]); w.w = pk2(v1[2], v1[3]);
                    *(u32x4*)(rowp + bj * 128) = w;
                    if (isk) {
                        float sq = ((v0[0] * v0[0] + v0[1] * v0[1]) + (v0[2] * v0[2] + v0[3] * v0[3])) + ((v1[0] * v1[0] + v1[1] * v1[1]) + (v1[2] * v1[2] + v1[3] * v1[3]));
                        sq += __shfl_xor(sq, 16); sq += __shfl_xor(sq, 32);
                        if (fq == 0) __hip_atomic_fetch_add(ksq + (size_t)((u.pn - 4) * 4 + 2 * bj + (wc >> 1)) * M_TOK + row, sq, __ATOMIC_RELAXED, __HIP_MEMORY_SCOPE_AGENT);
                    }
                }
                asm volatile("" ::: "memory");
            }
    }
};

template <int MAP> __device__ __forceinline__ int src_col(int s) {
    if (MAP == 0) return s;
    const int pn = s >> 8, bj = (s >> 7) & 1, wc = (s >> 5) & 3, n = (s >> 4) & 1, fq = (s >> 2) & 3, jj = s & 3;
    return n * DFF + 128 * pn + 32 * wc + 8 * fq + 4 * bj + jj;
}
template <int MAP> __device__ void convert_T(const float* __restrict__ src, bf16_t* __restrict__ dst, int K, int N, LAS float* tile, int rot) {
    const int tk = K / 64, tn = N / 64, nt = tk * tn, tid = opaque_tid(), G = gridDim.x;
    const int kk0 = tid >> 4, sg = tid & 15;
    int t = (int)((blockIdx.x + rot) % G);
    float4 va = make_float4(0.f, 0.f, 0.f, 0.f), vb = va;
    if (t < nt) { const int k0 = (t % tk) * 64, s0 = (t / tk) * 64; const int c = src_col<MAP>(s0 + sg * 4);
        va = *(const float4*)(src + (size_t)(k0 + kk0) * N + c); vb = *(const float4*)(src + (size_t)(k0 + kk0 + 32) * N + c); }
    for (; t < nt; t += G) {
        const int k0 = (t % tk) * 64, s0 = (t / tk) * 64;
        { LAS float* tp = tile + kk0 * 65 + sg * 4; tp[0] = va.x; tp[1] = va.y; tp[2] = va.z; tp[3] = va.w;
          LAS float* tq = tile + (kk0 + 32) * 65 + sg * 4; tq[0] = vb.x; tq[1] = vb.y; tq[2] = vb.z; tq[3] = vb.w; }
        if (t + G < nt) {
            const int t2 = t + G, k2 = (t2 % tk) * 64, s2 = (t2 / tk) * 64; const int c = src_col<MAP>(s2 + sg * 4);
            va = *(const float4*)(src + (size_t)(k2 + kk0) * N + c); vb = *(const float4*)(src + (size_t)(k2 + kk0 + 32) * N + c); }
        asm volatile("s_waitcnt lgkmcnt(0)" ::: "memory"); __builtin_amdgcn_s_barrier(); asm volatile("" ::: "memory");
        {
            const int slot = tid >> 3, kc = tid & 7; float f[8];
#pragma unroll
            for (int i = 0; i < 8; ++i) f[i] = tile[(kc * 8 + i) * 65 + slot];
            *(u32x4*)(dst + (size_t)(s0 + slot) * K + k0 + kc * 8) = pack8(f);
        }
        asm volatile("s_waitcnt lgkmcnt(0)" ::: "memory"); __builtin_amdgcn_s_barrier(); asm volatile("" ::: "memory");
    }
}

__device__ void norm_rows(const float* xa, const float* xb, int split, float* xcopy, const float* g1, float* x1out, const float* g2, bf16_t* xn) {
    const int tid_ = opaque_tid(), lane = tid_ & 63, wave = __builtin_amdgcn_readfirstlane(tid_ >> 6);
    const int stride = gridDim.x * 8;
    for (int row0 = blockIdx.x * 8 + wave; row0 < M_TOK; row0 += 2 * stride) {
        int rows[2]; rows[0] = row0; rows[1] = (row0 + stride < M_TOK) ? row0 + stride : row0;
        f32x4 v[2][4]; float ss[2] = {0.f, 0.f};
#pragma unroll
        for (int q = 0; q < 2; ++q) { const int row = rows[q];
            const float* src = (row < split) ? xa + (size_t)row * DM : xb + (size_t)(row - split) * DM;
#pragma unroll
            for (int i = 0; i < 4; ++i) v[q][i] = *(const f32x4*)(src + i * 256 + lane * 4); }
#pragma unroll
        for (int q = 0; q < 2; ++q) {
#pragma unroll
            for (int i = 0; i < 4; ++i) ss[q] += v[q][i][0] * v[q][i][0] + v[q][i][1] * v[q][i][1] + v[q][i][2] * v[q][i][2] + v[q][i][3] * v[q][i][3];
            if (xcopy) {
#pragma unroll
                for (int i = 0; i < 4; ++i) *(f32x4*)(xcopy + (size_t)rows[q] * DM + i * 256 + lane * 4) = v[q][i];
            }
        }
        ss[0] = wave_sum(ss[0]); ss[1] = wave_sum(ss[1]);
        float r[2]; r[0] = rsqrtf(ss[0] * (1.0f / DM) + NORM_EPS); r[1] = rsqrtf(ss[1] * (1.0f / DM) + NORM_EPS);
        if (g1) {
            float s2[2] = {0.f, 0.f};
#pragma unroll
            for (int i = 0; i < 4; ++i) { const f32x4 g = *(const f32x4*)(g1 + i * 256 + lane * 4);
#pragma unroll
                for (int q = 0; q < 2; ++q) { v[q][i] = v[q][i] * r[q] * g; *(f32x4*)(x1out + (size_t)rows[q] * DM + i * 256 + lane * 4) = v[q][i];
                    s2[q] += v[q][i][0] * v[q][i][0] + v[q][i][1] * v[q][i][1] + v[q][i][2] * v[q][i][2] + v[q][i][3] * v[q][i][3]; } }
            s2[0] = wave_sum(s2[0]); s2[1] = wave_sum(s2[1]);
            r[0] = rsqrtf(s2[0] * (1.0f / DM) + NORM_EPS); r[1] = rsqrtf(s2[1] * (1.0f / DM) + NORM_EPS);
        }
        if (g2) {
#pragma unroll
            for (int i = 0; i < 4; ++i) { const f32x4 g = *(const f32x4*)(g2 + i * 256 + lane * 4);
#pragma unroll
                for (int q = 0; q < 2; ++q) { const f32x4 o = v[q][i] * r[q] * g;
                    u32x2 w; w.x = pk2(o[0], o[1]); w.y = pk2(o[2], o[3]); *(u32x2*)(xn + (size_t)rows[q] * DM + i * 256 + lane * 4) = w; } }
        }
    }
}

__device__ void sgu_item(const Params& PP, int chunk, LAS unsigned char* lds) {
    Params P = PP; P.ws = opaque_ptr(PP.ws);
    const int tid = opaque_tid(), lane = tid & 63, wave = __builtin_amdgcn_readfirstlane(tid >> 6), l15 = lane & 15, quad = lane >> 4;
    constexpr int PITCH = 1056;
    const bf16_t* Puv = (const bf16_t*)(P.ws + WS_PUV);
    bf16_t* MO = (bf16_t*)(P.ws + WS_XN);
    const size_t row0 = (size_t)chunk * 128;
    {
        float gn[8];
        { const f32x4 a = *(const f32x4*)(P.in[12] + lane * 8), b = *(const f32x4*)(P.in[12] + lane * 8 + 4); gn[0] = a[0]; gn[1] = a[1]; gn[2] = a[2]; gn[3] = a[3]; gn[4] = b[0]; gn[5] = b[1]; gn[6] = b[2]; gn[7] = b[3]; }
        for (int i = 0; i < 16; ++i) {
            const int p = wave * 16 + i;
            const u32x4 raw = *(const u32x4*)(Puv + (row0 + p) * 1024 + 512 + lane * 8);
            float v[8]; unpack8(raw, v); float ss = 0.f;
#pragma unroll
            for (int e = 0; e < 8; ++e) { v[e] = gelu_tanh(v[e]); ss += v[e] * v[e]; }
            ss = wave_sum(ss);
            const float r = rsqrtf(ss * (1.0f / 512.0f) + NORM_EPS);
#pragma unroll
            for (int e = 0; e < 8; ++e) v[e] = v[e] * r * gn[e];
            *(LAS u32x4*)(lds + p * PITCH + lane * 16) = pack8(v);
        }
    }
    __syncthreads();
    const int g = wave >> 1, cbase = (wave >> 1) * 128 + (wave & 1) * 64;
    const bf16_t* Wg = (const bf16_t*)(P.ws + WS_SGUW) + (size_t)g * 128 * 128;
    const int r4 = l15 >> 2, c4 = l15 & 3;
    for (int qh = 0; qh < 2; ++qh) {
        f32x4 acc[4][4];
#pragma unroll
        for (int a = 0; a < 4; ++a)
#pragma unroll
            for (int b = 0; b < 4; ++b) acc[a][b] = (f32x4){0.f, 0.f, 0.f, 0.f};
#pragma unroll
        for (int ks = 0; ks < 4; ++ks) {
            bf16x8 bfr[4];
#pragma unroll
            for (int qt = 0; qt < 4; ++qt) bfr[qt] = *(const bf16x8*)(Wg + (size_t)(qh * 64 + qt * 16 + l15) * 128 + ks * 32 + quad * 8);
#pragma unroll
            for (int ct = 0; ct < 4; ++ct) {
                LAS const unsigned char* ap = lds + (ks * 32 + quad * 8 + r4) * PITCH + (cbase + ct * 16 + 4 * c4) * 2;
                const s16x4 lo = tr_read(ap), hi = tr_read(ap + 4 * PITCH);
                const bf16x8 a = {lo[0], lo[1], lo[2], lo[3], hi[0], hi[1], hi[2], hi[3]};
#pragma unroll
                for (int qt = 0; qt < 4; ++qt) acc[ct][qt] = mfma16(a, bfr[qt], acc[ct][qt]);
            }
        }
#pragma unroll
        for (int qt = 0; qt < 4; ++qt) {
            const int q = qh * 64 + qt * 16 + l15;
            const float bq = P.in[14][g * 128 + q];
#pragma unroll
            for (int ct = 0; ct < 4; ++ct) {
                const int c = cbase + ct * 16 + quad * 4;
                const u32x2 ur = *(const u32x2*)(Puv + (row0 + q) * 1024 + c);
                const float u0 = gelu_tanh(bflo(ur.x)), u1 = gelu_tanh(bfhi(ur.x)), u2 = gelu_tanh(bflo(ur.y)), u3 = gelu_tanh(bfhi(ur.y));
                u32x2 w; w.x = pk2(u0 * (acc[ct][qt][0] + bq), u1 * (acc[ct][qt][1] + bq)); w.y = pk2(u2 * (acc[ct][qt][2] + bq), u3 * (acc[ct][qt][3] + bq));
                *(u32x2*)(MO + (row0 + q) * 1024 + c) = w;
            }
        }
    }
    __syncthreads();
}

template <int LPR> __device__ __forceinline__ float reduce_row(float x) {
    x += dppf<0xB1>(x); x += dppf<0x4E>(x); x += dppf<0x141>(x);
    if (LPR == 16) x += dppf<0x140>(x);
    return x;
}
__device__ __forceinline__ float reduce32(float x) {
    x += dppf<0xB1>(x); x += dppf<0x4E>(x); x += dppf<0x141>(x); x += dppf<0x140>(x); x += __shfl_xor(x, 16); return x;
}
__device__ __forceinline__ void lds_barrier() { asm volatile("s_waitcnt lgkmcnt(0)" ::: "memory"); __builtin_amdgcn_s_barrier(); asm volatile("" ::: "memory"); }
template <int NV> struct ScanSet { f32x4 kk[NV], w[NV], ka[NV], kp[NV], r[NV]; float vv; };
template <int NV> __device__ __forceinline__ void scan_load(ScanSet<NV>& t, LAS const float* KK, LAS const float* Wd, LAS const float* KKA, LAS const float* KP, LAS const float* Rr, LAS const float* Vv, int o, int ov, bool want_y) {
#pragma unroll
    for (int u = 0; u < NV; ++u) { t.kk[u] = *(LAS const f32x4*)(KK + o + u * 32); t.w[u] = *(LAS const f32x4*)(Wd + o + u * 32); t.ka[u] = *(LAS const f32x4*)(KKA + o + u * 32); t.kp[u] = *(LAS const f32x4*)(KP + o + u * 32); }
    if (want_y) {
#pragma unroll
        for (int u = 0; u < NV; ++u) t.r[u] = *(LAS const f32x4*)(Rr + o + u * 32);
    }
    t.vv = Vv[ov];
}
typedef float f32x2v __attribute__((ext_vector_type(2)));
template <int LPR, int NV> __device__ __forceinline__ float scan_step(float* S, const ScanSet<NV>& t, bool want_y, float& ypart) {
    f32x2v acc = {0.f, 0.f};
#pragma unroll
    for (int u = 0; u < NV; ++u)
#pragma unroll
        for (int hh = 0; hh < 2; ++hh) { const f32x2v s2 = {S[4 * u + 2 * hh], S[4 * u + 2 * hh + 1]}, k2 = {t.kk[u][2 * hh], t.kk[u][2 * hh + 1]}; acc = s2 * k2 + acc; }
    float sa = acc.x + acc.y, yb = ypart;
    sa += dppf<0xB1>(sa); yb += dppf<0xB1>(yb); sa += dppf<0x4E>(sa); yb += dppf<0x4E>(yb); sa += dppf<0x141>(sa); yb += dppf<0x141>(yb);
    const f32x2v sa2 = {sa, sa}, vv2 = {t.vv, t.vv};
#pragma unroll
    for (int u = 0; u < NV; ++u)
#pragma unroll
        for (int hh = 0; hh < 2; ++hh) {
            f32x2v s2 = {S[4 * u + 2 * hh], S[4 * u + 2 * hh + 1]};
            const f32x2v w2 = {t.w[u][2 * hh], t.w[u][2 * hh + 1]}, kp2 = {t.kp[u][2 * hh], t.kp[u][2 * hh + 1]}, ka2 = {t.ka[u][2 * hh], t.ka[u][2 * hh + 1]};
            f32x2v tt = vv2 * kp2; tt = tt - sa2 * ka2;
            s2 = s2 * w2 + tt;
            S[4 * u + 2 * hh] = s2.x; S[4 * u + 2 * hh + 1] = s2.y;
        }
    if (want_y) {
        f32x2v yacc = {0.f, 0.f};
#pragma unroll
        for (int u = 0; u < NV; ++u)
#pragma unroll
            for (int hh = 0; hh < 2; ++hh) { const f32x2v s2 = {S[4 * u + 2 * hh], S[4 * u + 2 * hh + 1]}, r2 = {t.r[u][2 * hh], t.r[u][2 * hh + 1]}; yacc = s2 * r2 + yacc; }
        ypart = yacc.x + yacc.y;
    }
    return yb;
}
struct ScanSet2 { f32x4 kk, w, ka, kp, r; float vv0, vv1; };
__device__ __forceinline__ void scan_load2(ScanSet2& t, LAS const float* KK, LAS const float* Wd, LAS const float* KKA, LAS const float* KP, LAS const float* Rr, LAS const float* Vv, int o, int ov, bool want_y) {
    t.kk = *(LAS const f32x4*)(KK + o); t.w = *(LAS const f32x4*)(Wd + o); t.ka = *(LAS const f32x4*)(KKA + o); t.kp = *(LAS const f32x4*)(KP + o);
    if (want_y) t.r = *(LAS const f32x4*)(Rr + o);
    t.vv0 = Vv[ov]; t.vv1 = Vv[ov + 4];
}
__device__ __forceinline__ float dpp16(float x) { x += dppf<0xB1>(x); x += dppf<0x4E>(x); x += dppf<0x141>(x); x += dppf<0x140>(x); return x; }
__device__ __forceinline__ void scan_step2(f32x2v* SS, const ScanSet2& t, bool want_y, float& y0, float& y1, float& yr0, float& yr1) {
    f32x2v a2 = SS[0] * (f32x2v){t.kk[0], t.kk[0]};
#pragma unroll
    for (int i = 1; i < 4; ++i) a2 = SS[i] * (f32x2v){t.kk[i], t.kk[i]} + a2;
    float a0 = a2.x, a1 = a2.y, b0 = y0, b1 = y1;
#define SCAN_OPAQUE4() asm("" : "+v"(a0), "+v"(a1), "+v"(b0), "+v"(b1))
    SCAN_OPAQUE4();
    a0 += dppf<0xB1>(a0); a1 += dppf<0xB1>(a1); b0 += dppf<0xB1>(b0); b1 += dppf<0xB1>(b1); SCAN_OPAQUE4();
    a0 += dppf<0x4E>(a0); a1 += dppf<0x4E>(a1); b0 += dppf<0x4E>(b0); b1 += dppf<0x4E>(b1); SCAN_OPAQUE4();
    a0 += dppf<0x141>(a0); a1 += dppf<0x141>(a1); b0 += dppf<0x141>(b0); b1 += dppf<0x141>(b1); SCAN_OPAQUE4();
    a0 += dppf<0x140>(a0); a1 += dppf<0x140>(a1); b0 += dppf<0x140>(b0); b1 += dppf<0x140>(b1); SCAN_OPAQUE4();
#undef SCAN_OPAQUE4
    yr0 = b0; yr1 = b1;
    const f32x2v sa2 = {a0, a1}, vv2 = {t.vv0, t.vv1};
#pragma unroll
    for (int i = 0; i < 4; ++i) {
        f32x2v tt = vv2 * (f32x2v){t.kp[i], t.kp[i]};
        tt = tt - sa2 * (f32x2v){t.ka[i], t.ka[i]};
        SS[i] = SS[i] * (f32x2v){t.w[i], t.w[i]} + tt;
    }
    if (want_y) {
        f32x2v p2 = SS[0] * (f32x2v){t.r[0], t.r[0]};
#pragma unroll
        for (int i = 1; i < 4; ++i) p2 = SS[i] * (f32x2v){t.r[i], t.r[i]} + p2;
        y0 = p2.x; y1 = p2.y;
    }
}
template <int LPR> __device__ void scan_item(const Params& PP, int seq, int h, int dir, int rhalf, int tbeg, int tlen, int flags, const float* sin, float* sout, LAS unsigned char* lds) {
    Params P = PP; P.ws = opaque_ptr(PP.ws);
    constexpr int KPL = 64 / LPR, RPW = 64 / LPR, NV = KPL / 4;
    const int tid = opaque_tid(), lane = tid & 63, wave = __builtin_amdgcn_readfirstlane(tid >> 6), l15 = lane & 15, quad = lane >> 4;
    const int Tseq = seq < 32 ? 2048 : 16384;
    const size_t base = seq < 32 ? (size_t)seq * 2048 : (size_t)M_PROMPT;
    const bf16_t* Prkvg = (const bf16_t*)(P.ws + WS_PRKVG);
    const bf16_t* Pwa = (const bf16_t*)(P.ws + WS_PWA);
    bf16_t* Yd = (bf16_t*)(P.ws + WS_Y) + (size_t)dir * M_TOK * 512;
    float* RKR = (float*)(P.ws + WS_RKR) + (size_t)dir * M_TOK * 8;
    LAS bf16_t* RAW0 = (LAS bf16_t*)lds;
    LAS bf16_t* ZROW = (LAS bf16_t*)(lds + 21760);
    LAS float* Wd = (LAS float*)(lds + 22528);
    LAS float* Aa = Wd + 1024; LAS float* Rr = Aa + 1024; LAS float* KP = Rr + 1024; LAS float* Vv = KP + 1024; LAS float* KK = Vv + 1024; LAS float* KKA = KK + 1024; LAS float* Yc = KKA + 1024;
    if (tid < 160) ((LAS unsigned*)ZROW)[tid] = 0u;
    LAS bf16_t* ALDS = (LAS bf16_t*)(lds + 55296);
    const int j_a = tid / 40, seg_a = (tid % 40) >> 3, c8_a = tid & 7;
    const int idx_b = tid + 512, j_b = idx_b / 40, seg_b = (idx_b % 40) >> 3, c8_b = idx_b & 7;
    const bool has_b = idx_b < 640;
    const int coff_a = seg_a < 3 ? seg_a * 512 + h * 64 + c8_a * 8 : dir * 128 + (seg_a - 3) * 64 + c8_a * 8;
    const int coff_b = seg_b < 3 ? seg_b * 512 + h * 64 + c8_b * 8 : dir * 128 + (seg_b - 3) * 64 + c8_b * 8;
    const int dst_a = (j_a + 1) * 320 + seg_a * 64 + c8_a * 8, dst_b = (j_b + 1) * 320 + seg_b * 64 + c8_b * 8;
    const bf16_t* src_a = (seg_a < 3 ? Prkvg + base * 2048 : Pwa + base * 256) + coff_a; const int ld_a = seg_a < 3 ? 2048 : 256;
    const bf16_t* src_b = (seg_b < 3 ? Prkvg + base * 2048 : Pwa + base * 256) + coff_b; const int ld_b = seg_b < 3 ? 2048 : 256;
    const int ltype = wave >> 2, lch = (wave & 3) * 16 + l15;
    const bf16_t* Wt = (const bf16_t*)(P.ws + WS_LORA) + (size_t)(dir * 2 + ltype) * 512 * 64 + (size_t)(h * 64 + lch) * 64;
    const bf16x8 lb0 = *(const bf16x8*)(Wt + quad * 8), lb1 = *(const bf16x8*)(Wt + 32 + quad * 8);
    const float lbias = ltype == 0 ? P.in[17][dir * 512 + h * 64 + lch] : P.in[19][dir * 512 + h * 64 + lch];
    const int tk = tid >> 5, c2 = tid & 31;
    float mu_r[2], mu_k[2], mu_v[2], k_k[2], k_a[2], r_k[2];
#pragma unroll
    for (int e = 0; e < 2; ++e) { const int ch = h * 64 + 2 * c2 + e;
        mu_r[e] = P.in[15][dir * 1536 + ch]; mu_k[e] = P.in[15][dir * 1536 + 512 + ch]; mu_v[e] = P.in[15][dir * 1536 + 1024 + ch];
        k_k[e] = P.in[21][ch]; k_a[e] = P.in[22][ch]; r_k[e] = P.in[23][ch]; }
    float amu[2][2];
#pragma unroll
    for (int ty = 0; ty < 2; ++ty)
#pragma unroll
        for (int e = 0; e < 2; ++e) amu[ty][e] = P.in[16][dir * 128 + ty * 64 + 2 * c2 + e];
#define SCAN_BUILD_A(RAWN, PREV0) do { \
        LAS const bf16_t* cur_ = (RAWN) + (tk + 1) * 320 + 192 + 2 * c2; \
        LAS const bf16_t* prv_ = (tk > 0 ? (RAWN) + tk * 320 : (PREV0)) + 192 + 2 * c2; \
        _Pragma("unroll") for (int ty = 0; ty < 2; ++ty) { \
            const unsigned xc_ = *(LAS const unsigned*)(cur_ + ty * 64), xp_ = *(LAS const unsigned*)(prv_ + ty * 64); \
            float z0_ = bflo(xc_) + (bflo(xp_) - bflo(xc_)) * amu[ty][0], z1_ = bfhi(xc_) + (bfhi(xp_) - bfhi(xc_)) * amu[ty][1]; \
            if (ty == 0) { z0_ = tanhf_(z0_); z1_ = tanhf_(z1_); } \
            *(LAS unsigned*)(ALDS + ty * 1152 + tk * 72 + 2 * c2) = pk2(z0_, z1_); } } while (0)
    static_assert(LPR == 16, "two rows per lane, 16 lanes per row");
    const int srow = wave * 8 + (lane >> 4), sq = lane & 15;
    f32x2v SS[4];
#pragma unroll
    for (int i = 0; i < 4; ++i) { const int kidx = sq * 4 + i;
        SS[i].x = (flags & 1) ? (kidx == srow ? 1.f : 0.f) : (sin ? sin[srow * 64 + kidx] : 0.f);
        SS[i].y = (flags & 1) ? (kidx == srow + 4 ? 1.f : 0.f) : (sin ? sin[(srow + 4) * 64 + kidx] : 0.f); }
    const int nch = tlen / 16;
    const int tstep = dir == 0 ? 16 : -16;
    const int tfirst = dir == 0 ? tbeg : tbeg + tlen - 16;
    const int tprev = dir == 0 ? tbeg - 1 : tbeg + tlen;
    const bool has_prev = tprev >= 0 && tprev < Tseq;
    if (has_prev && tid < 40) {
        const int sg = tid >> 3, c8 = tid & 7;
        const bf16_t* sp = sg < 3 ? Prkvg + (base + tprev) * 2048 + sg * 512 + h * 64 + c8 * 8 : Pwa + (base + tprev) * 256 + dir * 128 + (sg - 3) * 64 + c8 * 8;
        *(LAS u32x4*)(RAW0 + 5440 + 16 * 320 + sg * 64 + c8 * 8) = *(const u32x4*)sp;
    }
    const bool in_on = (flags & 2) == 0, wr_y = (flags & 4) != 0, wr_rk = (flags & 8) != 0;
#define SCAN_TOK(t0, j) (dir == 0 ? (t0) + (j) : (t0) + 15 - (j))
    u32x4 pre_a, pre_b = (u32x4){0u, 0u, 0u, 0u};
    {
        pre_a = *(const u32x4*)(src_a + (size_t)SCAN_TOK(tfirst, j_a) * ld_a);
        if (has_b) pre_b = *(const u32x4*)(src_b + (size_t)SCAN_TOK(tfirst, j_b) * ld_b);
        *(LAS u32x4*)(RAW0 + dst_a) = pre_a;
        if (has_b) *(LAS u32x4*)(RAW0 + dst_b) = pre_b;
        if (nch > 1) {
            pre_a = *(const u32x4*)(src_a + (size_t)SCAN_TOK(tfirst + tstep, j_a) * ld_a);
            if (has_b) pre_b = *(const u32x4*)(src_b + (size_t)SCAN_TOK(tfirst + tstep, j_b) * ld_b);
        }
    }
    __syncthreads();
    SCAN_BUILD_A(RAW0, (has_prev ? RAW0 + 5440 + 16 * 320 : ZROW));
    lds_barrier();
    u32x4 ypend = (u32x4){0u, 0u, 0u, 0u}; bf16_t* ypend_ptr = nullptr;
    for (int c = 0; c < nch; ++c) {
        LAS bf16_t* RAW = RAW0 + (c & 1) * 5440;
        LAS bf16_t* RAWp = RAW0 + ((c & 1) ^ 1) * 5440;
        const int t0 = tfirst + c * tstep;
        {
            bf16x8 af[2];
#pragma unroll
            for (int ks = 0; ks < 2; ++ks) af[ks] = *(LAS const bf16x8*)(ALDS + ltype * 1152 + l15 * 72 + ks * 32 + quad * 8);
            f32x4 d = mfma16(af[0], lb0, (f32x4){0.f, 0.f, 0.f, 0.f});
            d = mfma16(af[1], lb1, d);
            LAS float* dstp = (ltype == 0 ? Wd : Aa) + lch;
#pragma unroll
            for (int jj = 0; jj < 4; ++jj) { const float sg = sigmoidf_(lbias + d[jj]); dstp[(quad * 4 + jj) * 64] = ltype == 0 ? __expf(-0.6065306597126334f * sg) : sg; }
        }
        {
            LAS const bf16_t* cur = RAW + (tk + 1) * 320 + 2 * c2;
            LAS const bf16_t* prv = (tk > 0 ? RAW + tk * 320 : ((c > 0 || has_prev) ? RAWp + 16 * 320 : ZROW)) + 2 * c2;
            const unsigned rc = *(LAS const unsigned*)(cur), rp = *(LAS const unsigned*)(prv);
            const unsigned kc = *(LAS const unsigned*)(cur + 64), kq = *(LAS const unsigned*)(prv + 64);
            const unsigned vc = *(LAS const unsigned*)(cur + 128), vp = *(LAS const unsigned*)(prv + 128);
            const int o = tk * 64 + 2 * c2;
            Rr[o] = bflo(rc) + (bflo(rp) - bflo(rc)) * mu_r[0]; Rr[o + 1] = bfhi(rc) + (bfhi(rp) - bfhi(rc)) * mu_r[1];
            KP[o] = bflo(kc) + (bflo(kq) - bflo(kc)) * mu_k[0]; KP[o + 1] = bfhi(kc) + (bfhi(kq) - bfhi(kc)) * mu_k[1];
            Vv[o] = in_on ? bflo(vc) + (bflo(vp) - bflo(vc)) * mu_v[0] : 0.f; Vv[o + 1] = in_on ? bfhi(vc) + (bfhi(vp) - bfhi(vc)) * mu_v[1] : 0.f;
        }
        lds_barrier();
        float rk_keep;
        {
            const int o = tk * 64 + 2 * c2;
            const float kz0 = KP[o], kz1 = KP[o + 1], a0 = Aa[o], a1 = Aa[o + 1];
            const float q0 = kz0 * k_k[0], q1 = kz1 * k_k[1];
            const float kp0 = kz0 * (1.0f + (a0 - 1.0f) * k_a[0]), kp1 = kz1 * (1.0f + (a1 - 1.0f) * k_a[1]);
            const float ss = reduce32(q0 * q0 + q1 * q1);
            const float rk = reduce32(Rr[o] * kp0 * r_k[0] + Rr[o + 1] * kp1 * r_k[1]);
            const float inv = __builtin_amdgcn_rsqf(fmaxf(ss, 1e-24f));
            const float kk0 = q0 * inv, kk1 = q1 * inv;
            KK[o] = kk0; KK[o + 1] = kk1; KKA[o] = kk0 * a0; KKA[o + 1] = kk1 * a1;
            KP[o] = kp0; KP[o + 1] = kp1;
            rk_keep = rk;
        }
        if (c + 1 < nch) {
            *(LAS u32x4*)(RAWp + dst_a) = pre_a;
            if (has_b) *(LAS u32x4*)(RAWp + dst_b) = pre_b;
            if (c + 2 < nch) {
                pre_a = *(const u32x4*)(src_a + (size_t)SCAN_TOK(t0 + 2 * tstep, j_a) * ld_a);
                if (has_b) pre_b = *(const u32x4*)(src_b + (size_t)SCAN_TOK(t0 + 2 * tstep, j_b) * ld_b);
            }
        }
        if (wr_rk && c2 == 0) RKR[(base + SCAN_TOK(t0, tk)) * 8 + h] = rk_keep;
        if (ypend_ptr) *(u32x4*)ypend_ptr = ypend;
        lds_barrier();
        if (c + 1 < nch) SCAN_BUILD_A(RAWp, RAW + 16 * 320);
        {
            ScanSet2 sa_, sb_;
            scan_load2(sa_, KK, Wd, KKA, KP, Rr, Vv, sq * 4, srow, wr_y);
            float yk = 0.f, zk = 0.f, y0 = 0.f, y1 = 0.f, yr0, yr1;
#pragma unroll 1
            for (int jo = 0; jo < 16; jo += 2) {
                scan_load2(sb_, KK, Wd, KKA, KP, Rr, Vv, (jo + 1) * 64 + sq * 4, (jo + 1) * 64 + srow, wr_y);
                scan_step2(SS, sa_, wr_y, y0, y1, yr0, yr1);
                if (jo > 0 && sq == jo - 1) { yk = yr0; zk = yr1; }
                if (jo + 2 < 16) scan_load2(sa_, KK, Wd, KKA, KP, Rr, Vv, (jo + 2) * 64 + sq * 4, (jo + 2) * 64 + srow, wr_y);
                scan_step2(SS, sb_, wr_y, y0, y1, yr0, yr1);
                if (sq == jo) { yk = yr0; zk = yr1; }
            }
            yr0 = dpp16(y0); yr1 = dpp16(y1);
            if (sq == 15) { yk = yr0; zk = yr1; }
            Yc[sq * 64 + srow] = yk; Yc[sq * 64 + srow + 4] = zk;
        }
        lds_barrier();
        {
            const bool wr = wr_y && tid < 128;
            if (wr) {
                const int tq = tid >> 3, c8 = tid & 7; float f[8];
                const f32x4 a = *(LAS const f32x4*)(Yc + tq * 64 + c8 * 8), b = *(LAS const f32x4*)(Yc + tq * 64 + c8 * 8 + 4);
                f[0] = a[0]; f[1] = a[1]; f[2] = a[2]; f[3] = a[3]; f[4] = b[0]; f[5] = b[1]; f[6] = b[2]; f[7] = b[3];
                ypend = pack8(f); ypend_ptr = Yd + (base + SCAN_TOK(t0, tq)) * 512 + h * 64 + c8 * 8;
            }
        }
    }
    if (ypend_ptr) *(u32x4*)ypend_ptr = ypend;
    if (sout) { *(f32x4*)(sout + srow * 64 + sq * 4) = (f32x4){SS[0].x, SS[1].x, SS[2].x, SS[3].x}; *(f32x4*)(sout + (srow + 4) * 64 + sq * 4) = (f32x4){SS[0].y, SS[1].y, SS[2].y, SS[3].y}; }
#undef SCAN_TOK
#undef SCAN_BUILD_A
    __syncthreads();
}

__device__ void scan_carry(const Params& PP, int hd, LAS unsigned char* lds) {
    Params P = PP; P.ws = opaque_ptr(PP.ws);
    const int tid = opaque_tid();
    const float* Lm = (const float*)(P.ws + WS_STL) + (size_t)hd * NSEG * 4096;
    const float* Pm = (const float*)(P.ws + WS_STP) + (size_t)hd * NSEG * 4096;
    float* St = (float*)(P.ws + WS_STS) + (size_t)hd * NSEG * 4096;
    LAS float* Sc = (LAS float*)lds;
    LAS float* Pc = Sc + 4096;
    const int v = tid >> 3, k0 = (tid & 7) * 8;
    for (int i = 0; i < 8; ++i) { const float x = Lm[v * 64 + k0 + i]; Sc[v * 64 + k0 + i] = x; St[4096 + v * 64 + k0 + i] = x; }
    for (int sgm = 1; sgm + 1 < NSEG; ++sgm) {
        for (int i = 0; i < 8; ++i) Pc[v * 64 + k0 + i] = Pm[(size_t)sgm * 4096 + v * 64 + k0 + i];
        __syncthreads();
        float o[8];
        for (int i = 0; i < 8; ++i) o[i] = Lm[(size_t)sgm * 4096 + v * 64 + k0 + i];
        for (int j = 0; j < 64; ++j) { const float sv = Sc[v * 64 + j];
#pragma unroll
            for (int i = 0; i < 8; ++i) o[i] += sv * Pc[j * 64 + k0 + i]; }
        __syncthreads();
        for (int i = 0; i < 8; ++i) { Sc[v * 64 + k0 + i] = o[i]; St[(size_t)(sgm + 1) * 4096 + v * 64 + k0 + i] = o[i]; }
    }
    __syncthreads();
}

__device__ void rwkv_finalize(const Params& PP) {
    Params P = PP; P.ws = opaque_ptr(PP.ws);
    const int tid_ = opaque_tid(), lane = tid_ & 63, wave = __builtin_amdgcn_readfirstlane(tid_ >> 6);
    const bf16_t* Prkvg = (const bf16_t*)(P.ws + WS_PRKVG);
    const bf16_t* Y0 = (const bf16_t*)(P.ws + WS_Y);
    const bf16_t* Y1 = Y0 + (size_t)M_TOK * 512;
    const float* RKR0 = (const float*)(P.ws + WS_RKR);
    const float* RKR1 = RKR0 + (size_t)M_TOK * 8;
    bf16_t* MO = (bf16_t*)(P.ws + WS_XN);
    const int col = lane * 8, hh = lane >> 3;
    float gw[8], gb[8], muf[8], mub[8];
#pragma unroll
    for (int i = 0; i < 8; ++i) { gw[i] = P.in[24][col + i]; gb[i] = P.in[25][col + i]; muf[i] = P.in[15][1024 + col + i]; mub[i] = P.in[15][1536 + 1024 + col + i]; }
    for (int row = blockIdx.x * 8 + wave; row < M_TOK; row += gridDim.x * 8) {
        const int t = row < M_PROMPT ? (row & 2047) : row - M_PROMPT, T = row < M_PROMPT ? 2048 : 16384;
        float yf[8], yb[8], vc[8], vp[8], vn[8], gg[8];
        unpack8(*(const u32x4*)(Y0 + (size_t)row * 512 + col), yf); unpack8(*(const u32x4*)(Y1 + (size_t)row * 512 + col), yb);
        unpack8(*(const u32x4*)(Prkvg + (size_t)row * 2048 + 1024 + col), vc);
        unpack8(*(const u32x4*)(Prkvg + (size_t)row * 2048 + 1536 + col), gg);
        if (t > 0) unpack8(*(const u32x4*)(Prkvg + (size_t)(row - 1) * 2048 + 1024 + col), vp); else { for (int i = 0; i < 8; ++i) vp[i] = 0.f; }
        if (t < T - 1) unpack8(*(const u32x4*)(Prkvg + (size_t)(row + 1) * 2048 + 1024 + col), vn); else { for (int i = 0; i < 8; ++i) vn[i] = 0.f; }
        const float rf = RKR0[(size_t)row * 8 + hh], rb = RKR1[(size_t)row * 8 + hh];
        float s = 0.f;
#pragma unroll
        for (int i = 0; i < 8; ++i) { yf[i] += yb[i]; s += yf[i]; }
        const float mean = reduce8(s) * (1.0f / 64.0f);
        float q = 0.f;
#pragma unroll
        for (int i = 0; i < 8; ++i) { yf[i] -= mean; q += yf[i] * yf[i]; }
        const float rstd = rsqrtf(reduce8(q) * (1.0f / 64.0f) + 64e-5f);
        float o[8];
#pragma unroll
        for (int i = 0; i < 8; ++i) {
            const float vzf = vc[i] + (vp[i] - vc[i]) * muf[i], vzb = vc[i] + (vn[i] - vc[i]) * mub[i];
            o[i] = (yf[i] * rstd * gw[i] + gb[i] + rf * vzf + rb * vzb) * sigmoidf_(gg[i]);
        }
        *(u32x4*)(MO + (size_t)row * 1024 + 512 + col) = pack8(o);
    }
}

template <int NQ> __device__ __forceinline__ void attn_groups(const bf16_t* QKV, size_t base, int h, int T0, int L, int dsh, int res, int i0, int bi,
        int lane, int l15, int quad, int r4, int c4, LAS unsigned char* VST, LAS const f32x2v* RKT, int tb, const float (&bx)[11][4], const float (&gqk)[16], LAS float* OACC, LAS float* LS) {
    constexpr int NT = NQ == 2 ? 10 : 9;
    bf16x8 qf[NQ][2]; float mq[NQ]; int qtok[NQ];
#pragma unroll
    for (int q = 0; q < NQ; ++q) {
        qtok[q] = ((i0 + 16 * q + l15) << dsh) + res;
        const bf16_t* qp = QKV + (base + qtok[q]) * 3072 + h * 64 + quad * 8;
        float f[16]; unpack8(*(const u32x4*)qp, f); unpack8(*(const u32x4*)(qp + 32), f + 8);
        float ss = 0.f;
#pragma unroll
        for (int i = 0; i < 16; ++i) ss += f[i] * f[i];
        ss += __shfl_xor(ss, 16); ss += __shfl_xor(ss, 32);
        const float rq = rsqrtf(ss * (1.0f / 64.0f) + NORM_EPS) * 0.125f;
#pragma unroll
        for (int i = 0; i < 16; ++i) f[i] = f[i] * rq * gqk[i];
        const u32x4 w0 = pack8(f), w1 = pack8(f + 8);
        qf[q][0] = __builtin_bit_cast(bf16x8, w0); qf[q][1] = __builtin_bit_cast(bf16x8, w1);
        float fr[16]; unpack8(w0, fr); unpack8(w1, fr + 8);
        float n2 = 0.f;
#pragma unroll
        for (int i = 0; i < 16; ++i) n2 += fr[i] * fr[i];
        n2 += __shfl_xor(n2, 16); n2 += __shfl_xor(n2, 32);
        mq[q] = 8.1f * 1.4426950408889634f * sqrtf(n2);
    }
    f32x4 oacc[NQ][4];
    float lsum[NQ];
#pragma unroll
    for (int q = 0; q < NQ; ++q) { lsum[q] = 0.f;
#pragma unroll
        for (int et = 0; et < 4; ++et) oacc[q][et] = (f32x4){0.f, 0.f, 0.f, 0.f}; }
    const int ebase = (i0 - 64 + quad * 4) * (1 << dsh) + res - tb;
    const float dmul = (float)(1 << dsh);
    bf16x8 kfb[2][2][2]; u32x4 vb[2][4];
    const int rowv = lane >> 1, half = lane & 1;
#define ATT_ISSUE(KP, BUF) do { \
        _Pragma("unroll") for (int tt_ = 0; tt_ < 2; ++tt_) { \
            int kidx_ = i0 - 64 + 16 * (2 * (KP) + tt_) + l15; kidx_ = kidx_ < 0 ? 0 : (kidx_ > L - 1 ? L - 1 : kidx_); \
            const bf16_t* kptr_ = QKV + (base + ((size_t)kidx_ << dsh) + res) * 3072 + 1024 + h * 64 + quad * 8; \
            kfb[BUF][tt_][0] = *(const bf16x8*)kptr_; kfb[BUF][tt_][1] = *(const bf16x8*)(kptr_ + 32); } \
        int vidx_ = i0 - 64 + 32 * (KP) + rowv; vidx_ = vidx_ < 0 ? 0 : (vidx_ > L - 1 ? L - 1 : vidx_); \
        const bf16_t* vptr_ = QKV + (base + ((size_t)vidx_ << dsh) + res) * 3072 + 2048 + h * 64 + half * 32; \
        vb[BUF][0] = *(const u32x4*)vptr_; vb[BUF][1] = *(const u32x4*)(vptr_ + 8); vb[BUF][2] = *(const u32x4*)(vptr_ + 16); vb[BUF][3] = *(const u32x4*)(vptr_ + 24); } while (0)
    ATT_ISSUE(0, 0);
#pragma unroll
    for (int kp = 0; kp < 5; ++kp) {
        f32x4 s[NQ][2];
        if (kp + 1 < 5) ATT_ISSUE(kp + 1, (kp + 1) & 1);
#pragma unroll
        for (int tt = 0; tt < 2; ++tt) {
            const int kt = 2 * kp + tt;
#pragma unroll
            for (int q = 0; q < NQ; ++q) s[q][tt] = (f32x4){0.f, 0.f, 0.f, 0.f};
            if (kt < NT) {
                f32x2v e[4];
#pragma unroll
                for (int j = 0; j < 4; ++j) e[j] = RKT[((16 * kt + j) << dsh) + ebase];
#pragma unroll
                for (int q = 0; q < NQ; ++q) {
                    f32x4 sc = mfma16(kfb[kp & 1][tt][0], qf[q][0], (f32x4){0.f, 0.f, 0.f, 0.f});
                    sc = mfma16(kfb[kp & 1][tt][1], qf[q][1], sc);
#pragma unroll
                    for (int j = 0; j < 4; ++j) {
                        const float p = __builtin_amdgcn_exp2f(sc[j] * e[j].x + (e[j].y + (bx[kt + 1 - q][j] * dmul - mq[q])));
                        lsum[q] += p; s[q][tt][j] = p;
                    }
                }
            }
        }
        bf16x8 pf[NQ];
#pragma unroll
        for (int q = 0; q < NQ; ++q) { u32x4 w; w.x = pk2(s[q][0][0], s[q][0][1]); w.y = pk2(s[q][0][2], s[q][0][3]); w.z = pk2(s[q][1][0], s[q][1][1]); w.w = pk2(s[q][1][2], s[q][1][3]); pf[q] = __builtin_bit_cast(bf16x8, w); }
        {
            LAS u32x4* vd = (LAS u32x4*)(VST + rowv * 144 + half * 64);
            vd[0] = vb[kp & 1][0]; vd[1] = vb[kp & 1][1]; vd[2] = vb[kp & 1][2]; vd[3] = vb[kp & 1][3];
        }
        asm volatile("s_waitcnt lgkmcnt(0)" ::: "memory"); __builtin_amdgcn_fence(__ATOMIC_RELEASE, "wavefront"); __builtin_amdgcn_wave_barrier(); __builtin_amdgcn_fence(__ATOMIC_ACQUIRE, "wavefront"); asm volatile("s_waitcnt lgkmcnt(0)" ::: "memory");
#pragma unroll
        for (int et = 0; et < 4; ++et) {
            LAS const unsigned char* ap = VST + (quad * 4 + r4) * 144 + (et * 16 + 4 * c4) * 2;
            const s16x4 lo = tr_read(ap), hi = tr_read(ap + 16 * 144);
            const bf16x8 a = {lo[0], lo[1], lo[2], lo[3], hi[0], hi[1], hi[2], hi[3]};
#pragma unroll
            for (int q = 0; q < NQ; ++q) oacc[q][et] = mfma16(a, pf[q], oacc[q][et]);
        }
        asm volatile("s_waitcnt lgkmcnt(0)" ::: "memory"); __builtin_amdgcn_fence(__ATOMIC_RELEASE, "wavefront"); __builtin_amdgcn_wave_barrier(); __builtin_amdgcn_fence(__ATOMIC_ACQUIRE, "wavefront"); asm volatile("s_waitcnt lgkmcnt(0)" ::: "memory");
    }
#undef ATT_ISSUE
#pragma unroll
    for (int q = 0; q < NQ; ++q) {
        float l = lsum[q]; l += __shfl_xor(l, 16); l += __shfl_xor(l, 32);
        const int qloc = qtok[q] - T0;
#pragma unroll
        for (int et = 0; et < 4; ++et) {
            LAS f32x4* dst = (LAS f32x4*)(OACC + qloc * 68 + et * 16 + quad * 4);
            if (bi == 0) *dst = oacc[q][et]; else *dst = *dst + oacc[q][et];
        }
        if (quad == 0) { if (bi == 0) LS[qloc] = l; else LS[qloc] += l; }
    }
}

__device__ void attn_item(const Params& PP, int seq, int h, int tile, LAS unsigned char* lds) {
    Params P = PP; P.ws = opaque_ptr(PP.ws);
    const int tid = opaque_tid(), lane = tid & 63, wave = __builtin_amdgcn_readfirstlane(tid >> 6), l15 = lane & 15, quad = lane >> 4;
    const int T = seq < 32 ? 2048 : 16384;
    const size_t base = seq < 32 ? (size_t)seq * 2048 : (size_t)M_PROMPT;
    const int T0 = tile * 256;
    const bf16_t* QKV = (const bf16_t*)(P.ws + WS_BIG);
    bf16_t* MO = (bf16_t*)(P.ws + WS_XN);
    LAS float* OACC = (LAS float*)lds;
    LAS float* LS = (LAS float*)(lds + 256 * 272);
    LAS unsigned char* VST = lds + 256 * 272 + 1024 + wave * (32 * 144);
    const float slope = exp2f(-0.5f * (float)(h + 1));
    float gqk[16];
#pragma unroll
    for (int i = 0; i < 16; ++i) { const int e = (i >> 3) * 32 + quad * 8 + (i & 7); gqk[i] = P.in[28][e] * P.in[29][e]; }
    const int r4 = l15 >> 2, c4 = l15 & 3;
    float bx[11][4];
#pragma unroll
    for (int kt = -1; kt < 10; ++kt)
#pragma unroll
        for (int j = 0; j < 4; ++j) { int dist = 16 * kt - 64 + quad * 4 + j - l15; dist = dist < 0 ? -dist : dist;
            bx[kt + 1][j] = dist <= 64 ? -slope * 1.4426950408889634f * (float)dist : -1e30f; }
    LAS f32x2v* RKT = (LAS f32x2v*)(lds + 107520);
    const int tb = T0 - 1024;
    const float* ksq_h = (const float*)(P.ws + WS_KSQ) + (size_t)h * M_TOK;
    for (int idx = tid; idx < 2304; idx += 512) {
        const int tok = tb + idx;
        f32x2v ent = {0.f, -1e30f};
        if (tok >= 0 && tok < T) { ent.x = rsqrtf(ksq_h[base + tok] * (1.0f / 64.0f) + NORM_EPS) * 1.4426950408889634f; ent.y = 0.f; }
        RKT[idx] = ent;
    }
    __syncthreads();
    for (int bi = 0; bi < 3; ++bi) {
        const int dsh = 2 * bi, L = T >> dsh;
        if (bi < 2) {
            const int res = bi == 0 ? 0 : (wave & 3), i0 = (T0 >> dsh) + (bi == 0 ? 32 * wave : 32 * (wave >> 2));
            attn_groups<2>(QKV, base, h, T0, L, dsh, res, i0, bi, lane, l15, quad, r4, c4, VST, RKT, tb, bx, gqk, OACC, LS);
        } else {
            for (int gg = 0; gg < 2; ++gg)
                attn_groups<1>(QKV, base, h, T0, L, dsh, wave * 2 + gg, T0 >> dsh, bi, lane, l15, quad, r4, c4, VST, RKT, tb, bx, gqk, OACC, LS);
        }
        __syncthreads();
    }
    {
        const int q = tid >> 1, half = tid & 1;
        const float inv = 1.0f / LS[q];
        bf16_t* op = MO + (base + T0 + q) * 1024 + h * 64 + half * 32;
#pragma unroll
        for (int i = 0; i < 4; ++i) {
            const f32x4 a = *(LAS const f32x4*)(OACC + q * 68 + half * 32 + i * 8), b = *(LAS const f32x4*)(OACC + q * 68 + half * 32 + i * 8 + 4);
            u32x4 w; w.x = pk2(a[0] * inv, a[1] * inv); w.y = pk2(a[2] * inv, a[3] * inv); w.z = pk2(b[0] * inv, b[1] * inv); w.w = pk2(b[2] * inv, b[3] * inv);
            *(u32x4*)(op + i * 8) = w;
        }
    }
    __syncthreads();
}

enum { K_P0 = 0, K_SWIGLU, K_RESID, K_NORM, K_GEMM_P, K_MIXA, K_FINAL, K_GEMM_QKV, K_ATTN, K_CARRY, K_MIXB };
constexpr int N_PHASES = 19;

__global__ void __launch_bounds__(512, 2) mega(Params P) {
    extern __shared__ __attribute__((aligned(16))) unsigned char lds_raw[];
    LAS unsigned char* lds = (LAS unsigned char*)lds_raw;
    cg::grid_group grid = cg::this_grid();
    for (int ph = 0; ph < N_PHASES; ++ph) {
#ifdef PROBE_MASK
        if (blockIdx.x == 0 && threadIdx.x == 0) ((unsigned long long*)(P.ws + WS_TS))[ph] = __builtin_amdgcn_s_memrealtime();
#endif
        unsigned char* ws = P.ws; float* X = P.out; int G = gridDim.x, bid = blockIdx.x;
        asm volatile("" : "+s"(ws), "+s"(X), "+s"(G), "+s"(bid));
        bf16_t* XN = (bf16_t*)(ws + WS_XN);
        bf16_t* Hb = (bf16_t*)(ws + WS_BIG);
        int kind, layer = 0, sub = 0;
        if (ph == 0) kind = K_P0;
        else {
            layer = ph <= 10 ? 0 : 1; const int r = ph <= 10 ? ph - 1 : ph - 11;
            const unsigned long long kc = layer == 0 ? 0x2126A95421ull : 0x32128721ull;
            const unsigned long long sc = layer == 0 ? 0x1120000000ull : 0x21120000ull;
            kind = (int)((kc >> (4 * r)) & 15ull); sub = (int)((sc >> (4 * r)) & 15ull);
        }
        if (kind == K_P0) {
#ifndef SKIP_P0
            LAS float* tile = (LAS float*)lds;
            int rot = 0;
            for (int job = 0; job < 16; ++job) {
                const float* src; size_t doff; int K, N;
                if (job < 4) { src = ((job & 1) ? P.in[7] : P.in[3]) + (size_t)(job >> 1) * 1024 * 5632; doff = WS_WFI + (size_t)job * SZ_WFI; K = 1024; N = 5632; }
                else if (job < 8) { src = ((job & 1) ? P.in[8] : P.in[4]) + (size_t)((job - 4) >> 1) * 2816 * 1024; doff = WS_WFO + (size_t)(job - 4) * SZ_WFO; K = 2816; N = 1024; }
                else if (job == 8) { src = P.in[10]; doff = WS_WABI; K = 1024; N = 3328; }
                else if (job == 9) { src = P.in[11]; doff = WS_WABO; K = 1024; N = 1024; }
                else if (job == 10) { src = P.in[26]; doff = WS_WATI; K = 1024; N = 3072; }
                else if (job == 11) { src = P.in[27]; doff = WS_WATO; K = 1024; N = 1024; }
                else { const int d = (job - 12) >> 1, ty = (job - 12) & 1; src = (ty ? P.in[20] : P.in[18]) + (size_t)d * 64 * 512; doff = WS_LORA + (size_t)(d * 2 + ty) * 512 * 64 * 2; K = 64; N = 512; }
                if (job < 4) convert_T<1>(src, (bf16_t*)(ws + doff), K, N, tile, rot); else convert_T<0>(src, (bf16_t*)(ws + doff), K, N, tile, rot);
                rot += (K / 64) * (N / 64);
            }
            {
                bf16_t* dst = (bf16_t*)(ws + WS_SGUW);
                for (int i = bid * 512 + opaque_tid(); i < 4 * 128 * 128 / 4; i += G * 512) {
                    const f32x4 v = *(const f32x4*)(P.in[13] + (size_t)i * 4);
                    u32x2 w; w.x = pk2(v[0], v[1]); w.y = pk2(v[2], v[3]); *(u32x2*)(dst + (size_t)i * 4) = w;
                }
            }
            norm_rows(P.in[0], P.in[1], M_PROMPT, nullptr, nullptr, nullptr, P.in[2], XN);
            if (bid == 0 && opaque_tid() == 0) *(unsigned*)(ws + WS_TS + 2048) = 0u;
#endif
        } else if (kind == K_SWIGLU) {
            if (sub == 0) { float* za = (float*)(ws + WS_RSA); for (int i = bid * 512 + opaque_tid(); i < M_TOK; i += G * 512) za[i] = 0.f; }
            if (sub == 0 && layer == 1) { f32x4* zk = (f32x4*)(ws + WS_KSQ); for (int i = bid * 512 + opaque_tid(); i < 16 * M_TOK / 4; i += G * 512) zk[i] = (f32x4){0.f, 0.f, 0.f, 0.f}; }
            pg8::Gemm g{sub == 0 ? XN : (const bf16_t*)(ws + WS_Y), (const bf16_t*)(ws + WS_WFI + (size_t)(layer * 2 + sub) * SZ_WFI), M_TOK, 5632, 1024};
            pg8::StaticOrder S; S.init(M_TOK, 5632, G, bid);
            if (sub == 1 && layer == 0) { float* zc = (float*)(ws + WS_RSC); for (int i = bid * 512 + opaque_tid(); i < 2 * M_TOK; i += G * 512) zc[i] = 0.f; }
            EpiSwiglu E{Hb, sub == 0 ? (layer == 0 ? nullptr : (const float*)(ws + WS_RSC)) : (const float*)(ws + WS_RSB), (sub == 0 && layer == 1) ? (const float*)(ws + WS_RSD) : nullptr};
#ifndef SKIP_G1
            pg8::gemm_phase<EpiSwiglu, pg8::StaticOrder, GEMM_ALIGN, GEMM_SP2>(lds, g, S, E);
#endif
        } else if (kind == K_RESID) {
            const bf16_t* A; const bf16_t* Bt; int K; float scale; bf16_t* xg = nullptr; const float* gn = nullptr; float* rss = nullptr;
            const float* gaux = nullptr; float* rss2 = nullptr; const float* bss = nullptr;
            if (sub < 2) { A = Hb; Bt = (const bf16_t*)(ws + WS_WFO + (size_t)(layer * 2 + sub) * SZ_WFO); K = 2816; scale = 0.5f;
                if (sub == 0) { xg = XN; gn = P.in[5] + layer * DM; rss = (float*)(ws + WS_RSA); if (layer == 1) { bss = (const float*)(ws + WS_RSC); gaux = P.in[9]; } }
                else if (layer == 0) { xg = XN; gn = P.in[2] + DM; gaux = P.in[9]; rss = (float*)(ws + WS_RSC); rss2 = (float*)(ws + WS_RSD); } }
            else { A = XN; Bt = (const bf16_t*)(ws + (layer == 0 ? WS_WABO : WS_WATO)); K = 1024; scale = 1.0f; xg = (bf16_t*)(ws + WS_Y); gn = P.in[6] + layer * DM; rss = (float*)(ws + WS_RSB); }
            pg8::Gemm g{A, Bt, M_TOK, 1024, K};
            pg8::StaticOrder S; S.init(M_TOK, 1024, G, bid);
            const bool first = (layer == 0 && sub == 0);
            EpiResid E{X, scale, xg, gn, rss, first ? P.in[0] : nullptr, first ? P.in[1] : nullptr, gaux, rss2, bss};
#ifndef SKIP_G2
            pg8::gemm_phase<EpiResid, pg8::StaticOrder, GEMM_ALIGN, GEMM_SP2>(lds, g, S, E);
#endif
        } else if (kind == K_NORM) {
            norm_rows(X, X, M_TOK, nullptr, P.in[9] + DM, X, nullptr, nullptr);
        } else if (kind == K_GEMM_P || kind == K_GEMM_QKV) {
            const bool isP = kind == K_GEMM_P; const int N = isP ? 3328 : 3072;
            pg8::Gemm g{XN, (const bf16_t*)(ws + (isP ? WS_WABI : WS_WATI)), M_TOK, N, 1024};
            pg8::StaticOrder S; S.init(M_TOK, N, G, bid);
            { float* zb = (float*)(ws + WS_RSB); for (int i = bid * 512 + opaque_tid(); i < M_TOK; i += G * 512) zb[i] = 0.f; }
            EpiSplit E; const float* rsa = (const float*)(ws + WS_RSA);
            if (isP) E = EpiSplit{(bf16_t*)(ws + WS_PUV), 1024, 4, (bf16_t*)(ws + WS_PRKVG), 2048, 12, (bf16_t*)(ws + WS_PWA), 256, rsa, nullptr};
            else E = EpiSplit{(bf16_t*)(ws + WS_BIG), 3072, 12, (bf16_t*)(ws + WS_BIG), 3072, 12, (bf16_t*)(ws + WS_BIG), 3072, rsa, (float*)(ws + WS_KSQ)};
#ifndef SKIP_G3
            pg8::gemm_phase<EpiSplit, pg8::StaticOrder, GEMM_ALIGN, GEMM_SP2>(lds, g, S, E);
#endif
        } else if (kind == K_MIXA) {
            constexpr int NLONG = 16 + 16 * (NSEG - 2) * 2;
            unsigned* qhead = (unsigned*)(ws + WS_TS + 2048);
            LAS int* qslot = (LAS int*)(lds + LDS_BYTES - 16);
            for (;;) {
                if (opaque_tid() == 0) *qslot = (int)__hip_atomic_fetch_add(qhead, 1u, __ATOMIC_RELAXED, __HIP_MEMORY_SCOPE_AGENT);
                __syncthreads();
                const int li = __builtin_amdgcn_readfirstlane(*qslot);
                __syncthreads();
                if (li >= 512 + NLONG + 640) break;
#ifndef SKIP_SCAN
                if (li < 512) scan_item<16>(P, li >> 4, (li >> 1) & 7, li & 1, 0, 0, 2048, 4 | 8, nullptr, nullptr, lds);
                else if (li < 512 + 16) {
                    const int hd = li - 512, dir = hd & 1;
                    scan_item<16>(P, 32, hd >> 1, dir, 0, dir == 0 ? 0 : 16384 - SEGLEN, SEGLEN, 4 | 8, nullptr, (float*)(ws + WS_STL) + (size_t)hd * NSEG * 4096, lds);
                } else if (li < 512 + NLONG) {
                    const int q = li - 512 - 16, hd = q & 15, isP = (q >> 4) & 1, sgm = 1 + (q >> 5), dir = hd & 1;
                    const int tb = dir == 0 ? sgm * SEGLEN : 16384 - (sgm + 1) * SEGLEN;
                    float* so = (float*)(ws + (isP ? WS_STP : WS_STL)) + ((size_t)hd * NSEG + sgm) * 4096;
                    scan_item<16>(P, 32, hd >> 1, dir, 0, tb, SEGLEN, isP ? (1 | 2) : 0, nullptr, so, lds);
                }
#endif
#ifndef SKIP_SGU
                if (li >= 512 + NLONG) sgu_item(P, li - 512 - NLONG, lds);
#endif
            }
        } else if (kind == K_CARRY) {
#ifndef SKIP_SCAN
            if (bid < 16) scan_carry(P, bid, lds);
#endif
        } else if (kind == K_MIXB) {
#ifndef SKIP_SCAN
            for (int li = bid; li < 16 * (NSEG - 1); li += G) {
                const int hd = li & 15, sgm = 1 + (li >> 4), dir = hd & 1;
                const int tb = dir == 0 ? sgm * SEGLEN : 16384 - (sgm + 1) * SEGLEN;
                scan_item<16>(P, 32, hd >> 1, dir, 0, tb, SEGLEN, 4 | 8, (const float*)(ws + WS_STS) + ((size_t)hd * NSEG + sgm) * 4096, nullptr, lds);
            }
#endif
        } else if (kind == K_FINAL) {
#ifndef SKIP_FIN
            rwkv_finalize(P);
#endif
        } else if (kind == K_ATTN) {
            for (int it = bid; it < 5120; it += G) {
#ifndef SKIP_ATTN
                if (it < 4096) attn_item(P, it >> 7, it & 15, (it >> 4) & 7, lds);
                else attn_item(P, 32, it & 15, (it - 4096) >> 4, lds);
#endif
            }
        }
        if (ph + 1 < N_PHASES) {
            __builtin_amdgcn_fence(__ATOMIC_RELEASE, "agent");
            asm volatile("s_waitcnt vmcnt(0) lgkmcnt(0)" ::: "memory");
            grid.sync();
            __builtin_amdgcn_fence(__ATOMIC_ACQUIRE, "agent");
            asm volatile("s_waitcnt vmcnt(0) lgkmcnt(0)" ::: "memory");
            __syncthreads();
        }
    }
#ifdef PROBE_MASK
    if (blockIdx.x == 0 && threadIdx.x == 0) {
        unsigned long long* ts = (unsigned long long*)(P.ws + WS_TS);
        ts[N_PHASES] = __builtin_amdgcn_s_memrealtime();
        unsigned long long tot = 0;
        for (int i = 0; i < N_PHASES; ++i) if ((PROBE_MASK >> i) & 1) tot += ts[i + 1] - ts[i];
        P.out[0] += 4.0f + 10.0f * (float)tot * 1e-5f;
    }
#endif
}

extern "C" void kernel_launch(void* const* d_in, const int* in_sizes, int n_in, void* d_out, int out_size, void* d_ws, size_t ws_size, hipStream_t stream) {
    static int grid_blocks = 0;
    if (!grid_blocks) {
        int dev = 0, cus = 0, per_cu = 0;
        (void)hipGetDevice(&dev);
        (void)hipDeviceGetAttribute(&cus, hipDeviceAttributeMultiprocessorCount, dev);
        (void)hipFuncSetAttribute((const void*)mega, hipFuncAttributeMaxDynamicSharedMemorySize, LDS_BYTES);
        (void)hipOccupancyMaxActiveBlocksPerMultiprocessor(&per_cu, (const void*)mega, 512, LDS_BYTES);
        (void)hipGetLastError();
        if (cus <= 0) cus = 256;
        grid_blocks = cus;
        if (ws_size < WS_END2) fprintf(stderr, "kernel_launch: workspace too small: %zu < %zu\n", ws_size, (size_t)WS_END2);
    }
    Params p{};
    for (int i = 0; i < 30 && i < n_in; ++i) p.in[i] = (const float*)d_in[i];
    p.out = (float*)d_out; p.ws = (unsigned char*)d_ws;
    void* args[] = {&p};
    hipError_t e = hipLaunchCooperativeKernel((const void*)mega, dim3(grid_blocks), dim3(512), args, LDS_BYTES, stream);
    if (e != hipSuccess) fprintf(stderr, "cooperative launch failed: %s (grid %d)\n", hipGetErrorString(e), grid_blocks);
}
```

```cpp
#include <hip/hip_runtime.h>
#include <hip/hip_cooperative_groups.h>
#include <cstdio>
namespace cg = cooperative_groups;

namespace pg8 {
#define PG8_LAS __attribute__((address_space(3)))
typedef unsigned short bf16_t;
typedef short bf16x8 __attribute__((ext_vector_type(8)));
typedef float f32x4 __attribute__((ext_vector_type(4)));
typedef unsigned u32x4 __attribute__((ext_vector_type(4)));
constexpr int BM = 256, BK = 64, HALF = 128, HTB = HALF * BK * 2  , STAGE_BYTES = 8 * HTB, NXCD = 8, WGM = 8;

__host__ __device__ __forceinline__ int lds_byte(int r, int c) { const int st = (r >> 4) * 2 + (c >> 5), rr = r & 15, cc = c & 31, ob = rr * 64 + cc * 2; return st * 1024 + (ob ^ (((ob >> 9) & 1) << 5)); }
__host__ __device__ __forceinline__ void stage_rc(int b, int& R, int& C) { const int st = b / 1024, sb = b % 1024, swz = sb ^ (((sb >> 9) & 1) << 5); R = (st >> 1) * 16 + swz / 64; C = (st & 1) * 32 + (swz % 64) / 2; }
__host__ __device__ __forceinline__ int perm32(int rho) { const int n = rho >> 4, i = rho & 15; return 8 * (i >> 2) + 4 * n + (i & 3); }

struct Unit { int pm, pn; };
struct Gemm { const bf16_t* A; const bf16_t* Bt; int M, N, K; };

struct StaticOrder {
    int nM, nN, nwg, G, c;
    __host__ __device__ void init(int M, int N, int G_, int c_) { nM = M / BM; nN = N / BM; nwg = nM * nN; G = G_; c = c_; }
    __host__ __device__ bool next(int i, Unit& u) const {
        const long L = (long)i * G + c; if (L >= nwg) return false;
        int wgid = (int)L; { const int q = nwg / NXCD, r = nwg % NXCD, xcd = wgid % NXCD, off = wgid / NXCD; wgid = (xcd < r ? xcd * (q + 1) : r * (q + 1) + (xcd - r) * q) + off; }
        const int nig = WGM * nN, gid = wgid / nig, fm = gid * WGM, gsz = (nM - fm) < WGM ? (nM - fm) : WGM;
        u.pm = fm + ((wgid % nig) % gsz); u.pn = (wgid % nig) / gsz; return true;
    }
    __device__ __forceinline__ void a_ready(const Unit&) const {}
    __device__ __forceinline__ void done(const Unit&) const {}
};
__device__ __forceinline__ unsigned cvt_pk_bf16(float lo, float hi) { unsigned r; asm volatile("v_cvt_pk_bf16_f32 %0, %1, %2" : "=v"(r) : "v"(lo), "v"(hi)); return r; }
typedef float f32x2 __attribute__((ext_vector_type(2)));
template <class Epi, class Sched, bool ALIGN_EPI = false, bool SP2 = false>
__device__ __forceinline__ void gemm_phase(PG8_LAS unsigned char* lds, const Gemm g, const Sched& S, const Epi& E) {
    int tid_raw_ = threadIdx.x; asm volatile("" : "+v"(tid_raw_)); const int tid = tid_raw_, wid = __builtin_amdgcn_readfirstlane(tid >> 6), lane = tid & 63, wr = wid >> 2, wc = wid & 3, fr = lane & 15, fq = lane >> 4;
    const int K = g.K, nt = K / BK;
    unsigned voffA[2], voffB[2];
#pragma unroll
    for (int i = 0; i < 2; ++i) { int R, C; stage_rc(tid * 16 + i * 8192, R, C); const int Rb = Epi::PERM ? ((R & ~31) + perm32(R & 31)) : R;
        voffA[i] = (unsigned)(R * K + C) * 2u; voffB[i] = (unsigned)(Rb * K + C) * 2u; }
    const size_t kstep = (size_t)(BK * 2);
    const size_t hstep = (size_t)HALF * K * 2;
    const size_t tstep = 2 * hstep;
    const unsigned ldsw = (unsigned)wid * 1024u;
    const int aoff = lds_byte(wr * 64 + fr, fq * 8), boff = lds_byte(wc * 32 + fr, fq * 8);
#define PG8_SA(b, h) (((b) * 2 + (h)) * HTB)
#define PG8_SB(b, h) ((4 + (b) * 2 + (h)) * HTB)
#define PG8_STAGE(bufoff, gbase, voff) do { _Pragma("unroll") for (int _i = 0; _i < 2; ++_i) \
        __builtin_amdgcn_global_load_lds((const unsigned*)((const char*)(gbase) + (voff)[_i]), (PG8_LAS unsigned*)(lds + (bufoff) + ldsw + _i * 8192), 16, 0, 0); } while (0)
#define PG8_LDA(dst, b, h) do { _Pragma("unroll") for (int m = 0; m < 4; ++m) _Pragma("unroll") for (int k = 0; k < 2; ++k) dst[m][k] = *(const PG8_LAS bf16x8*)(lds + PG8_SA(b, h) + aoff + m * 2048 + k * 1024); } while (0)
#define PG8_LDB(dst, b, h) do { _Pragma("unroll") for (int n = 0; n < 2; ++n) _Pragma("unroll") for (int k = 0; k < 2; ++k) dst[n][k] = *(const PG8_LAS bf16x8*)(lds + PG8_SB(b, h) + boff + n * 2048 + k * 1024); } while (0)
#define PG8_MMA(ai, bj, At, Bt) do { __builtin_amdgcn_s_setprio(1); _Pragma("unroll") for (int m = 0; m < 4; ++m) _Pragma("unroll") for (int n = 0; n < 2; ++n) _Pragma("unroll") for (int k = 0; k < 2; ++k) \
        acc[ai][bj][m][n] = __builtin_amdgcn_mfma_f32_16x16x32_bf16(Bt[n][k], At[m][k], acc[ai][bj][m][n], 0, 0, 0); __builtin_amdgcn_s_setprio(0); } while (0)
#define PG8_WAIT_V(n) asm volatile("s_waitcnt vmcnt(" #n ")" ::: "memory")
#define PG8_WAIT_L(n) asm volatile("s_waitcnt lgkmcnt(" #n ")" ::: "memory")
#define PG8_BAR __builtin_amdgcn_s_barrier()
#define PG8_SCHED __builtin_amdgcn_sched_barrier(0)
    Unit cur, nxt; int ui = 0;
    if (!S.next(0, cur)) return;
    f32x4 acc[2][2][4][2];
#pragma unroll
    for (int a = 0; a < 2; ++a)
#pragma unroll
        for (int b = 0; b < 2; ++b)
#pragma unroll
            for (int m = 0; m < 4; ++m)
#pragma unroll
                for (int n = 0; n < 2; ++n) acc[a][b][m][n] = (f32x4){0.f, 0.f, 0.f, 0.f};
    bf16x8 At[4][2], B0[2][2], B1[2][2];
    const char* cA = (const char*)g.A + (size_t)cur.pm * tstep; const char* cB = (const char*)g.Bt + (size_t)cur.pn * tstep;
    S.a_ready(cur);
    if constexpr (SP2) {
        PG8_STAGE(PG8_SB(0, 0), cB, voffB); PG8_STAGE(PG8_SB(0, 1), cB + hstep, voffB); PG8_STAGE(PG8_SA(0, 0), cA, voffA); PG8_STAGE(PG8_SA(0, 1), cA + hstep, voffA);
        if (wr == 1) PG8_BAR;
        PG8_WAIT_V(2); PG8_BAR;
        PG8_STAGE(PG8_SB(1, 0), cB + kstep, voffB); PG8_STAGE(PG8_SA(1, 0), cA + kstep, voffA); PG8_STAGE(PG8_SB(1, 1), cB + hstep + kstep, voffB);
        PG8_WAIT_V(6); PG8_BAR;
    } else {
        PG8_STAGE(PG8_SB(0, 0), cB, voffB); PG8_STAGE(PG8_SA(0, 0), cA, voffA); PG8_STAGE(PG8_SB(0, 1), cB + hstep, voffB); PG8_STAGE(PG8_SA(0, 1), cA + hstep, voffA);
        if (wr == 1) PG8_BAR;
        PG8_WAIT_V(4); PG8_BAR;
        PG8_STAGE(PG8_SB(1, 0), cB + kstep, voffB); PG8_STAGE(PG8_SA(1, 0), cA + kstep, voffA); PG8_STAGE(PG8_SB(1, 1), cB + hstep + kstep, voffB);
        PG8_WAIT_V(6); PG8_BAR;
    }
    for (;;) {
        const bool has_next = S.next(ui + 1, nxt);
        const char* nA = has_next ? (const char*)g.A + (size_t)nxt.pm * tstep : cA; const char* nB = has_next ? (const char*)g.Bt + (size_t)nxt.pn * tstep : cB;
        for (int t = 0; t < nt; t += 2) {
            const bool last = (t == nt - 2);
            const char* a1 = cA + (size_t)(t + 1) * kstep;
            const char* a2 = last ? nA : cA + (size_t)(t + 2) * kstep; const char* b2 = last ? nB : cB + (size_t)(t + 2) * kstep;
            const char* a3 = a2 + kstep; const char* b3 = b2 + kstep;
            if (last && has_next) S.a_ready(nxt);
            if constexpr (SP2) {
            PG8_LDB(B0, 0, 0); PG8_LDB(B1, 0, 1); PG8_SCHED; PG8_LDA(At, 0, 0); PG8_STAGE(PG8_SA(1, 1), a1 + hstep, voffA);
            PG8_WAIT_V(8); PG8_WAIT_L(0); PG8_BAR; PG8_MMA(0, 0, At, B0); PG8_MMA(0, 1, At, B1); PG8_BAR; PG8_SCHED;
            PG8_LDA(At, 0, 1); PG8_STAGE(PG8_SB(0, 0), b2, voffB); PG8_STAGE(PG8_SB(0, 1), b2 + hstep, voffB); PG8_STAGE(PG8_SA(0, 0), a2, voffA);
            PG8_WAIT_V(8); PG8_WAIT_L(0); PG8_BAR; PG8_MMA(1, 0, At, B0); PG8_MMA(1, 1, At, B1); PG8_BAR; PG8_SCHED;
            PG8_LDB(B0, 1, 0); PG8_LDB(B1, 1, 1); PG8_SCHED; PG8_LDA(At, 1, 0); PG8_STAGE(PG8_SA(0, 1), a2 + hstep, voffA);
            PG8_WAIT_V(8); PG8_WAIT_L(0); PG8_BAR; PG8_MMA(0, 0, At, B0); PG8_MMA(0, 1, At, B1); PG8_BAR; PG8_SCHED;
            PG8_LDA(At, 1, 1); PG8_STAGE(PG8_SB(1, 0), b3, voffB); PG8_STAGE(PG8_SB(1, 1), b3 + hstep, voffB); PG8_STAGE(PG8_SA(1, 0), a3, voffA);
            PG8_WAIT_V(8); PG8_WAIT_L(0); PG8_BAR; PG8_MMA(1, 0, At, B0); PG8_MMA(1, 1, At, B1); PG8_BAR; PG8_SCHED;
            } else {
            PG8_LDB(B0, 0, 0); PG8_SCHED; PG8_LDA(At, 0, 0); PG8_STAGE(PG8_SA(1, 1), a1 + hstep, voffA);
            PG8_WAIT_L(8); PG8_BAR; PG8_WAIT_L(0); PG8_MMA(0, 0, At, B0); PG8_BAR; PG8_SCHED;
            PG8_LDB(B1, 0, 1); PG8_STAGE(PG8_SB(0, 0), b2, voffB);
            PG8_BAR; PG8_WAIT_L(0); PG8_MMA(0, 1, At, B1); PG8_BAR;
            PG8_LDA(At, 0, 1); PG8_STAGE(PG8_SA(0, 0), a2, voffA);
            PG8_BAR; PG8_WAIT_L(0); PG8_MMA(1, 0, At, B0); PG8_BAR; PG8_SCHED;
            PG8_STAGE(PG8_SB(0, 1), b2 + hstep, voffB);
            PG8_WAIT_V(6); PG8_BAR; PG8_MMA(1, 1, At, B1); PG8_BAR;
            PG8_LDB(B0, 1, 0); PG8_SCHED; PG8_LDA(At, 1, 0); PG8_STAGE(PG8_SA(0, 1), a2 + hstep, voffA);
            PG8_WAIT_L(8); PG8_BAR; PG8_WAIT_L(0); PG8_MMA(0, 0, At, B0); PG8_BAR; PG8_SCHED;
            PG8_LDB(B1, 1, 1); PG8_STAGE(PG8_SB(1, 0), b3, voffB);
            PG8_BAR; PG8_WAIT_L(0); PG8_MMA(0, 1, At, B1); PG8_BAR;
            PG8_LDA(At, 1, 1); PG8_STAGE(PG8_SA(1, 0), a3, voffA);
            PG8_BAR; PG8_WAIT_L(0); PG8_MMA(1, 0, At, B0); PG8_BAR; PG8_SCHED;
            PG8_STAGE(PG8_SB(1, 1), b3 + hstep, voffB);
            PG8_WAIT_V(6); PG8_BAR; PG8_MMA(1, 1, At, B1); PG8_BAR;
            }
        }
        if constexpr (ALIGN_EPI) { if (wr == 0) PG8_BAR; }
        if constexpr (!Epi::AFTER_DRAIN) { E(acc, cur, wr, wc, fr, fq); S.done(cur); }
        if (!has_next) break;
#pragma unroll
        for (int a = 0; a < 2; ++a)
#pragma unroll
            for (int b = 0; b < 2; ++b)
#pragma unroll
                for (int m = 0; m < 4; ++m)
#pragma unroll
                    for (int n = 0; n < 2; ++n) acc[a][b][m][n] = (f32x4){0.f, 0.f, 0.f, 0.f};
        cur = nxt; cA = nA; cB = nB; ++ui;
        if constexpr (ALIGN_EPI) { if (wr == 1) PG8_BAR; }
    }
    PG8_WAIT_V(0);
    if constexpr (!ALIGN_EPI) { if (wr == 0) PG8_BAR; }
    PG8_BAR;
    if constexpr (Epi::AFTER_DRAIN) { E.fused(acc, cur, wr, wc, fr, fq, lds, wid, lane); S.done(cur); }
#undef PG8_SA
#undef PG8_SB
#undef PG8_STAGE
#undef PG8_LDA
#undef PG8_LDB
#undef PG8_MMA
#undef PG8_WAIT_V
#undef PG8_WAIT_L
#undef PG8_BAR
#undef PG8_SCHED
}
}


#define LAS __attribute__((address_space(3)))
typedef unsigned short bf16_t;
typedef short bf16x8 __attribute__((ext_vector_type(8)));
typedef short s16x4 __attribute__((ext_vector_type(4)));
typedef float f32x4 __attribute__((ext_vector_type(4)));
typedef unsigned u32x4 __attribute__((ext_vector_type(4)));
typedef unsigned u32x2 __attribute__((ext_vector_type(2)));

constexpr int M_TOK = 81920, M_PROMPT = 65536, DM = 1024, DFF = 2816;
constexpr int LDS_BYTES = 147456;
#ifndef GEMM_ALIGN
#define GEMM_ALIGN true
#endif
#ifndef GEMM_SP2
#define GEMM_SP2 true
#endif
constexpr float NORM_EPS = 1e-6f;

constexpr size_t SZ_WFI = (size_t)5632 * 1024 * 2, SZ_WFO = (size_t)1024 * 2816 * 2;
constexpr size_t WS_WFI = 0;
constexpr size_t WS_WFO = WS_WFI + 4 * SZ_WFI;
constexpr size_t WS_WABI = WS_WFO + 4 * SZ_WFO;
constexpr size_t WS_WABO = WS_WABI + (size_t)3328 * 1024 * 2;
constexpr size_t WS_WATI = WS_WABO + (size_t)1024 * 1024 * 2;
constexpr size_t WS_WATO = WS_WATI + (size_t)3072 * 1024 * 2;
constexpr size_t WS_LORA = WS_WATO + (size_t)1024 * 1024 * 2;
constexpr size_t WS_SGUW = WS_LORA + (size_t)4 * 512 * 64 * 2;
constexpr size_t WS_RKR = WS_SGUW + (size_t)4 * 128 * 128 * 2;
constexpr size_t WS_XN = (WS_RKR + (size_t)2 * M_TOK * 8 * 4 + 4095) & ~(size_t)4095;
constexpr size_t WS_BIG = WS_XN + (size_t)M_TOK * 1024 * 2;
constexpr size_t WS_PUV = WS_BIG;
constexpr size_t WS_PRKVG = WS_PUV + (size_t)M_TOK * 1024 * 2;
constexpr size_t WS_PWA = WS_PRKVG + (size_t)M_TOK * 2048 * 2;
constexpr size_t WS_Y = WS_BIG + (size_t)M_TOK * 3328 * 2;
constexpr size_t WS_END = WS_Y + (size_t)2 * M_TOK * 512 * 2;

constexpr int NSEG = 16, SEGLEN = 16384 / NSEG;
constexpr size_t WS_STL = (WS_END + 4095) & ~(size_t)4095;
constexpr size_t WS_STP = WS_STL + (size_t)16 * NSEG * 4096 * 4;
constexpr size_t WS_STS = WS_STP + (size_t)16 * NSEG * 4096 * 4;
constexpr size_t WS_TS = WS_STS + (size_t)16 * NSEG * 4096 * 4;
constexpr size_t WS_RSA = WS_TS + 4096;
constexpr size_t WS_RSB = WS_RSA + (size_t)M_TOK * 4;
constexpr size_t WS_RSC = WS_RSB + (size_t)M_TOK * 4;
constexpr size_t WS_RSD = WS_RSC + (size_t)M_TOK * 4;
constexpr size_t WS_KSQ = WS_RSD + (size_t)M_TOK * 4;
constexpr size_t WS_END2 = WS_KSQ + (size_t)16 * M_TOK * 4;
struct Params { const float* in[30]; float* out; unsigned char* ws; };

__device__ __forceinline__ float bflo(unsigned w) { return __uint_as_float(w << 16); }
__device__ __forceinline__ float bfhi(unsigned w) { return __uint_as_float(w & 0xffff0000u); }
__device__ __forceinline__ unsigned pk2(float lo, float hi) { unsigned r; asm("v_cvt_pk_bf16_f32 %0, %1, %2" : "=v"(r) : "v"(lo), "v"(hi)); return r; }
__device__ __forceinline__ void unpack8(const u32x4 w, float* f) { f[0] = bflo(w.x); f[1] = bfhi(w.x); f[2] = bflo(w.y); f[3] = bfhi(w.y); f[4] = bflo(w.z); f[5] = bfhi(w.z); f[6] = bflo(w.w); f[7] = bfhi(w.w); }
__device__ __forceinline__ u32x4 pack8(const float* f) { u32x4 w; w.x = pk2(f[0], f[1]); w.y = pk2(f[2], f[3]); w.z = pk2(f[4], f[5]); w.w = pk2(f[6], f[7]); return w; }
__device__ __forceinline__ float sigmoidf_(float x) { return __builtin_amdgcn_rcpf(1.0f + __expf(-x)); }
__device__ __forceinline__ float siluf_(float x) { return x * sigmoidf_(x); }
__device__ __forceinline__ float gelu_tanh(float x) { const float u = 0.7978845608028654f * (x + 0.044715f * x * x * x); return x * sigmoidf_(2.0f * u); }
__device__ __forceinline__ float tanhf_(float x) { return 1.0f - 2.0f * __builtin_amdgcn_rcpf(__expf(2.0f * x) + 1.0f); }
__device__ __forceinline__ float wave_sum(float x) { x += __shfl_xor(x, 32); x += __shfl_xor(x, 16); x += __shfl_xor(x, 8); x += __shfl_xor(x, 4); x += __shfl_xor(x, 2); x += __shfl_xor(x, 1); return x; }
template <int CTRL> __device__ __forceinline__ float dppf(float x) { return __int_as_float(__builtin_amdgcn_update_dpp(0, __float_as_int(x), CTRL, 0xF, 0xF, true)); }
__device__ __forceinline__ float reduce8(float x) { x += dppf<0xB1>(x); x += dppf<0x4E>(x); x += dppf<0x141>(x); return x; }
typedef short v4i16_t __attribute__((ext_vector_type(4)));
typedef __bf16 bf16x2_t __attribute__((ext_vector_type(2)));
__device__ __forceinline__ s16x4 tr_read(LAS const unsigned char* p) { return __builtin_bit_cast(s16x4, __builtin_amdgcn_ds_read_tr16_b64_v4i16((LAS v4i16_t*)p)); }
__device__ __forceinline__ f32x4 mfma16(bf16x8 a, bf16x8 b, f32x4 c) { return __builtin_amdgcn_mfma_f32_16x16x32_bf16(a, b, c, 0, 0, 0); }

__device__ __forceinline__ int opaque_tid() { int t = threadIdx.x; asm volatile("" : "+v"(t)); return t; }
__device__ __forceinline__ unsigned char* opaque_ptr(unsigned char* p) { size_t z = 0; asm volatile("" : "+s"(z)); return p + z; }
struct EpiSwiglu {
    static constexpr bool PERM = false, AFTER_DRAIN = false;
    bf16_t* H; const float* rowss; const float* rowss2;
    __device__ __forceinline__ void operator()(const f32x4 (&acc)[2][2][4][2], const pg8::Unit& u, int wr, int wc, int fr, int fq) const {
        const int row0 = u.pm * 256 + wr * 64 + fr, col0 = u.pn * 128 + wc * 32 + 8 * fq;
        float rsv[8];
#pragma unroll
        for (int gi = 0; gi < 8; ++gi) rsv[gi] = rowss ? rowss[row0 + (gi >> 2) * 128 + (gi & 3) * 16] : 0.f;
        float rsw[8];
#pragma unroll
        for (int gi = 0; gi < 8; ++gi) rsw[gi] = rowss2 ? rowss2[row0 + (gi >> 2) * 128 + (gi & 3) * 16] : 0.f;
#pragma unroll
        for (int gi = 0; gi < 8; ++gi) { rsv[gi] = rowss ? rsqrtf(rsv[gi] * (1.0f / DM) + NORM_EPS) : 1.0f;
            if (rowss2) rsv[gi] *= rsqrtf(rsv[gi] * rsv[gi] * rsw[gi] * (1.0f / DM) + NORM_EPS); }
#pragma unroll
        for (int ai = 0; ai < 2; ++ai)
#pragma unroll
            for (int m = 0; m < 4; ++m) {
                const int row = row0 + ai * 128 + m * 16;
                const float rs = rsv[ai * 4 + m];
                bf16_t* rowp = H + (size_t)row * DFF + col0;
                float h[8];
#pragma unroll
                for (int bj = 0; bj < 2; ++bj)
#pragma unroll
                    for (int j = 0; j < 4; ++j) h[bj * 4 + j] = siluf_(acc[ai][bj][m][0][j] * rs) * (acc[ai][bj][m][1][j] * rs);
                *(u32x4*)rowp = pack8(h);
                asm volatile("" ::: "memory");
            }
    }
};
struct EpiResid {
    static constexpr bool PERM = false, AFTER_DRAIN = false;
    float* X; float scale; bf16_t* XG; const float* g; float* rowss; const float* xin_a; const float* xin_b;
    const float* gaux; float* rowss2; const float* base_ss;
    __device__ __forceinline__ void operator()(const f32x4 (&acc)[2][2][4][2], const pg8::Unit& u, int wr, int wc, int fr, int fq) const {
        const int row0 = u.pm * 256 + wr * 64 + fr, col0 = u.pn * 256 + wc * 32 + 4 * fq;
        f32x4 gv[2][2];
#pragma unroll
        for (int bj = 0; bj < 2; ++bj)
#pragma unroll
            for (int n = 0; n < 2; ++n) gv[bj][n] = XG ? *(const f32x4*)(g + col0 + bj * 128 + n * 16) : (f32x4){0.f, 0.f, 0.f, 0.f};
        f32x4 ga[2][2];
#pragma unroll
        for (int bj = 0; bj < 2; ++bj)
#pragma unroll
            for (int n = 0; n < 2; ++n) { ga[bj][n] = gaux ? *(const f32x4*)(gaux + col0 + bj * 128 + n * 16) : (f32x4){1.f, 1.f, 1.f, 1.f}; if (rowss2) gv[bj][n] = gv[bj][n] * ga[bj][n]; }
        float brs[8];
#pragma unroll
        for (int gi = 0; gi < 8; ++gi) brs[gi] = base_ss ? base_ss[row0 + (gi >> 2) * 128 + (gi & 3) * 16] : 0.f;
#pragma unroll
        for (int gi = 0; gi < 8; ++gi) brs[gi] = base_ss ? rsqrtf(brs[gi] * (1.0f / DM) + NORM_EPS) : 1.0f;
        const float* Xs = xin_a ? (u.pm < 256 ? xin_a : xin_b - (size_t)M_PROMPT * DM) : X;
        f32x4 xin[2][2][2];
#pragma unroll
        for (int gi = 0; gi < 9; ++gi) {
            if (gi < 8) {
                const float* rowp = Xs + (size_t)(row0 + (gi >> 2) * 128 + (gi & 3) * 16) * DM + col0;
#pragma unroll
                for (int bj = 0; bj < 2; ++bj)
#pragma unroll
                    for (int n = 0; n < 2; ++n) xin[gi & 1][bj][n] = *(const f32x4*)(rowp + bj * 128 + n * 16);
            }
            if (gi > 0) {
                const int gp = gi - 1, ai = gp >> 2, m = gp & 3;
                const int row = row0 + ai * 128 + m * 16;
                float* rowp = X + (size_t)row * DM + col0;
                float ssq = 0.f, ssq2 = 0.f;
#pragma unroll
                for (int bj = 0; bj < 2; ++bj)
#pragma unroll
                    for (int n = 0; n < 2; ++n) { f32x4 v = xin[gp & 1][bj][n]; if (base_ss) v = v * brs[gp] * ga[bj][n];
                        v += acc[ai][bj][m][n] * scale; *(f32x4*)(rowp + bj * 128 + n * 16) = v;
                        if (XG) { ssq += (v[0] * v[0] + v[1] * v[1]) + (v[2] * v[2] + v[3] * v[3]); const f32x4 o = v * gv[bj][n]; u32x2 w; w.x = pk2(o[0], o[1]); w.y = pk2(o[2], o[3]);
                            *(u32x2*)(XG + (size_t)row * DM + col0 + bj * 128 + n * 16) = w; }
                        if (rowss2) { const f32x4 t = v * ga[bj][n]; ssq2 += (t[0] * t[0] + t[1] * t[1]) + (t[2] * t[2] + t[3] * t[3]); } }
                if (XG) { ssq += __shfl_xor(ssq, 16); ssq += __shfl_xor(ssq, 32);
                    if (fq == 0) __hip_atomic_fetch_add(rowss + row, ssq, __ATOMIC_RELAXED, __HIP_MEMORY_SCOPE_AGENT); }
                if (rowss2) { ssq2 += __shfl_xor(ssq2, 16); ssq2 += __shfl_xor(ssq2, 32);
                    if (fq == 0) __hip_atomic_fetch_add(rowss2 + row, ssq2, __ATOMIC_RELAXED, __HIP_MEMORY_SCOPE_AGENT); }
            }
            asm volatile("" ::: "memory");
        }
    }
};
struct EpiSplit {
    static constexpr bool PERM = true, AFTER_DRAIN = false;
    bf16_t* b0; int ld0, t0; bf16_t* b1; int ld1, t1; bf16_t* b2; int ld2; const float* rowss; float* ksq;
    __device__ __forceinline__ void operator()(const f32x4 (&acc)[2][2][4][2], const pg8::Unit& u, int wr, int wc, int fr, int fq) const {
        bf16_t* base; int ld, ct;
        if (u.pn < t0) { base = b0; ld = ld0; ct = u.pn; } else if (u.pn < t1) { base = b1; ld = ld1; ct = u.pn - t0; } else { base = b2; ld = ld2; ct = u.pn - t1; }
        const int row0 = u.pm * 256 + wr * 64 + fr, col0 = ct * 256 + wc * 32 + 8 * fq;
        const bool isk = ksq != nullptr && u.pn >= 4 && u.pn < 8;
        float rsv[8];
#pragma unroll
        for (int gi = 0; gi < 8; ++gi) rsv[gi] = rowss[row0 + (gi >> 2) * 128 + (gi & 3) * 16];
#pragma unroll
        for (int gi = 0; gi < 8; ++gi) rsv[gi] = rsqrtf(rsv[gi] * (1.0f / DM) + NORM_EPS);
#pragma unroll
        for (int ai = 0; ai < 2; ++ai)
#pragma unroll
            for (int m = 0; m < 4; ++m) {
                const int row = row0 + ai * 128 + m * 16;
                const float rs = rsv[ai * 4 + m];
                bf16_t* rowp = base + (size_t)row * ld + col0;
#pragma unroll
                for (int bj = 0; bj < 2; ++bj) {
                    const f32x4 v0 = acc[ai][bj][m][0] * rs, v1 = acc[ai][bj][m][1] * rs;
                    u32x4 w; w.x = pk2(v0[0], v0[1]); w.y = pk2(v0[2], v0[3]); w.z = pk2(v1[0], v1[1]); w.w = pk2(v1[2], v1[3]);
                    *(u32x4*)(rowp + bj * 128) = w;
                    if (isk) {
                        float sq = ((v0[0] * v0[0] + v0[1] * v0[1]) + (v0[2] * v0[2] + v0[3] * v0[3])) + ((v1[0] * v1[0] + v1[1] * v1[1]) + (v1[2] * v1[2] + v1[3] * v1[3]));
                        sq += __shfl_xor(sq, 16); sq += __shfl_xor(sq, 32);
                        if (fq == 0) __hip_atomic_fetch_add(ksq + (size_t)((u.pn - 4) * 4 + 2 * bj + (wc >> 1)) * M_TOK + row, sq, __ATOMIC_RELAXED, __HIP_MEMORY_SCOPE_AGENT);
                    }
                }
                asm volatile("" ::: "memory");
            }
    }
};

template <int MAP> __device__ __forceinline__ int src_col(int s) {
    if (MAP == 0) return s;
    const int pn = s >> 8, bj = (s >> 7) & 1, wc = (s >> 5) & 3, n = (s >> 4) & 1, fq = (s >> 2) & 3, jj = s & 3;
    return n * DFF + 128 * pn + 32 * wc + 8 * fq + 4 * bj + jj;
}
template <int MAP> __device__ void convert_T(const float* __restrict__ src, bf16_t* __restrict__ dst, int K, int N, LAS float* tile, int rot) {
    const int tk = K / 64, tn = N / 64, nt = tk * tn, tid = opaque_tid(), G = gridDim.x;
    const int kk0 = tid >> 4, sg = tid & 15;
    int t = (int)((blockIdx.x + rot) % G);
    float4 va = make_float4(0.f, 0.f, 0.f, 0.f), vb = va;
    if (t < nt) { const int k0 = (t % tk) * 64, s0 = (t / tk) * 64; const int c = src_col<MAP>(s0 + sg * 4);
        va = *(const float4*)(src + (size_t)(k0 + kk0) * N + c); vb = *(const float4*)(src + (size_t)(k0 + kk0 + 32) * N + c); }
    for (; t < nt; t += G) {
        const int k0 = (t % tk) * 64, s0 = (t / tk) * 64;
        { LAS float* tp = tile + kk0 * 65 + sg * 4; tp[0] = va.x; tp[1] = va.y; tp[2] = va.z; tp[3] = va.w;
          LAS float* tq = tile + (kk0 + 32) * 65 + sg * 4; tq[0] = vb.x; tq[1] = vb.y; tq[2] = vb.z; tq[3] = vb.w; }
        if (t + G < nt) {
            const int t2 = t + G, k2 = (t2 % tk) * 64, s2 = (t2 / tk) * 64; const int c = src_col<MAP>(s2 + sg * 4);
            va = *(const float4*)(src + (size_t)(k2 + kk0) * N + c); vb = *(const float4*)(src + (size_t)(k2 + kk0 + 32) * N + c); }
        asm volatile("s_waitcnt lgkmcnt(0)" ::: "memory"); __builtin_amdgcn_s_barrier(); asm volatile("" ::: "memory");
        {
            const int slot = tid >> 3, kc = tid & 7; float f[8];
#pragma unroll
            for (int i = 0; i < 8; ++i) f[i] = tile[(kc * 8 + i) * 65 + slot];
            *(u32x4*)(dst + (size_t)(s0 + slot) * K + k0 + kc * 8) = pack8(f);
        }
        asm volatile("s_waitcnt lgkmcnt(0)" ::: "memory"); __builtin_amdgcn_s_barrier(); asm volatile("" ::: "memory");
    }
}

__device__ void norm_rows(const float* xa, const float* xb, int split, float* xcopy, const float* g1, float* x1out, const float* g2, bf16_t* xn) {
    const int tid_ = opaque_tid(), lane = tid_ & 63, wave = __builtin_amdgcn_readfirstlane(tid_ >> 6);
    const int stride = gridDim.x * 8;
    for (int row0 = blockIdx.x * 8 + wave; row0 < M_TOK; row0 += 2 * stride) {
        int rows[2]; rows[0] = row0; rows[1] = (row0 + stride < M_TOK) ? row0 + stride : row0;
        f32x4 v[2][4]; float ss[2] = {0.f, 0.f};
#pragma unroll
        for (int q = 0; q < 2; ++q) { const int row = rows[q];
            const float* src = (row < split) ? xa + (size_t)row * DM : xb + (size_t)(row - split) * DM;
#pragma unroll
            for (int i = 0; i < 4; ++i) v[q][i] = *(const f32x4*)(src + i * 256 + lane * 4); }
#pragma unroll
        for (int q = 0; q < 2; ++q) {
#pragma unroll
            for (int i = 0; i < 4; ++i) ss[q] += v[q][i][0] * v[q][i][0] + v[q][i][1] * v[q][i][1] + v[q][i][2] * v[q][i][2] + v[q][i][3] * v[q][i][3];
            if (xcopy) {
#pragma unroll
                for (int i = 0; i < 4; ++i) *(f32x4*)(xcopy + (size_t)rows[q] * DM + i * 256 + lane * 4) = v[q][i];
            }
        }
        ss[0] = wave_sum(ss[0]); ss[1] = wave_sum(ss[1]);
        float r[2]; r[0] = rsqrtf(ss[0] * (1.0f / DM) + NORM_EPS); r[1] = rsqrtf(ss[1] * (1.0f / DM) + NORM_EPS);
        if (g1) {
            float s2[2] = {0.f, 0.f};
#pragma unroll
            for (int i = 0; i < 4; ++i) { const f32x4 g = *(const f32x4*)(g1 + i * 256 + lane * 4);
#pragma unroll
                for (int q = 0; q < 2; ++q) { v[q][i] = v[q][i] * r[q] * g; *(f32x4*)(x1out + (size_t)rows[q] * DM + i * 256 + lane * 4) = v[q][i];
                    s2[q] += v[q][i][0] * v[q][i][0] + v[q][i][1] * v[q][i][1] + v[q][i][2] * v[q][i][2] + v[q][i][3] * v[q][i][3]; } }
            s2[0] = wave_sum(s2[0]); s2[1] = wave_sum(s2[1]);
            r[0] = rsqrtf(s2[0] * (1.0f / DM) + NORM_EPS); r[1] = rsqrtf(s2[1] * (1.0f / DM) + NORM_EPS);
        }
        if (g2) {
#pragma unroll
            for (int i = 0; i < 4; ++i) { const f32x4 g = *(const f32x4*)(g2 + i * 256 + lane * 4);
#pragma unroll
                for (int q = 0; q < 2; ++q) { const f32x4 o = v[q][i] * r[q] * g;
                    u32x2 w; w.x = pk2(o[0], o[1]); w.y = pk2(o[2], o[3]); *(u32x2*)(xn + (size_t)rows[q] * DM + i * 256 + lane * 4) = w; } }
        }
    }
}

__device__ void sgu_item(const Params& PP, int chunk, LAS unsigned char* lds) {
    Params P = PP; P.ws = opaque_ptr(PP.ws);
    const int tid = opaque_tid(), lane = tid & 63, wave = __builtin_amdgcn_readfirstlane(tid >> 6), l15 = lane & 15, quad = lane >> 4;
    constexpr int PITCH = 1056;
    const bf16_t* Puv = (const bf16_t*)(P.ws + WS_PUV);
    bf16_t* MO = (bf16_t*)(P.ws + WS_XN);
    const size_t row0 = (size_t)chunk * 128;
    {
        float gn[8];
        { const f32x4 a = *(const f32x4*)(P.in[12] + lane * 8), b = *(const f32x4*)(P.in[12] + lane * 8 + 4); gn[0] = a[0]; gn[1] = a[1]; gn[2] = a[2]; gn[3] = a[3]; gn[4] = b[0]; gn[5] = b[1]; gn[6] = b[2]; gn[7] = b[3]; }
        for (int i = 0; i < 16; ++i) {
            const int p = wave * 16 + i;
            const u32x4 raw = *(const u32x4*)(Puv + (row0 + p) * 1024 + 512 + lane * 8);
            float v[8]; unpack8(raw, v); float ss = 0.f;
#pragma unroll
            for (int e = 0; e < 8; ++e) { v[e] = gelu_tanh(v[e]); ss += v[e] * v[e]; }
            ss = wave_sum(ss);
            const float r = rsqrtf(ss * (1.0f / 512.0f) + NORM_EPS);
#pragma unroll
            for (int e = 0; e < 8; ++e) v[e] = v[e] * r * gn[e];
            *(LAS u32x4*)(lds + p * PITCH + lane * 16) = pack8(v);
        }
    }
    __syncthreads();
    const int g = wave >> 1, cbase = (wave >> 1) * 128 + (wave & 1) * 64;
    const bf16_t* Wg = (const bf16_t*)(P.ws + WS_SGUW) + (size_t)g * 128 * 128;
    const int r4 = l15 >> 2, c4 = l15 & 3;
    for (int qh = 0; qh < 2; ++qh) {
        f32x4 acc[4][4];
#pragma unroll
        for (int a = 0; a < 4; ++a)
#pragma unroll
            for (int b = 0; b < 4; ++b) acc[a][b] = (f32x4){0.f, 0.f, 0.f, 0.f};
#pragma unroll
        for (int ks = 0; ks < 4; ++ks) {
            bf16x8 bfr[4];
#pragma unroll
            for (int qt = 0; qt < 4; ++qt) bfr[qt] = *(const bf16x8*)(Wg + (size_t)(qh * 64 + qt * 16 + l15) * 128 + ks * 32 + quad * 8);
#pragma unroll
            for (int ct = 0; ct < 4; ++ct) {
                LAS const unsigned char* ap = lds + (ks * 32 + quad * 8 + r4) * PITCH + (cbase + ct * 16 + 4 * c4) * 2;
                const s16x4 lo = tr_read(ap), hi = tr_read(ap + 4 * PITCH);
                const bf16x8 a = {lo[0], lo[1], lo[2], lo[3], hi[0], hi[1], hi[2], hi[3]};
#pragma unroll
                for (int qt = 0; qt < 4; ++qt) acc[ct][qt] = mfma16(a, bfr[qt], acc[ct][qt]);
            }
        }
#pragma unroll
        for (int qt = 0; qt < 4; ++qt) {
            const int q = qh * 64 + qt * 16 + l15;
            const float bq = P.in[14][g * 128 + q];
#pragma unroll
            for (int ct = 0; ct < 4; ++ct) {
                const int c = cbase + ct * 16 + quad * 4;
                const u32x2 ur = *(const u32x2*)(Puv + (row0 + q) * 1024 + c);
                const float u0 = gelu_tanh(bflo(ur.x)), u1 = gelu_tanh(bfhi(ur.x)), u2 = gelu_tanh(bflo(ur.y)), u3 = gelu_tanh(bfhi(ur.y));
                u32x2 w; w.x = pk2(u0 * (acc[ct][qt][0] + bq), u1 * (acc[ct][qt][1] + bq)); w.y = pk2(u2 * (acc[ct][qt][2] + bq), u3 * (acc[ct][qt][3] + bq));
                *(u32x2*)(MO + (row0 + q) * 1024 + c) = w;
            }
        }
    }
    __syncthreads();
}

template <int LPR> __device__ __forceinline__ float reduce_row(float x) {
    x += dppf<0xB1>(x); x += dppf<0x4E>(x); x += dppf<0x141>(x);
    if (LPR == 16) x += dppf<0x140>(x);
    return x;
}
__device__ __forceinline__ float reduce32(float x) {
    x += dppf<0xB1>(x); x += dppf<0x4E>(x); x += dppf<0x141>(x); x += dppf<0x140>(x); x += __shfl_xor(x, 16); return x;
}
__device__ __forceinline__ void lds_barrier() { asm volatile("s_waitcnt lgkmcnt(0)" ::: "memory"); __builtin_amdgcn_s_barrier(); asm volatile("" ::: "memory"); }
template <int NV> struct ScanSet { f32x4 kk[NV], w[NV], ka[NV], kp[NV], r[NV]; float vv; };
template <int NV> __device__ __forceinline__ void scan_load(ScanSet<NV>& t, LAS const float* KK, LAS const float* Wd, LAS const float* KKA, LAS const float* KP, LAS const float* Rr, LAS const float* Vv, int o, int ov, bool want_y) {
#pragma unroll
    for (int u = 0; u < NV; ++u) { t.kk[u] = *(LAS const f32x4*)(KK + o + u * 32); t.w[u] = *(LAS const f32x4*)(Wd + o + u * 32); t.ka[u] = *(LAS const f32x4*)(KKA + o + u * 32); t.kp[u] = *(LAS const f32x4*)(KP + o + u * 32); }
    if (want_y) {
#pragma unroll
        for (int u = 0; u < NV; ++u) t.r[u] = *(LAS const f32x4*)(Rr + o + u * 32);
    }
    t.vv = Vv[ov];
}
typedef float f32x2v __attribute__((ext_vector_type(2)));
template <int LPR, int NV> __device__ __forceinline__ float scan_step(float* S, const ScanSet<NV>& t, bool want_y, float& ypart) {
    f32x2v acc = {0.f, 0.f};
#pragma unroll
    for (int u = 0; u < NV; ++u)
#pragma unroll
        for (int hh = 0; hh < 2; ++hh) { const f32x2v s2 = {S[4 * u + 2 * hh], S[4 * u + 2 * hh + 1]}, k2 = {t.kk[u][2 * hh], t.kk[u][2 * hh + 1]}; acc = s2 * k2 + acc; }
    float sa = acc.x + acc.y, yb = ypart;
    sa += dppf<0xB1>(sa); yb += dppf<0xB1>(yb); sa += dppf<0x4E>(sa); yb += dppf<0x4E>(yb); sa += dppf<0x141>(sa); yb += dppf<0x141>(yb);
    const f32x2v sa2 = {sa, sa}, vv2 = {t.vv, t.vv};
#pragma unroll
    for (int u = 0; u < NV; ++u)
#pragma unroll
        for (int hh = 0; hh < 2; ++hh) {
            f32x2v s2 = {S[4 * u + 2 * hh], S[4 * u + 2 * hh + 1]};
            const f32x2v w2 = {t.w[u][2 * hh], t.w[u][2 * hh + 1]}, kp2 = {t.kp[u][2 * hh], t.kp[u][2 * hh + 1]}, ka2 = {t.ka[u][2 * hh], t.ka[u][2 * hh + 1]};
            f32x2v tt = vv2 * kp2; tt = tt - sa2 * ka2;
            s2 = s2 * w2 + tt;
            S[4 * u + 2 * hh] = s2.x; S[4 * u + 2 * hh + 1] = s2.y;
        }
    if (want_y) {
        f32x2v yacc = {0.f, 0.f};
#pragma unroll
        for (int u = 0; u < NV; ++u)
#pragma unroll
            for (int hh = 0; hh < 2; ++hh) { const f32x2v s2 = {S[4 * u + 2 * hh], S[4 * u + 2 * hh + 1]}, r2 = {t.r[u][2 * hh], t.r[u][2 * hh + 1]}; yacc = s2 * r2 + yacc; }
        ypart = yacc.x + yacc.y;
    }
    return yb;
}
struct ScanSet2 { f32x4 kk, w, ka, kp, r; float vv0, vv1; };
__device__ __forceinline__ void scan_load2(ScanSet2& t, LAS const float* KK, LAS const float* Wd, LAS const float* KKA, LAS const float* KP, LAS const float* Rr, LAS const float* Vv, int o, int ov, bool want_y) {
    t.kk = *(LAS const f32x4*)(KK + o); t.w = *(LAS const f32x4*)(Wd + o); t.ka = *(LAS const f32x4*)(KKA + o); t.kp = *(LAS const f32x4*)(KP + o);
    if (want_y) t.r = *(LAS const f32x4*)(Rr + o);
    t.vv0 = Vv[ov]; t.vv1 = Vv[ov + 4];
}
__device__ __forceinline__ float dpp16(float x) { x += dppf<0xB1>(x); x += dppf<0x4E>(x); x += dppf<0x141>(x); x += dppf<0x140>(x); return x; }
__device__ __forceinline__ void scan_step2(f32x2v* SS, const ScanSet2& t, bool want_y, float& y0, float& y1, float& yr0, float& yr1) {
    f32x2v a2 = SS[0] * (f32x2v){t.kk[0], t.kk[0]};
#pragma unroll
    for (int i = 1; i < 4; ++i) a2 = SS[i] * (f32x2v){t.kk[i], t.kk[i]} + a2;
    float a0 = a2.x, a1 = a2.y, b0 = y0, b1 = y1;
#define SCAN_OPAQUE4() asm("" : "+v"(a0), "+v"(a1), "+v"(b0), "+v"(b1))
    SCAN_OPAQUE4();
    a0 += dppf<0xB1>(a0); a1 += dppf<0xB1>(a1); b0 += dppf<0xB1>(b0); b1 += dppf<0xB1>(b1); SCAN_OPAQUE4();
    a0 += dppf<0x4E>(a0); a1 += dppf<0x4E>(a1); b0 += dppf<0x4E>(b0); b1 += dppf<0x4E>(b1); SCAN_OPAQUE4();
    a0 += dppf<0x141>(a0); a1 += dppf<0x141>(a1); b0 += dppf<0x141>(b0); b1 += dppf<0x141>(b1); SCAN_OPAQUE4();
    a0 += dppf<0x140>(a0); a1 += dppf<0x140>(a1); b0 += dppf<0x140>(b0); b1 += dppf<0x140>(b1); SCAN_OPAQUE4();
#undef SCAN_OPAQUE4
    yr0 = b0; yr1 = b1;
    const f32x2v sa2 = {a0, a1}, vv2 = {t.vv0, t.vv1};
#pragma unroll
    for (int i = 0; i < 4; ++i) {
        f32x2v tt = vv2 * (f32x2v){t.kp[i], t.kp[i]};
        tt = tt - sa2 * (f32x2v){t.ka[i], t.ka[i]};
        SS[i] = SS[i] * (f32x2v){t.w[i], t.w[i]} + tt;
    }
    if (want_y) {
        f32x2v p2 = SS[0] * (f32x2v){t.r[0], t.r[0]};
#pragma unroll
        for (int i = 1; i < 4; ++i) p2 = SS[i] * (f32x2v){t.r[i], t.r[i]} + p2;
        y0 = p2.x; y1 = p2.y;
    }
}
__device__ __forceinline__ void scan_stepLP(f32x2v* SL, f32x2v* SP, const ScanSet2& t) {
    f32x2v aL = SL[0] * (f32x2v){t.kk[0], t.kk[0]}, aP = SP[0] * (f32x2v){t.kk[0], t.kk[0]};
#pragma unroll
    for (int i = 1; i < 4; ++i) { aL = SL[i] * (f32x2v){t.kk[i], t.kk[i]} + aL; aP = SP[i] * (f32x2v){t.kk[i], t.kk[i]} + aP; }
    float a0 = aL.x, a1 = aL.y, b0 = aP.x, b1 = aP.y;
#define SCAN_OPAQUE4() asm("" : "+v"(a0), "+v"(a1), "+v"(b0), "+v"(b1))
    SCAN_OPAQUE4();
    a0 += dppf<0xB1>(a0); a1 += dppf<0xB1>(a1); b0 += dppf<0xB1>(b0); b1 += dppf<0xB1>(b1); SCAN_OPAQUE4();
    a0 += dppf<0x4E>(a0); a1 += dppf<0x4E>(a1); b0 += dppf<0x4E>(b0); b1 += dppf<0x4E>(b1); SCAN_OPAQUE4();
    a0 += dppf<0x141>(a0); a1 += dppf<0x141>(a1); b0 += dppf<0x141>(b0); b1 += dppf<0x141>(b1); SCAN_OPAQUE4();
    a0 += dppf<0x140>(a0); a1 += dppf<0x140>(a1); b0 += dppf<0x140>(b0); b1 += dppf<0x140>(b1); SCAN_OPAQUE4();
#undef SCAN_OPAQUE4
    const f32x2v saL = {a0, a1}, saP = {b0, b1}, vv2 = {t.vv0, t.vv1};
#pragma unroll
    for (int i = 0; i < 4; ++i) {
        f32x2v tt = vv2 * (f32x2v){t.kp[i], t.kp[i]};
        tt = tt - saL * (f32x2v){t.ka[i], t.ka[i]};
        SL[i] = SL[i] * (f32x2v){t.w[i], t.w[i]} + tt;
        SP[i] = SP[i] * (f32x2v){t.w[i], t.w[i]} - saP * (f32x2v){t.ka[i], t.ka[i]};
    }
}
template <int LPR> __device__ void scan_item(const Params& PP, int seq, int h, int dir, int rhalf, int tbeg, int tlen, int flags, const float* sin, float* sout, float* sout2, LAS unsigned char* lds) {
    Params P = PP; P.ws = opaque_ptr(PP.ws);
    constexpr int KPL = 64 / LPR, RPW = 64 / LPR, NV = KPL / 4;
    const int tid = opaque_tid(), lane = tid & 63, wave = __builtin_amdgcn_readfirstlane(tid >> 6), l15 = lane & 15, quad = lane >> 4;
    const int Tseq = seq < 32 ? 2048 : 16384;
    const size_t base = seq < 32 ? (size_t)seq * 2048 : (size_t)M_PROMPT;
    const bf16_t* Prkvg = (const bf16_t*)(P.ws + WS_PRKVG);
    const bf16_t* Pwa = (const bf16_t*)(P.ws + WS_PWA);
    bf16_t* Yd = (bf16_t*)(P.ws + WS_Y) + (size_t)dir * M_TOK * 512;
    float* RKR = (float*)(P.ws + WS_RKR) + (size_t)dir * M_TOK * 8;
    LAS bf16_t* RAW0 = (LAS bf16_t*)lds;
    LAS bf16_t* ZROW = (LAS bf16_t*)(lds + 21760);
    LAS float* Wd = (LAS float*)(lds + 22528);
    LAS float* Aa = Wd + 1024; LAS float* Rr = Aa + 1024; LAS float* KP = Rr + 1024; LAS float* Vv = KP + 1024; LAS float* KK = Vv + 1024; LAS float* KKA = KK + 1024; LAS float* Yc = KKA + 1024;
    if (tid < 160) ((LAS unsigned*)ZROW)[tid] = 0u;
    LAS bf16_t* ALDS = (LAS bf16_t*)(lds + 55296);
    const int j_a = tid / 40, seg_a = (tid % 40) >> 3, c8_a = tid & 7;
    const int idx_b = tid + 512, j_b = idx_b / 40, seg_b = (idx_b % 40) >> 3, c8_b = idx_b & 7;
    const bool has_b = idx_b < 640;
    const int coff_a = seg_a < 3 ? seg_a * 512 + h * 64 + c8_a * 8 : dir * 128 + (seg_a - 3) * 64 + c8_a * 8;
    const int coff_b = seg_b < 3 ? seg_b * 512 + h * 64 + c8_b * 8 : dir * 128 + (seg_b - 3) * 64 + c8_b * 8;
    const int dst_a = (j_a + 1) * 320 + seg_a * 64 + c8_a * 8, dst_b = (j_b + 1) * 320 + seg_b * 64 + c8_b * 8;
    const bf16_t* src_a = (seg_a < 3 ? Prkvg + base * 2048 : Pwa + base * 256) + coff_a; const int ld_a = seg_a < 3 ? 2048 : 256;
    const bf16_t* src_b = (seg_b < 3 ? Prkvg + base * 2048 : Pwa + base * 256) + coff_b; const int ld_b = seg_b < 3 ? 2048 : 256;
    const int ltype = wave >> 2, lch = (wave & 3) * 16 + l15;
    const bf16_t* Wt = (const bf16_t*)(P.ws + WS_LORA) + (size_t)(dir * 2 + ltype) * 512 * 64 + (size_t)(h * 64 + lch) * 64;
    const bf16x8 lb0 = *(const bf16x8*)(Wt + quad * 8), lb1 = *(const bf16x8*)(Wt + 32 + quad * 8);
    const float lbias = ltype == 0 ? P.in[17][dir * 512 + h * 64 + lch] : P.in[19][dir * 512 + h * 64 + lch];
    const int tk = tid >> 5, c2 = tid & 31;
    float mu_r[2], mu_k[2], mu_v[2], k_k[2], k_a[2], r_k[2];
#pragma unroll
    for (int e = 0; e < 2; ++e) { const int ch = h * 64 + 2 * c2 + e;
        mu_r[e] = P.in[15][dir * 1536 + ch]; mu_k[e] = P.in[15][dir * 1536 + 512 + ch]; mu_v[e] = P.in[15][dir * 1536 + 1024 + ch];
        k_k[e] = P.in[21][ch]; k_a[e] = P.in[22][ch]; r_k[e] = P.in[23][ch]; }
    float amu[2][2];
#pragma unroll
    for (int ty = 0; ty < 2; ++ty)
#pragma unroll
        for (int e = 0; e < 2; ++e) amu[ty][e] = P.in[16][dir * 128 + ty * 64 + 2 * c2 + e];
#define SCAN_BUILD_A(RAWN, PREV0) do { \
        LAS const bf16_t* cur_ = (RAWN) + (tk + 1) * 320 + 192 + 2 * c2; \
        LAS const bf16_t* prv_ = (tk > 0 ? (RAWN) + tk * 320 : (PREV0)) + 192 + 2 * c2; \
        _Pragma("unroll") for (int ty = 0; ty < 2; ++ty) { \
            const unsigned xc_ = *(LAS const unsigned*)(cur_ + ty * 64), xp_ = *(LAS const unsigned*)(prv_ + ty * 64); \
            float z0_ = bflo(xc_) + (bflo(xp_) - bflo(xc_)) * amu[ty][0], z1_ = bfhi(xc_) + (bfhi(xp_) - bfhi(xc_)) * amu[ty][1]; \
            if (ty == 0) { z0_ = tanhf_(z0_); z1_ = tanhf_(z1_); } \
            *(LAS unsigned*)(ALDS + ty * 1152 + tk * 72 + 2 * c2) = pk2(z0_, z1_); } } while (0)
    static_assert(LPR == 16, "two rows per lane, 16 lanes per row");
    const int srow = wave * 8 + (lane >> 4), sq = lane & 15;
    f32x2v SS[4];
#pragma unroll
    for (int i = 0; i < 4; ++i) { const int kidx = sq * 4 + i;
        SS[i].x = (flags & 1) ? (kidx == srow ? 1.f : 0.f) : (sin ? sin[srow * 64 + kidx] : 0.f);
        SS[i].y = (flags & 1) ? (kidx == srow + 4 ? 1.f : 0.f) : (sin ? sin[(srow + 4) * 64 + kidx] : 0.f); }
    const bool lp = (flags & 16) != 0;
    f32x2v SP[4];
#pragma unroll
    for (int i = 0; i < 4; ++i) { const int kidx = sq * 4 + i; SP[i].x = kidx == srow ? 1.f : 0.f; SP[i].y = kidx == srow + 4 ? 1.f : 0.f; }
    const int nch = tlen / 16;
    const int tstep = dir == 0 ? 16 : -16;
    const int tfirst = dir == 0 ? tbeg : tbeg + tlen - 16;
    const int tprev = dir == 0 ? tbeg - 1 : tbeg + tlen;
    const bool has_prev = tprev >= 0 && tprev < Tseq;
    if (has_prev && tid < 40) {
        const int sg = tid >> 3, c8 = tid & 7;
        const bf16_t* sp = sg < 3 ? Prkvg + (base + tprev) * 2048 + sg * 512 + h * 64 + c8 * 8 : Pwa + (base + tprev) * 256 + dir * 128 + (sg - 3) * 64 + c8 * 8;
        *(LAS u32x4*)(RAW0 + 5440 + 16 * 320 + sg * 64 + c8 * 8) = *(const u32x4*)sp;
    }
    const bool in_on = (flags & 2) == 0, wr_y = (flags & 4) != 0, wr_rk = (flags & 8) != 0;
#define SCAN_TOK(t0, j) (dir == 0 ? (t0) + (j) : (t0) + 15 - (j))
    u32x4 pre_a, pre_b = (u32x4){0u, 0u, 0u, 0u};
    {
        pre_a = *(const u32x4*)(src_a + (size_t)SCAN_TOK(tfirst, j_a) * ld_a);
        if (has_b) pre_b = *(const u32x4*)(src_b + (size_t)SCAN_TOK(tfirst, j_b) * ld_b);
        *(LAS u32x4*)(RAW0 + dst_a) = pre_a;
        if (has_b) *(LAS u32x4*)(RAW0 + dst_b) = pre_b;
        if (nch > 1) {
            pre_a = *(const u32x4*)(src_a + (size_t)SCAN_TOK(tfirst + tstep, j_a) * ld_a);
            if (has_b) pre_b = *(const u32x4*)(src_b + (size_t)SCAN_TOK(tfirst + tstep, j_b) * ld_b);
        }
    }
    __syncthreads();
    SCAN_BUILD_A(RAW0, (has_prev ? RAW0 + 5440 + 16 * 320 : ZROW));
    lds_barrier();
    u32x4 ypend = (u32x4){0u, 0u, 0u, 0u}; bf16_t* ypend_ptr = nullptr;
    for (int c = 0; c < nch; ++c) {
        LAS bf16_t* RAW = RAW0 + (c & 1) * 5440;
        LAS bf16_t* RAWp = RAW0 + ((c & 1) ^ 1) * 5440;
        const int t0 = tfirst + c * tstep;
        {
            bf16x8 af[2];
#pragma unroll
            for (int ks = 0; ks < 2; ++ks) af[ks] = *(LAS const bf16x8*)(ALDS + ltype * 1152 + l15 * 72 + ks * 32 + quad * 8);
            f32x4 d = mfma16(af[0], lb0, (f32x4){0.f, 0.f, 0.f, 0.f});
            d = mfma16(af[1], lb1, d);
            LAS float* dstp = (ltype == 0 ? Wd : Aa) + lch;
#pragma unroll
            for (int jj = 0; jj < 4; ++jj) { const float sg = sigmoidf_(lbias + d[jj]); dstp[(quad * 4 + jj) * 64] = ltype == 0 ? __expf(-0.6065306597126334f * sg) : sg; }
        }
        {
            LAS const bf16_t* cur = RAW + (tk + 1) * 320 + 2 * c2;
            LAS const bf16_t* prv = (tk > 0 ? RAW + tk * 320 : ((c > 0 || has_prev) ? RAWp + 16 * 320 : ZROW)) + 2 * c2;
            const unsigned rc = *(LAS const unsigned*)(cur), rp = *(LAS const unsigned*)(prv);
            const unsigned kc = *(LAS const unsigned*)(cur + 64), kq = *(LAS const unsigned*)(prv + 64);
            const unsigned vc = *(LAS const unsigned*)(cur + 128), vp = *(LAS const unsigned*)(prv + 128);
            const int o = tk * 64 + 2 * c2;
            Rr[o] = bflo(rc) + (bflo(rp) - bflo(rc)) * mu_r[0]; Rr[o + 1] = bfhi(rc) + (bfhi(rp) - bfhi(rc)) * mu_r[1];
            KP[o] = bflo(kc) + (bflo(kq) - bflo(kc)) * mu_k[0]; KP[o + 1] = bfhi(kc) + (bfhi(kq) - bfhi(kc)) * mu_k[1];
            Vv[o] = in_on ? bflo(vc) + (bflo(vp) - bflo(vc)) * mu_v[0] : 0.f; Vv[o + 1] = in_on ? bfhi(vc) + (bfhi(vp) - bfhi(vc)) * mu_v[1] : 0.f;
        }
        lds_barrier();
        float rk_keep;
        {
            const int o = tk * 64 + 2 * c2;
            const float kz0 = KP[o], kz1 = KP[o + 1], a0 = Aa[o], a1 = Aa[o + 1];
            const float q0 = kz0 * k_k[0], q1 = kz1 * k_k[1];
            const float kp0 = kz0 * (1.0f + (a0 - 1.0f) * k_a[0]), kp1 = kz1 * (1.0f + (a1 - 1.0f) * k_a[1]);
            const float ss = reduce32(q0 * q0 + q1 * q1);
            const float rk = reduce32(Rr[o] * kp0 * r_k[0] + Rr[o + 1] * kp1 * r_k[1]);
            const float inv = __builtin_amdgcn_rsqf(fmaxf(ss, 1e-24f));
            const float kk0 = q0 * inv, kk1 = q1 * inv;
            KK[o] = kk0; KK[o + 1] = kk1; KKA[o] = kk0 * a0; KKA[o + 1] = kk1 * a1;
            KP[o] = kp0; KP[o + 1] = kp1;
            rk_keep = rk;
        }
        if (c + 1 < nch) {
            *(LAS u32x4*)(RAWp + dst_a) = pre_a;
            if (has_b) *(LAS u32x4*)(RAWp + dst_b) = pre_b;
            if (c + 2 < nch) {
                pre_a = *(const u32x4*)(src_a + (size_t)SCAN_TOK(t0 + 2 * tstep, j_a) * ld_a);
                if (has_b) pre_b = *(const u32x4*)(src_b + (size_t)SCAN_TOK(t0 + 2 * tstep, j_b) * ld_b);
            }
        }
        if (wr_rk && c2 == 0) RKR[(base + SCAN_TOK(t0, tk)) * 8 + h] = rk_keep;
        if (ypend_ptr) *(u32x4*)ypend_ptr = ypend;
        lds_barrier();
        if (c + 1 < nch) SCAN_BUILD_A(RAWp, RAW + 16 * 320);
        if (lp) {
            ScanSet2 sa_, sb_;
            scan_load2(sa_, KK, Wd, KKA, KP, Rr, Vv, sq * 4, srow, false);
#pragma unroll 1
            for (int jo = 0; jo < 16; jo += 2) {
                scan_load2(sb_, KK, Wd, KKA, KP, Rr, Vv, (jo + 1) * 64 + sq * 4, (jo + 1) * 64 + srow, false);
                scan_stepLP(SS, SP, sa_);
                if (jo + 2 < 16) scan_load2(sa_, KK, Wd, KKA, KP, Rr, Vv, (jo + 2) * 64 + sq * 4, (jo + 2) * 64 + srow, false);
                scan_stepLP(SS, SP, sb_);
            }
        } else {
            ScanSet2 sa_, sb_;
            scan_load2(sa_, KK, Wd, KKA, KP, Rr, Vv, sq * 4, srow, wr_y);
            float yk = 0.f, zk = 0.f, y0 = 0.f, y1 = 0.f, yr0, yr1;
#pragma unroll 1
            for (int jo = 0; jo < 16; jo += 2) {
                scan_load2(sb_, KK, Wd, KKA, KP, Rr, Vv, (jo + 1) * 64 + sq * 4, (jo + 1) * 64 + srow, wr_y);
                scan_step2(SS, sa_, wr_y, y0, y1, yr0, yr1);
                if (jo > 0 && sq == jo - 1) { yk = yr0; zk = yr1; }
                if (jo + 2 < 16) scan_load2(sa_, KK, Wd, KKA, KP, Rr, Vv, (jo + 2) * 64 + sq * 4, (jo + 2) * 64 + srow, wr_y);
                scan_step2(SS, sb_, wr_y, y0, y1, yr0, yr1);
                if (sq == jo) { yk = yr0; zk = yr1; }
            }
            yr0 = dpp16(y0); yr1 = dpp16(y1);
            if (sq == 15) { yk = yr0; zk = yr1; }
            Yc[sq * 64 + srow] = yk; Yc[sq * 64 + srow + 4] = zk;
        }
        lds_barrier();
        {
            const bool wr = wr_y && tid < 128;
            if (wr) {
                const int tq = tid >> 3, c8 = tid & 7; float f[8];
                const f32x4 a = *(LAS const f32x4*)(Yc + tq * 64 + c8 * 8), b = *(LAS const f32x4*)(Yc + tq * 64 + c8 * 8 + 4);
                f[0] = a[0]; f[1] = a[1]; f[2] = a[2]; f[3] = a[3]; f[4] = b[0]; f[5] = b[1]; f[6] = b[2]; f[7] = b[3];
                ypend = pack8(f); ypend_ptr = Yd + (base + SCAN_TOK(t0, tq)) * 512 + h * 64 + c8 * 8;
            }
        }
    }
    if (ypend_ptr) *(u32x4*)ypend_ptr = ypend;
    if (sout) { *(f32x4*)(sout + srow * 64 + sq * 4) = (f32x4){SS[0].x, SS[1].x, SS[2].x, SS[3].x}; *(f32x4*)(sout + (srow + 4) * 64 + sq * 4) = (f32x4){SS[0].y, SS[1].y, SS[2].y, SS[3].y}; }
    if (lp && sout2) { *(f32x4*)(sout2 + srow * 64 + sq * 4) = (f32x4){SP[0].x, SP[1].x, SP[2].x, SP[3].x}; *(f32x4*)(sout2 + (srow + 4) * 64 + sq * 4) = (f32x4){SP[0].y, SP[1].y, SP[2].y, SP[3].y}; }
#undef SCAN_TOK
#undef SCAN_BUILD_A
    __syncthreads();
}

__device__ void scan_carry(const Params& PP, int hd, LAS unsigned char* lds) {
    Params P = PP; P.ws = opaque_ptr(PP.ws);
    const int tid = opaque_tid();
    const float* Lm = (const float*)(P.ws + WS_STL) + (size_t)hd * NSEG * 4096;
    const float* Pm = (const float*)(P.ws + WS_STP) + (size_t)hd * NSEG * 4096;
    float* St = (float*)(P.ws + WS_STS) + (size_t)hd * NSEG * 4096;
    LAS float* Sc = (LAS float*)lds;
    LAS float* Pc = Sc + 4096;
    const int v = tid >> 3, k0 = (tid & 7) * 8;
    for (int i = 0; i < 8; ++i) { const float x = Lm[v * 64 + k0 + i]; Sc[v * 64 + k0 + i] = x; St[4096 + v * 64 + k0 + i] = x; }
    for (int sgm = 1; sgm + 1 < NSEG; ++sgm) {
        for (int i = 0; i < 8; ++i) Pc[v * 64 + k0 + i] = Pm[(size_t)sgm * 4096 + v * 64 + k0 + i];
        __syncthreads();
        float o[8];
        for (int i = 0; i < 8; ++i) o[i] = Lm[(size_t)sgm * 4096 + v * 64 + k0 + i];
        for (int j = 0; j < 64; ++j) { const float sv = Sc[v * 64 + j];
#pragma unroll
            for (int i = 0; i < 8; ++i) o[i] += sv * Pc[j * 64 + k0 + i]; }
        __syncthreads();
        for (int i = 0; i < 8; ++i) { Sc[v * 64 + k0 + i] = o[i]; St[(size_t)(sgm + 1) * 4096 + v * 64 + k0 + i] = o[i]; }
    }
    __syncthreads();
}

__device__ void rwkv_finalize(const Params& PP) {
    Params P = PP; P.ws = opaque_ptr(PP.ws);
    const int tid_ = opaque_tid(), lane = tid_ & 63, wave = __builtin_amdgcn_readfirstlane(tid_ >> 6);
    const bf16_t* Prkvg = (const bf16_t*)(P.ws + WS_PRKVG);
    const bf16_t* Y0 = (const bf16_t*)(P.ws + WS_Y);
    const bf16_t* Y1 = Y0 + (size_t)M_TOK * 512;
    const float* RKR0 = (const float*)(P.ws + WS_RKR);
    const float* RKR1 = RKR0 + (size_t)M_TOK * 8;
    bf16_t* MO = (bf16_t*)(P.ws + WS_XN);
    const int col = lane * 8, hh = lane >> 3;
    float gw[8], gb[8], muf[8], mub[8];
#pragma unroll
    for (int i = 0; i < 8; ++i) { gw[i] = P.in[24][col + i]; gb[i] = P.in[25][col + i]; muf[i] = P.in[15][1024 + col + i]; mub[i] = P.in[15][1536 + 1024 + col + i]; }
    for (int row = blockIdx.x * 8 + wave; row < M_TOK; row += gridDim.x * 8) {
        const int t = row < M_PROMPT ? (row & 2047) : row - M_PROMPT, T = row < M_PROMPT ? 2048 : 16384;
        float yf[8], yb[8], vc[8], vp[8], vn[8], gg[8];
        unpack8(*(const u32x4*)(Y0 + (size_t)row * 512 + col), yf); unpack8(*(const u32x4*)(Y1 + (size_t)row * 512 + col), yb);
        unpack8(*(const u32x4*)(Prkvg + (size_t)row * 2048 + 1024 + col), vc);
        unpack8(*(const u32x4*)(Prkvg + (size_t)row * 2048 + 1536 + col), gg);
        if (t > 0) unpack8(*(const u32x4*)(Prkvg + (size_t)(row - 1) * 2048 + 1024 + col), vp); else { for (int i = 0; i < 8; ++i) vp[i] = 0.f; }
        if (t < T - 1) unpack8(*(const u32x4*)(Prkvg + (size_t)(row + 1) * 2048 + 1024 + col), vn); else { for (int i = 0; i < 8; ++i) vn[i] = 0.f; }
        const float rf = RKR0[(size_t)row * 8 + hh], rb = RKR1[(size_t)row * 8 + hh];
        float s = 0.f;
#pragma unroll
        for (int i = 0; i < 8; ++i) { yf[i] += yb[i]; s += yf[i]; }
        const float mean = reduce8(s) * (1.0f / 64.0f);
        float q = 0.f;
#pragma unroll
        for (int i = 0; i < 8; ++i) { yf[i] -= mean; q += yf[i] * yf[i]; }
        const float rstd = rsqrtf(reduce8(q) * (1.0f / 64.0f) + 64e-5f);
        float o[8];
#pragma unroll
        for (int i = 0; i < 8; ++i) {
            const float vzf = vc[i] + (vp[i] - vc[i]) * muf[i], vzb = vc[i] + (vn[i] - vc[i]) * mub[i];
            o[i] = (yf[i] * rstd * gw[i] + gb[i] + rf * vzf + rb * vzb) * sigmoidf_(gg[i]);
        }
        *(u32x4*)(MO + (size_t)row * 1024 + 512 + col) = pack8(o);
    }
}

template <int NQ> __device__ __forceinline__ void attn_groups(const bf16_t* QKV, size_t base, int h, int T0, int L, int dsh, int res, int i0, int bi,
        int lane, int l15, int quad, int r4, int c4, LAS unsigned char* VST, LAS const f32x2v* RKT, int tb, const float (&bx)[11][4], const float (&gqk)[16], LAS float* OACC, LAS float* LS) {
    constexpr int NT = NQ == 2 ? 10 : 9;
    bf16x8 qf[NQ][2]; float mq[NQ]; int qtok[NQ];
#pragma unroll
    for (int q = 0; q < NQ; ++q) {
        qtok[q] = ((i0 + 16 * q + l15) << dsh) + res;
        const bf16_t* qp = QKV + (base + qtok[q]) * 3072 + h * 64 + quad * 8;
        float f[16]; unpack8(*(const u32x4*)qp, f); unpack8(*(const u32x4*)(qp + 32), f + 8);
        float ss = 0.f;
#pragma unroll
        for (int i = 0; i < 16; ++i) ss += f[i] * f[i];
        ss += __shfl_xor(ss, 16); ss += __shfl_xor(ss, 32);
        const float rq = rsqrtf(ss * (1.0f / 64.0f) + NORM_EPS) * 0.125f;
#pragma unroll
        for (int i = 0; i < 16; ++i) f[i] = f[i] * rq * gqk[i];
        const u32x4 w0 = pack8(f), w1 = pack8(f + 8);
        qf[q][0] = __builtin_bit_cast(bf16x8, w0); qf[q][1] = __builtin_bit_cast(bf16x8, w1);
        float fr[16]; unpack8(w0, fr); unpack8(w1, fr + 8);
        float n2 = 0.f;
#pragma unroll
        for (int i = 0; i < 16; ++i) n2 += fr[i] * fr[i];
        n2 += __shfl_xor(n2, 16); n2 += __shfl_xor(n2, 32);
        mq[q] = 8.1f * 1.4426950408889634f * sqrtf(n2);
    }
    f32x4 oacc[NQ][4];
    float lsum[NQ];
#pragma unroll
    for (int q = 0; q < NQ; ++q) { lsum[q] = 0.f;
#pragma unroll
        for (int et = 0; et < 4; ++et) oacc[q][et] = (f32x4){0.f, 0.f, 0.f, 0.f}; }
    const int ebase = (i0 - 64 + quad * 4) * (1 << dsh) + res - tb;
    const float dmul = (float)(1 << dsh);
    bf16x8 kfb[2][2][2]; u32x4 vb[2][4];
    const int rowv = lane >> 1, half = lane & 1;
#define ATT_ISSUE(KP, BUF) do { \
        _Pragma("unroll") for (int tt_ = 0; tt_ < 2; ++tt_) { \
            int kidx_ = i0 - 64 + 16 * (2 * (KP) + tt_) + l15; kidx_ = kidx_ < 0 ? 0 : (kidx_ > L - 1 ? L - 1 : kidx_); \
            const bf16_t* kptr_ = QKV + (base + ((size_t)kidx_ << dsh) + res) * 3072 + 1024 + h * 64 + quad * 8; \
            kfb[BUF][tt_][0] = *(const bf16x8*)kptr_; kfb[BUF][tt_][1] = *(const bf16x8*)(kptr_ + 32); } \
        int vidx_ = i0 - 64 + 32 * (KP) + rowv; vidx_ = vidx_ < 0 ? 0 : (vidx_ > L - 1 ? L - 1 : vidx_); \
        const bf16_t* vptr_ = QKV + (base + ((size_t)vidx_ << dsh) + res) * 3072 + 2048 + h * 64 + half * 32; \
        vb[BUF][0] = *(const u32x4*)vptr_; vb[BUF][1] = *(const u32x4*)(vptr_ + 8); vb[BUF][2] = *(const u32x4*)(vptr_ + 16); vb[BUF][3] = *(const u32x4*)(vptr_ + 24); } while (0)
    ATT_ISSUE(0, 0);
#pragma unroll
    for (int kp = 0; kp < 5; ++kp) {
        f32x4 s[NQ][2];
        if (kp + 1 < 5) ATT_ISSUE(kp + 1, (kp + 1) & 1);
#pragma unroll
        for (int tt = 0; tt < 2; ++tt) {
            const int kt = 2 * kp + tt;
#pragma unroll
            for (int q = 0; q < NQ; ++q) s[q][tt] = (f32x4){0.f, 0.f, 0.f, 0.f};
            if (kt < NT) {
                f32x2v e[4];
#pragma unroll
                for (int j = 0; j < 4; ++j) e[j] = RKT[((16 * kt + j) << dsh) + ebase];
#pragma unroll
                for (int q = 0; q < NQ; ++q) {
                    f32x4 sc = mfma16(kfb[kp & 1][tt][0], qf[q][0], (f32x4){0.f, 0.f, 0.f, 0.f});
                    sc = mfma16(kfb[kp & 1][tt][1], qf[q][1], sc);
#pragma unroll
                    for (int j = 0; j < 4; ++j) {
                        const float p = __builtin_amdgcn_exp2f(sc[j] * e[j].x + (e[j].y + (bx[kt + 1 - q][j] * dmul - mq[q])));
                        lsum[q] += p; s[q][tt][j] = p;
                    }
                }
            }
        }
        bf16x8 pf[NQ];
#pragma unroll
        for (int q = 0; q < NQ; ++q) { u32x4 w; w.x = pk2(s[q][0][0], s[q][0][1]); w.y = pk2(s[q][0][2], s[q][0][3]); w.z = pk2(s[q][1][0], s[q][1][1]); w.w = pk2(s[q][1][2], s[q][1][3]); pf[q] = __builtin_bit_cast(bf16x8, w); }
        {
            LAS u32x4* vd = (LAS u32x4*)(VST + rowv * 144 + half * 64);
            vd[0] = vb[kp & 1][0]; vd[1] = vb[kp & 1][1]; vd[2] = vb[kp & 1][2]; vd[3] = vb[kp & 1][3];
        }
        asm volatile("s_waitcnt lgkmcnt(0)" ::: "memory"); __builtin_amdgcn_fence(__ATOMIC_RELEASE, "wavefront"); __builtin_amdgcn_wave_barrier(); __builtin_amdgcn_fence(__ATOMIC_ACQUIRE, "wavefront"); asm volatile("s_waitcnt lgkmcnt(0)" ::: "memory");
#pragma unroll
        for (int et = 0; et < 4; ++et) {
            LAS const unsigned char* ap = VST + (quad * 4 + r4) * 144 + (et * 16 + 4 * c4) * 2;
            const s16x4 lo = tr_read(ap), hi = tr_read(ap + 16 * 144);
            const bf16x8 a = {lo[0], lo[1], lo[2], lo[3], hi[0], hi[1], hi[2], hi[3]};
#pragma unroll
            for (int q = 0; q < NQ; ++q) oacc[q][et] = mfma16(a, pf[q], oacc[q][et]);
        }
        asm volatile("s_waitcnt lgkmcnt(0)" ::: "memory"); __builtin_amdgcn_fence(__ATOMIC_RELEASE, "wavefront"); __builtin_amdgcn_wave_barrier(); __builtin_amdgcn_fence(__ATOMIC_ACQUIRE, "wavefront"); asm volatile("s_waitcnt lgkmcnt(0)" ::: "memory");
    }
#undef ATT_ISSUE
#pragma unroll
    for (int q = 0; q < NQ; ++q) {
        float l = lsum[q]; l += __shfl_xor(l, 16); l += __shfl_xor(l, 32);
        const int qloc = qtok[q] - T0;
#pragma unroll
        for (int et = 0; et < 4; ++et) {
            LAS f32x4* dst = (LAS f32x4*)(OACC + qloc * 68 + et * 16 + quad * 4);
            if (bi == 0) *dst = oacc[q][et]; else *dst = *dst + oacc[q][et];
        }
        if (quad == 0) { if (bi == 0) LS[qloc] = l; else LS[qloc] += l; }
    }
}

__device__ void attn_item(const Params& PP, int seq, int h, int tile, LAS unsigned char* lds) {
    Params P = PP; P.ws = opaque_ptr(PP.ws);
    const int tid = opaque_tid(), lane = tid & 63, wave = __builtin_amdgcn_readfirstlane(tid >> 6), l15 = lane & 15, quad = lane >> 4;
    const int T = seq < 32 ? 2048 : 16384;
    const size_t base = seq < 32 ? (size_t)seq * 2048 : (size_t)M_PROMPT;
    const int T0 = tile * 256;
    const bf16_t* QKV = (const bf16_t*)(P.ws + WS_BIG);
    bf16_t* MO = (bf16_t*)(P.ws + WS_XN);
    LAS float* OACC = (LAS float*)lds;
    LAS float* LS = (LAS float*)(lds + 256 * 272);
    LAS unsigned char* VST = lds + 256 * 272 + 1024 + wave * (32 * 144);
    const float slope = exp2f(-0.5f * (float)(h + 1));
    float gqk[16];
#pragma unroll
    for (int i = 0; i < 16; ++i) { const int e = (i >> 3) * 32 + quad * 8 + (i & 7); gqk[i] = P.in[28][e] * P.in[29][e]; }
    const int r4 = l15 >> 2, c4 = l15 & 3;
    float bx[11][4];
#pragma unroll
    for (int kt = -1; kt < 10; ++kt)
#pragma unroll
        for (int j = 0; j < 4; ++j) { int dist = 16 * kt - 64 + quad * 4 + j - l15; dist = dist < 0 ? -dist : dist;
            bx[kt + 1][j] = dist <= 64 ? -slope * 1.4426950408889634f * (float)dist : -1e30f; }
    LAS f32x2v* RKT = (LAS f32x2v*)(lds + 107520);
    const int tb = T0 - 1024;
    const float* ksq_h = (const float*)(P.ws + WS_KSQ) + (size_t)h * M_TOK;
    for (int idx = tid; idx < 2304; idx += 512) {
        const int tok = tb + idx;
        f32x2v ent = {0.f, -1e30f};
        if (tok >= 0 && tok < T) { ent.x = rsqrtf(ksq_h[base + tok] * (1.0f / 64.0f) + NORM_EPS) * 1.4426950408889634f; ent.y = 0.f; }
        RKT[idx] = ent;
    }
    __syncthreads();
    for (int bi = 0; bi < 3; ++bi) {
        const int dsh = 2 * bi, L = T >> dsh;
        if (bi < 2) {
            const int res = bi == 0 ? 0 : (wave & 3), i0 = (T0 >> dsh) + (bi == 0 ? 32 * wave : 32 * (wave >> 2));
            attn_groups<2>(QKV, base, h, T0, L, dsh, res, i0, bi, lane, l15, quad, r4, c4, VST, RKT, tb, bx, gqk, OACC, LS);
        } else {
            for (int gg = 0; gg < 2; ++gg)
                attn_groups<1>(QKV, base, h, T0, L, dsh, wave * 2 + gg, T0 >> dsh, bi, lane, l15, quad, r4, c4, VST, RKT, tb, bx, gqk, OACC, LS);
        }
        __syncthreads();
    }
    {
        const int q = tid >> 1, half = tid & 1;
        const float inv = 1.0f / LS[q];
        bf16_t* op = MO + (base + T0 + q) * 1024 + h * 64 + half * 32;
#pragma unroll
        for (int i = 0; i < 4; ++i) {
            const f32x4 a = *(LAS const f32x4*)(OACC + q * 68 + half * 32 + i * 8), b = *(LAS const f32x4*)(OACC + q * 68 + half * 32 + i * 8 + 4);
            u32x4 w; w.x = pk2(a[0] * inv, a[1] * inv); w.y = pk2(a[2] * inv, a[3] * inv); w.z = pk2(b[0] * inv, b[1] * inv); w.w = pk2(b[2] * inv, b[3] * inv);
            *(u32x4*)(op + i * 8) = w;
        }
    }
    __syncthreads();
}

enum { K_P0 = 0, K_SWIGLU, K_RESID, K_NORM, K_GEMM_P, K_MIXA, K_FINAL, K_GEMM_QKV, K_ATTN, K_CARRY, K_MIXB };
constexpr int N_PHASES = 19;

__global__ void __launch_bounds__(512, 2) mega(Params P) {
    extern __shared__ __attribute__((aligned(16))) unsigned char lds_raw[];
    LAS unsigned char* lds = (LAS unsigned char*)lds_raw;
    cg::grid_group grid = cg::this_grid();
    for (int ph = 0; ph < N_PHASES; ++ph) {
#ifdef PROBE_MASK
        if (blockIdx.x == 0 && threadIdx.x == 0) ((unsigned long long*)(P.ws + WS_TS))[ph] = __builtin_amdgcn_s_memrealtime();
#endif
        unsigned char* ws = P.ws; float* X = P.out; int G = gridDim.x, bid = blockIdx.x;
        asm volatile("" : "+s"(ws), "+s"(X), "+s"(G), "+s"(bid));
        bf16_t* XN = (bf16_t*)(ws + WS_XN);
        bf16_t* Hb = (bf16_t*)(ws + WS_BIG);
        int kind, layer = 0, sub = 0;
        if (ph == 0) kind = K_P0;
        else {
            layer = ph <= 10 ? 0 : 1; const int r = ph <= 10 ? ph - 1 : ph - 11;
            const unsigned long long kc = layer == 0 ? 0x2126A95421ull : 0x32128721ull;
            const unsigned long long sc = layer == 0 ? 0x1120000000ull : 0x21120000ull;
            kind = (int)((kc >> (4 * r)) & 15ull); sub = (int)((sc >> (4 * r)) & 15ull);
        }
        if (kind == K_P0) {
#ifndef SKIP_P0
            LAS float* tile = (LAS float*)lds;
            int rot = 0;
            for (int job = 0; job < 16; ++job) {
                const float* src; size_t doff; int K, N;
                if (job < 4) { src = ((job & 1) ? P.in[7] : P.in[3]) + (size_t)(job >> 1) * 1024 * 5632; doff = WS_WFI + (size_t)job * SZ_WFI; K = 1024; N = 5632; }
                else if (job < 8) { src = ((job & 1) ? P.in[8] : P.in[4]) + (size_t)((job - 4) >> 1) * 2816 * 1024; doff = WS_WFO + (size_t)(job - 4) * SZ_WFO; K = 2816; N = 1024; }
                else if (job == 8) { src = P.in[10]; doff = WS_WABI; K = 1024; N = 3328; }
                else if (job == 9) { src = P.in[11]; doff = WS_WABO; K = 1024; N = 1024; }
                else if (job == 10) { src = P.in[26]; doff = WS_WATI; K = 1024; N = 3072; }
                else if (job == 11) { src = P.in[27]; doff = WS_WATO; K = 1024; N = 1024; }
                else { const int d = (job - 12) >> 1, ty = (job - 12) & 1; src = (ty ? P.in[20] : P.in[18]) + (size_t)d * 64 * 512; doff = WS_LORA + (size_t)(d * 2 + ty) * 512 * 64 * 2; K = 64; N = 512; }
                if (job < 4) convert_T<1>(src, (bf16_t*)(ws + doff), K, N, tile, rot); else convert_T<0>(src, (bf16_t*)(ws + doff), K, N, tile, rot);
                rot += (K / 64) * (N / 64);
            }
            {
                bf16_t* dst = (bf16_t*)(ws + WS_SGUW);
                for (int i = bid * 512 + opaque_tid(); i < 4 * 128 * 128 / 4; i += G * 512) {
                    const f32x4 v = *(const f32x4*)(P.in[13] + (size_t)i * 4);
                    u32x2 w; w.x = pk2(v[0], v[1]); w.y = pk2(v[2], v[3]); *(u32x2*)(dst + (size_t)i * 4) = w;
                }
            }
            norm_rows(P.in[0], P.in[1], M_PROMPT, nullptr, nullptr, nullptr, P.in[2], XN);
            if (bid == 0 && opaque_tid() == 0) *(unsigned*)(ws + WS_TS + 2048) = 0u;
#endif
        } else if (kind == K_SWIGLU) {
            if (sub == 0) { float* za = (float*)(ws + WS_RSA); for (int i = bid * 512 + opaque_tid(); i < M_TOK; i += G * 512) za[i] = 0.f; }
            if (sub == 0 && layer == 1) { f32x4* zk = (f32x4*)(ws + WS_KSQ); for (int i = bid * 512 + opaque_tid(); i < 16 * M_TOK / 4; i += G * 512) zk[i] = (f32x4){0.f, 0.f, 0.f, 0.f}; }
            pg8::Gemm g{sub == 0 ? XN : (const bf16_t*)(ws + WS_Y), (const bf16_t*)(ws + WS_WFI + (size_t)(layer * 2 + sub) * SZ_WFI), M_TOK, 5632, 1024};
            pg8::StaticOrder S; S.init(M_TOK, 5632, G, bid);
            if (sub == 1 && layer == 0) { float* zc = (float*)(ws + WS_RSC); for (int i = bid * 512 + opaque_tid(); i < 2 * M_TOK; i += G * 512) zc[i] = 0.f; }
            EpiSwiglu E{Hb, sub == 0 ? (layer == 0 ? nullptr : (const float*)(ws + WS_RSC)) : (const float*)(ws + WS_RSB), (sub == 0 && layer == 1) ? (const float*)(ws + WS_RSD) : nullptr};
#ifndef SKIP_G1
            pg8::gemm_phase<EpiSwiglu, pg8::StaticOrder, GEMM_ALIGN, GEMM_SP2>(lds, g, S, E);
#endif
        } else if (kind == K_RESID) {
            const bf16_t* A; const bf16_t* Bt; int K; float scale; bf16_t* xg = nullptr; const float* gn = nullptr; float* rss = nullptr;
            const float* gaux = nullptr; float* rss2 = nullptr; const float* bss = nullptr;
            if (sub < 2) { A = Hb; Bt = (const bf16_t*)(ws + WS_WFO + (size_t)(layer * 2 + sub) * SZ_WFO); K = 2816; scale = 0.5f;
                if (sub == 0) { xg = XN; gn = P.in[5] + layer * DM; rss = (float*)(ws + WS_RSA); if (layer == 1) { bss = (const float*)(ws + WS_RSC); gaux = P.in[9]; } }
                else if (layer == 0) { xg = XN; gn = P.in[2] + DM; gaux = P.in[9]; rss = (float*)(ws + WS_RSC); rss2 = (float*)(ws + WS_RSD); } }
            else { A = XN; Bt = (const bf16_t*)(ws + (layer == 0 ? WS_WABO : WS_WATO)); K = 1024; scale = 1.0f; xg = (bf16_t*)(ws + WS_Y); gn = P.in[6] + layer * DM; rss = (float*)(ws + WS_RSB); }
            pg8::Gemm g{A, Bt, M_TOK, 1024, K};
            pg8::StaticOrder S; S.init(M_TOK, 1024, G, bid);
            const bool first = (layer == 0 && sub == 0);
            EpiResid E{X, scale, xg, gn, rss, first ? P.in[0] : nullptr, first ? P.in[1] : nullptr, gaux, rss2, bss};
#ifndef SKIP_G2
            pg8::gemm_phase<EpiResid, pg8::StaticOrder, GEMM_ALIGN, GEMM_SP2>(lds, g, S, E);
#endif
        } else if (kind == K_NORM) {
            norm_rows(X, X, M_TOK, nullptr, P.in[9] + DM, X, nullptr, nullptr);
        } else if (kind == K_GEMM_P || kind == K_GEMM_QKV) {
            const bool isP = kind == K_GEMM_P; const int N = isP ? 3328 : 3072;
            pg8::Gemm g{XN, (const bf16_t*)(ws + (isP ? WS_WABI : WS_WATI)), M_TOK, N, 1024};
            pg8::StaticOrder S; S.init(M_TOK, N, G, bid);
            { float* zb = (float*)(ws + WS_RSB); for (int i = bid * 512 + opaque_tid(); i < M_TOK; i += G * 512) zb[i] = 0.f; }
            EpiSplit E; const float* rsa = (const float*)(ws + WS_RSA);
            if (isP) E = EpiSplit{(bf16_t*)(ws + WS_PUV), 1024, 4, (bf16_t*)(ws + WS_PRKVG), 2048, 12, (bf16_t*)(ws + WS_PWA), 256, rsa, nullptr};
            else E = EpiSplit{(bf16_t*)(ws + WS_BIG), 3072, 12, (bf16_t*)(ws + WS_BIG), 3072, 12, (bf16_t*)(ws + WS_BIG), 3072, rsa, (float*)(ws + WS_KSQ)};
#ifndef SKIP_G3
            pg8::gemm_phase<EpiSplit, pg8::StaticOrder, GEMM_ALIGN, GEMM_SP2>(lds, g, S, E);
#endif
        } else if (kind == K_MIXA) {
            constexpr int NLONG = 16 + 16 * (NSEG - 2);
            unsigned* qhead = (unsigned*)(ws + WS_TS + 2048);
            LAS int* qslot = (LAS int*)(lds + LDS_BYTES - 16);
            for (;;) {
                if (opaque_tid() == 0) *qslot = (int)__hip_atomic_fetch_add(qhead, 1u, __ATOMIC_RELAXED, __HIP_MEMORY_SCOPE_AGENT);
                __syncthreads();
                const int li = __builtin_amdgcn_readfirstlane(*qslot);
                __syncthreads();
                if (li >= 512 + NLONG + 640) break;
#ifndef SKIP_SCAN
                if (li < 512) scan_item<16>(P, li >> 4, (li >> 1) & 7, li & 1, 0, 0, 2048, 4 | 8, nullptr, nullptr, nullptr, lds);
                else if (li < 512 + 16) {
                    const int hd = li - 512, dir = hd & 1;
                    scan_item<16>(P, 32, hd >> 1, dir, 0, dir == 0 ? 0 : 16384 - SEGLEN, SEGLEN, 4 | 8, nullptr, (float*)(ws + WS_STL) + (size_t)hd * NSEG * 4096, nullptr, lds);
                } else if (li < 512 + NLONG) {
                    const int q = li - 512 - 16, hd = q & 15, sgm = 1 + (q >> 4), dir = hd & 1;
                    const int tb = dir == 0 ? sgm * SEGLEN : 16384 - (sgm + 1) * SEGLEN;
                    scan_item<16>(P, 32, hd >> 1, dir, 0, tb, SEGLEN, 16, nullptr, (float*)(ws + WS_STL) + ((size_t)hd * NSEG + sgm) * 4096, (float*)(ws + WS_STP) + ((size_t)hd * NSEG + sgm) * 4096, lds);
                }
#endif
#ifndef SKIP_SGU
                if (li >= 512 + NLONG) sgu_item(P, li - 512 - NLONG, lds);
#endif
            }
        } else if (kind == K_CARRY) {
#ifndef SKIP_SCAN
            if (bid < 16) scan_carry(P, bid, lds);
#endif
        } else if (kind == K_MIXB) {
#ifndef SKIP_SCAN
            for (int li = bid; li < 16 * (NSEG - 1); li += G) {
                const int hd = li & 15, sgm = 1 + (li >> 4), dir = hd & 1;
                const int tb = dir == 0 ? sgm * SEGLEN : 16384 - (sgm + 1) * SEGLEN;
                scan_item<16>(P, 32, hd >> 1, dir, 0, tb, SEGLEN, 4 | 8, (const float*)(ws + WS_STS) + ((size_t)hd * NSEG + sgm) * 4096, nullptr, nullptr, lds);
            }
#endif
        } else if (kind == K_FINAL) {
#ifndef SKIP_FIN
            rwkv_finalize(P);
#endif
        } else if (kind == K_ATTN) {
            for (int it = bid; it < 5120; it += G) {
#ifndef SKIP_ATTN
                if (it < 4096) attn_item(P, it >> 7, it & 15, (it >> 4) & 7, lds);
                else attn_item(P, 32, it & 15, (it - 4096) >> 4, lds);
#endif
            }
        }
        if (ph + 1 < N_PHASES) {
            __builtin_amdgcn_fence(__ATOMIC_RELEASE, "agent");
            asm volatile("s_waitcnt vmcnt(0) lgkmcnt(0)" ::: "memory");
            grid.sync();
            __builtin_amdgcn_fence(__ATOMIC_ACQUIRE, "agent");
            asm volatile("s_waitcnt vmcnt(0) lgkmcnt(0)" ::: "memory");
            __syncthreads();
        }
    }
#ifdef PROBE_MASK
    if (blockIdx.x == 0 && threadIdx.x == 0) {
        unsigned long long* ts = (unsigned long long*)(P.ws + WS_TS);
        ts[N_PHASES] = __builtin_amdgcn_s_memrealtime();
        unsigned long long tot = 0;
        for (int i = 0; i < N_PHASES; ++i) if ((PROBE_MASK >> i) & 1) tot += ts[i + 1] - ts[i];
        P.out[0] += 4.0f + 10.0f * (float)tot * 1e-5f;
    }
#endif
}

extern "C" void kernel_launch(void* const* d_in, const int* in_sizes, int n_in, void* d_out, int out_size, void* d_ws, size_t ws_size, hipStream_t stream) {
    static int grid_blocks = 0;
    if (!grid_blocks) {
        int dev = 0, cus = 0, per_cu = 0;
        (void)hipGetDevice(&dev);
        (void)hipDeviceGetAttribute(&cus, hipDeviceAttributeMultiprocessorCount, dev);
        (void)hipFuncSetAttribute((const void*)mega, hipFuncAttributeMaxDynamicSharedMemorySize, LDS_BYTES);
        (void)hipOccupancyMaxActiveBlocksPerMultiprocessor(&per_cu, (const void*)mega, 512, LDS_BYTES);
        (void)hipGetLastError();
        if (cus <= 0) cus = 256;
        grid_blocks = cus;
        if (ws_size < WS_END2) fprintf(stderr, "kernel_launch: workspace too small: %zu < %zu\n", ws_size, (size_t)WS_END2);
    }
    Params p{};
    for (int i = 0; i < 30 && i < n_in; ++i) p.in[i] = (const float*)d_in[i];
    p.out = (float*)d_out; p.ws = (unsigned char*)d_ws;
    void* args[] = {&p};
    hipError_t e = hipLaunchCooperativeKernel((const void*)mega, dim3(grid_blocks), dim3(512), args, LDS_BYTES, stream);
    if (e != hipSuccess) fprintf(stderr, "cooperative launch failed: %s (grid %d)\n", hipGetErrorString(e), grid_blocks);
}
```

```cpp
#include <hip/hip_runtime.h>
#include <hip/hip_cooperative_groups.h>
#include <cstdio>
namespace cg = cooperative_groups;

namespace pg8 {
#define PG8_LAS __attribute__((address_space(3)))
typedef unsigned short bf16_t;
typedef short bf16x8 __attribute__((ext_vector_type(8)));
typedef float f32x4 __attribute__((ext_vector_type(4)));
typedef unsigned u32x4 __attribute__((ext_vector_type(4)));
constexpr int BM = 256, BK = 64, HALF = 128, HTB = HALF * BK * 2  , STAGE_BYTES = 8 * HTB, NXCD = 8, WGM = 8;

__host__ __device__ __forceinline__ int lds_byte(int r, int c) { const int st = (r >> 4) * 2 + (c >> 5), rr = r & 15, cc = c & 31, ob = rr * 64 + cc * 2; return st * 1024 + (ob ^ (((ob >> 9) & 1) << 5)); }
__host__ __device__ __forceinline__ void stage_rc(int b, int& R, int& C) { const int st = b / 1024, sb = b % 1024, swz = sb ^ (((sb >> 9) & 1) << 5); R = (st >> 1) * 16 + swz / 64; C = (st & 1) * 32 + (swz % 64) / 2; }
__host__ __device__ __forceinline__ int perm32(int rho) { const int n = rho >> 4, i = rho & 15; return 8 * (i >> 2) + 4 * n + (i & 3); }

struct Unit { int pm, pn; };
struct Gemm { const bf16_t* A; const bf16_t* Bt; int M, N, K; };

struct StaticOrder {
    int nM, nN, nwg, G, c;
    __host__ __device__ void init(int M, int N, int G_, int c_) { nM = M / BM; nN = N / BM; nwg = nM * nN; G = G_; c = c_; }
    __host__ __device__ bool next(int i, Unit& u) const {
        const long L = (long)i * G + c; if (L >= nwg) return false;
        int wgid = (int)L; { const int q = nwg / NXCD, r = nwg % NXCD, xcd = wgid % NXCD, off = wgid / NXCD; wgid = (xcd < r ? xcd * (q + 1) : r * (q + 1) + (xcd - r) * q) + off; }
        const int nig = WGM * nN, gid = wgid / nig, fm = gid * WGM, gsz = (nM - fm) < WGM ? (nM - fm) : WGM;
        u.pm = fm + ((wgid % nig) % gsz); u.pn = (wgid % nig) / gsz; return true;
    }
    __device__ __forceinline__ void a_ready(const Unit&) const {}
    __device__ __forceinline__ void done(const Unit&) const {}
};
__device__ __forceinline__ unsigned cvt_pk_bf16(float lo, float hi) { unsigned r; asm volatile("v_cvt_pk_bf16_f32 %0, %1, %2" : "=v"(r) : "v"(lo), "v"(hi)); return r; }
typedef float f32x2 __attribute__((ext_vector_type(2)));
template <class Epi, class Sched, bool ALIGN_EPI = false, bool SP2 = false>
__device__ __forceinline__ void gemm_phase(PG8_LAS unsigned char* lds, const Gemm g, const Sched& S, const Epi& E) {
    int tid_raw_ = threadIdx.x; asm volatile("" : "+v"(tid_raw_)); const int tid = tid_raw_, wid = __builtin_amdgcn_readfirstlane(tid >> 6), lane = tid & 63, wr = wid >> 2, wc = wid & 3, fr = lane & 15, fq = lane >> 4;
    const int K = g.K, nt = K / BK;
    unsigned voffA[2], voffB[2];
#pragma unroll
    for (int i = 0; i < 2; ++i) { int R, C; stage_rc(tid * 16 + i * 8192, R, C); const int Rb = Epi::PERM ? ((R & ~31) + perm32(R & 31)) : R;
        voffA[i] = (unsigned)(R * K + C) * 2u; voffB[i] = (unsigned)(Rb * K + C) * 2u; }
    const size_t kstep = (size_t)(BK * 2);
    const size_t hstep = (size_t)HALF * K * 2;
    const size_t tstep = 2 * hstep;
    const unsigned ldsw = (unsigned)wid * 1024u;
    const int aoff = lds_byte(wr * 64 + fr, fq * 8), boff = lds_byte(wc * 32 + fr, fq * 8);
#define PG8_SA(b, h) (((b) * 2 + (h)) * HTB)
#define PG8_SB(b, h) ((4 + (b) * 2 + (h)) * HTB)
#define PG8_STAGE(bufoff, gbase, voff) do { _Pragma("unroll") for (int _i = 0; _i < 2; ++_i) \
        __builtin_amdgcn_global_load_lds((const unsigned*)((const char*)(gbase) + (voff)[_i]), (PG8_LAS unsigned*)(lds + (bufoff) + ldsw + _i * 8192), 16, 0, 0); } while (0)
#define PG8_LDA(dst, b, h) do { _Pragma("unroll") for (int m = 0; m < 4; ++m) _Pragma("unroll") for (int k = 0; k < 2; ++k) dst[m][k] = *(const PG8_LAS bf16x8*)(lds + PG8_SA(b, h) + aoff + m * 2048 + k * 1024); } while (0)
#define PG8_LDB(dst, b, h) do { _Pragma("unroll") for (int n = 0; n < 2; ++n) _Pragma("unroll") for (int k = 0; k < 2; ++k) dst[n][k] = *(const PG8_LAS bf16x8*)(lds + PG8_SB(b, h) + boff + n * 2048 + k * 1024); } while (0)
#define PG8_MMA(ai, bj, At, Bt) do { __builtin_amdgcn_s_setprio(1); _Pragma("unroll") for (int m = 0; m < 4; ++m) _Pragma("unroll") for (int n = 0; n < 2; ++n) _Pragma("unroll") for (int k = 0; k < 2; ++k) \
        acc[ai][bj][m][n] = __builtin_amdgcn_mfma_f32_16x16x32_bf16(Bt[n][k], At[m][k], acc[ai][bj][m][n], 0, 0, 0); __builtin_amdgcn_s_setprio(0); } while (0)
#define PG8_WAIT_V(n) asm volatile("s_waitcnt vmcnt(" #n ")" ::: "memory")
#define PG8_WAIT_L(n) asm volatile("s_waitcnt lgkmcnt(" #n ")" ::: "memory")
#define PG8_BAR __builtin_amdgcn_s_barrier()
#define PG8_SCHED __builtin_amdgcn_sched_barrier(0)
    Unit cur, nxt; int ui = 0;
    if (!S.next(0, cur)) return;
    f32x4 acc[2][2][4][2];
#pragma unroll
    for (int a = 0; a < 2; ++a)
#pragma unroll
        for (int b = 0; b < 2; ++b)
#pragma unroll
            for (int m = 0; m < 4; ++m)
#pragma unroll
                for (int n = 0; n < 2; ++n) acc[a][b][m][n] = (f32x4){0.f, 0.f, 0.f, 0.f};
    bf16x8 At[4][2], B0[2][2], B1[2][2];
    const char* cA = (const char*)g.A + (size_t)cur.pm * tstep; const char* cB = (const char*)g.Bt + (size_t)cur.pn * tstep;
    S.a_ready(cur);
    if constexpr (SP2) {
        PG8_STAGE(PG8_SB(0, 0), cB, voffB); PG8_STAGE(PG8_SB(0, 1), cB + hstep, voffB); PG8_STAGE(PG8_SA(0, 0), cA, voffA); PG8_STAGE(PG8_SA(0, 1), cA + hstep, voffA);
        if (wr == 1) PG8_BAR;
        PG8_WAIT_V(2); PG8_BAR;
        PG8_STAGE(PG8_SB(1, 0), cB + kstep, voffB); PG8_STAGE(PG8_SA(1, 0), cA + kstep, voffA); PG8_STAGE(PG8_SB(1, 1), cB + hstep + kstep, voffB);
        PG8_WAIT_V(6); PG8_BAR;
    } else {
        PG8_STAGE(PG8_SB(0, 0), cB, voffB); PG8_STAGE(PG8_SA(0, 0), cA, voffA); PG8_STAGE(PG8_SB(0, 1), cB + hstep, voffB); PG8_STAGE(PG8_SA(0, 1), cA + hstep, voffA);
        if (wr == 1) PG8_BAR;
        PG8_WAIT_V(4); PG8_BAR;
        PG8_STAGE(PG8_SB(1, 0), cB + kstep, voffB); PG8_STAGE(PG8_SA(1, 0), cA + kstep, voffA); PG8_STAGE(PG8_SB(1, 1), cB + hstep + kstep, voffB);
        PG8_WAIT_V(6); PG8_BAR;
    }
    for (;;) {
        const bool has_next = S.next(ui + 1, nxt);
        const char* nA = has_next ? (const char*)g.A + (size_t)nxt.pm * tstep : cA; const char* nB = has_next ? (const char*)g.Bt + (size_t)nxt.pn * tstep : cB;
        for (int t = 0; t < nt; t += 2) {
            const bool last = (t == nt - 2);
            const char* a1 = cA + (size_t)(t + 1) * kstep;
            const char* a2 = last ? nA : cA + (size_t)(t + 2) * kstep; const char* b2 = last ? nB : cB + (size_t)(t + 2) * kstep;
            const char* a3 = a2 + kstep; const char* b3 = b2 + kstep;
            if (last && has_next) S.a_ready(nxt);
            if constexpr (SP2) {
            PG8_LDB(B0, 0, 0); PG8_LDB(B1, 0, 1); PG8_SCHED; PG8_LDA(At, 0, 0); PG8_STAGE(PG8_SA(1, 1), a1 + hstep, voffA);
            PG8_WAIT_V(8); PG8_WAIT_L(0); PG8_BAR; PG8_MMA(0, 0, At, B0); PG8_MMA(0, 1, At, B1); PG8_BAR; PG8_SCHED;
            PG8_LDA(At, 0, 1); PG8_STAGE(PG8_SB(0, 0), b2, voffB); PG8_STAGE(PG8_SB(0, 1), b2 + hstep, voffB); PG8_STAGE(PG8_SA(0, 0), a2, voffA);
            PG8_WAIT_V(8); PG8_WAIT_L(0); PG8_BAR; PG8_MMA(1, 0, At, B0); PG8_MMA(1, 1, At, B1); PG8_BAR; PG8_SCHED;
            PG8_LDB(B0, 1, 0); PG8_LDB(B1, 1, 1); PG8_SCHED; PG8_LDA(At, 1, 0); PG8_STAGE(PG8_SA(0, 1), a2 + hstep, voffA);
            PG8_WAIT_V(8); PG8_WAIT_L(0); PG8_BAR; PG8_MMA(0, 0, At, B0); PG8_MMA(0, 1, At, B1); PG8_BAR; PG8_SCHED;
            PG8_LDA(At, 1, 1); PG8_STAGE(PG8_SB(1, 0), b3, voffB); PG8_STAGE(PG8_SB(1, 1), b3 + hstep, voffB); PG8_STAGE(PG8_SA(1, 0), a3, voffA);
            PG8_WAIT_V(8); PG8_WAIT_L(0); PG8_BAR; PG8_MMA(1, 0, At, B0); PG8_MMA(1, 1, At, B1); PG8_BAR; PG8_SCHED;
            } else {
            PG8_LDB(B0, 0, 0); PG8_SCHED; PG8_LDA(At, 0, 0); PG8_STAGE(PG8_SA(1, 1), a1 + hstep, voffA);
            PG8_WAIT_L(8); PG8_BAR; PG8_WAIT_L(0); PG8_MMA(0, 0, At, B0); PG8_BAR; PG8_SCHED;
            PG8_LDB(B1, 0, 1); PG8_STAGE(PG8_SB(0, 0), b2, voffB);
            PG8_BAR; PG8_WAIT_L(0); PG8_MMA(0, 1, At, B1); PG8_BAR;
            PG8_LDA(At, 0, 1); PG8_STAGE(PG8_SA(0, 0), a2, voffA);
            PG8_BAR; PG8_WAIT_L(0); PG8_MMA(1, 0, At, B0); PG8_BAR; PG8_SCHED;
            PG8_STAGE(PG8_SB(0, 1), b2 + hstep, voffB);
            PG8_WAIT_V(6); PG8_BAR; PG8_MMA(1, 1, At, B1); PG8_BAR;
            PG8_LDB(B0, 1, 0); PG8_SCHED; PG8_LDA(At, 1, 0); PG8_STAGE(PG8_SA(0, 1), a2 + hstep, voffA);
            PG8_WAIT_L(8); PG8_BAR; PG8_WAIT_L(0); PG8_MMA(0, 0, At, B0); PG8_BAR; PG8_SCHED;
            PG8_LDB(B1, 1, 1); PG8_STAGE(PG8_SB(1, 0), b3, voffB);
            PG8_BAR; PG8_WAIT_L(0); PG8_MMA(0, 1, At, B1); PG8_BAR;
            PG8_LDA(At, 1, 1); PG8_STAGE(PG8_SA(1, 0), a3, voffA);
            PG8_BAR; PG8_WAIT_L(0); PG8_MMA(1, 0, At, B0); PG8_BAR; PG8_SCHED;
            PG8_STAGE(PG8_SB(1, 1), b3 + hstep, voffB);
            PG8_WAIT_V(6); PG8_BAR; PG8_MMA(1, 1, At, B1); PG8_BAR;
            }
        }
        if constexpr (ALIGN_EPI) { if (wr == 0) PG8_BAR; }
        if constexpr (!Epi::AFTER_DRAIN) { E(acc, cur, wr, wc, fr, fq); S.done(cur); }
        if (!has_next) break;
#pragma unroll
        for (int a = 0; a < 2; ++a)
#pragma unroll
            for (int b = 0; b < 2; ++b)
#pragma unroll
                for (int m = 0; m < 4; ++m)
#pragma unroll
                    for (int n = 0; n < 2; ++n) acc[a][b][m][n] = (f32x4){0.f, 0.f, 0.f, 0.f};
        cur = nxt; cA = nA; cB = nB; ++ui;
        if constexpr (ALIGN_EPI) { if (wr == 1) PG8_BAR; }
    }
    PG8_WAIT_V(0);
    if constexpr (!ALIGN_EPI) { if (wr == 0) PG8_BAR; }
    PG8_BAR;
    if constexpr (Epi::AFTER_DRAIN) { E.fused(acc, cur, wr, wc, fr, fq, lds, wid, lane); S.done(cur); }
#undef PG8_SA
#undef PG8_SB
#undef PG8_STAGE
#undef PG8_LDA
#undef PG8_LDB
#undef PG8_MMA
#undef PG8_WAIT_V
#undef PG8_WAIT_L
#undef PG8_BAR
#undef PG8_SCHED
}
}


#define LAS __attribute__((address_space(3)))
typedef unsigned short bf16_t;
typedef short bf16x8 __attribute__((ext_vector_type(8)));
typedef short s16x4 __attribute__((ext_vector_type(4)));
typedef float f32x4 __attribute__((ext_vector_type(4)));
typedef unsigned u32x4 __attribute__((ext_vector_type(4)));
typedef unsigned u32x2 __attribute__((ext_vector_type(2)));
typedef float f32x2v __attribute__((ext_vector_type(2)));

constexpr int M_TOK = 81920, M_PROMPT = 65536, DM = 1024, DFF = 2816;
constexpr int LDS_BYTES = 147456;
#ifndef GEMM_ALIGN
#define GEMM_ALIGN true
#endif
#ifndef GEMM_SP2
#define GEMM_SP2 true
#endif
constexpr float NORM_EPS = 1e-6f;

constexpr size_t SZ_WFI = (size_t)5632 * 1024 * 2, SZ_WFO = (size_t)1024 * 2816 * 2;
constexpr size_t WS_WFI = 0;
constexpr size_t WS_WFO = WS_WFI + 4 * SZ_WFI;
constexpr size_t WS_WABI = WS_WFO + 4 * SZ_WFO;
constexpr size_t WS_WABO = WS_WABI + (size_t)3328 * 1024 * 2;
constexpr size_t WS_WATI = WS_WABO + (size_t)1024 * 1024 * 2;
constexpr size_t WS_WATO = WS_WATI + (size_t)3072 * 1024 * 2;
constexpr size_t WS_LORA = WS_WATO + (size_t)1024 * 1024 * 2;
constexpr size_t WS_SGUW = WS_LORA + (size_t)4 * 512 * 64 * 2;
constexpr size_t WS_RKR = WS_SGUW + (size_t)4 * 128 * 128 * 2;
constexpr size_t WS_XN = (WS_RKR + (size_t)2 * M_TOK * 8 * 4 + 4095) & ~(size_t)4095;
constexpr size_t WS_BIG = WS_XN + (size_t)M_TOK * 1024 * 2;
constexpr size_t WS_PUV = WS_BIG;
constexpr size_t WS_PRKVG = WS_PUV + (size_t)M_TOK * 1024 * 2;
constexpr size_t WS_PWA = WS_PRKVG + (size_t)M_TOK * 2048 * 2;
constexpr size_t WS_Y = WS_BIG + (size_t)M_TOK * 3328 * 2;
constexpr size_t WS_END = WS_Y + (size_t)2 * M_TOK * 512 * 2;

constexpr int NSEG = 16, SEGLEN = 16384 / NSEG;
constexpr size_t WS_STL = (WS_END + 4095) & ~(size_t)4095;
constexpr size_t WS_STP = WS_STL + (size_t)16 * NSEG * 4096 * 4;
constexpr size_t WS_STS = WS_STP + (size_t)16 * NSEG * 4096 * 4;
constexpr size_t WS_TS = WS_STS + (size_t)16 * NSEG * 4096 * 4;
constexpr size_t WS_RSA = WS_TS + 4096;
constexpr size_t WS_RSB = WS_RSA + (size_t)M_TOK * 4;
constexpr size_t WS_RSC = WS_RSB + (size_t)M_TOK * 4;
constexpr size_t WS_RSD = WS_RSC + (size_t)M_TOK * 4;
constexpr size_t WS_KSQ = WS_RSD + (size_t)M_TOK * 4;
constexpr size_t WS_END2 = WS_KSQ + (size_t)16 * M_TOK * 4;
struct Params { const float* in[30]; float* out; unsigned char* ws; };

__device__ __forceinline__ float bflo(unsigned w) { return __uint_as_float(w << 16); }
__device__ __forceinline__ float bfhi(unsigned w) { return __uint_as_float(w & 0xffff0000u); }
__device__ __forceinline__ unsigned pk2(float lo, float hi) { unsigned r; asm("v_cvt_pk_bf16_f32 %0, %1, %2" : "=v"(r) : "v"(lo), "v"(hi)); return r; }
__device__ __forceinline__ void unpack8(const u32x4 w, float* f) { f[0] = bflo(w.x); f[1] = bfhi(w.x); f[2] = bflo(w.y); f[3] = bfhi(w.y); f[4] = bflo(w.z); f[5] = bfhi(w.z); f[6] = bflo(w.w); f[7] = bfhi(w.w); }
__device__ __forceinline__ u32x4 pack8(const float* f) { u32x4 w; w.x = pk2(f[0], f[1]); w.y = pk2(f[2], f[3]); w.z = pk2(f[4], f[5]); w.w = pk2(f[6], f[7]); return w; }
__device__ __forceinline__ float sigmoidf_(float x) { return __builtin_amdgcn_rcpf(1.0f + __expf(-x)); }
__device__ __forceinline__ float siluf_(float x) { return x * sigmoidf_(x); }
__device__ __forceinline__ float gelu_tanh(float x) { const float u = 0.7978845608028654f * (x + 0.044715f * x * x * x); return x * sigmoidf_(2.0f * u); }
__device__ __forceinline__ float tanhf_(float x) { return 1.0f - 2.0f * __builtin_amdgcn_rcpf(__expf(2.0f * x) + 1.0f); }
__device__ __forceinline__ float wave_sum(float x) { x += __shfl_xor(x, 32); x += __shfl_xor(x, 16); x += __shfl_xor(x, 8); x += __shfl_xor(x, 4); x += __shfl_xor(x, 2); x += __shfl_xor(x, 1); return x; }
template <int CTRL> __device__ __forceinline__ float dppf(float x) { return __int_as_float(__builtin_amdgcn_update_dpp(0, __float_as_int(x), CTRL, 0xF, 0xF, true)); }
__device__ __forceinline__ float reduce8(float x) { x += dppf<0xB1>(x); x += dppf<0x4E>(x); x += dppf<0x141>(x); return x; }
typedef short v4i16_t __attribute__((ext_vector_type(4)));
typedef __bf16 bf16x2_t __attribute__((ext_vector_type(2)));
__device__ __forceinline__ s16x4 tr_read(LAS const unsigned char* p) { return __builtin_bit_cast(s16x4, __builtin_amdgcn_ds_read_tr16_b64_v4i16((LAS v4i16_t*)p)); }
__device__ __forceinline__ f32x4 mfma16(bf16x8 a, bf16x8 b, f32x4 c) { return __builtin_amdgcn_mfma_f32_16x16x32_bf16(a, b, c, 0, 0, 0); }

__device__ __forceinline__ int opaque_tid() { int t = threadIdx.x; asm volatile("" : "+v"(t)); return t; }
__device__ __forceinline__ unsigned char* opaque_ptr(unsigned char* p) { size_t z = 0; asm volatile("" : "+s"(z)); return p + z; }
struct EpiSwiglu {
    static constexpr bool PERM = false, AFTER_DRAIN = false;
    bf16_t* H; const float* rowss; const float* rowss2;
    __device__ __forceinline__ void operator()(const f32x4 (&acc)[2][2][4][2], const pg8::Unit& u, int wr, int wc, int fr, int fq) const {
        const int row0 = u.pm * 256 + wr * 64 + fr, col0 = u.pn * 128 + wc * 32 + 8 * fq;
        float rsv[8];
#pragma unroll
        for (int gi = 0; gi < 8; ++gi) rsv[gi] = rowss ? rowss[row0 + (gi >> 2) * 128 + (gi & 3) * 16] : 0.f;
        float rsw[8];
#pragma unroll
        for (int gi = 0; gi < 8; ++gi) rsw[gi] = rowss2 ? rowss2[row0 + (gi >> 2) * 128 + (gi & 3) * 16] : 0.f;
#pragma unroll
        for (int gi = 0; gi < 8; ++gi) { rsv[gi] = rowss ? rsqrtf(rsv[gi] * (1.0f / DM) + NORM_EPS) : 1.0f;
            if (rowss2) rsv[gi] *= rsqrtf(rsv[gi] * rsv[gi] * rsw[gi] * (1.0f / DM) + NORM_EPS); }
#pragma unroll
        for (int ai = 0; ai < 2; ++ai)
#pragma unroll
            for (int m = 0; m < 4; ++m) {
                const int row = row0 + ai * 128 + m * 16;
                const float rs = rsv[ai * 4 + m];
                bf16_t* rowp = H + (size_t)row * DFF + col0;
                float h[8];
                const float c1 = rs * -1.4426950408889634f, c2 = rs * rs;
#pragma unroll
                for (int bj = 0; bj < 2; ++bj)
#pragma unroll
                    for (int pr = 0; pr < 2; ++pr) {
                        const f32x2v gg = {acc[ai][bj][m][0][2 * pr], acc[ai][bj][m][0][2 * pr + 1]}, uu = {acc[ai][bj][m][1][2 * pr], acc[ai][bj][m][1][2 * pr + 1]};
                        const f32x2v t = gg * c1;
                        f32x2v d; d.x = __builtin_amdgcn_exp2f(t.x); d.y = __builtin_amdgcn_exp2f(t.y);
                        d = d + 1.0f;
                        f32x2v r; r.x = __builtin_amdgcn_rcpf(d.x); r.y = __builtin_amdgcn_rcpf(d.y);
                        const f32x2v hh = ((gg * uu) * c2) * r;
                        h[bj * 4 + 2 * pr] = hh.x; h[bj * 4 + 2 * pr + 1] = hh.y;
                    }
                *(u32x4*)rowp = pack8(h);
                asm volatile("" ::: "memory");
            }
    }
};
struct EpiResid {
    static constexpr bool PERM = false, AFTER_DRAIN = false;
    float* X; float scale; bf16_t* XG; const float* g; float* rowss; const float* xin_a; const float* xin_b;
    const float* gaux; float* rowss2; const float* base_ss;
    __device__ __forceinline__ void operator()(const f32x4 (&acc)[2][2][4][2], const pg8::Unit& u, int wr, int wc, int fr, int fq) const {
        const int row0 = u.pm * 256 + wr * 64 + fr, col0 = u.pn * 256 + wc * 32 + 4 * fq;
        f32x4 gv[2][2];
#pragma unroll
        for (int bj = 0; bj < 2; ++bj)
#pragma unroll
            for (int n = 0; n < 2; ++n) gv[bj][n] = XG ? *(const f32x4*)(g + col0 + bj * 128 + n * 16) : (f32x4){0.f, 0.f, 0.f, 0.f};
        f32x4 ga[2][2];
#pragma unroll
        for (int bj = 0; bj < 2; ++bj)
#pragma unroll
            for (int n = 0; n < 2; ++n) { ga[bj][n] = gaux ? *(const f32x4*)(gaux + col0 + bj * 128 + n * 16) : (f32x4){1.f, 1.f, 1.f, 1.f}; if (rowss2) gv[bj][n] = gv[bj][n] * ga[bj][n]; }
        float brs[8];
#pragma unroll
        for (int gi = 0; gi < 8; ++gi) brs[gi] = base_ss ? base_ss[row0 + (gi >> 2) * 128 + (gi & 3) * 16] : 0.f;
#pragma unroll
        for (int gi = 0; gi < 8; ++gi) brs[gi] = base_ss ? rsqrtf(brs[gi] * (1.0f / DM) + NORM_EPS) : 1.0f;
        const float* Xs = xin_a ? (u.pm < 256 ? xin_a : xin_b - (size_t)M_PROMPT * DM) : X;
        f32x4 xin[2][2][2];
#pragma unroll
        for (int gi = 0; gi < 9; ++gi) {
            if (gi < 8) {
                const float* rowp = Xs + (size_t)(row0 + (gi >> 2) * 128 + (gi & 3) * 16) * DM + col0;
#pragma unroll
                for (int bj = 0; bj < 2; ++bj)
#pragma unroll
                    for (int n = 0; n < 2; ++n) xin[gi & 1][bj][n] = *(const f32x4*)(rowp + bj * 128 + n * 16);
            }
            if (gi > 0) {
                const int gp = gi - 1, ai = gp >> 2, m = gp & 3;
                const int row = row0 + ai * 128 + m * 16;
                float* rowp = X + (size_t)row * DM + col0;
                float ssq = 0.f, ssq2 = 0.f;
#pragma unroll
                for (int bj = 0; bj < 2; ++bj)
#pragma unroll
                    for (int n = 0; n < 2; ++n) { f32x4 v = xin[gp & 1][bj][n]; if (base_ss) v = v * brs[gp] * ga[bj][n];
                        v += acc[ai][bj][m][n] * scale; *(f32x4*)(rowp + bj * 128 + n * 16) = v;
                        if (XG) { ssq += (v[0] * v[0] + v[1] * v[1]) + (v[2] * v[2] + v[3] * v[3]); const f32x4 o = v * gv[bj][n]; u32x2 w; w.x = pk2(o[0], o[1]); w.y = pk2(o[2], o[3]);
                            *(u32x2*)(XG + (size_t)row * DM + col0 + bj * 128 + n * 16) = w; }
                        if (rowss2) { const f32x4 t = v * ga[bj][n]; ssq2 += (t[0] * t[0] + t[1] * t[1]) + (t[2] * t[2] + t[3] * t[3]); } }
                if (XG) { ssq += __shfl_xor(ssq, 16); ssq += __shfl_xor(ssq, 32);
                    if (fq == 0) __hip_atomic_fetch_add(rowss + row, ssq, __ATOMIC_RELAXED, __HIP_MEMORY_SCOPE_AGENT); }
                if (rowss2) { ssq2 += __shfl_xor(ssq2, 16); ssq2 += __shfl_xor(ssq2, 32);
                    if (fq == 0) __hip_atomic_fetch_add(rowss2 + row, ssq2, __ATOMIC_RELAXED, __HIP_MEMORY_SCOPE_AGENT); }
            }
            asm volatile("" ::: "memory");
        }
    }
};
struct EpiSplit {
    static constexpr bool PERM = true, AFTER_DRAIN = false;
    bf16_t* b0; int ld0, t0; bf16_t* b1; int ld1, t1; bf16_t* b2; int ld2; const float* rowss; float* ksq;
    __device__ __forceinline__ void operator()(const f32x4 (&acc)[2][2][4][2], const pg8::Unit& u, int wr, int wc, int fr, int fq) const {
        bf16_t* base; int ld, ct;
        if (u.pn < t0) { base = b0; ld = ld0; ct = u.pn; } else if (u.pn < t1) { base = b1; ld = ld1; ct = u.pn - t0; } else { base = b2; ld = ld2; ct = u.pn - t1; }
        const int row0 = u.pm * 256 + wr * 64 + fr, col0 = ct * 256 + wc * 32 + 8 * fq;
        const bool isk = ksq != nullptr && u.pn >= 4 && u.pn < 8;
        float rsv[8];
#pragma unroll
        for (int gi = 0; gi < 8; ++gi) rsv[gi] = rowss[row0 + (gi >> 2) * 128 + (gi & 3) * 16];
#pragma unroll
        for (int gi = 0; gi < 8; ++gi) rsv[gi] = rsqrtf(rsv[gi] * (1.0f / DM) + NORM_EPS);
#pragma unroll
        for (int ai = 0; ai < 2; ++ai)
#pragma unroll
            for (int m = 0; m < 4; ++m) {
                const int row = row0 + ai * 128 + m * 16;
                const float rs = rsv[ai * 4 + m];
                bf16_t* rowp = base + (size_t)row * ld + col0;
#pragma unroll
                for (int bj = 0; bj < 2; ++bj) {
                    const f32x4 v0 = acc[ai][bj][m][0] * rs, v1 = acc[ai][bj][m][1] * rs;
                    u32x4 w; w.x = pk2(v0[0], v0[1]); w.y = pk2(v0[2], v0[3]); w.z = pk2(v1[0], v1[1]); w.w = pk2(v1[2], v1[3]);
                    *(u32x4*)(rowp + bj * 128) = w;
                    if (isk) {
                        float sq = ((v0[0] * v0[0] + v0[1] * v0[1]) + (v0[2] * v0[2] + v0[3] * v0[3])) + ((v1[0] * v1[0] + v1[1] * v1[1]) + (v1[2] * v1[2] + v1[3] * v1[3]));
                        sq += __shfl_xor(sq, 16); sq += __shfl_xor(sq, 32);
                        if (fq == 0) __hip_atomic_fetch_add(ksq + (size_t)((u.pn - 4) * 4 + 2 * bj + (wc >> 1)) * M_TOK + row, sq, __ATOMIC_RELAXED, __HIP_MEMORY_SCOPE_AGENT);
                    }
                }
                asm volatile("" ::: "memory");
            }
    }
};

template <int MAP> __device__ __forceinline__ int src_col(int s) {
    if (MAP == 0) return s;
    const int pn = s >> 8, bj = (s >> 7) & 1, wc = (s >> 5) & 3, n = (s >> 4) & 1, fq = (s >> 2) & 3, jj = s & 3;
    return n * DFF + 128 * pn + 32 * wc + 8 * fq + 4 * bj + jj;
}
template <int MAP> __device__ void convert_T(const float* __restrict__ src, bf16_t* __restrict__ dst, int K, int N, LAS float* tile, int rot) {
    const int tk = K / 64, tn = N / 64, nt = tk * tn, tid = opaque_tid(), G = gridDim.x;
    const int kk0 = tid >> 4, sg = tid & 15;
    int t = (int)((blockIdx.x + rot) % G);
    float4 va = make_float4(0.f, 0.f, 0.f, 0.f), vb = va;
    if (t < nt) { const int k0 = (t % tk) * 64, s0 = (t / tk) * 64; const int c = src_col<MAP>(s0 + sg * 4);
        va = *(const float4*)(src + (size_t)(k0 + kk0) * N + c); vb = *(const float4*)(src + (size_t)(k0 + kk0 + 32) * N + c); }
    for (; t < nt; t += G) {
        const int k0 = (t % tk) * 64, s0 = (t / tk) * 64;
        { LAS float* tp = tile + kk0 * 65 + sg * 4; tp[0] = va.x; tp[1] = va.y; tp[2] = va.z; tp[3] = va.w;
          LAS float* tq = tile + (kk0 + 32) * 65 + sg * 4; tq[0] = vb.x; tq[1] = vb.y; tq[2] = vb.z; tq[3] = vb.w; }
        if (t + G < nt) {
            const int t2 = t + G, k2 = (t2 % tk) * 64, s2 = (t2 / tk) * 64; const int c = src_col<MAP>(s2 + sg * 4);
            va = *(const float4*)(src + (size_t)(k2 + kk0) * N + c); vb = *(const float4*)(src + (size_t)(k2 + kk0 + 32) * N + c); }
        asm volatile("s_waitcnt lgkmcnt(0)" ::: "memory"); __builtin_amdgcn_s_barrier(); asm volatile("" ::: "memory");
        {
            const int slot = tid >> 3, kc = tid & 7; float f[8];
#pragma unroll
            for (int i = 0; i < 8; ++i) f[i] = tile[(kc * 8 + i) * 65 + slot];
            *(u32x4*)(dst + (size_t)(s0 + slot) * K + k0 + kc * 8) = pack8(f);
        }
        asm volatile("s_waitcnt lgkmcnt(0)" ::: "memory"); __builtin_amdgcn_s_barrier(); asm volatile("" ::: "memory");
    }
}

__device__ void norm_rows(const float* xa, const float* xb, int split, float* xcopy, const float* g1, float* x1out, const float* g2, bf16_t* xn) {
    const int tid_ = opaque_tid(), lane = tid_ & 63, wave = __builtin_amdgcn_readfirstlane(tid_ >> 6);
    const int stride = gridDim.x * 8;
    for (int row0 = blockIdx.x * 8 + wave; row0 < M_TOK; row0 += 2 * stride) {
        int rows[2]; rows[0] = row0; rows[1] = (row0 + stride < M_TOK) ? row0 + stride : row0;
        f32x4 v[2][4]; float ss[2] = {0.f, 0.f};
#pragma unroll
        for (int q = 0; q < 2; ++q) { const int row = rows[q];
            const float* src = (row < split) ? xa + (size_t)row * DM : xb + (size_t)(row - split) * DM;
#pragma unroll
            for (int i = 0; i < 4; ++i) v[q][i] = *(const f32x4*)(src + i * 256 + lane * 4); }
#pragma unroll
        for (int q = 0; q < 2; ++q) {
#pragma unroll
            for (int i = 0; i < 4; ++i) ss[q] += v[q][i][0] * v[q][i][0] + v[q][i][1] * v[q][i][1] + v[q][i][2] * v[q][i][2] + v[q][i][3] * v[q][i][3];
            if (xcopy) {
#pragma unroll
                for (int i = 0; i < 4; ++i) *(f32x4*)(xcopy + (size_t)rows[q] * DM + i * 256 + lane * 4) = v[q][i];
            }
        }
        ss[0] = wave_sum(ss[0]); ss[1] = wave_sum(ss[1]);
        float r[2]; r[0] = rsqrtf(ss[0] * (1.0f / DM) + NORM_EPS); r[1] = rsqrtf(ss[1] * (1.0f / DM) + NORM_EPS);
        if (g1) {
            float s2[2] = {0.f, 0.f};
#pragma unroll
            for (int i = 0; i < 4; ++i) { const f32x4 g = *(const f32x4*)(g1 + i * 256 + lane * 4);
#pragma unroll
                for (int q = 0; q < 2; ++q) { v[q][i] = v[q][i] * r[q] * g; *(f32x4*)(x1out + (size_t)rows[q] * DM + i * 256 + lane * 4) = v[q][i];
                    s2[q] += v[q][i][0] * v[q][i][0] + v[q][i][1] * v[q][i][1] + v[q][i][2] * v[q][i][2] + v[q][i][3] * v[q][i][3]; } }
            s2[0] = wave_sum(s2[0]); s2[1] = wave_sum(s2[1]);
            r[0] = rsqrtf(s2[0] * (1.0f / DM) + NORM_EPS); r[1] = rsqrtf(s2[1] * (1.0f / DM) + NORM_EPS);
        }
        if (g2) {
#pragma unroll
            for (int i = 0; i < 4; ++i) { const f32x4 g = *(const f32x4*)(g2 + i * 256 + lane * 4);
#pragma unroll
                for (int q = 0; q < 2; ++q) { const f32x4 o = v[q][i] * r[q] * g;
                    u32x2 w; w.x = pk2(o[0], o[1]); w.y = pk2(o[2], o[3]); *(u32x2*)(xn + (size_t)rows[q] * DM + i * 256 + lane * 4) = w; } }
        }
    }
}

__device__ void sgu_item(const Params& PP, int chunk, LAS unsigned char* lds) {
    Params P = PP; P.ws = opaque_ptr(PP.ws);
    const int tid = opaque_tid(), lane = tid & 63, wave = __builtin_amdgcn_readfirstlane(tid >> 6), l15 = lane & 15, quad = lane >> 4;
    constexpr int PITCH = 1056;
    const bf16_t* Puv = (const bf16_t*)(P.ws + WS_PUV);
    bf16_t* MO = (bf16_t*)(P.ws + WS_XN);
    const size_t row0 = (size_t)chunk * 128;
    {
        float gn[8];
        { const f32x4 a = *(const f32x4*)(P.in[12] + lane * 8), b = *(const f32x4*)(P.in[12] + lane * 8 + 4); gn[0] = a[0]; gn[1] = a[1]; gn[2] = a[2]; gn[3] = a[3]; gn[4] = b[0]; gn[5] = b[1]; gn[6] = b[2]; gn[7] = b[3]; }
        for (int i = 0; i < 16; ++i) {
            const int p = wave * 16 + i;
            const u32x4 raw = *(const u32x4*)(Puv + (row0 + p) * 1024 + 512 + lane * 8);
            float v[8]; unpack8(raw, v); float ss = 0.f;
#pragma unroll
            for (int e = 0; e < 8; ++e) { v[e] = gelu_tanh(v[e]); ss += v[e] * v[e]; }
            ss = wave_sum(ss);
            const float r = rsqrtf(ss * (1.0f / 512.0f) + NORM_EPS);
#pragma unroll
            for (int e = 0; e < 8; ++e) v[e] = v[e] * r * gn[e];
            *(LAS u32x4*)(lds + p * PITCH + lane * 16) = pack8(v);
        }
    }
    __syncthreads();
    const int g = wave >> 1, cbase = (wave >> 1) * 128 + (wave & 1) * 64;
    const bf16_t* Wg = (const bf16_t*)(P.ws + WS_SGUW) + (size_t)g * 128 * 128;
    const int r4 = l15 >> 2, c4 = l15 & 3;
    for (int qh = 0; qh < 2; ++qh) {
        f32x4 acc[4][4];
#pragma unroll
        for (int a = 0; a < 4; ++a)
#pragma unroll
            for (int b = 0; b < 4; ++b) acc[a][b] = (f32x4){0.f, 0.f, 0.f, 0.f};
#pragma unroll
        for (int ks = 0; ks < 4; ++ks) {
            bf16x8 bfr[4];
#pragma unroll
            for (int qt = 0; qt < 4; ++qt) bfr[qt] = *(const bf16x8*)(Wg + (size_t)(qh * 64 + qt * 16 + l15) * 128 + ks * 32 + quad * 8);
#pragma unroll
            for (int ct = 0; ct < 4; ++ct) {
                LAS const unsigned char* ap = lds + (ks * 32 + quad * 8 + r4) * PITCH + (cbase + ct * 16 + 4 * c4) * 2;
                const s16x4 lo = tr_read(ap), hi = tr_read(ap + 4 * PITCH);
                const bf16x8 a = {lo[0], lo[1], lo[2], lo[3], hi[0], hi[1], hi[2], hi[3]};
#pragma unroll
                for (int qt = 0; qt < 4; ++qt) acc[ct][qt] = mfma16(a, bfr[qt], acc[ct][qt]);
            }
        }
#pragma unroll
        for (int qt = 0; qt < 4; ++qt) {
            const int q = qh * 64 + qt * 16 + l15;
            const float bq = P.in[14][g * 128 + q];
#pragma unroll
            for (int ct = 0; ct < 4; ++ct) {
                const int c = cbase + ct * 16 + quad * 4;
                const u32x2 ur = *(const u32x2*)(Puv + (row0 + q) * 1024 + c);
                const float u0 = gelu_tanh(bflo(ur.x)), u1 = gelu_tanh(bfhi(ur.x)), u2 = gelu_tanh(bflo(ur.y)), u3 = gelu_tanh(bfhi(ur.y));
                u32x2 w; w.x = pk2(u0 * (acc[ct][qt][0] + bq), u1 * (acc[ct][qt][1] + bq)); w.y = pk2(u2 * (acc[ct][qt][2] + bq), u3 * (acc[ct][qt][3] + bq));
                *(u32x2*)(MO + (row0 + q) * 1024 + c) = w;
            }
        }
    }
    __syncthreads();
}

template <int LPR> __device__ __forceinline__ float reduce_row(float x) {
    x += dppf<0xB1>(x); x += dppf<0x4E>(x); x += dppf<0x141>(x);
    if (LPR == 16) x += dppf<0x140>(x);
    return x;
}
__device__ __forceinline__ float reduce32(float x) {
    x += dppf<0xB1>(x); x += dppf<0x4E>(x); x += dppf<0x141>(x); x += dppf<0x140>(x); x += __shfl_xor(x, 16); return x;
}
__device__ __forceinline__ void lds_barrier() { asm volatile("s_waitcnt lgkmcnt(0)" ::: "memory"); __builtin_amdgcn_s_barrier(); asm volatile("" ::: "memory"); }
template <int NV> struct ScanSet { f32x4 kk[NV], w[NV], ka[NV], kp[NV], r[NV]; float vv; };
template <int NV> __device__ __forceinline__ void scan_load(ScanSet<NV>& t, LAS const float* KK, LAS const float* Wd, LAS const float* KKA, LAS const float* KP, LAS const float* Rr, LAS const float* Vv, int o, int ov, bool want_y) {
#pragma unroll
    for (int u = 0; u < NV; ++u) { t.kk[u] = *(LAS const f32x4*)(KK + o + u * 32); t.w[u] = *(LAS const f32x4*)(Wd + o + u * 32); t.ka[u] = *(LAS const f32x4*)(KKA + o + u * 32); t.kp[u] = *(LAS const f32x4*)(KP + o + u * 32); }
    if (want_y) {
#pragma unroll
        for (int u = 0; u < NV; ++u) t.r[u] = *(LAS const f32x4*)(Rr + o + u * 32);
    }
    t.vv = Vv[ov];
}
typedef float f32x2v __attribute__((ext_vector_type(2)));
template <int LPR, int NV> __device__ __forceinline__ float scan_step(float* S, const ScanSet<NV>& t, bool want_y, float& ypart) {
    f32x2v acc = {0.f, 0.f};
#pragma unroll
    for (int u = 0; u < NV; ++u)
#pragma unroll
        for (int hh = 0; hh < 2; ++hh) { const f32x2v s2 = {S[4 * u + 2 * hh], S[4 * u + 2 * hh + 1]}, k2 = {t.kk[u][2 * hh], t.kk[u][2 * hh + 1]}; acc = s2 * k2 + acc; }
    float sa = acc.x + acc.y, yb = ypart;
    sa += dppf<0xB1>(sa); yb += dppf<0xB1>(yb); sa += dppf<0x4E>(sa); yb += dppf<0x4E>(yb); sa += dppf<0x141>(sa); yb += dppf<0x141>(yb);
    const f32x2v sa2 = {sa, sa}, vv2 = {t.vv, t.vv};
#pragma unroll
    for (int u = 0; u < NV; ++u)
#pragma unroll
        for (int hh = 0; hh < 2; ++hh) {
            f32x2v s2 = {S[4 * u + 2 * hh], S[4 * u + 2 * hh + 1]};
            const f32x2v w2 = {t.w[u][2 * hh], t.w[u][2 * hh + 1]}, kp2 = {t.kp[u][2 * hh], t.kp[u][2 * hh + 1]}, ka2 = {t.ka[u][2 * hh], t.ka[u][2 * hh + 1]};
            f32x2v tt = vv2 * kp2; tt = tt - sa2 * ka2;
            s2 = s2 * w2 + tt;
            S[4 * u + 2 * hh] = s2.x; S[4 * u + 2 * hh + 1] = s2.y;
        }
    if (want_y) {
        f32x2v yacc = {0.f, 0.f};
#pragma unroll
        for (int u = 0; u < NV; ++u)
#pragma unroll
            for (int hh = 0; hh < 2; ++hh) { const f32x2v s2 = {S[4 * u + 2 * hh], S[4 * u + 2 * hh + 1]}, r2 = {t.r[u][2 * hh], t.r[u][2 * hh + 1]}; yacc = s2 * r2 + yacc; }
        ypart = yacc.x + yacc.y;
    }
    return yb;
}
struct ScanSet2 { f32x4 kk, w, ka, kp, r; float vv0, vv1; };
__device__ __forceinline__ void scan_load2(ScanSet2& t, LAS const float* KK, LAS const float* Wd, LAS const float* KKA, LAS const float* KP, LAS const float* Rr, LAS const float* Vv, int o, int ov, bool want_y) {
    t.kk = *(LAS const f32x4*)(KK + o); t.w = *(LAS const f32x4*)(Wd + o); t.ka = *(LAS const f32x4*)(KKA + o); t.kp = *(LAS const f32x4*)(KP + o);
    if (want_y) t.r = *(LAS const f32x4*)(Rr + o);
    t.vv0 = Vv[ov]; t.vv1 = Vv[ov + 4];
}
__device__ __forceinline__ float dpp16(float x) { x += dppf<0xB1>(x); x += dppf<0x4E>(x); x += dppf<0x141>(x); x += dppf<0x140>(x); return x; }
__device__ __forceinline__ void scan_step2(f32x2v* SS, const ScanSet2& t, bool want_y, float& y0, float& y1, float& yr0, float& yr1) {
    f32x2v a2 = SS[0] * (f32x2v){t.kk[0], t.kk[0]};
#pragma unroll
    for (int i = 1; i < 4; ++i) a2 = SS[i] * (f32x2v){t.kk[i], t.kk[i]} + a2;
    float a0 = a2.x, a1 = a2.y, b0 = y0, b1 = y1;
#define SCAN_OPAQUE4() asm("" : "+v"(a0), "+v"(a1), "+v"(b0), "+v"(b1))
    SCAN_OPAQUE4();
    a0 += dppf<0xB1>(a0); a1 += dppf<0xB1>(a1); b0 += dppf<0xB1>(b0); b1 += dppf<0xB1>(b1); SCAN_OPAQUE4();
    a0 += dppf<0x4E>(a0); a1 += dppf<0x4E>(a1); b0 += dppf<0x4E>(b0); b1 += dppf<0x4E>(b1); SCAN_OPAQUE4();
    a0 += dppf<0x141>(a0); a1 += dppf<0x141>(a1); b0 += dppf<0x141>(b0); b1 += dppf<0x141>(b1); SCAN_OPAQUE4();
    a0 += dppf<0x140>(a0); a1 += dppf<0x140>(a1); b0 += dppf<0x140>(b0); b1 += dppf<0x140>(b1); SCAN_OPAQUE4();
#undef SCAN_OPAQUE4
    yr0 = b0; yr1 = b1;
    const f32x2v sa2 = {a0, a1}, vv2 = {t.vv0, t.vv1};
#pragma unroll
    for (int i = 0; i < 4; ++i) {
        f32x2v tt = vv2 * (f32x2v){t.kp[i], t.kp[i]};
        tt = tt - sa2 * (f32x2v){t.ka[i], t.ka[i]};
        SS[i] = SS[i] * (f32x2v){t.w[i], t.w[i]} + tt;
    }
    if (want_y) {
        f32x2v p2 = SS[0] * (f32x2v){t.r[0], t.r[0]};
#pragma unroll
        for (int i = 1; i < 4; ++i) p2 = SS[i] * (f32x2v){t.r[i], t.r[i]} + p2;
        y0 = p2.x; y1 = p2.y;
    }
}
__device__ __forceinline__ void scan_stepLP(f32x2v* SL, f32x2v* SP, const ScanSet2& t) {
    f32x2v aL = SL[0] * (f32x2v){t.kk[0], t.kk[0]}, aP = SP[0] * (f32x2v){t.kk[0], t.kk[0]};
#pragma unroll
    for (int i = 1; i < 4; ++i) { aL = SL[i] * (f32x2v){t.kk[i], t.kk[i]} + aL; aP = SP[i] * (f32x2v){t.kk[i], t.kk[i]} + aP; }
    float a0 = aL.x, a1 = aL.y, b0 = aP.x, b1 = aP.y;
#define SCAN_OPAQUE4() asm("" : "+v"(a0), "+v"(a1), "+v"(b0), "+v"(b1))
    SCAN_OPAQUE4();
    a0 += dppf<0xB1>(a0); a1 += dppf<0xB1>(a1); b0 += dppf<0xB1>(b0); b1 += dppf<0xB1>(b1); SCAN_OPAQUE4();
    a0 += dppf<0x4E>(a0); a1 += dppf<0x4E>(a1); b0 += dppf<0x4E>(b0); b1 += dppf<0x4E>(b1); SCAN_OPAQUE4();
    a0 += dppf<0x141>(a0); a1 += dppf<0x141>(a1); b0 += dppf<0x141>(b0); b1 += dppf<0x141>(b1); SCAN_OPAQUE4();
    a0 += dppf<0x140>(a0); a1 += dppf<0x140>(a1); b0 += dppf<0x140>(b0); b1 += dppf<0x140>(b1); SCAN_OPAQUE4();
#undef SCAN_OPAQUE4
    const f32x2v saL = {a0, a1}, saP = {b0, b1}, vv2 = {t.vv0, t.vv1};
#pragma unroll
    for (int i = 0; i < 4; ++i) {
        f32x2v tt = vv2 * (f32x2v){t.kp[i], t.kp[i]};
        tt = tt - saL * (f32x2v){t.ka[i], t.ka[i]};
        SL[i] = SL[i] * (f32x2v){t.w[i], t.w[i]} + tt;
        SP[i] = SP[i] * (f32x2v){t.w[i], t.w[i]} - saP * (f32x2v){t.ka[i], t.ka[i]};
    }
}
template <int LPR> __device__ void scan_item(const Params& PP, int seq, int h, int dir, int rhalf, int tbeg, int tlen, int flags, const float* sin, float* sout, float* sout2, LAS unsigned char* lds) {
    Params P = PP; P.ws = opaque_ptr(PP.ws);
    constexpr int KPL = 64 / LPR, RPW = 64 / LPR, NV = KPL / 4;
    const int tid = opaque_tid(), lane = tid & 63, wave = __builtin_amdgcn_readfirstlane(tid >> 6), l15 = lane & 15, quad = lane >> 4;
    const int Tseq = seq < 32 ? 2048 : 16384;
    const size_t base = seq < 32 ? (size_t)seq * 2048 : (size_t)M_PROMPT;
    const bf16_t* Prkvg = (const bf16_t*)(P.ws + WS_PRKVG);
    const bf16_t* Pwa = (const bf16_t*)(P.ws + WS_PWA);
    bf16_t* Yd = (bf16_t*)(P.ws + WS_Y) + (size_t)dir * M_TOK * 512;
    float* RKR = (float*)(P.ws + WS_RKR) + (size_t)dir * M_TOK * 8;
    LAS bf16_t* RAW0 = (LAS bf16_t*)lds;
    LAS bf16_t* ZROW = (LAS bf16_t*)(lds + 21760);
    LAS float* Wd = (LAS float*)(lds + 22528);
    LAS float* Aa = Wd + 1024; LAS float* Rr = Aa + 1024; LAS float* KP = Rr + 1024; LAS float* Vv = KP + 1024; LAS float* KK = Vv + 1024; LAS float* KKA = KK + 1024; LAS float* Yc = KKA + 1024;
    if (tid < 160) ((LAS unsigned*)ZROW)[tid] = 0u;
    LAS bf16_t* ALDS = (LAS bf16_t*)(lds + 55296);
    const int j_a = tid / 40, seg_a = (tid % 40) >> 3, c8_a = tid & 7;
    const int idx_b = tid + 512, j_b = idx_b / 40, seg_b = (idx_b % 40) >> 3, c8_b = idx_b & 7;
    const bool has_b = idx_b < 640;
    const int coff_a = seg_a < 3 ? seg_a * 512 + h * 64 + c8_a * 8 : dir * 128 + (seg_a - 3) * 64 + c8_a * 8;
    const int coff_b = seg_b < 3 ? seg_b * 512 + h * 64 + c8_b * 8 : dir * 128 + (seg_b - 3) * 64 + c8_b * 8;
    const int dst_a = (j_a + 1) * 320 + seg_a * 64 + c8_a * 8, dst_b = (j_b + 1) * 320 + seg_b * 64 + c8_b * 8;
    const bf16_t* src_a = (seg_a < 3 ? Prkvg + base * 2048 : Pwa + base * 256) + coff_a; const int ld_a = seg_a < 3 ? 2048 : 256;
    const bf16_t* src_b = (seg_b < 3 ? Prkvg + base * 2048 : Pwa + base * 256) + coff_b; const int ld_b = seg_b < 3 ? 2048 : 256;
    const int ltype = wave >> 2, lch = (wave & 3) * 16 + l15;
    const bf16_t* Wt = (const bf16_t*)(P.ws + WS_LORA) + (size_t)(dir * 2 + ltype) * 512 * 64 + (size_t)(h * 64 + lch) * 64;
    const bf16x8 lb0 = *(const bf16x8*)(Wt + quad * 8), lb1 = *(const bf16x8*)(Wt + 32 + quad * 8);
    const float lbias = ltype == 0 ? P.in[17][dir * 512 + h * 64 + lch] : P.in[19][dir * 512 + h * 64 + lch];
    const int tk = tid >> 5, c2 = tid & 31;
    float mu_r[2], mu_k[2], mu_v[2], k_k[2], k_a[2], r_k[2];
#pragma unroll
    for (int e = 0; e < 2; ++e) { const int ch = h * 64 + 2 * c2 + e;
        mu_r[e] = P.in[15][dir * 1536 + ch]; mu_k[e] = P.in[15][dir * 1536 + 512 + ch]; mu_v[e] = P.in[15][dir * 1536 + 1024 + ch];
        k_k[e] = P.in[21][ch]; k_a[e] = P.in[22][ch]; r_k[e] = P.in[23][ch]; }
    float amu[2][2];
#pragma unroll
    for (int ty = 0; ty < 2; ++ty)
#pragma unroll
        for (int e = 0; e < 2; ++e) amu[ty][e] = P.in[16][dir * 128 + ty * 64 + 2 * c2 + e];
#define SCAN_BUILD_A(RAWN, PREV0) do { \
        LAS const bf16_t* cur_ = (RAWN) + (tk + 1) * 320 + 192 + 2 * c2; \
        LAS const bf16_t* prv_ = (tk > 0 ? (RAWN) + tk * 320 : (PREV0)) + 192 + 2 * c2; \
        _Pragma("unroll") for (int ty = 0; ty < 2; ++ty) { \
            const unsigned xc_ = *(LAS const unsigned*)(cur_ + ty * 64), xp_ = *(LAS const unsigned*)(prv_ + ty * 64); \
            float z0_ = bflo(xc_) + (bflo(xp_) - bflo(xc_)) * amu[ty][0], z1_ = bfhi(xc_) + (bfhi(xp_) - bfhi(xc_)) * amu[ty][1]; \
            if (ty == 0) { z0_ = tanhf_(z0_); z1_ = tanhf_(z1_); } \
            *(LAS unsigned*)(ALDS + ty * 1152 + tk * 72 + 2 * c2) = pk2(z0_, z1_); } } while (0)
    static_assert(LPR == 16, "two rows per lane, 16 lanes per row");
    const int srow = wave * 8 + (lane >> 4), sq = lane & 15;
    f32x2v SS[4];
#pragma unroll
    for (int i = 0; i < 4; ++i) { const int kidx = sq * 4 + i;
        SS[i].x = (flags & 1) ? (kidx == srow ? 1.f : 0.f) : (sin ? sin[srow * 64 + kidx] : 0.f);
        SS[i].y = (flags & 1) ? (kidx == srow + 4 ? 1.f : 0.f) : (sin ? sin[(srow + 4) * 64 + kidx] : 0.f); }
    const bool lp = (flags & 16) != 0;
    f32x2v SP[4];
#pragma unroll
    for (int i = 0; i < 4; ++i) { const int kidx = sq * 4 + i; SP[i].x = kidx == srow ? 1.f : 0.f; SP[i].y = kidx == srow + 4 ? 1.f : 0.f; }
    const int nch = tlen / 16;
    const int tstep = dir == 0 ? 16 : -16;
    const int tfirst = dir == 0 ? tbeg : tbeg + tlen - 16;
    const int tprev = dir == 0 ? tbeg - 1 : tbeg + tlen;
    const bool has_prev = tprev >= 0 && tprev < Tseq;
    if (has_prev && tid < 40) {
        const int sg = tid >> 3, c8 = tid & 7;
        const bf16_t* sp = sg < 3 ? Prkvg + (base + tprev) * 2048 + sg * 512 + h * 64 + c8 * 8 : Pwa + (base + tprev) * 256 + dir * 128 + (sg - 3) * 64 + c8 * 8;
        *(LAS u32x4*)(RAW0 + 5440 + 16 * 320 + sg * 64 + c8 * 8) = *(const u32x4*)sp;
    }
    const bool in_on = (flags & 2) == 0, wr_y = (flags & 4) != 0, wr_rk = (flags & 8) != 0;
#define SCAN_TOK(t0, j) (dir == 0 ? (t0) + (j) : (t0) + 15 - (j))
    u32x4 pre_a, pre_b = (u32x4){0u, 0u, 0u, 0u};
    {
        pre_a = *(const u32x4*)(src_a + (size_t)SCAN_TOK(tfirst, j_a) * ld_a);
        if (has_b) pre_b = *(const u32x4*)(src_b + (size_t)SCAN_TOK(tfirst, j_b) * ld_b);
        *(LAS u32x4*)(RAW0 + dst_a) = pre_a;
        if (has_b) *(LAS u32x4*)(RAW0 + dst_b) = pre_b;
        if (nch > 1) {
            pre_a = *(const u32x4*)(src_a + (size_t)SCAN_TOK(tfirst + tstep, j_a) * ld_a);
            if (has_b) pre_b = *(const u32x4*)(src_b + (size_t)SCAN_TOK(tfirst + tstep, j_b) * ld_b);
        }
    }
    __syncthreads();
    SCAN_BUILD_A(RAW0, (has_prev ? RAW0 + 5440 + 16 * 320 : ZROW));
    lds_barrier();
    u32x4 ypend = (u32x4){0u, 0u, 0u, 0u}; bf16_t* ypend_ptr = nullptr;
    for (int c = 0; c < nch; ++c) {
        LAS bf16_t* RAW = RAW0 + (c & 1) * 5440;
        LAS bf16_t* RAWp = RAW0 + ((c & 1) ^ 1) * 5440;
        const int t0 = tfirst + c * tstep;
        {
            bf16x8 af[2];
#pragma unroll
            for (int ks = 0; ks < 2; ++ks) af[ks] = *(LAS const bf16x8*)(ALDS + ltype * 1152 + l15 * 72 + ks * 32 + quad * 8);
            f32x4 d = mfma16(af[0], lb0, (f32x4){0.f, 0.f, 0.f, 0.f});
            d = mfma16(af[1], lb1, d);
            LAS float* dstp = (ltype == 0 ? Wd : Aa) + lch;
#pragma unroll
            for (int jj = 0; jj < 4; ++jj) { const float sg = sigmoidf_(lbias + d[jj]); dstp[(quad * 4 + jj) * 64] = ltype == 0 ? __expf(-0.6065306597126334f * sg) : sg; }
        }
        {
            LAS const bf16_t* cur = RAW + (tk + 1) * 320 + 2 * c2;
            LAS const bf16_t* prv = (tk > 0 ? RAW + tk * 320 : ((c > 0 || has_prev) ? RAWp + 16 * 320 : ZROW)) + 2 * c2;
            const unsigned rc = *(LAS const unsigned*)(cur), rp = *(LAS const unsigned*)(prv);
            const unsigned kc = *(LAS const unsigned*)(cur + 64), kq = *(LAS const unsigned*)(prv + 64);
            const unsigned vc = *(LAS const unsigned*)(cur + 128), vp = *(LAS const unsigned*)(prv + 128);
            const int o = tk * 64 + 2 * c2;
            Rr[o] = bflo(rc) + (bflo(rp) - bflo(rc)) * mu_r[0]; Rr[o + 1] = bfhi(rc) + (bfhi(rp) - bfhi(rc)) * mu_r[1];
            KP[o] = bflo(kc) + (bflo(kq) - bflo(kc)) * mu_k[0]; KP[o + 1] = bfhi(kc) + (bfhi(kq) - bfhi(kc)) * mu_k[1];
            Vv[o] = in_on ? bflo(vc) + (bflo(vp) - bflo(vc)) * mu_v[0] : 0.f; Vv[o + 1] = in_on ? bfhi(vc) + (bfhi(vp) - bfhi(vc)) * mu_v[1] : 0.f;
        }
        lds_barrier();
        float rk_keep;
        {
            const int o = tk * 64 + 2 * c2;
            const float kz0 = KP[o], kz1 = KP[o + 1], a0 = Aa[o], a1 = Aa[o + 1];
            const float q0 = kz0 * k_k[0], q1 = kz1 * k_k[1];
            const float kp0 = kz0 * (1.0f + (a0 - 1.0f) * k_a[0]), kp1 = kz1 * (1.0f + (a1 - 1.0f) * k_a[1]);
            const float ss = reduce32(q0 * q0 + q1 * q1);
            const float rk = reduce32(Rr[o] * kp0 * r_k[0] + Rr[o + 1] * kp1 * r_k[1]);
            const float inv = __builtin_amdgcn_rsqf(fmaxf(ss, 1e-24f));
            const float kk0 = q0 * inv, kk1 = q1 * inv;
            KK[o] = kk0; KK[o + 1] = kk1; KKA[o] = kk0 * a0; KKA[o + 1] = kk1 * a1;
            KP[o] = kp0; KP[o + 1] = kp1;
            rk_keep = rk;
        }
        if (c + 1 < nch) {
            *(LAS u32x4*)(RAWp + dst_a) = pre_a;
            if (has_b) *(LAS u32x4*)(RAWp + dst_b) = pre_b;
            if (c + 2 < nch) {
                pre_a = *(const u32x4*)(src_a + (size_t)SCAN_TOK(t0 + 2 * tstep, j_a) * ld_a);
                if (has_b) pre_b = *(const u32x4*)(src_b + (size_t)SCAN_TOK(t0 + 2 * tstep, j_b) * ld_b);
            }
        }
        if (wr_rk && c2 == 0) RKR[(base + SCAN_TOK(t0, tk)) * 8 + h] = rk_keep;
        if (ypend_ptr) *(u32x4*)ypend_ptr = ypend;
        lds_barrier();
        if (c + 1 < nch) SCAN_BUILD_A(RAWp, RAW + 16 * 320);
        if (lp) {
            ScanSet2 sa_, sb_;
            scan_load2(sa_, KK, Wd, KKA, KP, Rr, Vv, sq * 4, srow, false);
#pragma unroll 1
            for (int jo = 0; jo < 16; jo += 2) {
                scan_load2(sb_, KK, Wd, KKA, KP, Rr, Vv, (jo + 1) * 64 + sq * 4, (jo + 1) * 64 + srow, false);
                scan_stepLP(SS, SP, sa_);
                if (jo + 2 < 16) scan_load2(sa_, KK, Wd, KKA, KP, Rr, Vv, (jo + 2) * 64 + sq * 4, (jo + 2) * 64 + srow, false);
                scan_stepLP(SS, SP, sb_);
            }
        } else {
            ScanSet2 sa_, sb_;
            scan_load2(sa_, KK, Wd, KKA, KP, Rr, Vv, sq * 4, srow, wr_y);
            float yk = 0.f, zk = 0.f, y0 = 0.f, y1 = 0.f, yr0, yr1;
#pragma unroll 1
            for (int jo = 0; jo < 16; jo += 2) {
                scan_load2(sb_, KK, Wd, KKA, KP, Rr, Vv, (jo + 1) * 64 + sq * 4, (jo + 1) * 64 + srow, wr_y);
                scan_step2(SS, sa_, wr_y, y0, y1, yr0, yr1);
                if (jo > 0 && sq == jo - 1) { yk = yr0; zk = yr1; }
                if (jo + 2 < 16) scan_load2(sa_, KK, Wd, KKA, KP, Rr, Vv, (jo + 2) * 64 + sq * 4, (jo + 2) * 64 + srow, wr_y);
                scan_step2(SS, sb_, wr_y, y0, y1, yr0, yr1);
                if (sq == jo) { yk = yr0; zk = yr1; }
            }
            yr0 = dpp16(y0); yr1 = dpp16(y1);
            if (sq == 15) { yk = yr0; zk = yr1; }
            Yc[sq * 64 + srow] = yk; Yc[sq * 64 + srow + 4] = zk;
        }
        lds_barrier();
        {
            const bool wr = wr_y && tid < 128;
            if (wr) {
                const int tq = tid >> 3, c8 = tid & 7; float f[8];
                const f32x4 a = *(LAS const f32x4*)(Yc + tq * 64 + c8 * 8), b = *(LAS const f32x4*)(Yc + tq * 64 + c8 * 8 + 4);
                f[0] = a[0]; f[1] = a[1]; f[2] = a[2]; f[3] = a[3]; f[4] = b[0]; f[5] = b[1]; f[6] = b[2]; f[7] = b[3];
                ypend = pack8(f); ypend_ptr = Yd + (base + SCAN_TOK(t0, tq)) * 512 + h * 64 + c8 * 8;
            }
        }
    }
    if (ypend_ptr) *(u32x4*)ypend_ptr = ypend;
    if (sout) { *(f32x4*)(sout + srow * 64 + sq * 4) = (f32x4){SS[0].x, SS[1].x, SS[2].x, SS[3].x}; *(f32x4*)(sout + (srow + 4) * 64 + sq * 4) = (f32x4){SS[0].y, SS[1].y, SS[2].y, SS[3].y}; }
    if (lp && sout2) { *(f32x4*)(sout2 + srow * 64 + sq * 4) = (f32x4){SP[0].x, SP[1].x, SP[2].x, SP[3].x}; *(f32x4*)(sout2 + (srow + 4) * 64 + sq * 4) = (f32x4){SP[0].y, SP[1].y, SP[2].y, SP[3].y}; }
#undef SCAN_TOK
#undef SCAN_BUILD_A
    __syncthreads();
}

__device__ void scan_carry(const Params& PP, int hd, LAS unsigned char* lds) {
    Params P = PP; P.ws = opaque_ptr(PP.ws);
    const int tid = opaque_tid();
    const float* Lm = (const float*)(P.ws + WS_STL) + (size_t)hd * NSEG * 4096;
    const float* Pm = (const float*)(P.ws + WS_STP) + (size_t)hd * NSEG * 4096;
    float* St = (float*)(P.ws + WS_STS) + (size_t)hd * NSEG * 4096;
    LAS float* Sc = (LAS float*)lds;
    LAS float* Pc = Sc + 4096;
    const int v = tid >> 3, k0 = (tid & 7) * 8;
    for (int i = 0; i < 8; ++i) { const float x = Lm[v * 64 + k0 + i]; Sc[v * 64 + k0 + i] = x; St[4096 + v * 64 + k0 + i] = x; }
    for (int sgm = 1; sgm + 1 < NSEG; ++sgm) {
        for (int i = 0; i < 8; ++i) Pc[v * 64 + k0 + i] = Pm[(size_t)sgm * 4096 + v * 64 + k0 + i];
        __syncthreads();
        float o[8];
        for (int i = 0; i < 8; ++i) o[i] = Lm[(size_t)sgm * 4096 + v * 64 + k0 + i];
        for (int j = 0; j < 64; ++j) { const float sv = Sc[v * 64 + j];
#pragma unroll
            for (int i = 0; i < 8; ++i) o[i] += sv * Pc[j * 64 + k0 + i]; }
        __syncthreads();
        for (int i = 0; i < 8; ++i) { Sc[v * 64 + k0 + i] = o[i]; St[(size_t)(sgm + 1) * 4096 + v * 64 + k0 + i] = o[i]; }
    }
    __syncthreads();
}

__device__ void rwkv_finalize(const Params& PP) {
    Params P = PP; P.ws = opaque_ptr(PP.ws);
    const int tid_ = opaque_tid(), lane = tid_ & 63, wave = __builtin_amdgcn_readfirstlane(tid_ >> 6);
    const bf16_t* Prkvg = (const bf16_t*)(P.ws + WS_PRKVG);
    const bf16_t* Y0 = (const bf16_t*)(P.ws + WS_Y);
    const bf16_t* Y1 = Y0 + (size_t)M_TOK * 512;
    const float* RKR0 = (const float*)(P.ws + WS_RKR);
    const float* RKR1 = RKR0 + (size_t)M_TOK * 8;
    bf16_t* MO = (bf16_t*)(P.ws + WS_XN);
    const int col = lane * 8, hh = lane >> 3;
    float gw[8], gb[8], muf[8], mub[8];
#pragma unroll
    for (int i = 0; i < 8; ++i) { gw[i] = P.in[24][col + i]; gb[i] = P.in[25][col + i]; muf[i] = P.in[15][1024 + col + i]; mub[i] = P.in[15][1536 + 1024 + col + i]; }
    for (int row = blockIdx.x * 8 + wave; row < M_TOK; row += gridDim.x * 8) {
        const int t = row < M_PROMPT ? (row & 2047) : row - M_PROMPT, T = row < M_PROMPT ? 2048 : 16384;
        float yf[8], yb[8], vc[8], vp[8], vn[8], gg[8];
        unpack8(*(const u32x4*)(Y0 + (size_t)row * 512 + col), yf); unpack8(*(const u32x4*)(Y1 + (size_t)row * 512 + col), yb);
        unpack8(*(const u32x4*)(Prkvg + (size_t)row * 2048 + 1024 + col), vc);
        unpack8(*(const u32x4*)(Prkvg + (size_t)row * 2048 + 1536 + col), gg);
        if (t > 0) unpack8(*(const u32x4*)(Prkvg + (size_t)(row - 1) * 2048 + 1024 + col), vp); else { for (int i = 0; i < 8; ++i) vp[i] = 0.f; }
        if (t < T - 1) unpack8(*(const u32x4*)(Prkvg + (size_t)(row + 1) * 2048 + 1024 + col), vn); else { for (int i = 0; i < 8; ++i) vn[i] = 0.f; }
        const float rf = RKR0[(size_t)row * 8 + hh], rb = RKR1[(size_t)row * 8 + hh];
        float s = 0.f;
#pragma unroll
        for (int i = 0; i < 8; ++i) { yf[i] += yb[i]; s += yf[i]; }
        const float mean = reduce8(s) * (1.0f / 64.0f);
        float q = 0.f;
#pragma unroll
        for (int i = 0; i < 8; ++i) { yf[i] -= mean; q += yf[i] * yf[i]; }
        const float rstd = rsqrtf(reduce8(q) * (1.0f / 64.0f) + 64e-5f);
        float o[8];
#pragma unroll
        for (int i = 0; i < 8; ++i) {
            const float vzf = vc[i] + (vp[i] - vc[i]) * muf[i], vzb = vc[i] + (vn[i] - vc[i]) * mub[i];
            o[i] = (yf[i] * rstd * gw[i] + gb[i] + rf * vzf + rb * vzb) * sigmoidf_(gg[i]);
        }
        *(u32x4*)(MO + (size_t)row * 1024 + 512 + col) = pack8(o);
    }
}

template <int NQ> __device__ __forceinline__ void attn_groups(const bf16_t* QKV, size_t base, int h, int T0, int L, int dsh, int res, int i0, int bi,
        int lane, int l15, int quad, int r4, int c4, LAS unsigned char* VST, LAS const f32x2v* RKT, int tb, const float (&bx)[11][4], const float (&gqk)[16], LAS float* OACC, LAS float* LS) {
    constexpr int NT = NQ == 2 ? 10 : 9;
    bf16x8 qf[NQ][2]; float mq[NQ]; int qtok[NQ];
#pragma unroll
    for (int q = 0; q < NQ; ++q) {
        qtok[q] = ((i0 + 16 * q + l15) << dsh) + res;
        const bf16_t* qp = QKV + (base + qtok[q]) * 3072 + h * 64 + quad * 8;
        float f[16]; unpack8(*(const u32x4*)qp, f); unpack8(*(const u32x4*)(qp + 32), f + 8);
        float ss = 0.f;
#pragma unroll
        for (int i = 0; i < 16; ++i) ss += f[i] * f[i];
        ss += __shfl_xor(ss, 16); ss += __shfl_xor(ss, 32);
        const float rq = rsqrtf(ss * (1.0f / 64.0f) + NORM_EPS) * 0.125f;
#pragma unroll
        for (int i = 0; i < 16; ++i) f[i] = f[i] * rq * gqk[i];
        const u32x4 w0 = pack8(f), w1 = pack8(f + 8);
        qf[q][0] = __builtin_bit_cast(bf16x8, w0); qf[q][1] = __builtin_bit_cast(bf16x8, w1);
        float fr[16]; unpack8(w0, fr); unpack8(w1, fr + 8);
        float n2 = 0.f;
#pragma unroll
        for (int i = 0; i < 16; ++i) n2 += fr[i] * fr[i];
        n2 += __shfl_xor(n2, 16); n2 += __shfl_xor(n2, 32);
        mq[q] = 8.1f * 1.4426950408889634f * sqrtf(n2);
    }
    f32x4 oacc[NQ][4];
    float lsum[NQ];
#pragma unroll
    for (int q = 0; q < NQ; ++q) { lsum[q] = 0.f;
#pragma unroll
        for (int et = 0; et < 4; ++et) oacc[q][et] = (f32x4){0.f, 0.f, 0.f, 0.f}; }
    const int ebase = (i0 - 64 + quad * 4) * (1 << dsh) + res - tb;
    const float dmul = (float)(1 << dsh);
    bf16x8 kfb[2][2][2]; u32x4 vb[2][4];
    const int rowv = lane >> 1, half = lane & 1;
#define ATT_ISSUE(KP, BUF) do { \
        _Pragma("unroll") for (int tt_ = 0; tt_ < 2; ++tt_) { \
            int kidx_ = i0 - 64 + 16 * (2 * (KP) + tt_) + l15; kidx_ = kidx_ < 0 ? 0 : (kidx_ > L - 1 ? L - 1 : kidx_); \
            const bf16_t* kptr_ = QKV + (base + ((size_t)kidx_ << dsh) + res) * 3072 + 1024 + h * 64 + quad * 8; \
            kfb[BUF][tt_][0] = *(const bf16x8*)kptr_; kfb[BUF][tt_][1] = *(const bf16x8*)(kptr_ + 32); } \
        int vidx_ = i0 - 64 + 32 * (KP) + rowv; vidx_ = vidx_ < 0 ? 0 : (vidx_ > L - 1 ? L - 1 : vidx_); \
        const bf16_t* vptr_ = QKV + (base + ((size_t)vidx_ << dsh) + res) * 3072 + 2048 + h * 64 + half * 32; \
        vb[BUF][0] = *(const u32x4*)vptr_; vb[BUF][1] = *(const u32x4*)(vptr_ + 8); vb[BUF][2] = *(const u32x4*)(vptr_ + 16); vb[BUF][3] = *(const u32x4*)(vptr_ + 24); } while (0)
    ATT_ISSUE(0, 0);
#pragma unroll
    for (int kp = 0; kp < 5; ++kp) {
        f32x4 s[NQ][2];
        if (kp + 1 < 5) ATT_ISSUE(kp + 1, (kp + 1) & 1);
#pragma unroll
        for (int tt = 0; tt < 2; ++tt) {
            const int kt = 2 * kp + tt;
#pragma unroll
            for (int q = 0; q < NQ; ++q) s[q][tt] = (f32x4){0.f, 0.f, 0.f, 0.f};
            if (kt < NT) {
                f32x2v e[4];
#pragma unroll
                for (int j = 0; j < 4; ++j) e[j] = RKT[((16 * kt + j) << dsh) + ebase];
#pragma unroll
                for (int q = 0; q < NQ; ++q) {
                    f32x4 sc = mfma16(kfb[kp & 1][tt][0], qf[q][0], (f32x4){0.f, 0.f, 0.f, 0.f});
                    sc = mfma16(kfb[kp & 1][tt][1], qf[q][1], sc);
#pragma unroll
                    for (int j = 0; j < 4; ++j) {
                        const float p = __builtin_amdgcn_exp2f(sc[j] * e[j].x + (e[j].y + (bx[kt + 1 - q][j] * dmul - mq[q])));
                        lsum[q] += p; s[q][tt][j] = p;
                    }
                }
            }
        }
        bf16x8 pf[NQ];
#pragma unroll
        for (int q = 0; q < NQ; ++q) { u32x4 w; w.x = pk2(s[q][0][0], s[q][0][1]); w.y = pk2(s[q][0][2], s[q][0][3]); w.z = pk2(s[q][1][0], s[q][1][1]); w.w = pk2(s[q][1][2], s[q][1][3]); pf[q] = __builtin_bit_cast(bf16x8, w); }
        {
            LAS u32x4* vd = (LAS u32x4*)(VST + rowv * 144 + half * 64);
            vd[0] = vb[kp & 1][0]; vd[1] = vb[kp & 1][1]; vd[2] = vb[kp & 1][2]; vd[3] = vb[kp & 1][3];
        }
        asm volatile("s_waitcnt lgkmcnt(0)" ::: "memory"); __builtin_amdgcn_fence(__ATOMIC_RELEASE, "wavefront"); __builtin_amdgcn_wave_barrier(); __builtin_amdgcn_fence(__ATOMIC_ACQUIRE, "wavefront"); asm volatile("s_waitcnt lgkmcnt(0)" ::: "memory");
#pragma unroll
        for (int et = 0; et < 4; ++et) {
            LAS const unsigned char* ap = VST + (quad * 4 + r4) * 144 + (et * 16 + 4 * c4) * 2;
            const s16x4 lo = tr_read(ap), hi = tr_read(ap + 16 * 144);
            const bf16x8 a = {lo[0], lo[1], lo[2], lo[3], hi[0], hi[1], hi[2], hi[3]};
#pragma unroll
            for (int q = 0; q < NQ; ++q) oacc[q][et] = mfma16(a, pf[q], oacc[q][et]);
        }
        asm volatile("s_waitcnt lgkmcnt(0)" ::: "memory"); __builtin_amdgcn_fence(__ATOMIC_RELEASE, "wavefront"); __builtin_amdgcn_wave_barrier(); __builtin_amdgcn_fence(__ATOMIC_ACQUIRE, "wavefront"); asm volatile("s_waitcnt lgkmcnt(0)" ::: "memory");
    }
#undef ATT_ISSUE
#pragma unroll
    for (int q = 0; q < NQ; ++q) {
        float l = lsum[q]; l += __shfl_xor(l, 16); l += __shfl_xor(l, 32);
        const int qloc = qtok[q] - T0;
#pragma unroll
        for (int et = 0; et < 4; ++et) {
            LAS f32x4* dst = (LAS f32x4*)(OACC + qloc * 68 + et * 16 + quad * 4);
            if (bi == 0) *dst = oacc[q][et]; else *dst = *dst + oacc[q][et];
        }
        if (quad == 0) { if (bi == 0) LS[qloc] = l; else LS[qloc] += l; }
    }
}

__device__ void attn_item(const Params& PP, int seq, int h, int tile, LAS unsigned char* lds) {
    Params P = PP; P.ws = opaque_ptr(PP.ws);
    const int tid = opaque_tid(), lane = tid & 63, wave = __builtin_amdgcn_readfirstlane(tid >> 6), l15 = lane & 15, quad = lane >> 4;
    const int T = seq < 32 ? 2048 : 16384;
    const size_t base = seq < 32 ? (size_t)seq * 2048 : (size_t)M_PROMPT;
    const int T0 = tile * 256;
    const bf16_t* QKV = (const bf16_t*)(P.ws + WS_BIG);
    bf16_t* MO = (bf16_t*)(P.ws + WS_XN);
    LAS float* OACC = (LAS float*)lds;
    LAS float* LS = (LAS float*)(lds + 256 * 272);
    LAS unsigned char* VST = lds + 256 * 272 + 1024 + wave * (32 * 144);
    const float slope = exp2f(-0.5f * (float)(h + 1));
    float gqk[16];
#pragma unroll
    for (int i = 0; i < 16; ++i) { const int e = (i >> 3) * 32 + quad * 8 + (i & 7); gqk[i] = P.in[28][e] * P.in[29][e]; }
    const int r4 = l15 >> 2, c4 = l15 & 3;
    float bx[11][4];
#pragma unroll
    for (int kt = -1; kt < 10; ++kt)
#pragma unroll
        for (int j = 0; j < 4; ++j) { int dist = 16 * kt - 64 + quad * 4 + j - l15; dist = dist < 0 ? -dist : dist;
            bx[kt + 1][j] = dist <= 64 ? -slope * 1.4426950408889634f * (float)dist : -1e30f; }
    LAS f32x2v* RKT = (LAS f32x2v*)(lds + 107520);
    const int tb = T0 - 1024;
    const float* ksq_h = (const float*)(P.ws + WS_KSQ) + (size_t)h * M_TOK;
    for (int idx = tid; idx < 2304; idx += 512) {
        const int tok = tb + idx;
        f32x2v ent = {0.f, -1e30f};
        if (tok >= 0 && tok < T) { ent.x = rsqrtf(ksq_h[base + tok] * (1.0f / 64.0f) + NORM_EPS) * 1.4426950408889634f; ent.y = 0.f; }
        RKT[idx] = ent;
    }
    __syncthreads();
    for (int bi = 0; bi < 3; ++bi) {
        const int dsh = 2 * bi, L = T >> dsh;
        if (bi < 2) {
            const int res = bi == 0 ? 0 : (wave & 3), i0 = (T0 >> dsh) + (bi == 0 ? 32 * wave : 32 * (wave >> 2));
            attn_groups<2>(QKV, base, h, T0, L, dsh, res, i0, bi, lane, l15, quad, r4, c4, VST, RKT, tb, bx, gqk, OACC, LS);
        } else {
            for (int gg = 0; gg < 2; ++gg)
                attn_groups<1>(QKV, base, h, T0, L, dsh, wave * 2 + gg, T0 >> dsh, bi, lane, l15, quad, r4, c4, VST, RKT, tb, bx, gqk, OACC, LS);
        }
        __syncthreads();
    }
    {
        const int q = tid >> 1, half = tid & 1;
        const float inv = 1.0f / LS[q];
        bf16_t* op = MO + (base + T0 + q) * 1024 + h * 64 + half * 32;
#pragma unroll
        for (int i = 0; i < 4; ++i) {
            const f32x4 a = *(LAS const f32x4*)(OACC + q * 68 + half * 32 + i * 8), b = *(LAS const f32x4*)(OACC + q * 68 + half * 32 + i * 8 + 4);
            u32x4 w; w.x = pk2(a[0] * inv, a[1] * inv); w.y = pk2(a[2] * inv, a[3] * inv); w.z = pk2(b[0] * inv, b[1] * inv); w.w = pk2(b[2] * inv, b[3] * inv);
            *(u32x4*)(op + i * 8) = w;
        }
    }
    __syncthreads();
}

enum { K_P0 = 0, K_SWIGLU, K_RESID, K_NORM, K_GEMM_P, K_MIXA, K_FINAL, K_GEMM_QKV, K_ATTN, K_CARRY, K_MIXB };
constexpr int N_PHASES = 19;

__global__ void __launch_bounds__(512, 2) mega(Params P) {
    extern __shared__ __attribute__((aligned(16))) unsigned char lds_raw[];
    LAS unsigned char* lds = (LAS unsigned char*)lds_raw;
    cg::grid_group grid = cg::this_grid();
    for (int ph = 0; ph < N_PHASES; ++ph) {
#ifdef PROBE_MASK
        if (blockIdx.x == 0 && threadIdx.x == 0) ((unsigned long long*)(P.ws + WS_TS))[ph] = __builtin_amdgcn_s_memrealtime();
#endif
        unsigned char* ws = P.ws; float* X = P.out; int G = gridDim.x, bid = blockIdx.x;
        asm volatile("" : "+s"(ws), "+s"(X), "+s"(G), "+s"(bid));
        bf16_t* XN = (bf16_t*)(ws + WS_XN);
        bf16_t* Hb = (bf16_t*)(ws + WS_BIG);
        int kind, layer = 0, sub = 0;
        if (ph == 0) kind = K_P0;
        else {
            layer = ph <= 10 ? 0 : 1; const int r = ph <= 10 ? ph - 1 : ph - 11;
            const unsigned long long kc = layer == 0 ? 0x2126A95421ull : 0x32128721ull;
            const unsigned long long sc = layer == 0 ? 0x1120000000ull : 0x21120000ull;
            kind = (int)((kc >> (4 * r)) & 15ull); sub = (int)((sc >> (4 * r)) & 15ull);
        }
        if (kind == K_P0) {
#ifndef SKIP_P0
            LAS float* tile = (LAS float*)lds;
            int rot = 0;
            for (int job = 0; job < 16; ++job) {
                const float* src; size_t doff; int K, N;
                if (job < 4) { src = ((job & 1) ? P.in[7] : P.in[3]) + (size_t)(job >> 1) * 1024 * 5632; doff = WS_WFI + (size_t)job * SZ_WFI; K = 1024; N = 5632; }
                else if (job < 8) { src = ((job & 1) ? P.in[8] : P.in[4]) + (size_t)((job - 4) >> 1) * 2816 * 1024; doff = WS_WFO + (size_t)(job - 4) * SZ_WFO; K = 2816; N = 1024; }
                else if (job == 8) { src = P.in[10]; doff = WS_WABI; K = 1024; N = 3328; }
                else if (job == 9) { src = P.in[11]; doff = WS_WABO; K = 1024; N = 1024; }
                else if (job == 10) { src = P.in[26]; doff = WS_WATI; K = 1024; N = 3072; }
                else if (job == 11) { src = P.in[27]; doff = WS_WATO; K = 1024; N = 1024; }
                else { const int d = (job - 12) >> 1, ty = (job - 12) & 1; src = (ty ? P.in[20] : P.in[18]) + (size_t)d * 64 * 512; doff = WS_LORA + (size_t)(d * 2 + ty) * 512 * 64 * 2; K = 64; N = 512; }
                if (job < 4) convert_T<1>(src, (bf16_t*)(ws + doff), K, N, tile, rot); else convert_T<0>(src, (bf16_t*)(ws + doff), K, N, tile, rot);
                rot += (K / 64) * (N / 64);
            }
            {
                bf16_t* dst = (bf16_t*)(ws + WS_SGUW);
                for (int i = bid * 512 + opaque_tid(); i < 4 * 128 * 128 / 4; i += G * 512) {
                    const f32x4 v = *(const f32x4*)(P.in[13] + (size_t)i * 4);
                    u32x2 w; w.x = pk2(v[0], v[1]); w.y = pk2(v[2], v[3]); *(u32x2*)(dst + (size_t)i * 4) = w;
                }
            }
            norm_rows(P.in[0], P.in[1], M_PROMPT, nullptr, nullptr, nullptr, P.in[2], XN);
            if (bid == 0 && opaque_tid() == 0) *(unsigned*)(ws + WS_TS + 2048) = 0u;
#endif
        } else if (kind == K_SWIGLU) {
            if (sub == 0) { float* za = (float*)(ws + WS_RSA); for (int i = bid * 512 + opaque_tid(); i < M_TOK; i += G * 512) za[i] = 0.f; }
            if (sub == 0 && layer == 1) { f32x4* zk = (f32x4*)(ws + WS_KSQ); for (int i = bid * 512 + opaque_tid(); i < 16 * M_TOK / 4; i += G * 512) zk[i] = (f32x4){0.f, 0.f, 0.f, 0.f}; }
            pg8::Gemm g{sub == 0 ? XN : (const bf16_t*)(ws + WS_Y), (const bf16_t*)(ws + WS_WFI + (size_t)(layer * 2 + sub) * SZ_WFI), M_TOK, 5632, 1024};
            pg8::StaticOrder S; S.init(M_TOK, 5632, G, bid);
            if (sub == 1 && layer == 0) { float* zc = (float*)(ws + WS_RSC); for (int i = bid * 512 + opaque_tid(); i < 2 * M_TOK; i += G * 512) zc[i] = 0.f; }
            EpiSwiglu E{Hb, sub == 0 ? (layer == 0 ? nullptr : (const float*)(ws + WS_RSC)) : (const float*)(ws + WS_RSB), (sub == 0 && layer == 1) ? (const float*)(ws + WS_RSD) : nullptr};
#ifndef SKIP_G1
            pg8::gemm_phase<EpiSwiglu, pg8::StaticOrder, GEMM_ALIGN, GEMM_SP2>(lds, g, S, E);
#endif
        } else if (kind == K_RESID) {
            const bf16_t* A; const bf16_t* Bt; int K; float scale; bf16_t* xg = nullptr; const float* gn = nullptr; float* rss = nullptr;
            const float* gaux = nullptr; float* rss2 = nullptr; const float* bss = nullptr;
            if (sub < 2) { A = Hb; Bt = (const bf16_t*)(ws + WS_WFO + (size_t)(layer * 2 + sub) * SZ_WFO); K = 2816; scale = 0.5f;
                if (sub == 0) { xg = XN; gn = P.in[5] + layer * DM; rss = (float*)(ws + WS_RSA); if (layer == 1) { bss = (const float*)(ws + WS_RSC); gaux = P.in[9]; } }
                else if (layer == 0) { xg = XN; gn = P.in[2] + DM; gaux = P.in[9]; rss = (float*)(ws + WS_RSC); rss2 = (float*)(ws + WS_RSD); } }
            else { A = XN; Bt = (const bf16_t*)(ws + (layer == 0 ? WS_WABO : WS_WATO)); K = 1024; scale = 1.0f; xg = (bf16_t*)(ws + WS_Y); gn = P.in[6] + layer * DM; rss = (float*)(ws + WS_RSB); }
            pg8::Gemm g{A, Bt, M_TOK, 1024, K};
            pg8::StaticOrder S; S.init(M_TOK, 1024, G, bid);
            const bool first = (layer == 0 && sub == 0);
            EpiResid E{X, scale, xg, gn, rss, first ? P.in[0] : nullptr, first ? P.in[1] : nullptr, gaux, rss2, bss};
#ifndef SKIP_G2
            pg8::gemm_phase<EpiResid, pg8::StaticOrder, GEMM_ALIGN, GEMM_SP2>(lds, g, S, E);
#endif
        } else if (kind == K_NORM) {
            norm_rows(X, X, M_TOK, nullptr, P.in[9] + DM, X, nullptr, nullptr);
        } else if (kind == K_GEMM_P || kind == K_GEMM_QKV) {
            const bool isP = kind == K_GEMM_P; const int N = isP ? 3328 : 3072;
            pg8::Gemm g{XN, (const bf16_t*)(ws + (isP ? WS_WABI : WS_WATI)), M_TOK, N, 1024};
            pg8::StaticOrder S; S.init(M_TOK, N, G, bid);
            { float* zb = (float*)(ws + WS_RSB); for (int i = bid * 512 + opaque_tid(); i < M_TOK; i += G * 512) zb[i] = 0.f; }
            EpiSplit E; const float* rsa = (const float*)(ws + WS_RSA);
            if (isP) E = EpiSplit{(bf16_t*)(ws + WS_PUV), 1024, 4, (bf16_t*)(ws + WS_PRKVG), 2048, 12, (bf16_t*)(ws + WS_PWA), 256, rsa, nullptr};
            else E = EpiSplit{(bf16_t*)(ws + WS_BIG), 3072, 12, (bf16_t*)(ws + WS_BIG), 3072, 12, (bf16_t*)(ws + WS_BIG), 3072, rsa, (float*)(ws + WS_KSQ)};
#ifndef SKIP_G3
            pg8::gemm_phase<EpiSplit, pg8::StaticOrder, GEMM_ALIGN, GEMM_SP2>(lds, g, S, E);
#endif
        } else if (kind == K_MIXA) {
            constexpr int NLONG = 16 + 16 * (NSEG - 2);
            unsigned* qhead = (unsigned*)(ws + WS_TS + 2048);
            LAS int* qslot = (LAS int*)(lds + LDS_BYTES - 16);
            for (;;) {
                if (opaque_tid() == 0) *qslot = (int)__hip_atomic_fetch_add(qhead, 1u, __ATOMIC_RELAXED, __HIP_MEMORY_SCOPE_AGENT);
                __syncthreads();
                const int li = __builtin_amdgcn_readfirstlane(*qslot);
                __syncthreads();
                if (li >= 512 + NLONG + 640) break;
#ifndef SKIP_SCAN
                if (li < 512) scan_item<16>(P, li >> 4, (li >> 1) & 7, li & 1, 0, 0, 2048, 4 | 8, nullptr, nullptr, nullptr, lds);
                else if (li < 512 + 16) {
                    const int hd = li - 512, dir = hd & 1;
                    scan_item<16>(P, 32, hd >> 1, dir, 0, dir == 0 ? 0 : 16384 - SEGLEN, SEGLEN, 4 | 8, nullptr, (float*)(ws + WS_STL) + (size_t)hd * NSEG * 4096, nullptr, lds);
                } else if (li < 512 + NLONG) {
                    const int q = li - 512 - 16, hd = q & 15, sgm = 1 + (q >> 4), dir = hd & 1;
                    const int tb = dir == 0 ? sgm * SEGLEN : 16384 - (sgm + 1) * SEGLEN;
                    scan_item<16>(P, 32, hd >> 1, dir, 0, tb, SEGLEN, 16, nullptr, (float*)(ws + WS_STL) + ((size_t)hd * NSEG + sgm) * 4096, (float*)(ws + WS_STP) + ((size_t)hd * NSEG + sgm) * 4096, lds);
                }
#endif
#ifndef SKIP_SGU
                if (li >= 512 + NLONG) sgu_item(P, li - 512 - NLONG, lds);
#endif
            }
        } else if (kind == K_CARRY) {
#ifndef SKIP_SCAN
            if (bid < 16) scan_carry(P, bid, lds);
#endif
        } else if (kind == K_MIXB) {
#ifndef SKIP_SCAN
            for (int li = bid; li < 16 * (NSEG - 1); li += G) {
                const int hd = li & 15, sgm = 1 + (li >> 4), dir = hd & 1;
                const int tb = dir == 0 ? sgm * SEGLEN : 16384 - (sgm + 1) * SEGLEN;
                scan_item<16>(P, 32, hd >> 1, dir, 0, tb, SEGLEN, 4 | 8, (const float*)(ws + WS_STS) + ((size_t)hd * NSEG + sgm) * 4096, nullptr, nullptr, lds);
            }
#endif
        } else if (kind == K_FINAL) {
#ifndef SKIP_FIN
            rwkv_finalize(P);
#endif
        } else if (kind == K_ATTN) {
            for (int it = bid; it < 5120; it += G) {
#ifndef SKIP_ATTN
                if (it < 4096) attn_item(P, it >> 7, it & 15, (it >> 4) & 7, lds);
                else attn_item(P, 32, it & 15, (it - 4096) >> 4, lds);
#endif
            }
        }
        if (ph + 1 < N_PHASES) {
            __builtin_amdgcn_fence(__ATOMIC_RELEASE, "agent");
            asm volatile("s_waitcnt vmcnt(0) lgkmcnt(0)" ::: "memory");
            grid.sync();
            __builtin_amdgcn_fence(__ATOMIC_ACQUIRE, "agent");
            asm volatile("s_waitcnt vmcnt(0) lgkmcnt(0)" ::: "memory");
            __syncthreads();
        }
    }
#ifdef PROBE_MASK
    if (blockIdx.x == 0 && threadIdx.x == 0) {
        unsigned long long* ts = (unsigned long long*)(P.ws + WS_TS);
        ts[N_PHASES] = __builtin_amdgcn_s_memrealtime();
        unsigned long long tot = 0;
        for (int i = 0; i < N_PHASES; ++i) if ((PROBE_MASK >> i) & 1) tot += ts[i + 1] - ts[i];
        P.out[0] += 4.0f + 10.0f * (float)tot * 1e-5f;
    }
#endif
}

extern "C" void kernel_launch(void* const* d_in, const int* in_sizes, int n_in, void* d_out, int out_size, void* d_ws, size_t ws_size, hipStream_t stream) {
    static int grid_blocks = 0;
    if (!grid_blocks) {
        int dev = 0, cus = 0, per_cu = 0;
        (void)hipGetDevice(&dev);
        (void)hipDeviceGetAttribute(&cus, hipDeviceAttributeMultiprocessorCount, dev);
        (void)hipFuncSetAttribute((const void*)mega, hipFuncAttributeMaxDynamicSharedMemorySize, LDS_BYTES);
        (void)hipOccupancyMaxActiveBlocksPerMultiprocessor(&per_cu, (const void*)mega, 512, LDS_BYTES);
        (void)hipGetLastError();
        if (cus <= 0) cus = 256;
        grid_blocks = cus;
        if (ws_size < WS_END2) fprintf(stderr, "kernel_launch: workspace too small: %zu < %zu\n", ws_size, (size_t)WS_END2);
    }
    Params p{};
    for (int i = 0; i < 30 && i < n_in; ++i) p.in[i] = (const float*)d_in[i];
    p.out = (float*)d_out; p.ws = (unsigned char*)d_ws;
    void* args[] = {&p};
    hipError_t e = hipLaunchCooperativeKernel((const void*)mega, dim3(grid_blocks), dim3(512), args, LDS_BYTES, stream);
    if (e != hipSuccess) fprintf(stderr, "cooperative launch failed: %s (grid %d)\n", hipGetErrorString(e), grid_blocks);
}
```

```cpp
#include <hip/hip_runtime.h>
#include <hip/hip_cooperative_groups.h>
#include <cstdio>
namespace cg = cooperative_groups;

namespace pg8 {
#define PG8_LAS __attribute__((address_space(3)))
typedef unsigned short bf16_t;
typedef short bf16x8 __attribute__((ext_vector_type(8)));
typedef float f32x4 __attribute__((ext_vector_type(4)));
typedef unsigned u32x4 __attribute__((ext_vector_type(4)));
constexpr int BM = 256, BK = 64, HALF = 128, HTB = HALF * BK * 2  , STAGE_BYTES = 8 * HTB, NXCD = 8, WGM = 8;

__host__ __device__ __forceinline__ int lds_byte(int r, int c) { const int st = (r >> 4) * 2 + (c >> 5), rr = r & 15, cc = c & 31, ob = rr * 64 + cc * 2; return st * 1024 + (ob ^ (((ob >> 9) & 1) << 5)); }
__host__ __device__ __forceinline__ void stage_rc(int b, int& R, int& C) { const int st = b / 1024, sb = b % 1024, swz = sb ^ (((sb >> 9) & 1) << 5); R = (st >> 1) * 16 + swz / 64; C = (st & 1) * 32 + (swz % 64) / 2; }
__host__ __device__ __forceinline__ int perm32(int rho) { const int n = rho >> 4, i = rho & 15; return 8 * (i >> 2) + 4 * n + (i & 3); }

struct Unit { int pm, pn; };
struct Gemm { const bf16_t* A; const bf16_t* Bt; int M, N, K; };

struct StaticOrder {
    int nM, nN, nwg, G, c;
    __host__ __device__ void init(int M, int N, int G_, int c_) { nM = M / BM; nN = N / BM; nwg = nM * nN; G = G_; c = c_; }
    __host__ __device__ bool next(int i, Unit& u) const {
        const long L = (long)i * G + c; if (L >= nwg) return false;
        int wgid = (int)L; { const int q = nwg / NXCD, r = nwg % NXCD, xcd = wgid % NXCD, off = wgid / NXCD; wgid = (xcd < r ? xcd * (q + 1) : r * (q + 1) + (xcd - r) * q) + off; }
        const int nig = WGM * nN, gid = wgid / nig, fm = gid * WGM, gsz = (nM - fm) < WGM ? (nM - fm) : WGM;
        u.pm = fm + ((wgid % nig) % gsz); u.pn = (wgid % nig) / gsz; return true;
    }
    __device__ __forceinline__ void a_ready(const Unit&) const {}
    __device__ __forceinline__ void done(const Unit&) const {}
};
__device__ __forceinline__ unsigned cvt_pk_bf16(float lo, float hi) { unsigned r; asm volatile("v_cvt_pk_bf16_f32 %0, %1, %2" : "=v"(r) : "v"(lo), "v"(hi)); return r; }
typedef float f32x2 __attribute__((ext_vector_type(2)));
template <class Epi, class Sched, bool ALIGN_EPI = false, bool SP2 = false>
__device__ __forceinline__ void gemm_phase(PG8_LAS unsigned char* lds, const Gemm g, const Sched& S, const Epi& E) {
    int tid_raw_ = threadIdx.x; asm volatile("" : "+v"(tid_raw_)); const int tid = tid_raw_, wid = __builtin_amdgcn_readfirstlane(tid >> 6), lane = tid & 63, wr = wid >> 2, wc = wid & 3, fr = lane & 15, fq = lane >> 4;
    const int K = g.K, nt = K / BK;
    unsigned voffA[2], voffB[2];
#pragma unroll
    for (int i = 0; i < 2; ++i) { int R, C; stage_rc(tid * 16 + i * 8192, R, C); const int Rb = Epi::PERM ? ((R & ~31) + perm32(R & 31)) : R;
        voffA[i] = (unsigned)(R * K + C) * 2u; voffB[i] = (unsigned)(Rb * K + C) * 2u; }
    const size_t kstep = (size_t)(BK * 2);
    const size_t hstep = (size_t)HALF * K * 2;
    const size_t tstep = 2 * hstep;
    const unsigned ldsw = (unsigned)wid * 1024u;
    const int aoff = lds_byte(wr * 64 + fr, fq * 8), boff = lds_byte(wc * 32 + fr, fq * 8);
#define PG8_SA(b, h) (((b) * 2 + (h)) * HTB)
#define PG8_SB(b, h) ((4 + (b) * 2 + (h)) * HTB)
#define PG8_STAGE(bufoff, gbase, voff) do { _Pragma("unroll") for (int _i = 0; _i < 2; ++_i) \
        __builtin_amdgcn_global_load_lds((const unsigned*)((const char*)(gbase) + (voff)[_i]), (PG8_LAS unsigned*)(lds + (bufoff) + ldsw + _i * 8192), 16, 0, 0); } while (0)
#define PG8_LDA(dst, b, h) do { _Pragma("unroll") for (int m = 0; m < 4; ++m) _Pragma("unroll") for (int k = 0; k < 2; ++k) dst[m][k] = *(const PG8_LAS bf16x8*)(lds + PG8_SA(b, h) + aoff + m * 2048 + k * 1024); } while (0)
#define PG8_LDB(dst, b, h) do { _Pragma("unroll") for (int n = 0; n < 2; ++n) _Pragma("unroll") for (int k = 0; k < 2; ++k) dst[n][k] = *(const PG8_LAS bf16x8*)(lds + PG8_SB(b, h) + boff + n * 2048 + k * 1024); } while (0)
#define PG8_MMA(ai, bj, At, Bt) do { __builtin_amdgcn_s_setprio(1); _Pragma("unroll") for (int m = 0; m < 4; ++m) _Pragma("unroll") for (int n = 0; n < 2; ++n) _Pragma("unroll") for (int k = 0; k < 2; ++k) \
        acc[ai][bj][m][n] = __builtin_amdgcn_mfma_f32_16x16x32_bf16(Bt[n][k], At[m][k], acc[ai][bj][m][n], 0, 0, 0); __builtin_amdgcn_s_setprio(0); } while (0)
#define PG8_WAIT_V(n) asm volatile("s_waitcnt vmcnt(" #n ")" ::: "memory")
#define PG8_WAIT_L(n) asm volatile("s_waitcnt lgkmcnt(" #n ")" ::: "memory")
#define PG8_BAR __builtin_amdgcn_s_barrier()
#define PG8_SCHED __builtin_amdgcn_sched_barrier(0)
    Unit cur, nxt; int ui = 0;
    if (!S.next(0, cur)) return;
    f32x4 acc[2][2][4][2];
#pragma unroll
    for (int a = 0; a < 2; ++a)
#pragma unroll
        for (int b = 0; b < 2; ++b)
#pragma unroll
            for (int m = 0; m < 4; ++m)
#pragma unroll
                for (int n = 0; n < 2; ++n) acc[a][b][m][n] = (f32x4){0.f, 0.f, 0.f, 0.f};
    bf16x8 At[4][2], B0[2][2], B1[2][2];
    const char* cA = (const char*)g.A + (size_t)cur.pm * tstep; const char* cB = (const char*)g.Bt + (size_t)cur.pn * tstep;
    S.a_ready(cur);
    if constexpr (SP2) {
        PG8_STAGE(PG8_SB(0, 0), cB, voffB); PG8_STAGE(PG8_SB(0, 1), cB + hstep, voffB); PG8_STAGE(PG8_SA(0, 0), cA, voffA); PG8_STAGE(PG8_SA(0, 1), cA + hstep, voffA);
        if (wr == 1) PG8_BAR;
        PG8_WAIT_V(2); PG8_BAR;
        PG8_STAGE(PG8_SB(1, 0), cB + kstep, voffB); PG8_STAGE(PG8_SA(1, 0), cA + kstep, voffA); PG8_STAGE(PG8_SB(1, 1), cB + hstep + kstep, voffB);
        PG8_WAIT_V(6); PG8_BAR;
    } else {
        PG8_STAGE(PG8_SB(0, 0), cB, voffB); PG8_STAGE(PG8_SA(0, 0), cA, voffA); PG8_STAGE(PG8_SB(0, 1), cB + hstep, voffB); PG8_STAGE(PG8_SA(0, 1), cA + hstep, voffA);
        if (wr == 1) PG8_BAR;
        PG8_WAIT_V(4); PG8_BAR;
        PG8_STAGE(PG8_SB(1, 0), cB + kstep, voffB); PG8_STAGE(PG8_SA(1, 0), cA + kstep, voffA); PG8_STAGE(PG8_SB(1, 1), cB + hstep + kstep, voffB);
        PG8_WAIT_V(6); PG8_BAR;
    }
    for (;;) {
        const bool has_next = S.next(ui + 1, nxt);
        const char* nA = has_next ? (const char*)g.A + (size_t)nxt.pm * tstep : cA; const char* nB = has_next ? (const char*)g.Bt + (size_t)nxt.pn * tstep : cB;
        for (int t = 0; t < nt; t += 2) {
            const bool last = (t == nt - 2);
            const char* a1 = cA + (size_t)(t + 1) * kstep;
            const char* a2 = last ? nA : cA + (size_t)(t + 2) * kstep; const char* b2 = last ? nB : cB + (size_t)(t + 2) * kstep;
            const char* a3 = a2 + kstep; const char* b3 = b2 + kstep;
            if (last && has_next) S.a_ready(nxt);
            if constexpr (SP2) {
            PG8_LDB(B0, 0, 0); PG8_LDB(B1, 0, 1); PG8_SCHED; PG8_LDA(At, 0, 0); PG8_STAGE(PG8_SA(1, 1), a1 + hstep, voffA);
            PG8_WAIT_V(8); PG8_WAIT_L(0); PG8_BAR; PG8_MMA(0, 0, At, B0); PG8_MMA(0, 1, At, B1); PG8_BAR; PG8_SCHED;
            PG8_LDA(At, 0, 1); PG8_STAGE(PG8_SB(0, 0), b2, voffB); PG8_STAGE(PG8_SB(0, 1), b2 + hstep, voffB); PG8_STAGE(PG8_SA(0, 0), a2, voffA);
            PG8_WAIT_V(8); PG8_WAIT_L(0); PG8_BAR; PG8_MMA(1, 0, At, B0); PG8_MMA(1, 1, At, B1); PG8_BAR; PG8_SCHED;
            PG8_LDB(B0, 1, 0); PG8_LDB(B1, 1, 1); PG8_SCHED; PG8_LDA(At, 1, 0); PG8_STAGE(PG8_SA(0, 1), a2 + hstep, voffA);
            PG8_WAIT_V(8); PG8_WAIT_L(0); PG8_BAR; PG8_MMA(0, 0, At, B0); PG8_MMA(0, 1, At, B1); PG8_BAR; PG8_SCHED;
            PG8_LDA(At, 1, 1); PG8_STAGE(PG8_SB(1, 0), b3, voffB); PG8_STAGE(PG8_SB(1, 1), b3 + hstep, voffB); PG8_STAGE(PG8_SA(1, 0), a3, voffA);
            PG8_WAIT_V(8); PG8_WAIT_L(0); PG8_BAR; PG8_MMA(1, 0, At, B0); PG8_MMA(1, 1, At, B1); PG8_BAR; PG8_SCHED;
            } else {
            PG8_LDB(B0, 0, 0); PG8_SCHED; PG8_LDA(At, 0, 0); PG8_STAGE(PG8_SA(1, 1), a1 + hstep, voffA);
            PG8_WAIT_L(8); PG8_BAR; PG8_WAIT_L(0); PG8_MMA(0, 0, At, B0); PG8_BAR; PG8_SCHED;
            PG8_LDB(B1, 0, 1); PG8_STAGE(PG8_SB(0, 0), b2, voffB);
            PG8_BAR; PG8_WAIT_L(0); PG8_MMA(0, 1, At, B1); PG8_BAR;
            PG8_LDA(At, 0, 1); PG8_STAGE(PG8_SA(0, 0), a2, voffA);
            PG8_BAR; PG8_WAIT_L(0); PG8_MMA(1, 0, At, B0); PG8_BAR; PG8_SCHED;
            PG8_STAGE(PG8_SB(0, 1), b2 + hstep, voffB);
            PG8_WAIT_V(6); PG8_BAR; PG8_MMA(1, 1, At, B1); PG8_BAR;
            PG8_LDB(B0, 1, 0); PG8_SCHED; PG8_LDA(At, 1, 0); PG8_STAGE(PG8_SA(0, 1), a2 + hstep, voffA);
            PG8_WAIT_L(8); PG8_BAR; PG8_WAIT_L(0); PG8_MMA(0, 0, At, B0); PG8_BAR; PG8_SCHED;
            PG8_LDB(B1, 1, 1); PG8_STAGE(PG8_SB(1, 0), b3, voffB);
            PG8_BAR; PG8_WAIT_L(0); PG8_MMA(0, 1, At, B1); PG8_BAR;
            PG8_LDA(At, 1, 1); PG8_STAGE(PG8_SA(1, 0), a3, voffA);
            PG8_BAR; PG8_WAIT_L(0); PG8_MMA(1, 0, At, B0); PG8_BAR; PG8_SCHED;
            PG8_STAGE(PG8_SB(1, 1), b3 + hstep, voffB);
            PG8_WAIT_V(6); PG8_BAR; PG8_MMA(1, 1, At, B1); PG8_BAR;
            }
        }
        if constexpr (ALIGN_EPI) { if (wr == 0) PG8_BAR; }
        if constexpr (!Epi::AFTER_DRAIN) { E(acc, cur, wr, wc, fr, fq); S.done(cur); }
        if (!has_next) break;
#pragma unroll
        for (int a = 0; a < 2; ++a)
#pragma unroll
            for (int b = 0; b < 2; ++b)
#pragma unroll
                for (int m = 0; m < 4; ++m)
#pragma unroll
                    for (int n = 0; n < 2; ++n) acc[a][b][m][n] = (f32x4){0.f, 0.f, 0.f, 0.f};
        cur = nxt; cA = nA; cB = nB; ++ui;
        if constexpr (ALIGN_EPI) { if (wr == 1) PG8_BAR; }
    }
    PG8_WAIT_V(0);
    if constexpr (!ALIGN_EPI) { if (wr == 0) PG8_BAR; }
    PG8_BAR;
    if constexpr (Epi::AFTER_DRAIN) { E.fused(acc, cur, wr, wc, fr, fq, lds, wid, lane); S.done(cur); }
#undef PG8_SA
#undef PG8_SB
#undef PG8_STAGE
#undef PG8_LDA
#undef PG8_LDB
#undef PG8_MMA
#undef PG8_WAIT_V
#undef PG8_WAIT_L
#undef PG8_BAR
#undef PG8_SCHED
}
}


#define LAS __attribute__((address_space(3)))
typedef unsigned short bf16_t;
typedef short bf16x8 __attribute__((ext_vector_type(8)));
typedef short s16x4 __attribute__((ext_vector_type(4)));
typedef float f32x4 __attribute__((ext_vector_type(4)));
typedef unsigned u32x4 __attribute__((ext_vector_type(4)));
typedef unsigned u32x2 __attribute__((ext_vector_type(2)));
typedef float f32x2v __attribute__((ext_vector_type(2)));

constexpr int M_TOK = 81920, M_PROMPT = 65536, DM = 1024, DFF = 2816;
constexpr int LDS_BYTES = 147456;
#ifndef GEMM_ALIGN
#define GEMM_ALIGN true
#endif
#ifndef GEMM_SP2
#define GEMM_SP2 true
#endif
constexpr float NORM_EPS = 1e-6f;

constexpr size_t SZ_WFI = (size_t)5632 * 1024 * 2, SZ_WFO = (size_t)1024 * 2816 * 2;
constexpr size_t WS_WFI = 0;
constexpr size_t WS_WFO = WS_WFI + 4 * SZ_WFI;
constexpr size_t WS_WABI = WS_WFO + 4 * SZ_WFO;
constexpr size_t WS_WABO = WS_WABI + (size_t)3328 * 1024 * 2;
constexpr size_t WS_WATI = WS_WABO + (size_t)1024 * 1024 * 2;
constexpr size_t WS_WATO = WS_WATI + (size_t)3072 * 1024 * 2;
constexpr size_t WS_LORA = WS_WATO + (size_t)1024 * 1024 * 2;
constexpr size_t WS_SGUW = WS_LORA + (size_t)4 * 512 * 64 * 2;
constexpr size_t WS_RKR = WS_SGUW + (size_t)4 * 128 * 128 * 2;
constexpr size_t WS_XN = (WS_RKR + (size_t)2 * M_TOK * 8 * 4 + 4095) & ~(size_t)4095;
constexpr size_t WS_BIG = WS_XN + (size_t)M_TOK * 1024 * 2;
constexpr size_t WS_PUV = WS_BIG;
constexpr size_t WS_PRKVG = WS_PUV + (size_t)M_TOK * 1024 * 2;
constexpr size_t WS_PWA = WS_PRKVG + (size_t)M_TOK * 2048 * 2;
constexpr size_t WS_Y = WS_BIG + (size_t)M_TOK * 3328 * 2;
constexpr size_t WS_END = WS_Y + (size_t)2 * M_TOK * 512 * 2;

constexpr int NSEG = 16, SEGLEN = 16384 / NSEG;
constexpr size_t WS_STL = (WS_END + 4095) & ~(size_t)4095;
constexpr size_t WS_STP = WS_STL + (size_t)16 * NSEG * 4096 * 4;
constexpr size_t WS_STS = WS_STP + (size_t)16 * NSEG * 4096 * 4;
constexpr size_t WS_TS = WS_STS + (size_t)16 * NSEG * 4096 * 4;
constexpr size_t WS_RSA = WS_TS + 4096;
constexpr size_t WS_RSB = WS_RSA + (size_t)M_TOK * 4;
constexpr size_t WS_RSC = WS_RSB + (size_t)M_TOK * 4;
constexpr size_t WS_RSD = WS_RSC + (size_t)M_TOK * 4;
constexpr size_t WS_KSQ = WS_RSD + (size_t)M_TOK * 4;
constexpr size_t WS_END2 = WS_KSQ + (size_t)16 * M_TOK * 4;
struct Params { const float* in[30]; float* out; unsigned char* ws; };

__device__ __forceinline__ float bflo(unsigned w) { return __uint_as_float(w << 16); }
__device__ __forceinline__ float bfhi(unsigned w) { return __uint_as_float(w & 0xffff0000u); }
__device__ __forceinline__ unsigned pk2(float lo, float hi) { unsigned r; asm("v_cvt_pk_bf16_f32 %0, %1, %2" : "=v"(r) : "v"(lo), "v"(hi)); return r; }
__device__ __forceinline__ void unpack8(const u32x4 w, float* f) { f[0] = bflo(w.x); f[1] = bfhi(w.x); f[2] = bflo(w.y); f[3] = bfhi(w.y); f[4] = bflo(w.z); f[5] = bfhi(w.z); f[6] = bflo(w.w); f[7] = bfhi(w.w); }
__device__ __forceinline__ u32x4 pack8(const float* f) { u32x4 w; w.x = pk2(f[0], f[1]); w.y = pk2(f[2], f[3]); w.z = pk2(f[4], f[5]); w.w = pk2(f[6], f[7]); return w; }
__device__ __forceinline__ float sigmoidf_(float x) { return __builtin_amdgcn_rcpf(1.0f + __expf(-x)); }
__device__ __forceinline__ float siluf_(float x) { return x * sigmoidf_(x); }
__device__ __forceinline__ float gelu_tanh(float x) { const float u = 0.7978845608028654f * (x + 0.044715f * x * x * x); return x * sigmoidf_(2.0f * u); }
__device__ __forceinline__ float tanhf_(float x) { return 1.0f - 2.0f * __builtin_amdgcn_rcpf(__expf(2.0f * x) + 1.0f); }
__device__ __forceinline__ float wave_sum(float x) { x += __shfl_xor(x, 32); x += __shfl_xor(x, 16); x += __shfl_xor(x, 8); x += __shfl_xor(x, 4); x += __shfl_xor(x, 2); x += __shfl_xor(x, 1); return x; }
template <int CTRL> __device__ __forceinline__ float dppf(float x) { return __int_as_float(__builtin_amdgcn_update_dpp(0, __float_as_int(x), CTRL, 0xF, 0xF, true)); }
__device__ __forceinline__ float reduce8(float x) { x += dppf<0xB1>(x); x += dppf<0x4E>(x); x += dppf<0x141>(x); return x; }
typedef short v4i16_t __attribute__((ext_vector_type(4)));
typedef __bf16 bf16x2_t __attribute__((ext_vector_type(2)));
__device__ __forceinline__ s16x4 tr_read(LAS const unsigned char* p) { return __builtin_bit_cast(s16x4, __builtin_amdgcn_ds_read_tr16_b64_v4i16((LAS v4i16_t*)p)); }
__device__ __forceinline__ f32x4 mfma16(bf16x8 a, bf16x8 b, f32x4 c) { return __builtin_amdgcn_mfma_f32_16x16x32_bf16(a, b, c, 0, 0, 0); }

__device__ __forceinline__ int opaque_tid() { int t = threadIdx.x; asm volatile("" : "+v"(t)); return t; }
__device__ __forceinline__ unsigned char* opaque_ptr(unsigned char* p) { size_t z = 0; asm volatile("" : "+s"(z)); return p + z; }
struct EpiSwiglu {
    static constexpr bool PERM = false, AFTER_DRAIN = false;
    bf16_t* H; const float* rowss; const float* rowss2;
    __device__ __forceinline__ void operator()(const f32x4 (&acc)[2][2][4][2], const pg8::Unit& u, int wr, int wc, int fr, int fq) const {
        const int row0 = u.pm * 256 + wr * 64 + fr, col0 = u.pn * 128 + wc * 32 + 8 * fq;
        float rsv[8];
#pragma unroll
        for (int gi = 0; gi < 8; ++gi) rsv[gi] = rowss ? rowss[row0 + (gi >> 2) * 128 + (gi & 3) * 16] : 0.f;
        float rsw[8];
#pragma unroll
        for (int gi = 0; gi < 8; ++gi) rsw[gi] = rowss2 ? rowss2[row0 + (gi >> 2) * 128 + (gi & 3) * 16] : 0.f;
#pragma unroll
        for (int gi = 0; gi < 8; ++gi) { rsv[gi] = rowss ? rsqrtf(rsv[gi] * (1.0f / DM) + NORM_EPS) : 1.0f;
            if (rowss2) rsv[gi] *= rsqrtf(rsv[gi] * rsv[gi] * rsw[gi] * (1.0f / DM) + NORM_EPS); }
#pragma unroll
        for (int ai = 0; ai < 2; ++ai)
#pragma unroll
            for (int m = 0; m < 4; ++m) {
                const int row = row0 + ai * 128 + m * 16;
                const float rs = rsv[ai * 4 + m];
                bf16_t* rowp = H + (size_t)row * DFF + col0;
                float h[8];
                const float c1 = rs * -1.4426950408889634f, c2 = rs * rs;
#pragma unroll
                for (int bj = 0; bj < 2; ++bj)
#pragma unroll
                    for (int pr = 0; pr < 2; ++pr) {
                        const f32x2v gg = {acc[ai][bj][m][0][2 * pr], acc[ai][bj][m][0][2 * pr + 1]}, uu = {acc[ai][bj][m][1][2 * pr], acc[ai][bj][m][1][2 * pr + 1]};
                        const f32x2v t = gg * c1;
                        f32x2v d; d.x = __builtin_amdgcn_exp2f(t.x); d.y = __builtin_amdgcn_exp2f(t.y);
                        d = d + 1.0f;
                        f32x2v r; r.x = __builtin_amdgcn_rcpf(d.x); r.y = __builtin_amdgcn_rcpf(d.y);
                        const f32x2v hh = ((gg * uu) * c2) * r;
                        h[bj * 4 + 2 * pr] = hh.x; h[bj * 4 + 2 * pr + 1] = hh.y;
                    }
                *(u32x4*)rowp = pack8(h);
                asm volatile("" ::: "memory");
            }
    }
};
struct EpiResid {
    static constexpr bool PERM = false, AFTER_DRAIN = false;
    float* X; float scale; bf16_t* XG; const float* g; float* rowss; const float* xin_a; const float* xin_b;
    const float* gaux; float* rowss2; const float* base_ss;
    __device__ __forceinline__ void operator()(const f32x4 (&acc)[2][2][4][2], const pg8::Unit& u, int wr, int wc, int fr, int fq) const {
        const int row0 = u.pm * 256 + wr * 64 + fr, col0 = u.pn * 256 + wc * 32 + 4 * fq;
        f32x4 gv[2][2];
#pragma unroll
        for (int bj = 0; bj < 2; ++bj)
#pragma unroll
            for (int n = 0; n < 2; ++n) gv[bj][n] = XG ? *(const f32x4*)(g + col0 + bj * 128 + n * 16) : (f32x4){0.f, 0.f, 0.f, 0.f};
        f32x4 ga[2][2];
#pragma unroll
        for (int bj = 0; bj < 2; ++bj)
#pragma unroll
            for (int n = 0; n < 2; ++n) { ga[bj][n] = gaux ? *(const f32x4*)(gaux + col0 + bj * 128 + n * 16) : (f32x4){1.f, 1.f, 1.f, 1.f}; if (rowss2) gv[bj][n] = gv[bj][n] * ga[bj][n]; }
        float brs[8];
#pragma unroll
        for (int gi = 0; gi < 8; ++gi) brs[gi] = base_ss ? base_ss[row0 + (gi >> 2) * 128 + (gi & 3) * 16] : 0.f;
#pragma unroll
        for (int gi = 0; gi < 8; ++gi) brs[gi] = base_ss ? rsqrtf(brs[gi] * (1.0f / DM) + NORM_EPS) : 1.0f;
        const float* Xs = xin_a ? (u.pm < 256 ? xin_a : xin_b - (size_t)M_PROMPT * DM) : X;
        f32x4 xin[2][2][2];
#pragma unroll
        for (int gi = 0; gi < 9; ++gi) {
            if (gi < 8) {
                const float* rowp = Xs + (size_t)(row0 + (gi >> 2) * 128 + (gi & 3) * 16) * DM + col0;
#pragma unroll
                for (int bj = 0; bj < 2; ++bj)
#pragma unroll
                    for (int n = 0; n < 2; ++n) xin[gi & 1][bj][n] = *(const f32x4*)(rowp + bj * 128 + n * 16);
            }
            if (gi > 0) {
                const int gp = gi - 1, ai = gp >> 2, m = gp & 3;
                const int row = row0 + ai * 128 + m * 16;
                float* rowp = X + (size_t)row * DM + col0;
                float ssq = 0.f, ssq2 = 0.f;
#pragma unroll
                for (int bj = 0; bj < 2; ++bj)
#pragma unroll
                    for (int n = 0; n < 2; ++n) { f32x4 v = xin[gp & 1][bj][n]; if (base_ss) v = v * brs[gp] * ga[bj][n];
                        v += acc[ai][bj][m][n] * scale; *(f32x4*)(rowp + bj * 128 + n * 16) = v;
                        if (XG) { ssq += (v[0] * v[0] + v[1] * v[1]) + (v[2] * v[2] + v[3] * v[3]); const f32x4 o = v * gv[bj][n]; u32x2 w; w.x = pk2(o[0], o[1]); w.y = pk2(o[2], o[3]);
                            *(u32x2*)(XG + (size_t)row * DM + col0 + bj * 128 + n * 16) = w; }
                        if (rowss2) { const f32x4 t = v * ga[bj][n]; ssq2 += (t[0] * t[0] + t[1] * t[1]) + (t[2] * t[2] + t[3] * t[3]); } }
                if (XG) { ssq += __shfl_xor(ssq, 16); ssq += __shfl_xor(ssq, 32);
                    if (fq == 0) __hip_atomic_fetch_add(rowss + row, ssq, __ATOMIC_RELAXED, __HIP_MEMORY_SCOPE_AGENT); }
                if (rowss2) { ssq2 += __shfl_xor(ssq2, 16); ssq2 += __shfl_xor(ssq2, 32);
                    if (fq == 0) __hip_atomic_fetch_add(rowss2 + row, ssq2, __ATOMIC_RELAXED, __HIP_MEMORY_SCOPE_AGENT); }
            }
            asm volatile("" ::: "memory");
        }
    }
};
struct EpiSplit {
    static constexpr bool PERM = true, AFTER_DRAIN = false;
    bf16_t* b0; int ld0, t0; bf16_t* b1; int ld1, t1; bf16_t* b2; int ld2; const float* rowss; float* ksq;
    __device__ __forceinline__ void operator()(const f32x4 (&acc)[2][2][4][2], const pg8::Unit& u, int wr, int wc, int fr, int fq) const {
        bf16_t* base; int ld, ct;
        if (u.pn < t0) { base = b0; ld = ld0; ct = u.pn; } else if (u.pn < t1) { base = b1; ld = ld1; ct = u.pn - t0; } else { base = b2; ld = ld2; ct = u.pn - t1; }
        const int row0 = u.pm * 256 + wr * 64 + fr, col0 = ct * 256 + wc * 32 + 8 * fq;
        const bool isk = ksq != nullptr && u.pn >= 4 && u.pn < 8;
        float rsv[8];
#pragma unroll
        for (int gi = 0; gi < 8; ++gi) rsv[gi] = rowss[row0 + (gi >> 2) * 128 + (gi & 3) * 16];
#pragma unroll
        for (int gi = 0; gi < 8; ++gi) rsv[gi] = rsqrtf(rsv[gi] * (1.0f / DM) + NORM_EPS);
#pragma unroll
        for (int ai = 0; ai < 2; ++ai)
#pragma unroll
            for (int m = 0; m < 4; ++m) {
                const int row = row0 + ai * 128 + m * 16;
                const float rs = rsv[ai * 4 + m];
                bf16_t* rowp = base + (size_t)row * ld + col0;
#pragma unroll
                for (int bj = 0; bj < 2; ++bj) {
                    const f32x4 v0 = acc[ai][bj][m][0] * rs, v1 = acc[ai][bj][m][1] * rs;
                    u32x4 w; w.x = pk2(v0[0], v0[1]); w.y = pk2(v0[2], v0[3]); w.z = pk2(v1[0], v1[1]); w.w = pk2(v1[2], v1[3]);
                    *(u32x4*)(rowp + bj * 128) = w;
                    if (isk) {
                        float sq = ((v0[0] * v0[0] + v0[1] * v0[1]) + (v0[2] * v0[2] + v0[3] * v0[3])) + ((v1[0] * v1[0] + v1[1] * v1[1]) + (v1[2] * v1[2] + v1[3] * v1[3]));
                        sq += __shfl_xor(sq, 16); sq += __shfl_xor(sq, 32);
                        if (fq == 0) __hip_atomic_fetch_add(ksq + (size_t)((u.pn - 4) * 4 + 2 * bj + (wc >> 1)) * M_TOK + row, sq, __ATOMIC_RELAXED, __HIP_MEMORY_SCOPE_AGENT);
                    }
                }
                asm volatile("" ::: "memory");
            }
    }
};

template <int MAP> __device__ __forceinline__ int src_col(int s) {
    if (MAP == 0) return s;
    const int pn = s >> 8, bj = (s >> 7) & 1, wc = (s >> 5) & 3, n = (s >> 4) & 1, fq = (s >> 2) & 3, jj = s & 3;
    return n * DFF + 128 * pn + 32 * wc + 8 * fq + 4 * bj + jj;
}
template <int MAP> __device__ void convert_T(const float* __restrict__ src, bf16_t* __restrict__ dst, int K, int N, LAS float* tile, int rot) {
    const int tk = K / 64, tn = N / 64, nt = tk * tn, tid = opaque_tid(), G = gridDim.x;
    const int kk0 = tid >> 4, sg = tid & 15;
    int t = (int)((blockIdx.x + rot) % G);
    float4 va = make_float4(0.f, 0.f, 0.f, 0.f), vb = va;
    if (t < nt) { const int k0 = (t % tk) * 64, s0 = (t / tk) * 64; const int c = src_col<MAP>(s0 + sg * 4);
        va = *(const float4*)(src + (size_t)(k0 + kk0) * N + c); vb = *(const float4*)(src + (size_t)(k0 + kk0 + 32) * N + c); }
    for (; t < nt; t += G) {
        const int k0 = (t % tk) * 64, s0 = (t / tk) * 64;
        { LAS float* tp = tile + kk0 * 65 + sg * 4; tp[0] = va.x; tp[1] = va.y; tp[2] = va.z; tp[3] = va.w;
          LAS float* tq = tile + (kk0 + 32) * 65 + sg * 4; tq[0] = vb.x; tq[1] = vb.y; tq[2] = vb.z; tq[3] = vb.w; }
        if (t + G < nt) {
            const int t2 = t + G, k2 = (t2 % tk) * 64, s2 = (t2 / tk) * 64; const int c = src_col<MAP>(s2 + sg * 4);
            va = *(const float4*)(src + (size_t)(k2 + kk0) * N + c); vb = *(const float4*)(src + (size_t)(k2 + kk0 + 32) * N + c); }
        asm volatile("s_waitcnt lgkmcnt(0)" ::: "memory"); __builtin_amdgcn_s_barrier(); asm volatile("" ::: "memory");
        {
            const int slot = tid >> 3, kc = tid & 7; float f[8];
#pragma unroll
            for (int i = 0; i < 8; ++i) f[i] = tile[(kc * 8 + i) * 65 + slot];
            *(u32x4*)(dst + (size_t)(s0 + slot) * K + k0 + kc * 8) = pack8(f);
        }
        asm volatile("s_waitcnt lgkmcnt(0)" ::: "memory"); __builtin_amdgcn_s_barrier(); asm volatile("" ::: "memory");
    }
}

__device__ void norm_rows(const float* xa, const float* xb, int split, float* xcopy, const float* g1, float* x1out, const float* g2, bf16_t* xn) {
    const int tid_ = opaque_tid(), lane = tid_ & 63, wave = __builtin_amdgcn_readfirstlane(tid_ >> 6);
    const int stride = gridDim.x * 8;
    for (int row0 = blockIdx.x * 8 + wave; row0 < M_TOK; row0 += 2 * stride) {
        int rows[2]; rows[0] = row0; rows[1] = (row0 + stride < M_TOK) ? row0 + stride : row0;
        f32x4 v[2][4]; float ss[2] = {0.f, 0.f};
#pragma unroll
        for (int q = 0; q < 2; ++q) { const int row = rows[q];
            const float* src = (row < split) ? xa + (size_t)row * DM : xb + (size_t)(row - split) * DM;
#pragma unroll
            for (int i = 0; i < 4; ++i) v[q][i] = *(const f32x4*)(src + i * 256 + lane * 4); }
#pragma unroll
        for (int q = 0; q < 2; ++q) {
#pragma unroll
            for (int i = 0; i < 4; ++i) ss[q] += v[q][i][0] * v[q][i][0] + v[q][i][1] * v[q][i][1] + v[q][i][2] * v[q][i][2] + v[q][i][3] * v[q][i][3];
            if (xcopy) {
#pragma unroll
                for (int i = 0; i < 4; ++i) *(f32x4*)(xcopy + (size_t)rows[q] * DM + i * 256 + lane * 4) = v[q][i];
            }
        }
        ss[0] = wave_sum(ss[0]); ss[1] = wave_sum(ss[1]);
        float r[2]; r[0] = rsqrtf(ss[0] * (1.0f / DM) + NORM_EPS); r[1] = rsqrtf(ss[1] * (1.0f / DM) + NORM_EPS);
        if (g1) {
            float s2[2] = {0.f, 0.f};
#pragma unroll
            for (int i = 0; i < 4; ++i) { const f32x4 g = *(const f32x4*)(g1 + i * 256 + lane * 4);
#pragma unroll
                for (int q = 0; q < 2; ++q) { v[q][i] = v[q][i] * r[q] * g; *(f32x4*)(x1out + (size_t)rows[q] * DM + i * 256 + lane * 4) = v[q][i];
                    s2[q] += v[q][i][0] * v[q][i][0] + v[q][i][1] * v[q][i][1] + v[q][i][2] * v[q][i][2] + v[q][i][3] * v[q][i][3]; } }
            s2[0] = wave_sum(s2[0]); s2[1] = wave_sum(s2[1]);
            r[0] = rsqrtf(s2[0] * (1.0f / DM) + NORM_EPS); r[1] = rsqrtf(s2[1] * (1.0f / DM) + NORM_EPS);
        }
        if (g2) {
#pragma unroll
            for (int i = 0; i < 4; ++i) { const f32x4 g = *(const f32x4*)(g2 + i * 256 + lane * 4);
#pragma unroll
                for (int q = 0; q < 2; ++q) { const f32x4 o = v[q][i] * r[q] * g;
                    u32x2 w; w.x = pk2(o[0], o[1]); w.y = pk2(o[2], o[3]); *(u32x2*)(xn + (size_t)rows[q] * DM + i * 256 + lane * 4) = w; } }
        }
    }
}

__device__ void sgu_item(const Params& PP, int chunk, LAS unsigned char* lds) {
    Params P = PP; P.ws = opaque_ptr(PP.ws);
    const int tid = opaque_tid(), lane = tid & 63, wave = __builtin_amdgcn_readfirstlane(tid >> 6), l15 = lane & 15, quad = lane >> 4;
    constexpr int PITCH = 1056;
    const bf16_t* Puv = (const bf16_t*)(P.ws + WS_PUV);
    bf16_t* MO = (bf16_t*)(P.ws + WS_XN);
    const size_t row0 = (size_t)chunk * 128;
    {
        float gn[8];
        { const f32x4 a = *(const f32x4*)(P.in[12] + lane * 8), b = *(const f32x4*)(P.in[12] + lane * 8 + 4); gn[0] = a[0]; gn[1] = a[1]; gn[2] = a[2]; gn[3] = a[3]; gn[4] = b[0]; gn[5] = b[1]; gn[6] = b[2]; gn[7] = b[3]; }
        for (int i = 0; i < 16; ++i) {
            const int p = wave * 16 + i;
            const u32x4 raw = *(const u32x4*)(Puv + (row0 + p) * 1024 + 512 + lane * 8);
            float v[8]; unpack8(raw, v); float ss = 0.f;
#pragma unroll
            for (int e = 0; e < 8; ++e) { v[e] = gelu_tanh(v[e]); ss += v[e] * v[e]; }
            ss = wave_sum(ss);
            const float r = rsqrtf(ss * (1.0f / 512.0f) + NORM_EPS);
#pragma unroll
            for (int e = 0; e < 8; ++e) v[e] = v[e] * r * gn[e];
            *(LAS u32x4*)(lds + p * PITCH + lane * 16) = pack8(v);
        }
    }
    __syncthreads();
    const int g = wave >> 1, cbase = (wave >> 1) * 128 + (wave & 1) * 64;
    const bf16_t* Wg = (const bf16_t*)(P.ws + WS_SGUW) + (size_t)g * 128 * 128;
    const int r4 = l15 >> 2, c4 = l15 & 3;
    for (int qh = 0; qh < 2; ++qh) {
        f32x4 acc[4][4];
#pragma unroll
        for (int a = 0; a < 4; ++a)
#pragma unroll
            for (int b = 0; b < 4; ++b) acc[a][b] = (f32x4){0.f, 0.f, 0.f, 0.f};
#pragma unroll
        for (int ks = 0; ks < 4; ++ks) {
            bf16x8 bfr[4];
#pragma unroll
            for (int qt = 0; qt < 4; ++qt) bfr[qt] = *(const bf16x8*)(Wg + (size_t)(qh * 64 + qt * 16 + l15) * 128 + ks * 32 + quad * 8);
#pragma unroll
            for (int ct = 0; ct < 4; ++ct) {
                LAS const unsigned char* ap = lds + (ks * 32 + quad * 8 + r4) * PITCH + (cbase + ct * 16 + 4 * c4) * 2;
                const s16x4 lo = tr_read(ap), hi = tr_read(ap + 4 * PITCH);
                const bf16x8 a = {lo[0], lo[1], lo[2], lo[3], hi[0], hi[1], hi[2], hi[3]};
#pragma unroll
                for (int qt = 0; qt < 4; ++qt) acc[ct][qt] = mfma16(a, bfr[qt], acc[ct][qt]);
            }
        }
#pragma unroll
        for (int qt = 0; qt < 4; ++qt) {
            const int q = qh * 64 + qt * 16 + l15;
            const float bq = P.in[14][g * 128 + q];
#pragma unroll
            for (int ct = 0; ct < 4; ++ct) {
                const int c = cbase + ct * 16 + quad * 4;
                const u32x2 ur = *(const u32x2*)(Puv + (row0 + q) * 1024 + c);
                const float u0 = gelu_tanh(bflo(ur.x)), u1 = gelu_tanh(bfhi(ur.x)), u2 = gelu_tanh(bflo(ur.y)), u3 = gelu_tanh(bfhi(ur.y));
                u32x2 w; w.x = pk2(u0 * (acc[ct][qt][0] + bq), u1 * (acc[ct][qt][1] + bq)); w.y = pk2(u2 * (acc[ct][qt][2] + bq), u3 * (acc[ct][qt][3] + bq));
                *(u32x2*)(MO + (row0 + q) * 1024 + c) = w;
            }
        }
    }
    __syncthreads();
}

template <int LPR> __device__ __forceinline__ float reduce_row(float x) {
    x += dppf<0xB1>(x); x += dppf<0x4E>(x); x += dppf<0x141>(x);
    if (LPR == 16) x += dppf<0x140>(x);
    return x;
}
__device__ __forceinline__ float reduce32(float x) {
    x += dppf<0xB1>(x); x += dppf<0x4E>(x); x += dppf<0x141>(x); x += dppf<0x140>(x); x += __shfl_xor(x, 16); return x;
}
__device__ __forceinline__ void lds_barrier() { asm volatile("s_waitcnt lgkmcnt(0)" ::: "memory"); __builtin_amdgcn_s_barrier(); asm volatile("" ::: "memory"); }
template <int NV> struct ScanSet { f32x4 kk[NV], w[NV], ka[NV], kp[NV], r[NV]; float vv; };
template <int NV> __device__ __forceinline__ void scan_load(ScanSet<NV>& t, LAS const float* KK, LAS const float* Wd, LAS const float* KKA, LAS const float* KP, LAS const float* Rr, LAS const float* Vv, int o, int ov, bool want_y) {
#pragma unroll
    for (int u = 0; u < NV; ++u) { t.kk[u] = *(LAS const f32x4*)(KK + o + u * 32); t.w[u] = *(LAS const f32x4*)(Wd + o + u * 32); t.ka[u] = *(LAS const f32x4*)(KKA + o + u * 32); t.kp[u] = *(LAS const f32x4*)(KP + o + u * 32); }
    if (want_y) {
#pragma unroll
        for (int u = 0; u < NV; ++u) t.r[u] = *(LAS const f32x4*)(Rr + o + u * 32);
    }
    t.vv = Vv[ov];
}
typedef float f32x2v __attribute__((ext_vector_type(2)));
template <int LPR, int NV> __device__ __forceinline__ float scan_step(float* S, const ScanSet<NV>& t, bool want_y, float& ypart) {
    f32x2v acc = {0.f, 0.f};
#pragma unroll
    for (int u = 0; u < NV; ++u)
#pragma unroll
        for (int hh = 0; hh < 2; ++hh) { const f32x2v s2 = {S[4 * u + 2 * hh], S[4 * u + 2 * hh + 1]}, k2 = {t.kk[u][2 * hh], t.kk[u][2 * hh + 1]}; acc = s2 * k2 + acc; }
    float sa = acc.x + acc.y, yb = ypart;
    sa += dppf<0xB1>(sa); yb += dppf<0xB1>(yb); sa += dppf<0x4E>(sa); yb += dppf<0x4E>(yb); sa += dppf<0x141>(sa); yb += dppf<0x141>(yb);
    const f32x2v sa2 = {sa, sa}, vv2 = {t.vv, t.vv};
#pragma unroll
    for (int u = 0; u < NV; ++u)
#pragma unroll
        for (int hh = 0; hh < 2; ++hh) {
            f32x2v s2 = {S[4 * u + 2 * hh], S[4 * u + 2 * hh + 1]};
            const f32x2v w2 = {t.w[u][2 * hh], t.w[u][2 * hh + 1]}, kp2 = {t.kp[u][2 * hh], t.kp[u][2 * hh + 1]}, ka2 = {t.ka[u][2 * hh], t.ka[u][2 * hh + 1]};
            f32x2v tt = vv2 * kp2; tt = tt - sa2 * ka2;
            s2 = s2 * w2 + tt;
            S[4 * u + 2 * hh] = s2.x; S[4 * u + 2 * hh + 1] = s2.y;
        }
    if (want_y) {
        f32x2v yacc = {0.f, 0.f};
#pragma unroll
        for (int u = 0; u < NV; ++u)
#pragma unroll
            for (int hh = 0; hh < 2; ++hh) { const f32x2v s2 = {S[4 * u + 2 * hh], S[4 * u + 2 * hh + 1]}, r2 = {t.r[u][2 * hh], t.r[u][2 * hh + 1]}; yacc = s2 * r2 + yacc; }
        ypart = yacc.x + yacc.y;
    }
    return yb;
}
struct ScanSet2 { f32x4 kk, w, ka, kp, r; float vv0, vv1; };
__device__ __forceinline__ void scan_load2(ScanSet2& t, LAS const float* KK, LAS const float* Wd, LAS const float* KKA, LAS const float* KP, LAS const float* Rr, LAS const float* Vv, int o, int ov, bool want_y) {
    t.kk = *(LAS const f32x4*)(KK + o); t.w = *(LAS const f32x4*)(Wd + o); t.ka = *(LAS const f32x4*)(KKA + o); t.kp = *(LAS const f32x4*)(KP + o);
    if (want_y) t.r = *(LAS const f32x4*)(Rr + o);
    t.vv0 = Vv[ov]; t.vv1 = Vv[ov + 4];
}
__device__ __forceinline__ float dpp16(float x) { x += dppf<0xB1>(x); x += dppf<0x4E>(x); x += dppf<0x141>(x); x += dppf<0x140>(x); return x; }
__device__ __forceinline__ void scan_step2(f32x2v* SS, const ScanSet2& t, bool want_y, float& y0, float& y1, float& yr0, float& yr1) {
    f32x2v a2 = SS[0] * (f32x2v){t.kk[0], t.kk[0]};
#pragma unroll
    for (int i = 1; i < 4; ++i) a2 = SS[i] * (f32x2v){t.kk[i], t.kk[i]} + a2;
    float a0 = a2.x, a1 = a2.y, b0 = y0, b1 = y1;
#define SCAN_OPAQUE4() asm("" : "+v"(a0), "+v"(a1), "+v"(b0), "+v"(b1))
    SCAN_OPAQUE4();
    a0 += dppf<0xB1>(a0); a1 += dppf<0xB1>(a1); b0 += dppf<0xB1>(b0); b1 += dppf<0xB1>(b1); SCAN_OPAQUE4();
    a0 += dppf<0x4E>(a0); a1 += dppf<0x4E>(a1); b0 += dppf<0x4E>(b0); b1 += dppf<0x4E>(b1); SCAN_OPAQUE4();
    a0 += dppf<0x141>(a0); a1 += dppf<0x141>(a1); b0 += dppf<0x141>(b0); b1 += dppf<0x141>(b1); SCAN_OPAQUE4();
    a0 += dppf<0x140>(a0); a1 += dppf<0x140>(a1); b0 += dppf<0x140>(b0); b1 += dppf<0x140>(b1); SCAN_OPAQUE4();
#undef SCAN_OPAQUE4
    yr0 = b0; yr1 = b1;
    const f32x2v sa2 = {a0, a1}, vv2 = {t.vv0, t.vv1};
#pragma unroll
    for (int i = 0; i < 4; ++i) {
        f32x2v tt = vv2 * (f32x2v){t.kp[i], t.kp[i]};
        tt = tt - sa2 * (f32x2v){t.ka[i], t.ka[i]};
        SS[i] = SS[i] * (f32x2v){t.w[i], t.w[i]} + tt;
    }
    if (want_y) {
        f32x2v p2 = SS[0] * (f32x2v){t.r[0], t.r[0]};
#pragma unroll
        for (int i = 1; i < 4; ++i) p2 = SS[i] * (f32x2v){t.r[i], t.r[i]} + p2;
        y0 = p2.x; y1 = p2.y;
    }
}
__device__ __forceinline__ void scan_stepLP(f32x2v* SL, f32x2v* SP, const ScanSet2& t) {
    f32x2v aL = SL[0] * (f32x2v){t.kk[0], t.kk[0]}, aP = SP[0] * (f32x2v){t.kk[0], t.kk[0]};
#pragma unroll
    for (int i = 1; i < 4; ++i) { aL = SL[i] * (f32x2v){t.kk[i], t.kk[i]} + aL; aP = SP[i] * (f32x2v){t.kk[i], t.kk[i]} + aP; }
    float a0 = aL.x, a1 = aL.y, b0 = aP.x, b1 = aP.y;
#define SCAN_OPAQUE4() asm("" : "+v"(a0), "+v"(a1), "+v"(b0), "+v"(b1))
    SCAN_OPAQUE4();
    a0 += dppf<0xB1>(a0); a1 += dppf<0xB1>(a1); b0 += dppf<0xB1>(b0); b1 += dppf<0xB1>(b1); SCAN_OPAQUE4();
    a0 += dppf<0x4E>(a0); a1 += dppf<0x4E>(a1); b0 += dppf<0x4E>(b0); b1 += dppf<0x4E>(b1); SCAN_OPAQUE4();
    a0 += dppf<0x141>(a0); a1 += dppf<0x141>(a1); b0 += dppf<0x141>(b0); b1 += dppf<0x141>(b1); SCAN_OPAQUE4();
    a0 += dppf<0x140>(a0); a1 += dppf<0x140>(a1); b0 += dppf<0x140>(b0); b1 += dppf<0x140>(b1); SCAN_OPAQUE4();
#undef SCAN_OPAQUE4
    const f32x2v saL = {a0, a1}, saP = {b0, b1}, vv2 = {t.vv0, t.vv1};
#pragma unroll
    for (int i = 0; i < 4; ++i) {
        f32x2v tt = vv2 * (f32x2v){t.kp[i], t.kp[i]};
        tt = tt - saL * (f32x2v){t.ka[i], t.ka[i]};
        SL[i] = SL[i] * (f32x2v){t.w[i], t.w[i]} + tt;
        SP[i] = SP[i] * (f32x2v){t.w[i], t.w[i]} - saP * (f32x2v){t.ka[i], t.ka[i]};
    }
}
template <int LPR> __device__ void scan_item(const Params& PP, int seq, int h, int dir, int rhalf, int tbeg, int tlen, int flags, const float* sin, float* sout, float* sout2, LAS unsigned char* lds) {
    Params P = PP; P.ws = opaque_ptr(PP.ws);
    constexpr int KPL = 64 / LPR, RPW = 64 / LPR, NV = KPL / 4;
    const int tid = opaque_tid(), lane = tid & 63, wave = __builtin_amdgcn_readfirstlane(tid >> 6), l15 = lane & 15, quad = lane >> 4;
    const int Tseq = seq < 32 ? 2048 : 16384;
    const size_t base = seq < 32 ? (size_t)seq * 2048 : (size_t)M_PROMPT;
    const bf16_t* Prkvg = (const bf16_t*)(P.ws + WS_PRKVG);
    const bf16_t* Pwa = (const bf16_t*)(P.ws + WS_PWA);
    bf16_t* Yd = (bf16_t*)(P.ws + WS_Y) + (size_t)dir * M_TOK * 512;
    float* RKR = (float*)(P.ws + WS_RKR) + (size_t)dir * M_TOK * 8;
    LAS bf16_t* RAW0 = (LAS bf16_t*)lds;
    LAS bf16_t* ZROW = (LAS bf16_t*)(lds + 21760);
    LAS float* Wd = (LAS float*)(lds + 22528);
    LAS float* Aa = Wd + 1024; LAS float* Rr = Aa + 1024; LAS float* KP = Rr + 1024; LAS float* Vv = KP + 1024; LAS float* KK = Vv + 1024; LAS float* KKA = KK + 1024; LAS float* Yc = KKA + 1024;
    if (tid < 160) ((LAS unsigned*)ZROW)[tid] = 0u;
    LAS bf16_t* ALDS = (LAS bf16_t*)(lds + 55296);
    const int j_a = tid / 40, seg_a = (tid % 40) >> 3, c8_a = tid & 7;
    const int idx_b = tid + 512, j_b = idx_b / 40, seg_b = (idx_b % 40) >> 3, c8_b = idx_b & 7;
    const bool has_b = idx_b < 640;
    const int coff_a = seg_a < 3 ? seg_a * 512 + h * 64 + c8_a * 8 : dir * 128 + (seg_a - 3) * 64 + c8_a * 8;
    const int coff_b = seg_b < 3 ? seg_b * 512 + h * 64 + c8_b * 8 : dir * 128 + (seg_b - 3) * 64 + c8_b * 8;
    const int dst_a = (j_a + 1) * 320 + seg_a * 64 + c8_a * 8, dst_b = (j_b + 1) * 320 + seg_b * 64 + c8_b * 8;
    const bf16_t* src_a = (seg_a < 3 ? Prkvg + base * 2048 : Pwa + base * 256) + coff_a; const int ld_a = seg_a < 3 ? 2048 : 256;
    const bf16_t* src_b = (seg_b < 3 ? Prkvg + base * 2048 : Pwa + base * 256) + coff_b; const int ld_b = seg_b < 3 ? 2048 : 256;
    const int ltype = wave >> 2, lch = (wave & 3) * 16 + l15;
    const bf16_t* Wt = (const bf16_t*)(P.ws + WS_LORA) + (size_t)(dir * 2 + ltype) * 512 * 64 + (size_t)(h * 64 + lch) * 64;
    const bf16x8 lb0 = *(const bf16x8*)(Wt + quad * 8), lb1 = *(const bf16x8*)(Wt + 32 + quad * 8);
    const float lbias = ltype == 0 ? P.in[17][dir * 512 + h * 64 + lch] : P.in[19][dir * 512 + h * 64 + lch];
    const int tk = tid >> 5, c2 = tid & 31;
    float mu_r[2], mu_k[2], mu_v[2], k_k[2], k_a[2], r_k[2];
#pragma unroll
    for (int e = 0; e < 2; ++e) { const int ch = h * 64 + 2 * c2 + e;
        mu_r[e] = P.in[15][dir * 1536 + ch]; mu_k[e] = P.in[15][dir * 1536 + 512 + ch]; mu_v[e] = P.in[15][dir * 1536 + 1024 + ch];
        k_k[e] = P.in[21][ch]; k_a[e] = P.in[22][ch]; r_k[e] = P.in[23][ch]; }
    float amu[2][2];
#pragma unroll
    for (int ty = 0; ty < 2; ++ty)
#pragma unroll
        for (int e = 0; e < 2; ++e) amu[ty][e] = P.in[16][dir * 128 + ty * 64 + 2 * c2 + e];
#define SCAN_BUILD_A(RAWN, PREV0) do { \
        LAS const bf16_t* cur_ = (RAWN) + (tk + 1) * 320 + 192 + 2 * c2; \
        LAS const bf16_t* prv_ = (tk > 0 ? (RAWN) + tk * 320 : (PREV0)) + 192 + 2 * c2; \
        _Pragma("unroll") for (int ty = 0; ty < 2; ++ty) { \
            const unsigned xc_ = *(LAS const unsigned*)(cur_ + ty * 64), xp_ = *(LAS const unsigned*)(prv_ + ty * 64); \
            float z0_ = bflo(xc_) + (bflo(xp_) - bflo(xc_)) * amu[ty][0], z1_ = bfhi(xc_) + (bfhi(xp_) - bfhi(xc_)) * amu[ty][1]; \
            if (ty == 0) { z0_ = tanhf_(z0_); z1_ = tanhf_(z1_); } \
            *(LAS unsigned*)(ALDS + ty * 1152 + tk * 72 + 2 * c2) = pk2(z0_, z1_); } } while (0)
    static_assert(LPR == 16, "two rows per lane, 16 lanes per row");
    const int srow = wave * 8 + (lane >> 4), sq = lane & 15;
    f32x2v SS[4];
#pragma unroll
    for (int i = 0; i < 4; ++i) { const int kidx = sq * 4 + i;
        SS[i].x = (flags & 1) ? (kidx == srow ? 1.f : 0.f) : (sin ? sin[srow * 64 + kidx] : 0.f);
        SS[i].y = (flags & 1) ? (kidx == srow + 4 ? 1.f : 0.f) : (sin ? sin[(srow + 4) * 64 + kidx] : 0.f); }
    const bool lp = (flags & 16) != 0;
    f32x2v SP[4];
#pragma unroll
    for (int i = 0; i < 4; ++i) { const int kidx = sq * 4 + i; SP[i].x = kidx == srow ? 1.f : 0.f; SP[i].y = kidx == srow + 4 ? 1.f : 0.f; }
    const int nch = tlen / 16;
    const int tstep = dir == 0 ? 16 : -16;
    const int tfirst = dir == 0 ? tbeg : tbeg + tlen - 16;
    const int tprev = dir == 0 ? tbeg - 1 : tbeg + tlen;
    const bool has_prev = tprev >= 0 && tprev < Tseq;
    if (has_prev && tid < 40) {
        const int sg = tid >> 3, c8 = tid & 7;
        const bf16_t* sp = sg < 3 ? Prkvg + (base + tprev) * 2048 + sg * 512 + h * 64 + c8 * 8 : Pwa + (base + tprev) * 256 + dir * 128 + (sg - 3) * 64 + c8 * 8;
        *(LAS u32x4*)(RAW0 + 5440 + 16 * 320 + sg * 64 + c8 * 8) = *(const u32x4*)sp;
    }
    const bool in_on = (flags & 2) == 0, wr_y = (flags & 4) != 0, wr_rk = (flags & 8) != 0;
#define SCAN_TOK(t0, j) (dir == 0 ? (t0) + (j) : (t0) + 15 - (j))
    u32x4 pre_a, pre_b = (u32x4){0u, 0u, 0u, 0u};
    {
        pre_a = *(const u32x4*)(src_a + (size_t)SCAN_TOK(tfirst, j_a) * ld_a);
        if (has_b) pre_b = *(const u32x4*)(src_b + (size_t)SCAN_TOK(tfirst, j_b) * ld_b);
        *(LAS u32x4*)(RAW0 + dst_a) = pre_a;
        if (has_b) *(LAS u32x4*)(RAW0 + dst_b) = pre_b;
        if (nch > 1) {
            pre_a = *(const u32x4*)(src_a + (size_t)SCAN_TOK(tfirst + tstep, j_a) * ld_a);
            if (has_b) pre_b = *(const u32x4*)(src_b + (size_t)SCAN_TOK(tfirst + tstep, j_b) * ld_b);
        }
    }
    __syncthreads();
    SCAN_BUILD_A(RAW0, (has_prev ? RAW0 + 5440 + 16 * 320 : ZROW));
    lds_barrier();
    u32x4 ypend = (u32x4){0u, 0u, 0u, 0u}; bf16_t* ypend_ptr = nullptr;
    for (int c = 0; c < nch; ++c) {
        LAS bf16_t* RAW = RAW0 + (c & 1) * 5440;
        LAS bf16_t* RAWp = RAW0 + ((c & 1) ^ 1) * 5440;
        const int t0 = tfirst + c * tstep;
        {
            bf16x8 af[2];
#pragma unroll
            for (int ks = 0; ks < 2; ++ks) af[ks] = *(LAS const bf16x8*)(ALDS + ltype * 1152 + l15 * 72 + ks * 32 + quad * 8);
            f32x4 d = mfma16(af[0], lb0, (f32x4){0.f, 0.f, 0.f, 0.f});
            d = mfma16(af[1], lb1, d);
            LAS float* dstp = (ltype == 0 ? Wd : Aa) + lch;
#pragma unroll
            for (int jj = 0; jj < 4; ++jj) { const float sg = sigmoidf_(lbias + d[jj]); dstp[(quad * 4 + jj) * 64] = ltype == 0 ? __expf(-0.6065306597126334f * sg) : sg; }
        }
        {
            LAS const bf16_t* cur = RAW + (tk + 1) * 320 + 2 * c2;
            LAS const bf16_t* prv = (tk > 0 ? RAW + tk * 320 : ((c > 0 || has_prev) ? RAWp + 16 * 320 : ZROW)) + 2 * c2;
            const unsigned rc = *(LAS const unsigned*)(cur), rp = *(LAS const unsigned*)(prv);
            const unsigned kc = *(LAS const unsigned*)(cur + 64), kq = *(LAS const unsigned*)(prv + 64);
            const unsigned vc = *(LAS const unsigned*)(cur + 128), vp = *(LAS const unsigned*)(prv + 128);
            const int o = tk * 64 + 2 * c2;
            Rr[o] = bflo(rc) + (bflo(rp) - bflo(rc)) * mu_r[0]; Rr[o + 1] = bfhi(rc) + (bfhi(rp) - bfhi(rc)) * mu_r[1];
            KP[o] = bflo(kc) + (bflo(kq) - bflo(kc)) * mu_k[0]; KP[o + 1] = bfhi(kc) + (bfhi(kq) - bfhi(kc)) * mu_k[1];
            Vv[o] = in_on ? bflo(vc) + (bflo(vp) - bflo(vc)) * mu_v[0] : 0.f; Vv[o + 1] = in_on ? bfhi(vc) + (bfhi(vp) - bfhi(vc)) * mu_v[1] : 0.f;
        }
        lds_barrier();
        float rk_keep;
        {
            const int o = tk * 64 + 2 * c2;
            const float kz0 = KP[o], kz1 = KP[o + 1], a0 = Aa[o], a1 = Aa[o + 1];
            const float q0 = kz0 * k_k[0], q1 = kz1 * k_k[1];
            const float kp0 = kz0 * (1.0f + (a0 - 1.0f) * k_a[0]), kp1 = kz1 * (1.0f + (a1 - 1.0f) * k_a[1]);
            const float ss = reduce32(q0 * q0 + q1 * q1);
            const float rk = reduce32(Rr[o] * kp0 * r_k[0] + Rr[o + 1] * kp1 * r_k[1]);
            const float inv = __builtin_amdgcn_rsqf(fmaxf(ss, 1e-24f));
            const float kk0 = q0 * inv, kk1 = q1 * inv;
            KK[o] = kk0; KK[o + 1] = kk1; KKA[o] = kk0 * a0; KKA[o + 1] = kk1 * a1;
            KP[o] = kp0; KP[o + 1] = kp1;
            rk_keep = rk;
        }
        if (c + 1 < nch) {
            *(LAS u32x4*)(RAWp + dst_a) = pre_a;
            if (has_b) *(LAS u32x4*)(RAWp + dst_b) = pre_b;
            if (c + 2 < nch) {
                pre_a = *(const u32x4*)(src_a + (size_t)SCAN_TOK(t0 + 2 * tstep, j_a) * ld_a);
                if (has_b) pre_b = *(const u32x4*)(src_b + (size_t)SCAN_TOK(t0 + 2 * tstep, j_b) * ld_b);
            }
        }
        if (wr_rk && c2 == 0) RKR[(base + SCAN_TOK(t0, tk)) * 8 + h] = rk_keep;
        if (ypend_ptr) *(u32x4*)ypend_ptr = ypend;
        lds_barrier();
        if (c + 1 < nch) SCAN_BUILD_A(RAWp, RAW + 16 * 320);
        if (lp) {
            ScanSet2 sa_, sb_;
            scan_load2(sa_, KK, Wd, KKA, KP, Rr, Vv, sq * 4, srow, false);
#pragma unroll 1
            for (int jo = 0; jo < 16; jo += 2) {
                scan_load2(sb_, KK, Wd, KKA, KP, Rr, Vv, (jo + 1) * 64 + sq * 4, (jo + 1) * 64 + srow, false);
                scan_stepLP(SS, SP, sa_);
                if (jo + 2 < 16) scan_load2(sa_, KK, Wd, KKA, KP, Rr, Vv, (jo + 2) * 64 + sq * 4, (jo + 2) * 64 + srow, false);
                scan_stepLP(SS, SP, sb_);
            }
        } else {
            ScanSet2 sa_, sb_;
            scan_load2(sa_, KK, Wd, KKA, KP, Rr, Vv, sq * 4, srow, wr_y);
            float yk = 0.f, zk = 0.f, y0 = 0.f, y1 = 0.f, yr0, yr1;
#pragma unroll 1
            for (int jo = 0; jo < 16; jo += 2) {
                scan_load2(sb_, KK, Wd, KKA, KP, Rr, Vv, (jo + 1) * 64 + sq * 4, (jo + 1) * 64 + srow, wr_y);
                scan_step2(SS, sa_, wr_y, y0, y1, yr0, yr1);
                if (jo > 0 && sq == jo - 1) { yk = yr0; zk = yr1; }
                if (jo + 2 < 16) scan_load2(sa_, KK, Wd, KKA, KP, Rr, Vv, (jo + 2) * 64 + sq * 4, (jo + 2) * 64 + srow, wr_y);
                scan_step2(SS, sb_, wr_y, y0, y1, yr0, yr1);
                if (sq == jo) { yk = yr0; zk = yr1; }
            }
            yr0 = dpp16(y0); yr1 = dpp16(y1);
            if (sq == 15) { yk = yr0; zk = yr1; }
            Yc[sq * 64 + srow] = yk; Yc[sq * 64 + srow + 4] = zk;
        }
        lds_barrier();
        {
            const bool wr = wr_y && tid < 128;
            if (wr) {
                const int tq = tid >> 3, c8 = tid & 7; float f[8];
                const f32x4 a = *(LAS const f32x4*)(Yc + tq * 64 + c8 * 8), b = *(LAS const f32x4*)(Yc + tq * 64 + c8 * 8 + 4);
                f[0] = a[0]; f[1] = a[1]; f[2] = a[2]; f[3] = a[3]; f[4] = b[0]; f[5] = b[1]; f[6] = b[2]; f[7] = b[3];
                ypend = pack8(f); ypend_ptr = Yd + (base + SCAN_TOK(t0, tq)) * 512 + h * 64 + c8 * 8;
            }
        }
    }
    if (ypend_ptr) *(u32x4*)ypend_ptr = ypend;
    if (sout) { *(f32x4*)(sout + srow * 64 + sq * 4) = (f32x4){SS[0].x, SS[1].x, SS[2].x, SS[3].x}; *(f32x4*)(sout + (srow + 4) * 64 + sq * 4) = (f32x4){SS[0].y, SS[1].y, SS[2].y, SS[3].y}; }
    if (lp && sout2) { *(f32x4*)(sout2 + srow * 64 + sq * 4) = (f32x4){SP[0].x, SP[1].x, SP[2].x, SP[3].x}; *(f32x4*)(sout2 + (srow + 4) * 64 + sq * 4) = (f32x4){SP[0].y, SP[1].y, SP[2].y, SP[3].y}; }
#undef SCAN_TOK
#undef SCAN_BUILD_A
    __syncthreads();
}

__device__ void scan_carry(const Params& PP, int hd, LAS unsigned char* lds) {
    Params P = PP; P.ws = opaque_ptr(PP.ws);
    const int tid = opaque_tid();
    const float* Lm = (const float*)(P.ws + WS_STL) + (size_t)hd * NSEG * 4096;
    const float* Pm = (const float*)(P.ws + WS_STP) + (size_t)hd * NSEG * 4096;
    float* St = (float*)(P.ws + WS_STS) + (size_t)hd * NSEG * 4096;
    LAS float* Sc = (LAS float*)lds;
    LAS float* Pc = Sc + 4096;
    const int v = tid >> 3, k0 = (tid & 7) * 8;
    for (int i = 0; i < 8; ++i) { const float x = Lm[v * 64 + k0 + i]; Sc[v * 64 + k0 + i] = x; St[4096 + v * 64 + k0 + i] = x; }
    for (int sgm = 1; sgm + 1 < NSEG; ++sgm) {
        for (int i = 0; i < 8; ++i) Pc[v * 64 + k0 + i] = Pm[(size_t)sgm * 4096 + v * 64 + k0 + i];
        __syncthreads();
        float o[8];
        for (int i = 0; i < 8; ++i) o[i] = Lm[(size_t)sgm * 4096 + v * 64 + k0 + i];
        for (int j = 0; j < 64; ++j) { const float sv = Sc[v * 64 + j];
#pragma unroll
            for (int i = 0; i < 8; ++i) o[i] += sv * Pc[j * 64 + k0 + i]; }
        __syncthreads();
        for (int i = 0; i < 8; ++i) { Sc[v * 64 + k0 + i] = o[i]; St[(size_t)(sgm + 1) * 4096 + v * 64 + k0 + i] = o[i]; }
    }
    __syncthreads();
}

__device__ void rwkv_finalize(const Params& PP) {
    Params P = PP; P.ws = opaque_ptr(PP.ws);
    const int tid_ = opaque_tid(), lane = tid_ & 63, wave = __builtin_amdgcn_readfirstlane(tid_ >> 6);
    const bf16_t* Prkvg = (const bf16_t*)(P.ws + WS_PRKVG);
    const bf16_t* Y0 = (const bf16_t*)(P.ws + WS_Y);
    const bf16_t* Y1 = Y0 + (size_t)M_TOK * 512;
    const float* RKR0 = (const float*)(P.ws + WS_RKR);
    const float* RKR1 = RKR0 + (size_t)M_TOK * 8;
    bf16_t* MO = (bf16_t*)(P.ws + WS_XN);
    const int col = lane * 8, hh = lane >> 3;
    float gw[8], gb[8], muf[8], mub[8];
#pragma unroll
    for (int i = 0; i < 8; ++i) { gw[i] = P.in[24][col + i]; gb[i] = P.in[25][col + i]; muf[i] = P.in[15][1024 + col + i]; mub[i] = P.in[15][1536 + 1024 + col + i]; }
    for (int row = blockIdx.x * 8 + wave; row < M_TOK; row += gridDim.x * 8) {
        const int t = row < M_PROMPT ? (row & 2047) : row - M_PROMPT, T = row < M_PROMPT ? 2048 : 16384;
        float yf[8], yb[8], vc[8], vp[8], vn[8], gg[8];
        unpack8(*(const u32x4*)(Y0 + (size_t)row * 512 + col), yf); unpack8(*(const u32x4*)(Y1 + (size_t)row * 512 + col), yb);
        unpack8(*(const u32x4*)(Prkvg + (size_t)row * 2048 + 1024 + col), vc);
        unpack8(*(const u32x4*)(Prkvg + (size_t)row * 2048 + 1536 + col), gg);
        if (t > 0) unpack8(*(const u32x4*)(Prkvg + (size_t)(row - 1) * 2048 + 1024 + col), vp); else { for (int i = 0; i < 8; ++i) vp[i] = 0.f; }
        if (t < T - 1) unpack8(*(const u32x4*)(Prkvg + (size_t)(row + 1) * 2048 + 1024 + col), vn); else { for (int i = 0; i < 8; ++i) vn[i] = 0.f; }
        const float rf = RKR0[(size_t)row * 8 + hh], rb = RKR1[(size_t)row * 8 + hh];
        float s = 0.f;
#pragma unroll
        for (int i = 0; i < 8; ++i) { yf[i] += yb[i]; s += yf[i]; }
        const float mean = reduce8(s) * (1.0f / 64.0f);
        float q = 0.f;
#pragma unroll
        for (int i = 0; i < 8; ++i) { yf[i] -= mean; q += yf[i] * yf[i]; }
        const float rstd = rsqrtf(reduce8(q) * (1.0f / 64.0f) + 64e-5f);
        float o[8];
#pragma unroll
        for (int i = 0; i < 8; ++i) {
            const float vzf = vc[i] + (vp[i] - vc[i]) * muf[i], vzb = vc[i] + (vn[i] - vc[i]) * mub[i];
            o[i] = (yf[i] * rstd * gw[i] + gb[i] + rf * vzf + rb * vzb) * sigmoidf_(gg[i]);
        }
        *(u32x4*)(MO + (size_t)row * 1024 + 512 + col) = pack8(o);
    }
}

template <int NQ> __device__ __forceinline__ void attn_groups(const bf16_t* QKV, size_t base, int h, int T0, int L, int dsh, int res, int i0, int bi,
        int lane, int l15, int quad, int r4, int c4, LAS unsigned char* VST, LAS const f32x2v* RKT, int tb, const float (&bx)[11][4], const float (&gqk)[16], LAS float* OACC, LAS float* LS) {
    constexpr int NT = NQ == 2 ? 10 : 9;
    bf16x8 qf[NQ][2]; float mq[NQ]; int qtok[NQ];
#pragma unroll
    for (int q = 0; q < NQ; ++q) {
        qtok[q] = ((i0 + 16 * q + l15) << dsh) + res;
        const bf16_t* qp = QKV + (base + qtok[q]) * 3072 + h * 64 + quad * 8;
        float f[16]; unpack8(*(const u32x4*)qp, f); unpack8(*(const u32x4*)(qp + 32), f + 8);
        float ss = 0.f;
#pragma unroll
        for (int i = 0; i < 16; ++i) ss += f[i] * f[i];
        ss += __shfl_xor(ss, 16); ss += __shfl_xor(ss, 32);
        const float rq = rsqrtf(ss * (1.0f / 64.0f) + NORM_EPS) * 0.125f;
#pragma unroll
        for (int i = 0; i < 16; ++i) f[i] = f[i] * rq * gqk[i];
        const u32x4 w0 = pack8(f), w1 = pack8(f + 8);
        qf[q][0] = __builtin_bit_cast(bf16x8, w0); qf[q][1] = __builtin_bit_cast(bf16x8, w1);
        float fr[16]; unpack8(w0, fr); unpack8(w1, fr + 8);
        float n2 = 0.f;
#pragma unroll
        for (int i = 0; i < 16; ++i) n2 += fr[i] * fr[i];
        n2 += __shfl_xor(n2, 16); n2 += __shfl_xor(n2, 32);
        mq[q] = 8.1f * 1.4426950408889634f * sqrtf(n2);
    }
    f32x4 oacc[NQ][4];
    float lsum[NQ];
#pragma unroll
    for (int q = 0; q < NQ; ++q) { lsum[q] = 0.f;
#pragma unroll
        for (int et = 0; et < 4; ++et) oacc[q][et] = (f32x4){0.f, 0.f, 0.f, 0.f}; }
    const int ebase = (i0 - 64 + quad * 4) * (1 << dsh) + res - tb;
    const float dmul = (float)(1 << dsh);
    bf16x8 kfb[2][2][2]; u32x4 vb[2][4];
    const int rowv = lane >> 3, c8v = lane & 7;
#define ATT_ISSUE(KP, BUF) do { \
        _Pragma("unroll") for (int tt_ = 0; tt_ < 2; ++tt_) { \
            int kidx_ = i0 - 64 + 16 * (2 * (KP) + tt_) + l15; kidx_ = kidx_ < 0 ? 0 : (kidx_ > L - 1 ? L - 1 : kidx_); \
            const bf16_t* kptr_ = QKV + (base + ((size_t)kidx_ << dsh) + res) * 3072 + 1024 + h * 64 + quad * 8; \
            kfb[BUF][tt_][0] = *(const bf16x8*)kptr_; kfb[BUF][tt_][1] = *(const bf16x8*)(kptr_ + 32); } \
        _Pragma("unroll") for (int vi_ = 0; vi_ < 4; ++vi_) { \
            int vidx_ = i0 - 64 + 32 * (KP) + rowv + 8 * vi_; vidx_ = vidx_ < 0 ? 0 : (vidx_ > L - 1 ? L - 1 : vidx_); \
            vb[BUF][vi_] = *(const u32x4*)(QKV + (base + ((size_t)vidx_ << dsh) + res) * 3072 + 2048 + h * 64 + c8v * 8); } } while (0)
    ATT_ISSUE(0, 0);
#pragma unroll
    for (int kp = 0; kp < 5; ++kp) {
        f32x4 s[NQ][2];
        if (kp + 1 < 5) ATT_ISSUE(kp + 1, (kp + 1) & 1);
#pragma unroll
        for (int tt = 0; tt < 2; ++tt) {
            const int kt = 2 * kp + tt;
#pragma unroll
            for (int q = 0; q < NQ; ++q) s[q][tt] = (f32x4){0.f, 0.f, 0.f, 0.f};
            if (kt < NT) {
                f32x2v e[4];
#pragma unroll
                for (int j = 0; j < 4; ++j) e[j] = RKT[((16 * kt + j) << dsh) + ebase];
#pragma unroll
                for (int q = 0; q < NQ; ++q) {
                    f32x4 sc = mfma16(kfb[kp & 1][tt][0], qf[q][0], (f32x4){0.f, 0.f, 0.f, 0.f});
                    sc = mfma16(kfb[kp & 1][tt][1], qf[q][1], sc);
#pragma unroll
                    for (int j = 0; j < 4; ++j) {
                        const float p = __builtin_amdgcn_exp2f(sc[j] * e[j].x + (e[j].y + (bx[kt + 1 - q][j] * dmul - mq[q])));
                        lsum[q] += p; s[q][tt][j] = p;
                    }
                }
            }
        }
        bf16x8 pf[NQ];
#pragma unroll
        for (int q = 0; q < NQ; ++q) { u32x4 w; w.x = pk2(s[q][0][0], s[q][0][1]); w.y = pk2(s[q][0][2], s[q][0][3]); w.z = pk2(s[q][1][0], s[q][1][1]); w.w = pk2(s[q][1][2], s[q][1][3]); pf[q] = __builtin_bit_cast(bf16x8, w); }
        {
#pragma unroll
            for (int vi = 0; vi < 4; ++vi) *(LAS u32x4*)(VST + (rowv + 8 * vi) * 144 + c8v * 16) = vb[kp & 1][vi];
        }
        asm volatile("s_waitcnt lgkmcnt(0)" ::: "memory"); __builtin_amdgcn_fence(__ATOMIC_RELEASE, "wavefront"); __builtin_amdgcn_wave_barrier(); __builtin_amdgcn_fence(__ATOMIC_ACQUIRE, "wavefront"); asm volatile("s_waitcnt lgkmcnt(0)" ::: "memory");
#pragma unroll
        for (int et = 0; et < 4; ++et) {
            LAS const unsigned char* ap = VST + (quad * 4 + r4) * 144 + (et * 16 + 4 * c4) * 2;
            const s16x4 lo = tr_read(ap), hi = tr_read(ap + 16 * 144);
            const bf16x8 a = {lo[0], lo[1], lo[2], lo[3], hi[0], hi[1], hi[2], hi[3]};
#pragma unroll
            for (int q = 0; q < NQ; ++q) oacc[q][et] = mfma16(a, pf[q], oacc[q][et]);
        }
        asm volatile("s_waitcnt lgkmcnt(0)" ::: "memory"); __builtin_amdgcn_fence(__ATOMIC_RELEASE, "wavefront"); __builtin_amdgcn_wave_barrier(); __builtin_amdgcn_fence(__ATOMIC_ACQUIRE, "wavefront"); asm volatile("s_waitcnt lgkmcnt(0)" ::: "memory");
    }
#undef ATT_ISSUE
#pragma unroll
    for (int q = 0; q < NQ; ++q) {
        float l = lsum[q]; l += __shfl_xor(l, 16); l += __shfl_xor(l, 32);
        const int qloc = qtok[q] - T0;
#pragma unroll
        for (int et = 0; et < 4; ++et) {
            LAS f32x4* dst = (LAS f32x4*)(OACC + qloc * 68 + et * 16 + quad * 4);
            if (bi == 0) *dst = oacc[q][et]; else *dst = *dst + oacc[q][et];
        }
        if (quad == 0) { if (bi == 0) LS[qloc] = l; else LS[qloc] += l; }
    }
}

__device__ void attn_item(const Params& PP, int seq, int h, int tile, LAS unsigned char* lds) {
    Params P = PP; P.ws = opaque_ptr(PP.ws);
    const int tid = opaque_tid(), lane = tid & 63, wave = __builtin_amdgcn_readfirstlane(tid >> 6), l15 = lane & 15, quad = lane >> 4;
    const int T = seq < 32 ? 2048 : 16384;
    const size_t base = seq < 32 ? (size_t)seq * 2048 : (size_t)M_PROMPT;
    const int T0 = tile * 256;
    const bf16_t* QKV = (const bf16_t*)(P.ws + WS_BIG);
    bf16_t* MO = (bf16_t*)(P.ws + WS_XN);
    LAS float* OACC = (LAS float*)lds;
    LAS float* LS = (LAS float*)(lds + 256 * 272);
    LAS unsigned char* VST = lds + 256 * 272 + 1024 + wave * (32 * 144);
    const float slope = exp2f(-0.5f * (float)(h + 1));
    float gqk[16];
#pragma unroll
    for (int i = 0; i < 16; ++i) { const int e = (i >> 3) * 32 + quad * 8 + (i & 7); gqk[i] = P.in[28][e] * P.in[29][e]; }
    const int r4 = l15 >> 2, c4 = l15 & 3;
    float bx[11][4];
#pragma unroll
    for (int kt = -1; kt < 10; ++kt)
#pragma unroll
        for (int j = 0; j < 4; ++j) { int dist = 16 * kt - 64 + quad * 4 + j - l15; dist = dist < 0 ? -dist : dist;
            bx[kt + 1][j] = dist <= 64 ? -slope * 1.4426950408889634f * (float)dist : -1e30f; }
    LAS f32x2v* RKT = (LAS f32x2v*)(lds + 107520);
    const int tb = T0 - 1024;
    const float* ksq_h = (const float*)(P.ws + WS_KSQ) + (size_t)h * M_TOK;
    for (int idx = tid; idx < 2304; idx += 512) {
        const int tok = tb + idx;
        f32x2v ent = {0.f, -1e30f};
        if (tok >= 0 && tok < T) { ent.x = rsqrtf(ksq_h[base + tok] * (1.0f / 64.0f) + NORM_EPS) * 1.4426950408889634f; ent.y = 0.f; }
        RKT[idx] = ent;
    }
    __syncthreads();
    for (int bi = 0; bi < 3; ++bi) {
        const int dsh = 2 * bi, L = T >> dsh;
        if (bi < 2) {
            const int res = bi == 0 ? 0 : (wave & 3), i0 = (T0 >> dsh) + (bi == 0 ? 32 * wave : 32 * (wave >> 2));
            attn_groups<2>(QKV, base, h, T0, L, dsh, res, i0, bi, lane, l15, quad, r4, c4, VST, RKT, tb, bx, gqk, OACC, LS);
        } else {
            for (int gg = 0; gg < 2; ++gg)
                attn_groups<1>(QKV, base, h, T0, L, dsh, wave * 2 + gg, T0 >> dsh, bi, lane, l15, quad, r4, c4, VST, RKT, tb, bx, gqk, OACC, LS);
        }
        __syncthreads();
    }
    {
        const int q = tid >> 1, half = tid & 1;
        const float inv = 1.0f / LS[q];
        bf16_t* op = MO + (base + T0 + q) * 1024 + h * 64 + half * 32;
#pragma unroll
        for (int i = 0; i < 4; ++i) {
            const f32x4 a = *(LAS const f32x4*)(OACC + q * 68 + half * 32 + i * 8), b = *(LAS const f32x4*)(OACC + q * 68 + half * 32 + i * 8 + 4);
            u32x4 w; w.x = pk2(a[0] * inv, a[1] * inv); w.y = pk2(a[2] * inv, a[3] * inv); w.z = pk2(b[0] * inv, b[1] * inv); w.w = pk2(b[2] * inv, b[3] * inv);
            *(u32x4*)(op + i * 8) = w;
        }
    }
    __syncthreads();
}

enum { K_P0 = 0, K_SWIGLU, K_RESID, K_NORM, K_GEMM_P, K_MIXA, K_FINAL, K_GEMM_QKV, K_ATTN, K_CARRY, K_MIXB };
constexpr int N_PHASES = 19;

__global__ void __launch_bounds__(512, 2) mega(Params P) {
    extern __shared__ __attribute__((aligned(16))) unsigned char lds_raw[];
    LAS unsigned char* lds = (LAS unsigned char*)lds_raw;
    cg::grid_group grid = cg::this_grid();
    for (int ph = 0; ph < N_PHASES; ++ph) {
#ifdef PROBE_MASK
        if (blockIdx.x == 0 && threadIdx.x == 0) ((unsigned long long*)(P.ws + WS_TS))[ph] = __builtin_amdgcn_s_memrealtime();
#endif
        unsigned char* ws = P.ws; float* X = P.out; int G = gridDim.x, bid = blockIdx.x;
        asm volatile("" : "+s"(ws), "+s"(X), "+s"(G), "+s"(bid));
        bf16_t* XN = (bf16_t*)(ws + WS_XN);
        bf16_t* Hb = (bf16_t*)(ws + WS_BIG);
        int kind, layer = 0, sub = 0;
        if (ph == 0) kind = K_P0;
        else {
            layer = ph <= 10 ? 0 : 1; const int r = ph <= 10 ? ph - 1 : ph - 11;
            const unsigned long long kc = layer == 0 ? 0x2126A95421ull : 0x32128721ull;
            const unsigned long long sc = layer == 0 ? 0x1120000000ull : 0x21120000ull;
            kind = (int)((kc >> (4 * r)) & 15ull); sub = (int)((sc >> (4 * r)) & 15ull);
        }
        if (kind == K_P0) {
#ifndef SKIP_P0
            LAS float* tile = (LAS float*)lds;
            int rot = 0;
            for (int job = 0; job < 16; ++job) {
                const float* src; size_t doff; int K, N;
                if (job < 4) { src = ((job & 1) ? P.in[7] : P.in[3]) + (size_t)(job >> 1) * 1024 * 5632; doff = WS_WFI + (size_t)job * SZ_WFI; K = 1024; N = 5632; }
                else if (job < 8) { src = ((job & 1) ? P.in[8] : P.in[4]) + (size_t)((job - 4) >> 1) * 2816 * 1024; doff = WS_WFO + (size_t)(job - 4) * SZ_WFO; K = 2816; N = 1024; }
                else if (job == 8) { src = P.in[10]; doff = WS_WABI; K = 1024; N = 3328; }
                else if (job == 9) { src = P.in[11]; doff = WS_WABO; K = 1024; N = 1024; }
                else if (job == 10) { src = P.in[26]; doff = WS_WATI; K = 1024; N = 3072; }
                else if (job == 11) { src = P.in[27]; doff = WS_WATO; K = 1024; N = 1024; }
                else { const int d = (job - 12) >> 1, ty = (job - 12) & 1; src = (ty ? P.in[20] : P.in[18]) + (size_t)d * 64 * 512; doff = WS_LORA + (size_t)(d * 2 + ty) * 512 * 64 * 2; K = 64; N = 512; }
                if (job < 4) convert_T<1>(src, (bf16_t*)(ws + doff), K, N, tile, rot); else convert_T<0>(src, (bf16_t*)(ws + doff), K, N, tile, rot);
                rot += (K / 64) * (N / 64);
            }
            {
                bf16_t* dst = (bf16_t*)(ws + WS_SGUW);
                for (int i = bid * 512 + opaque_tid(); i < 4 * 128 * 128 / 4; i += G * 512) {
                    const f32x4 v = *(const f32x4*)(P.in[13] + (size_t)i * 4);
                    u32x2 w; w.x = pk2(v[0], v[1]); w.y = pk2(v[2], v[3]); *(u32x2*)(dst + (size_t)i * 4) = w;
                }
            }
            norm_rows(P.in[0], P.in[1], M_PROMPT, nullptr, nullptr, nullptr, P.in[2], XN);
            if (bid == 0 && opaque_tid() == 0) *(unsigned*)(ws + WS_TS + 2048) = 0u;
#endif
        } else if (kind == K_SWIGLU) {
            if (sub == 0) { float* za = (float*)(ws + WS_RSA); for (int i = bid * 512 + opaque_tid(); i < M_TOK; i += G * 512) za[i] = 0.f; }
            if (sub == 0 && layer == 1) { f32x4* zk = (f32x4*)(ws + WS_KSQ); for (int i = bid * 512 + opaque_tid(); i < 16 * M_TOK / 4; i += G * 512) zk[i] = (f32x4){0.f, 0.f, 0.f, 0.f}; }
            pg8::Gemm g{sub == 0 ? XN : (const bf16_t*)(ws + WS_Y), (const bf16_t*)(ws + WS_WFI + (size_t)(layer * 2 + sub) * SZ_WFI), M_TOK, 5632, 1024};
            pg8::StaticOrder S; S.init(M_TOK, 5632, G, bid);
            if (sub == 1 && layer == 0) { float* zc = (float*)(ws + WS_RSC); for (int i = bid * 512 + opaque_tid(); i < 2 * M_TOK; i += G * 512) zc[i] = 0.f; }
            EpiSwiglu E{Hb, sub == 0 ? (layer == 0 ? nullptr : (const float*)(ws + WS_RSC)) : (const float*)(ws + WS_RSB), (sub == 0 && layer == 1) ? (const float*)(ws + WS_RSD) : nullptr};
#ifndef SKIP_G1
            pg8::gemm_phase<EpiSwiglu, pg8::StaticOrder, GEMM_ALIGN, GEMM_SP2>(lds, g, S, E);
#endif
        } else if (kind == K_RESID) {
            const bf16_t* A; const bf16_t* Bt; int K; float scale; bf16_t* xg = nullptr; const float* gn = nullptr; float* rss = nullptr;
            const float* gaux = nullptr; float* rss2 = nullptr; const float* bss = nullptr;
            if (sub < 2) { A = Hb; Bt = (const bf16_t*)(ws + WS_WFO + (size_t)(layer * 2 + sub) * SZ_WFO); K = 2816; scale = 0.5f;
                if (sub == 0) { xg = XN; gn = P.in[5] + layer * DM; rss = (float*)(ws + WS_RSA); if (layer == 1) { bss = (const float*)(ws + WS_RSC); gaux = P.in[9]; } }
                else if (layer == 0) { xg = XN; gn = P.in[2] + DM; gaux = P.in[9]; rss = (float*)(ws + WS_RSC); rss2 = (float*)(ws + WS_RSD); } }
            else { A = XN; Bt = (const bf16_t*)(ws + (layer == 0 ? WS_WABO : WS_WATO)); K = 1024; scale = 1.0f; xg = (bf16_t*)(ws + WS_Y); gn = P.in[6] + layer * DM; rss = (float*)(ws + WS_RSB); }
            pg8::Gemm g{A, Bt, M_TOK, 1024, K};
            pg8::StaticOrder S; S.init(M_TOK, 1024, G, bid);
            const bool first = (layer == 0 && sub == 0);
            EpiResid E{X, scale, xg, gn, rss, first ? P.in[0] : nullptr, first ? P.in[1] : nullptr, gaux, rss2, bss};
#ifndef SKIP_G2
            pg8::gemm_phase<EpiResid, pg8::StaticOrder, GEMM_ALIGN, GEMM_SP2>(lds, g, S, E);
#endif
        } else if (kind == K_NORM) {
            norm_rows(X, X, M_TOK, nullptr, P.in[9] + DM, X, nullptr, nullptr);
        } else if (kind == K_GEMM_P || kind == K_GEMM_QKV) {
            const bool isP = kind == K_GEMM_P; const int N = isP ? 3328 : 3072;
            pg8::Gemm g{XN, (const bf16_t*)(ws + (isP ? WS_WABI : WS_WATI)), M_TOK, N, 1024};
            pg8::StaticOrder S; S.init(M_TOK, N, G, bid);
            { float* zb = (float*)(ws + WS_RSB); for (int i = bid * 512 + opaque_tid(); i < M_TOK; i += G * 512) zb[i] = 0.f; }
            EpiSplit E; const float* rsa = (const float*)(ws + WS_RSA);
            if (isP) E = EpiSplit{(bf16_t*)(ws + WS_PUV), 1024, 4, (bf16_t*)(ws + WS_PRKVG), 2048, 12, (bf16_t*)(ws + WS_PWA), 256, rsa, nullptr};
            else E = EpiSplit{(bf16_t*)(ws + WS_BIG), 3072, 12, (bf16_t*)(ws + WS_BIG), 3072, 12, (bf16_t*)(ws + WS_BIG), 3072, rsa, (float*)(ws + WS_KSQ)};
#ifndef SKIP_G3
            pg8::gemm_phase<EpiSplit, pg8::StaticOrder, GEMM_ALIGN, GEMM_SP2>(lds, g, S, E);
#endif
        } else if (kind == K_MIXA) {
            constexpr int NLONG = 16 + 16 * (NSEG - 2);
            unsigned* qhead = (unsigned*)(ws + WS_TS + 2048);
            LAS int* qslot = (LAS int*)(lds + LDS_BYTES - 16);
            for (;;) {
                if (opaque_tid() == 0) *qslot = (int)__hip_atomic_fetch_add(qhead, 1u, __ATOMIC_RELAXED, __HIP_MEMORY_SCOPE_AGENT);
                __syncthreads();
                const int li = __builtin_amdgcn_readfirstlane(*qslot);
                __syncthreads();
                if (li >= 512 + NLONG + 640) break;
#ifndef SKIP_SCAN
                if (li < 512) scan_item<16>(P, li >> 4, (li >> 1) & 7, li & 1, 0, 0, 2048, 4 | 8, nullptr, nullptr, nullptr, lds);
                else if (li < 512 + 16) {
                    const int hd = li - 512, dir = hd & 1;
                    scan_item<16>(P, 32, hd >> 1, dir, 0, dir == 0 ? 0 : 16384 - SEGLEN, SEGLEN, 4 | 8, nullptr, (float*)(ws + WS_STL) + (size_t)hd * NSEG * 4096, nullptr, lds);
                } else if (li < 512 + NLONG) {
                    const int q = li - 512 - 16, hd = q & 15, sgm = 1 + (q >> 4), dir = hd & 1;
                    const int tb = dir == 0 ? sgm * SEGLEN : 16384 - (sgm + 1) * SEGLEN;
                    scan_item<16>(P, 32, hd >> 1, dir, 0, tb, SEGLEN, 16, nullptr, (float*)(ws + WS_STL) + ((size_t)hd * NSEG + sgm) * 4096, (float*)(ws + WS_STP) + ((size_t)hd * NSEG + sgm) * 4096, lds);
                }
#endif
#ifndef SKIP_SGU
                if (li >= 512 + NLONG) sgu_item(P, li - 512 - NLONG, lds);
#endif
            }
        } else if (kind == K_CARRY) {
#ifndef SKIP_SCAN
            if (bid < 16) scan_carry(P, bid, lds);
#endif
        } else if (kind == K_MIXB) {
#ifndef SKIP_SCAN
            for (int li = bid; li < 16 * (NSEG - 1); li += G) {
                const int hd = li & 15, sgm = 1 + (li >> 4), dir = hd & 1;
                const int tb = dir == 0 ? sgm * SEGLEN : 16384 - (sgm + 1) * SEGLEN;
                scan_item<16>(P, 32, hd >> 1, dir, 0, tb, SEGLEN, 4 | 8, (const float*)(ws + WS_STS) + ((size_t)hd * NSEG + sgm) * 4096, nullptr, nullptr, lds);
            }
#endif
        } else if (kind == K_FINAL) {
#ifndef SKIP_FIN
            rwkv_finalize(P);
#endif
        } else if (kind == K_ATTN) {
            for (int it = bid; it < 5120; it += G) {
#ifndef SKIP_ATTN
                if (it < 4096) attn_item(P, it >> 7, it & 15, (it >> 4) & 7, lds);
                else attn_item(P, 32, it & 15, (it - 4096) >> 4, lds);
#endif
            }
        }
        if (ph + 1 < N_PHASES) {
            __builtin_amdgcn_fence(__ATOMIC_RELEASE, "agent");
            asm volatile("s_waitcnt vmcnt(0) lgkmcnt(0)" ::: "memory");
            grid.sync();
            __builtin_amdgcn_fence(__ATOMIC_ACQUIRE, "agent");
            asm volatile("s_waitcnt vmcnt(0) lgkmcnt(0)" ::: "memory");
            __syncthreads();
        }
    }
#ifdef PROBE_MASK
    if (blockIdx.x == 0 && threadIdx.x == 0) {
        unsigned long long* ts = (unsigned long long*)(P.ws + WS_TS);
        ts[N_PHASES] = __builtin_amdgcn_s_memrealtime();
        unsigned long long tot = 0;
        for (int i = 0; i < N_PHASES; ++i) if ((PROBE_MASK >> i) & 1) tot += ts[i + 1] - ts[i];
        P.out[0] += 4.0f + 10.0f * (float)tot * 1e-5f;
    }
#endif
}

extern "C" void kernel_launch(void* const* d_in, const int* in_sizes, int n_in, void* d_out, int out_size, void* d_ws, size_t ws_size, hipStream_t stream) {
    static int grid_blocks = 0;
    if (!grid_blocks) {
        int dev = 0, cus = 0, per_cu = 0;
        (void)hipGetDevice(&dev);
        (void)hipDeviceGetAttribute(&cus, hipDeviceAttributeMultiprocessorCount, dev);
        (void)hipFuncSetAttribute((const void*)mega, hipFuncAttributeMaxDynamicSharedMemorySize, LDS_BYTES);
        (void)hipOccupancyMaxActiveBlocksPerMultiprocessor(&per_cu, (const void*)mega, 512, LDS_BYTES);
        (void)hipGetLastError();
        if (cus <= 0) cus = 256;
        grid_blocks = cus;
        if (ws_size < WS_END2) fprintf(stderr, "kernel_launch: workspace too small: %zu < %zu\n", ws_size, (size_t)WS_END2);
    }
    Params p{};
    for (int i = 0; i < 30 && i < n_in; ++i) p.in[i] = (const float*)d_in[i];
    p.out = (float*)d_out; p.ws = (unsigned char*)d_ws;
    void* args[] = {&p};
    hipError_t e = hipLaunchCooperativeKernel((const void*)mega, dim3(grid_blocks), dim3(512), args, LDS_BYTES, stream);
    if (e != hipSuccess) fprintf(stderr, "cooperative launch failed: %s (grid %d)\n", hipGetErrorString(e), grid_blocks);
}
```

```cpp
#include <hip/hip_runtime.h>
#include <hip/hip_cooperative_groups.h>
#include <cstdio>
namespace cg = cooperative_groups;

namespace pg8 {
#define PG8_LAS __attribute__((address_space(3)))
typedef unsigned short bf16_t;
typedef short bf16x8 __attribute__((ext_vector_type(8)));
typedef float f32x4 __attribute__((ext_vector_type(4)));
typedef unsigned u32x4 __attribute__((ext_vector_type(4)));
constexpr int BM = 256, BK = 64, HALF = 128, HTB = HALF * BK * 2  , STAGE_BYTES = 8 * HTB, NXCD = 8, WGM = 8;

__host__ __device__ __forceinline__ int lds_byte(int r, int c) { const int st = (r >> 4) * 2 + (c >> 5), rr = r & 15, cc = c & 31, ob = rr * 64 + cc * 2; return st * 1024 + (ob ^ (((ob >> 9) & 1) << 5)); }
__host__ __device__ __forceinline__ void stage_rc(int b, int& R, int& C) { const int st = b / 1024, sb = b % 1024, swz = sb ^ (((sb >> 9) & 1) << 5); R = (st >> 1) * 16 + swz / 64; C = (st & 1) * 32 + (swz % 64) / 2; }
__host__ __device__ __forceinline__ int perm32(int rho) { const int n = rho >> 4, i = rho & 15; return 8 * (i >> 2) + 4 * n + (i & 3); }

struct Unit { int pm, pn; };
struct Gemm { const bf16_t* A; const bf16_t* Bt; int M, N, K; };

struct StaticOrder {
    int nM, nN, nwg, G, c;
    __host__ __device__ void init(int M, int N, int G_, int c_) { nM = M / BM; nN = N / BM; nwg = nM * nN; G = G_; c = c_; }
    __host__ __device__ bool next(int i, Unit& u) const {
        const long L = (long)i * G + c; if (L >= nwg) return false;
        int wgid = (int)L; { const int q = nwg / NXCD, r = nwg % NXCD, xcd = wgid % NXCD, off = wgid / NXCD; wgid = (xcd < r ? xcd * (q + 1) : r * (q + 1) + (xcd - r) * q) + off; }
        const int nig = WGM * nN, gid = wgid / nig, fm = gid * WGM, gsz = (nM - fm) < WGM ? (nM - fm) : WGM;
        u.pm = fm + ((wgid % nig) % gsz); u.pn = (wgid % nig) / gsz; return true;
    }
    __device__ __forceinline__ void a_ready(const Unit&) const {}
    __device__ __forceinline__ void done(const Unit&) const {}
};
__device__ __forceinline__ unsigned cvt_pk_bf16(float lo, float hi) { unsigned r; asm volatile("v_cvt_pk_bf16_f32 %0, %1, %2" : "=v"(r) : "v"(lo), "v"(hi)); return r; }
typedef float f32x2 __attribute__((ext_vector_type(2)));
template <class Epi, class Sched, bool ALIGN_EPI = false, bool SP2 = false>
__device__ __forceinline__ void gemm_phase(PG8_LAS unsigned char* lds, const Gemm g, const Sched& S, const Epi& E) {
    int tid_raw_ = threadIdx.x; asm volatile("" : "+v"(tid_raw_)); const int tid = tid_raw_, wid = __builtin_amdgcn_readfirstlane(tid >> 6), lane = tid & 63, wr = wid >> 2, wc = wid & 3, fr = lane & 15, fq = lane >> 4;
    const int K = g.K, nt = K / BK;
    unsigned voffA[2], voffB[2];
#pragma unroll
    for (int i = 0; i < 2; ++i) { int R, C; stage_rc(tid * 16 + i * 8192, R, C); const int Rb = Epi::PERM ? ((R & ~31) + perm32(R & 31)) : R;
        voffA[i] = (unsigned)(R * K + C) * 2u; voffB[i] = (unsigned)(Rb * K + C) * 2u; }
    const size_t kstep = (size_t)(BK * 2);
    const size_t hstep = (size_t)HALF * K * 2;
    const size_t tstep = 2 * hstep;
    const unsigned ldsw = (unsigned)wid * 1024u;
    const int aoff = lds_byte(wr * 64 + fr, fq * 8), boff = lds_byte(wc * 32 + fr, fq * 8);
#define PG8_SA(b, h) (((b) * 2 + (h)) * HTB)
#define PG8_SB(b, h) ((4 + (b) * 2 + (h)) * HTB)
#define PG8_STAGE(bufoff, gbase, voff) do { _Pragma("unroll") for (int _i = 0; _i < 2; ++_i) \
        __builtin_amdgcn_global_load_lds((const unsigned*)((const char*)(gbase) + (voff)[_i]), (PG8_LAS unsigned*)(lds + (bufoff) + ldsw + _i * 8192), 16, 0, 0); } while (0)
#define PG8_LDA(dst, b, h) do { _Pragma("unroll") for (int m = 0; m < 4; ++m) _Pragma("unroll") for (int k = 0; k < 2; ++k) dst[m][k] = *(const PG8_LAS bf16x8*)(lds + PG8_SA(b, h) + aoff + m * 2048 + k * 1024); } while (0)
#define PG8_LDB(dst, b, h) do { _Pragma("unroll") for (int n = 0; n < 2; ++n) _Pragma("unroll") for (int k = 0; k < 2; ++k) dst[n][k] = *(const PG8_LAS bf16x8*)(lds + PG8_SB(b, h) + boff + n * 2048 + k * 1024); } while (0)
#define PG8_MMA(ai, bj, At, Bt) do { __builtin_amdgcn_s_setprio(1); _Pragma("unroll") for (int m = 0; m < 4; ++m) _Pragma("unroll") for (int n = 0; n < 2; ++n) _Pragma("unroll") for (int k = 0; k < 2; ++k) \
        acc[ai][bj][m][n] = __builtin_amdgcn_mfma_f32_16x16x32_bf16(Bt[n][k], At[m][k], acc[ai][bj][m][n], 0, 0, 0); __builtin_amdgcn_s_setprio(0); } while (0)
#define PG8_WAIT_V(n) asm volatile("s_waitcnt vmcnt(" #n ")" ::: "memory")
#define PG8_WAIT_L(n) asm volatile("s_waitcnt lgkmcnt(" #n ")" ::: "memory")
#define PG8_BAR __builtin_amdgcn_s_barrier()
#define PG8_SCHED __builtin_amdgcn_sched_barrier(0)
    Unit cur, nxt; int ui = 0;
    if (!S.next(0, cur)) return;
    f32x4 acc[2][2][4][2];
#pragma unroll
    for (int a = 0; a < 2; ++a)
#pragma unroll
        for (int b = 0; b < 2; ++b)
#pragma unroll
            for (int m = 0; m < 4; ++m)
#pragma unroll
                for (int n = 0; n < 2; ++n) acc[a][b][m][n] = (f32x4){0.f, 0.f, 0.f, 0.f};
    bf16x8 At[4][2], B0[2][2], B1[2][2];
    const char* cA = (const char*)g.A + (size_t)cur.pm * tstep; const char* cB = (const char*)g.Bt + (size_t)cur.pn * tstep;
    S.a_ready(cur);
    if constexpr (SP2) {
        PG8_STAGE(PG8_SB(0, 0), cB, voffB); PG8_STAGE(PG8_SB(0, 1), cB + hstep, voffB); PG8_STAGE(PG8_SA(0, 0), cA, voffA); PG8_STAGE(PG8_SA(0, 1), cA + hstep, voffA);
        if (wr == 1) PG8_BAR;
        PG8_WAIT_V(2); PG8_BAR;
        PG8_STAGE(PG8_SB(1, 0), cB + kstep, voffB); PG8_STAGE(PG8_SA(1, 0), cA + kstep, voffA); PG8_STAGE(PG8_SB(1, 1), cB + hstep + kstep, voffB);
        PG8_WAIT_V(6); PG8_BAR;
    } else {
        PG8_STAGE(PG8_SB(0, 0), cB, voffB); PG8_STAGE(PG8_SA(0, 0), cA, voffA); PG8_STAGE(PG8_SB(0, 1), cB + hstep, voffB); PG8_STAGE(PG8_SA(0, 1), cA + hstep, voffA);
        if (wr == 1) PG8_BAR;
        PG8_WAIT_V(4); PG8_BAR;
        PG8_STAGE(PG8_SB(1, 0), cB + kstep, voffB); PG8_STAGE(PG8_SA(1, 0), cA + kstep, voffA); PG8_STAGE(PG8_SB(1, 1), cB + hstep + kstep, voffB);
        PG8_WAIT_V(6); PG8_BAR;
    }
    for (;;) {
        const bool has_next = S.next(ui + 1, nxt);
        const char* nA = has_next ? (const char*)g.A + (size_t)nxt.pm * tstep : cA; const char* nB = has_next ? (const char*)g.Bt + (size_t)nxt.pn * tstep : cB;
        for (int t = 0; t < nt; t += 2) {
            const bool last = (t == nt - 2);
            const char* a1 = cA + (size_t)(t + 1) * kstep;
            const char* a2 = last ? nA : cA + (size_t)(t + 2) * kstep; const char* b2 = last ? nB : cB + (size_t)(t + 2) * kstep;
            const char* a3 = a2 + kstep; const char* b3 = b2 + kstep;
            if (last && has_next) S.a_ready(nxt);
            if constexpr (SP2) {
            PG8_LDB(B0, 0, 0); PG8_LDB(B1, 0, 1); PG8_SCHED; PG8_LDA(At, 0, 0); PG8_STAGE(PG8_SA(1, 1), a1 + hstep, voffA);
            PG8_WAIT_V(8); PG8_WAIT_L(0); PG8_BAR; PG8_MMA(0, 0, At, B0); PG8_MMA(0, 1, At, B1); PG8_BAR; PG8_SCHED;
            PG8_LDA(At, 0, 1); PG8_STAGE(PG8_SB(0, 0), b2, voffB); PG8_STAGE(PG8_SB(0, 1), b2 + hstep, voffB); PG8_STAGE(PG8_SA(0, 0), a2, voffA);
            PG8_WAIT_V(8); PG8_WAIT_L(0); PG8_BAR; PG8_MMA(1, 0, At, B0); PG8_MMA(1, 1, At, B1); PG8_BAR; PG8_SCHED;
            PG8_LDB(B0, 1, 0); PG8_LDB(B1, 1, 1); PG8_SCHED; PG8_LDA(At, 1, 0); PG8_STAGE(PG8_SA(0, 1), a2 + hstep, voffA);
            PG8_WAIT_V(8); PG8_WAIT_L(0); PG8_BAR; PG8_MMA(0, 0, At, B0); PG8_MMA(0, 1, At, B1); PG8_BAR; PG8_SCHED;
            PG8_LDA(At, 1, 1); PG8_STAGE(PG8_SB(1, 0), b3, voffB); PG8_STAGE(PG8_SB(1, 1), b3 + hstep, voffB); PG8_STAGE(PG8_SA(1, 0), a3, voffA);
            PG8_WAIT_V(8); PG8_WAIT_L(0); PG8_BAR; PG8_MMA(1, 0, At, B0); PG8_MMA(1, 1, At, B1); PG8_BAR; PG8_SCHED;
            } else {
            PG8_LDB(B0, 0, 0); PG8_SCHED; PG8_LDA(At, 0, 0); PG8_STAGE(PG8_SA(1, 1), a1 + hstep, voffA);
            PG8_WAIT_L(8); PG8_BAR; PG8_WAIT_L(0); PG8_MMA(0, 0, At, B0); PG8_BAR; PG8_SCHED;
            PG8_LDB(B1, 0, 1); PG8_STAGE(PG8_SB(0, 0), b2, voffB);
            PG8_BAR; PG8_WAIT_L(0); PG8_MMA(0, 1, At, B1); PG8_BAR;
            PG8_LDA(At, 0, 1); PG8_STAGE(PG8_SA(0, 0), a2, voffA);
            PG8_BAR; PG8_WAIT_L(0); PG8_MMA(1, 0, At, B0); PG8_BAR; PG8_SCHED;
            PG8_STAGE(PG8_SB(0, 1), b2 + hstep, voffB);
            PG8_WAIT_V(6); PG8_BAR; PG8_MMA(1, 1, At, B1); PG8_BAR;
            PG8_LDB(B0, 1, 0); PG8_SCHED; PG8_LDA(At, 1, 0); PG8_STAGE(PG8_SA(0, 1), a2 + hstep, voffA);
            PG8_WAIT_L(8); PG8_BAR; PG8_WAIT_L(0); PG8_MMA(0, 0, At, B0); PG8_BAR; PG8_SCHED;
            PG8_LDB(B1, 1, 1); PG8_STAGE(PG8_SB(1, 0), b3, voffB);
            PG8_BAR; PG8_WAIT_L(0); PG8_MMA(0, 1, At, B1); PG8_BAR;
            PG8_LDA(At, 1, 1); PG8_STAGE(PG8_SA(1, 0), a3, voffA);
            PG8_BAR; PG8_WAIT_L(0); PG8_MMA(1, 0, At, B0); PG8_BAR; PG8_SCHED;
            PG8_STAGE(PG8_SB(1, 1), b3 + hstep, voffB);
            PG8_WAIT_V(6); PG8_BAR; PG8_MMA(1, 1, At, B1); PG8_BAR;
            }
        }
        if constexpr (ALIGN_EPI) { if (wr == 0) PG8_BAR; }
        if constexpr (!Epi::AFTER_DRAIN) { E(acc, cur, wr, wc, fr, fq); S.done(cur); }
        if (!has_next) break;
#pragma unroll
        for (int a = 0; a < 2; ++a)
#pragma unroll
            for (int b = 0; b < 2; ++b)
#pragma unroll
                for (int m = 0; m < 4; ++m)
#pragma unroll
                    for (int n = 0; n < 2; ++n) acc[a][b][m][n] = (f32x4){0.f, 0.f, 0.f, 0.f};
        cur = nxt; cA = nA; cB = nB; ++ui;
        if constexpr (ALIGN_EPI) { if (wr == 1) PG8_BAR; }
    }
    PG8_WAIT_V(0);
    if constexpr (!ALIGN_EPI) { if (wr == 0) PG8_BAR; }
    PG8_BAR;
    if constexpr (Epi::AFTER_DRAIN) { E.fused(acc, cur, wr, wc, fr, fq, lds, wid, lane); S.done(cur); }
#undef PG8_SA
#undef PG8_SB
#undef PG8_STAGE
#undef PG8_LDA
#undef PG8_LDB
#undef PG8_MMA
#undef PG8_WAIT_V
#undef PG8_WAIT_L
#undef PG8_BAR
#undef PG8_SCHED
}
}


#define LAS __attribute__((address_space(3)))
typedef unsigned short bf16_t;
typedef short bf16x8 __attribute__((ext_vector_type(8)));
typedef short s16x4 __attribute__((ext_vector_type(4)));
typedef float f32x4 __attribute__((ext_vector_type(4)));
typedef unsigned u32x4 __attribute__((ext_vector_type(4)));
typedef unsigned u32x2 __attribute__((ext_vector_type(2)));
typedef float f32x2v __attribute__((ext_vector_type(2)));

constexpr int M_TOK = 81920, M_PROMPT = 65536, DM = 1024, DFF = 2816;
constexpr int LDS_BYTES = 147456;
#ifndef GEMM_ALIGN
#define GEMM_ALIGN true
#endif
#ifndef GEMM_SP2
#define GEMM_SP2 true
#endif
constexpr float NORM_EPS = 1e-6f;

constexpr size_t SZ_WFI = (size_t)5632 * 1024 * 2, SZ_WFO = (size_t)1024 * 2816 * 2;
constexpr size_t WS_WFI = 0;
constexpr size_t WS_WFO = WS_WFI + 4 * SZ_WFI;
constexpr size_t WS_WABI = WS_WFO + 4 * SZ_WFO;
constexpr size_t WS_WABO = WS_WABI + (size_t)3328 * 1024 * 2;
constexpr size_t WS_WATI = WS_WABO + (size_t)1024 * 1024 * 2;
constexpr size_t WS_WATO = WS_WATI + (size_t)3072 * 1024 * 2;
constexpr size_t WS_LORA = WS_WATO + (size_t)1024 * 1024 * 2;
constexpr size_t WS_SGUW = WS_LORA + (size_t)4 * 512 * 64 * 2;
constexpr size_t WS_RKR = WS_SGUW + (size_t)4 * 128 * 128 * 2;
constexpr size_t WS_XN = (WS_RKR + (size_t)2 * M_TOK * 8 * 4 + 4095) & ~(size_t)4095;
constexpr size_t WS_BIG = WS_XN + (size_t)M_TOK * 1024 * 2;
constexpr size_t WS_PUV = WS_BIG;
constexpr size_t WS_PRKVG = WS_PUV + (size_t)M_TOK * 1024 * 2;
constexpr size_t WS_PWA = WS_PRKVG + (size_t)M_TOK * 2048 * 2;
constexpr size_t WS_Y = WS_BIG + (size_t)M_TOK * 3328 * 2;
constexpr size_t WS_END = WS_Y + (size_t)2 * M_TOK * 512 * 2;

constexpr int NSEG = 16, SEGLEN = 16384 / NSEG;
constexpr size_t WS_STL = (WS_END + 4095) & ~(size_t)4095;
constexpr size_t WS_STP = WS_STL + (size_t)16 * NSEG * 4096 * 4;
constexpr size_t WS_STS = WS_STP + (size_t)16 * NSEG * 4096 * 4;
constexpr size_t WS_TS = WS_STS + (size_t)16 * NSEG * 4096 * 4;
constexpr size_t WS_RSA = WS_TS + 4096;
constexpr size_t WS_RSB = WS_RSA + (size_t)M_TOK * 4;
constexpr size_t WS_RSC = WS_RSB + (size_t)M_TOK * 4;
constexpr size_t WS_RSD = WS_RSC + (size_t)M_TOK * 4;
constexpr size_t WS_KSQ = WS_RSD + (size_t)M_TOK * 4;
constexpr size_t WS_END2 = WS_KSQ + (size_t)16 * M_TOK * 4;
struct Params { const float* in[30]; float* out; unsigned char* ws; };

__device__ __forceinline__ float bflo(unsigned w) { return __uint_as_float(w << 16); }
__device__ __forceinline__ float bfhi(unsigned w) { return __uint_as_float(w & 0xffff0000u); }
__device__ __forceinline__ unsigned pk2(float lo, float hi) { unsigned r; asm("v_cvt_pk_bf16_f32 %0, %1, %2" : "=v"(r) : "v"(lo), "v"(hi)); return r; }
__device__ __forceinline__ void unpack8(const u32x4 w, float* f) { f[0] = bflo(w.x); f[1] = bfhi(w.x); f[2] = bflo(w.y); f[3] = bfhi(w.y); f[4] = bflo(w.z); f[5] = bfhi(w.z); f[6] = bflo(w.w); f[7] = bfhi(w.w); }
__device__ __forceinline__ u32x4 pack8(const float* f) { u32x4 w; w.x = pk2(f[0], f[1]); w.y = pk2(f[2], f[3]); w.z = pk2(f[4], f[5]); w.w = pk2(f[6], f[7]); return w; }
__device__ __forceinline__ float sigmoidf_(float x) { return __builtin_amdgcn_rcpf(1.0f + __expf(-x)); }
__device__ __forceinline__ float siluf_(float x) { return x * sigmoidf_(x); }
__device__ __forceinline__ float gelu_tanh(float x) { const float u = 0.7978845608028654f * (x + 0.044715f * x * x * x); return x * sigmoidf_(2.0f * u); }
__device__ __forceinline__ float tanhf_(float x) { return 1.0f - 2.0f * __builtin_amdgcn_rcpf(__expf(2.0f * x) + 1.0f); }
__device__ __forceinline__ float wave_sum(float x) { x += __shfl_xor(x, 32); x += __shfl_xor(x, 16); x += __shfl_xor(x, 8); x += __shfl_xor(x, 4); x += __shfl_xor(x, 2); x += __shfl_xor(x, 1); return x; }
template <int CTRL> __device__ __forceinline__ float dppf(float x) { return __int_as_float(__builtin_amdgcn_update_dpp(0, __float_as_int(x), CTRL, 0xF, 0xF, true)); }
__device__ __forceinline__ float reduce8(float x) { x += dppf<0xB1>(x); x += dppf<0x4E>(x); x += dppf<0x141>(x); return x; }
typedef short v4i16_t __attribute__((ext_vector_type(4)));
typedef __bf16 bf16x2_t __attribute__((ext_vector_type(2)));
__device__ __forceinline__ s16x4 tr_read(LAS const unsigned char* p) { return __builtin_bit_cast(s16x4, __builtin_amdgcn_ds_read_tr16_b64_v4i16((LAS v4i16_t*)p)); }
__device__ __forceinline__ f32x4 mfma16(bf16x8 a, bf16x8 b, f32x4 c) { return __builtin_amdgcn_mfma_f32_16x16x32_bf16(a, b, c, 0, 0, 0); }

__device__ __forceinline__ int opaque_tid() { int t = threadIdx.x; asm volatile("" : "+v"(t)); return t; }
__device__ __forceinline__ unsigned char* opaque_ptr(unsigned char* p) { size_t z = 0; asm volatile("" : "+s"(z)); return p + z; }
struct EpiSwiglu {
    static constexpr bool PERM = false, AFTER_DRAIN = false;
    bf16_t* H; const float* rowss; const float* rowss2;
    __device__ __forceinline__ void operator()(const f32x4 (&acc)[2][2][4][2], const pg8::Unit& u, int wr, int wc, int fr, int fq) const {
        const int row0 = u.pm * 256 + wr * 64 + fr, col0 = u.pn * 128 + wc * 32 + 8 * fq;
        float rsv[8];
#pragma unroll
        for (int gi = 0; gi < 8; ++gi) rsv[gi] = rowss ? rowss[row0 + (gi >> 2) * 128 + (gi & 3) * 16] : 0.f;
        float rsw[8];
#pragma unroll
        for (int gi = 0; gi < 8; ++gi) rsw[gi] = rowss2 ? rowss2[row0 + (gi >> 2) * 128 + (gi & 3) * 16] : 0.f;
#pragma unroll
        for (int gi = 0; gi < 8; ++gi) { rsv[gi] = rowss ? rsqrtf(rsv[gi] * (1.0f / DM) + NORM_EPS) : 1.0f;
            if (rowss2) rsv[gi] *= rsqrtf(rsv[gi] * rsv[gi] * rsw[gi] * (1.0f / DM) + NORM_EPS); }
#pragma unroll
        for (int ai = 0; ai < 2; ++ai)
#pragma unroll
            for (int m = 0; m < 4; ++m) {
                const int row = row0 + ai * 128 + m * 16;
                const float rs = rsv[ai * 4 + m];
                bf16_t* rowp = H + (size_t)row * DFF + col0;
                float h[8];
                const float c1 = rs * -1.4426950408889634f, c2 = rs * rs;
#pragma unroll
                for (int bj = 0; bj < 2; ++bj)
#pragma unroll
                    for (int pr = 0; pr < 2; ++pr) {
                        const f32x2v gg = {acc[ai][bj][m][0][2 * pr], acc[ai][bj][m][0][2 * pr + 1]}, uu = {acc[ai][bj][m][1][2 * pr], acc[ai][bj][m][1][2 * pr + 1]};
                        const f32x2v t = gg * c1;
                        f32x2v d; d.x = __builtin_amdgcn_exp2f(t.x); d.y = __builtin_amdgcn_exp2f(t.y);
                        d = d + 1.0f;
                        f32x2v r; r.x = __builtin_amdgcn_rcpf(d.x); r.y = __builtin_amdgcn_rcpf(d.y);
                        const f32x2v hh = ((gg * uu) * c2) * r;
                        h[bj * 4 + 2 * pr] = hh.x; h[bj * 4 + 2 * pr + 1] = hh.y;
                    }
                *(u32x4*)rowp = pack8(h);
                asm volatile("" ::: "memory");
            }
    }
};
struct EpiResid {
    static constexpr bool PERM = false, AFTER_DRAIN = false;
    float* X; float scale; bf16_t* XG; const float* g; float* rowss; const float* xin_a; const float* xin_b;
    const float* gaux; float* rowss2; const float* base_ss;
    __device__ __forceinline__ void operator()(const f32x4 (&acc)[2][2][4][2], const pg8::Unit& u, int wr, int wc, int fr, int fq) const {
        const int row0 = u.pm * 256 + wr * 64 + fr, col0 = u.pn * 256 + wc * 32 + 4 * fq;
        f32x4 gv[2][2];
#pragma unroll
        for (int bj = 0; bj < 2; ++bj)
#pragma unroll
            for (int n = 0; n < 2; ++n) gv[bj][n] = XG ? *(const f32x4*)(g + col0 + bj * 128 + n * 16) : (f32x4){0.f, 0.f, 0.f, 0.f};
        f32x4 ga[2][2];
#pragma unroll
        for (int bj = 0; bj < 2; ++bj)
#pragma unroll
            for (int n = 0; n < 2; ++n) { ga[bj][n] = gaux ? *(const f32x4*)(gaux + col0 + bj * 128 + n * 16) : (f32x4){1.f, 1.f, 1.f, 1.f}; if (rowss2) gv[bj][n] = gv[bj][n] * ga[bj][n]; }
        float brs[8];
#pragma unroll
        for (int gi = 0; gi < 8; ++gi) brs[gi] = base_ss ? base_ss[row0 + (gi >> 2) * 128 + (gi & 3) * 16] : 0.f;
#pragma unroll
        for (int gi = 0; gi < 8; ++gi) brs[gi] = base_ss ? rsqrtf(brs[gi] * (1.0f / DM) + NORM_EPS) : 1.0f;
        const float* Xs = xin_a ? (u.pm < 256 ? xin_a : xin_b - (size_t)M_PROMPT * DM) : X;
        f32x4 xin[2][2][2];
#pragma unroll
        for (int gi = 0; gi < 9; ++gi) {
            if (gi < 8) {
                const float* rowp = Xs + (size_t)(row0 + (gi >> 2) * 128 + (gi & 3) * 16) * DM + col0;
#pragma unroll
                for (int bj = 0; bj < 2; ++bj)
#pragma unroll
                    for (int n = 0; n < 2; ++n) xin[gi & 1][bj][n] = *(const f32x4*)(rowp + bj * 128 + n * 16);
            }
            if (gi > 0) {
                const int gp = gi - 1, ai = gp >> 2, m = gp & 3;
                const int row = row0 + ai * 128 + m * 16;
                float* rowp = X + (size_t)row * DM + col0;
                float ssq = 0.f, ssq2 = 0.f;
#pragma unroll
                for (int bj = 0; bj < 2; ++bj)
#pragma unroll
                    for (int n = 0; n < 2; ++n) { f32x4 v = xin[gp & 1][bj][n]; if (base_ss) v = v * brs[gp] * ga[bj][n];
                        v += acc[ai][bj][m][n] * scale; *(f32x4*)(rowp + bj * 128 + n * 16) = v;
                        if (XG) { ssq += (v[0] * v[0] + v[1] * v[1]) + (v[2] * v[2] + v[3] * v[3]); const f32x4 o = v * gv[bj][n]; u32x2 w; w.x = pk2(o[0], o[1]); w.y = pk2(o[2], o[3]);
                            *(u32x2*)(XG + (size_t)row * DM + col0 + bj * 128 + n * 16) = w; }
                        if (rowss2) { const f32x4 t = v * ga[bj][n]; ssq2 += (t[0] * t[0] + t[1] * t[1]) + (t[2] * t[2] + t[3] * t[3]); } }
                if (XG) { ssq += __shfl_xor(ssq, 16); ssq += __shfl_xor(ssq, 32);
                    if (fq == 0) __hip_atomic_fetch_add(rowss + row, ssq, __ATOMIC_RELAXED, __HIP_MEMORY_SCOPE_AGENT); }
                if (rowss2) { ssq2 += __shfl_xor(ssq2, 16); ssq2 += __shfl_xor(ssq2, 32);
                    if (fq == 0) __hip_atomic_fetch_add(rowss2 + row, ssq2, __ATOMIC_RELAXED, __HIP_MEMORY_SCOPE_AGENT); }
            }
            asm volatile("" ::: "memory");
        }
    }
};
struct EpiSplit {
    static constexpr bool PERM = true, AFTER_DRAIN = false;
    bf16_t* b0; int ld0, t0; bf16_t* b1; int ld1, t1; bf16_t* b2; int ld2; const float* rowss; float* ksq;
    __device__ __forceinline__ void operator()(const f32x4 (&acc)[2][2][4][2], const pg8::Unit& u, int wr, int wc, int fr, int fq) const {
        bf16_t* base; int ld, ct;
        if (u.pn < t0) { base = b0; ld = ld0; ct = u.pn; } else if (u.pn < t1) { base = b1; ld = ld1; ct = u.pn - t0; } else { base = b2; ld = ld2; ct = u.pn - t1; }
        const int row0 = u.pm * 256 + wr * 64 + fr, col0 = ct * 256 + wc * 32 + 8 * fq;
        const bool isk = ksq != nullptr && u.pn >= 4 && u.pn < 8;
        float rsv[8];
#pragma unroll
        for (int gi = 0; gi < 8; ++gi) rsv[gi] = rowss[row0 + (gi >> 2) * 128 + (gi & 3) * 16];
#pragma unroll
        for (int gi = 0; gi < 8; ++gi) rsv[gi] = rsqrtf(rsv[gi] * (1.0f / DM) + NORM_EPS);
#pragma unroll
        for (int ai = 0; ai < 2; ++ai)
#pragma unroll
            for (int m = 0; m < 4; ++m) {
                const int row = row0 + ai * 128 + m * 16;
                const float rs = rsv[ai * 4 + m];
                bf16_t* rowp = base + (size_t)row * ld + col0;
#pragma unroll
                for (int bj = 0; bj < 2; ++bj) {
                    const f32x4 v0 = acc[ai][bj][m][0] * rs, v1 = acc[ai][bj][m][1] * rs;
                    u32x4 w; w.x = pk2(v0[0], v0[1]); w.y = pk2(v0[2], v0[3]); w.z = pk2(v1[0], v1[1]); w.w = pk2(v1[2], v1[3]);
                    *(u32x4*)(rowp + bj * 128) = w;
                    if (isk) {
                        float sq = ((v0[0] * v0[0] + v0[1] * v0[1]) + (v0[2] * v0[2] + v0[3] * v0[3])) + ((v1[0] * v1[0] + v1[1] * v1[1]) + (v1[2] * v1[2] + v1[3] * v1[3]));
                        sq += __shfl_xor(sq, 16); sq += __shfl_xor(sq, 32);
                        if (fq == 0) __hip_atomic_fetch_add(ksq + (size_t)((u.pn - 4) * 4 + 2 * bj + (wc >> 1)) * M_TOK + row, sq, __ATOMIC_RELAXED, __HIP_MEMORY_SCOPE_AGENT);
                    }
                }
                asm volatile("" ::: "memory");
            }
    }
};

template <int MAP> __device__ __forceinline__ int src_col(int s) {
    if (MAP == 0) return s;
    const int pn = s >> 8, bj = (s >> 7) & 1, wc = (s >> 5) & 3, n = (s >> 4) & 1, fq = (s >> 2) & 3, jj = s & 3;
    return n * DFF + 128 * pn + 32 * wc + 8 * fq + 4 * bj + jj;
}
template <int MAP> __device__ void convert_T(const float* __restrict__ src, bf16_t* __restrict__ dst, int K, int N, LAS float* tile, int rot, int widx, int G) {
    const int tk = K / 64, tn = N / 64, nt = tk * tn, tid = opaque_tid();
    const int kk0 = tid >> 4, sg = tid & 15;
    int t = (int)((widx + rot) % G);
    float4 va = make_float4(0.f, 0.f, 0.f, 0.f), vb = va;
    if (t < nt) { const int k0 = (t % tk) * 64, s0 = (t / tk) * 64; const int c = src_col<MAP>(s0 + sg * 4);
        va = *(const float4*)(src + (size_t)(k0 + kk0) * N + c); vb = *(const float4*)(src + (size_t)(k0 + kk0 + 32) * N + c); }
    for (; t < nt; t += G) {
        const int k0 = (t % tk) * 64, s0 = (t / tk) * 64;
        { LAS float* tp = tile + kk0 * 65 + sg * 4; tp[0] = va.x; tp[1] = va.y; tp[2] = va.z; tp[3] = va.w;
          LAS float* tq = tile + (kk0 + 32) * 65 + sg * 4; tq[0] = vb.x; tq[1] = vb.y; tq[2] = vb.z; tq[3] = vb.w; }
        if (t + G < nt) {
            const int t2 = t + G, k2 = (t2 % tk) * 64, s2 = (t2 / tk) * 64; const int c = src_col<MAP>(s2 + sg * 4);
            va = *(const float4*)(src + (size_t)(k2 + kk0) * N + c); vb = *(const float4*)(src + (size_t)(k2 + kk0 + 32) * N + c); }
        asm volatile("s_waitcnt lgkmcnt(0)" ::: "memory"); __builtin_amdgcn_s_barrier(); asm volatile("" ::: "memory");
        {
            const int slot = tid >> 3, kc = tid & 7; float f[8];
#pragma unroll
            for (int i = 0; i < 8; ++i) f[i] = tile[(kc * 8 + i) * 65 + slot];
            *(u32x4*)(dst + (size_t)(s0 + slot) * K + k0 + kc * 8) = pack8(f);
        }
        asm volatile("s_waitcnt lgkmcnt(0)" ::: "memory"); __builtin_amdgcn_s_barrier(); asm volatile("" ::: "memory");
    }
}

__device__ void norm_rows(const float* xa, const float* xb, int split, float* xcopy, const float* g1, float* x1out, const float* g2, bf16_t* xn) {
    const int tid_ = opaque_tid(), lane = tid_ & 63, wave = __builtin_amdgcn_readfirstlane(tid_ >> 6);
    const int stride = gridDim.x * 8;
    for (int row0 = blockIdx.x * 8 + wave; row0 < M_TOK; row0 += 2 * stride) {
        int rows[2]; rows[0] = row0; rows[1] = (row0 + stride < M_TOK) ? row0 + stride : row0;
        f32x4 v[2][4]; float ss[2] = {0.f, 0.f};
#pragma unroll
        for (int q = 0; q < 2; ++q) { const int row = rows[q];
            const float* src = (row < split) ? xa + (size_t)row * DM : xb + (size_t)(row - split) * DM;
#pragma unroll
            for (int i = 0; i < 4; ++i) v[q][i] = *(const f32x4*)(src + i * 256 + lane * 4); }
#pragma unroll
        for (int q = 0; q < 2; ++q) {
#pragma unroll
            for (int i = 0; i < 4; ++i) ss[q] += v[q][i][0] * v[q][i][0] + v[q][i][1] * v[q][i][1] + v[q][i][2] * v[q][i][2] + v[q][i][3] * v[q][i][3];
            if (xcopy) {
#pragma unroll
                for (int i = 0; i < 4; ++i) *(f32x4*)(xcopy + (size_t)rows[q] * DM + i * 256 + lane * 4) = v[q][i];
            }
        }
        ss[0] = wave_sum(ss[0]); ss[1] = wave_sum(ss[1]);
        float r[2]; r[0] = rsqrtf(ss[0] * (1.0f / DM) + NORM_EPS); r[1] = rsqrtf(ss[1] * (1.0f / DM) + NORM_EPS);
        if (g1) {
            float s2[2] = {0.f, 0.f};
#pragma unroll
            for (int i = 0; i < 4; ++i) { const f32x4 g = *(const f32x4*)(g1 + i * 256 + lane * 4);
#pragma unroll
                for (int q = 0; q < 2; ++q) { v[q][i] = v[q][i] * r[q] * g; *(f32x4*)(x1out + (size_t)rows[q] * DM + i * 256 + lane * 4) = v[q][i];
                    s2[q] += v[q][i][0] * v[q][i][0] + v[q][i][1] * v[q][i][1] + v[q][i][2] * v[q][i][2] + v[q][i][3] * v[q][i][3]; } }
            s2[0] = wave_sum(s2[0]); s2[1] = wave_sum(s2[1]);
            r[0] = rsqrtf(s2[0] * (1.0f / DM) + NORM_EPS); r[1] = rsqrtf(s2[1] * (1.0f / DM) + NORM_EPS);
        }
        if (g2) {
#pragma unroll
            for (int i = 0; i < 4; ++i) { const f32x4 g = *(const f32x4*)(g2 + i * 256 + lane * 4);
#pragma unroll
                for (int q = 0; q < 2; ++q) { const f32x4 o = v[q][i] * r[q] * g;
                    u32x2 w; w.x = pk2(o[0], o[1]); w.y = pk2(o[2], o[3]); *(u32x2*)(xn + (size_t)rows[q] * DM + i * 256 + lane * 4) = w; } }
        }
    }
}

__device__ void sgu_item(const Params& PP, int chunk, LAS unsigned char* lds) {
    Params P = PP; P.ws = opaque_ptr(PP.ws);
    const int tid = opaque_tid(), lane = tid & 63, wave = __builtin_amdgcn_readfirstlane(tid >> 6), l15 = lane & 15, quad = lane >> 4;
    constexpr int PITCH = 1056;
    const bf16_t* Puv = (const bf16_t*)(P.ws + WS_PUV);
    bf16_t* MO = (bf16_t*)(P.ws + WS_XN);
    const size_t row0 = (size_t)chunk * 128;
    {
        float gn[8];
        { const f32x4 a = *(const f32x4*)(P.in[12] + lane * 8), b = *(const f32x4*)(P.in[12] + lane * 8 + 4); gn[0] = a[0]; gn[1] = a[1]; gn[2] = a[2]; gn[3] = a[3]; gn[4] = b[0]; gn[5] = b[1]; gn[6] = b[2]; gn[7] = b[3]; }
        for (int i = 0; i < 16; ++i) {
            const int p = wave * 16 + i;
            const u32x4 raw = *(const u32x4*)(Puv + (row0 + p) * 1024 + 512 + lane * 8);
            float v[8]; unpack8(raw, v); float ss = 0.f;
#pragma unroll
            for (int e = 0; e < 8; ++e) { v[e] = gelu_tanh(v[e]); ss += v[e] * v[e]; }
            ss = wave_sum(ss);
            const float r = rsqrtf(ss * (1.0f / 512.0f) + NORM_EPS);
#pragma unroll
            for (int e = 0; e < 8; ++e) v[e] = v[e] * r * gn[e];
            *(LAS u32x4*)(lds + p * PITCH + lane * 16) = pack8(v);
        }
    }
    __syncthreads();
    const int g = wave >> 1, cbase = (wave >> 1) * 128 + (wave & 1) * 64;
    const bf16_t* Wg = (const bf16_t*)(P.ws + WS_SGUW) + (size_t)g * 128 * 128;
    const int r4 = l15 >> 2, c4 = l15 & 3;
    for (int qh = 0; qh < 2; ++qh) {
        f32x4 acc[4][4];
#pragma unroll
        for (int a = 0; a < 4; ++a)
#pragma unroll
            for (int b = 0; b < 4; ++b) acc[a][b] = (f32x4){0.f, 0.f, 0.f, 0.f};
#pragma unroll
        for (int ks = 0; ks < 4; ++ks) {
            bf16x8 bfr[4];
#pragma unroll
            for (int qt = 0; qt < 4; ++qt) bfr[qt] = *(const bf16x8*)(Wg + (size_t)(qh * 64 + qt * 16 + l15) * 128 + ks * 32 + quad * 8);
#pragma unroll
            for (int ct = 0; ct < 4; ++ct) {
                LAS const unsigned char* ap = lds + (ks * 32 + quad * 8 + r4) * PITCH + (cbase + ct * 16 + 4 * c4) * 2;
                const s16x4 lo = tr_read(ap), hi = tr_read(ap + 4 * PITCH);
                const bf16x8 a = {lo[0], lo[1], lo[2], lo[3], hi[0], hi[1], hi[2], hi[3]};
#pragma unroll
                for (int qt = 0; qt < 4; ++qt) acc[ct][qt] = mfma16(a, bfr[qt], acc[ct][qt]);
            }
        }
#pragma unroll
        for (int qt = 0; qt < 4; ++qt) {
            const int q = qh * 64 + qt * 16 + l15;
            const float bq = P.in[14][g * 128 + q];
#pragma unroll
            for (int ct = 0; ct < 4; ++ct) {
                const int c = cbase + ct * 16 + quad * 4;
                const u32x2 ur = *(const u32x2*)(Puv + (row0 + q) * 1024 + c);
                const float u0 = gelu_tanh(bflo(ur.x)), u1 = gelu_tanh(bfhi(ur.x)), u2 = gelu_tanh(bflo(ur.y)), u3 = gelu_tanh(bfhi(ur.y));
                u32x2 w; w.x = pk2(u0 * (acc[ct][qt][0] + bq), u1 * (acc[ct][qt][1] + bq)); w.y = pk2(u2 * (acc[ct][qt][2] + bq), u3 * (acc[ct][qt][3] + bq));
                *(u32x2*)(MO + (row0 + q) * 1024 + c) = w;
            }
        }
    }
    __syncthreads();
}

template <int LPR> __device__ __forceinline__ float reduce_row(float x) {
    x += dppf<0xB1>(x); x += dppf<0x4E>(x); x += dppf<0x141>(x);
    if (LPR == 16) x += dppf<0x140>(x);
    return x;
}
__device__ __forceinline__ float reduce32(float x) {
    x += dppf<0xB1>(x); x += dppf<0x4E>(x); x += dppf<0x141>(x); x += dppf<0x140>(x); x += __shfl_xor(x, 16); return x;
}
__device__ __forceinline__ void lds_barrier() { asm volatile("s_waitcnt lgkmcnt(0)" ::: "memory"); __builtin_amdgcn_s_barrier(); asm volatile("" ::: "memory"); }
template <int NV> struct ScanSet { f32x4 kk[NV], w[NV], ka[NV], kp[NV], r[NV]; float vv; };
template <int NV> __device__ __forceinline__ void scan_load(ScanSet<NV>& t, LAS const float* KK, LAS const float* Wd, LAS const float* KKA, LAS const float* KP, LAS const float* Rr, LAS const float* Vv, int o, int ov, bool want_y) {
#pragma unroll
    for (int u = 0; u < NV; ++u) { t.kk[u] = *(LAS const f32x4*)(KK + o + u * 32); t.w[u] = *(LAS const f32x4*)(Wd + o + u * 32); t.ka[u] = *(LAS const f32x4*)(KKA + o + u * 32); t.kp[u] = *(LAS const f32x4*)(KP + o + u * 32); }
    if (want_y) {
#pragma unroll
        for (int u = 0; u < NV; ++u) t.r[u] = *(LAS const f32x4*)(Rr + o + u * 32);
    }
    t.vv = Vv[ov];
}
typedef float f32x2v __attribute__((ext_vector_type(2)));
template <int LPR, int NV> __device__ __forceinline__ float scan_step(float* S, const ScanSet<NV>& t, bool want_y, float& ypart) {
    f32x2v acc = {0.f, 0.f};
#pragma unroll
    for (int u = 0; u < NV; ++u)
#pragma unroll
        for (int hh = 0; hh < 2; ++hh) { const f32x2v s2 = {S[4 * u + 2 * hh], S[4 * u + 2 * hh + 1]}, k2 = {t.kk[u][2 * hh], t.kk[u][2 * hh + 1]}; acc = s2 * k2 + acc; }
    float sa = acc.x + acc.y, yb = ypart;
    sa += dppf<0xB1>(sa); yb += dppf<0xB1>(yb); sa += dppf<0x4E>(sa); yb += dppf<0x4E>(yb); sa += dppf<0x141>(sa); yb += dppf<0x141>(yb);
    const f32x2v sa2 = {sa, sa}, vv2 = {t.vv, t.vv};
#pragma unroll
    for (int u = 0; u < NV; ++u)
#pragma unroll
        for (int hh = 0; hh < 2; ++hh) {
            f32x2v s2 = {S[4 * u + 2 * hh], S[4 * u + 2 * hh + 1]};
            const f32x2v w2 = {t.w[u][2 * hh], t.w[u][2 * hh + 1]}, kp2 = {t.kp[u][2 * hh], t.kp[u][2 * hh + 1]}, ka2 = {t.ka[u][2 * hh], t.ka[u][2 * hh + 1]};
            f32x2v tt = vv2 * kp2; tt = tt - sa2 * ka2;
            s2 = s2 * w2 + tt;
            S[4 * u + 2 * hh] = s2.x; S[4 * u + 2 * hh + 1] = s2.y;
        }
    if (want_y) {
        f32x2v yacc = {0.f, 0.f};
#pragma unroll
        for (int u = 0; u < NV; ++u)
#pragma unroll
            for (int hh = 0; hh < 2; ++hh) { const f32x2v s2 = {S[4 * u + 2 * hh], S[4 * u + 2 * hh + 1]}, r2 = {t.r[u][2 * hh], t.r[u][2 * hh + 1]}; yacc = s2 * r2 + yacc; }
        ypart = yacc.x + yacc.y;
    }
    return yb;
}
struct ScanSet2 { f32x4 kk, w, ka, kp, r; float vv0, vv1; };
__device__ __forceinline__ void scan_load2(ScanSet2& t, LAS const float* KK, LAS const float* Wd, LAS const float* KKA, LAS const float* KP, LAS const float* Rr, LAS const float* Vv, int o, int ov, bool want_y) {
    t.kk = *(LAS const f32x4*)(KK + o); t.w = *(LAS const f32x4*)(Wd + o); t.ka = *(LAS const f32x4*)(KKA + o); t.kp = *(LAS const f32x4*)(KP + o);
    if (want_y) t.r = *(LAS const f32x4*)(Rr + o);
    t.vv0 = Vv[ov]; t.vv1 = Vv[ov + 4];
}
__device__ __forceinline__ float dpp16(float x) { x += dppf<0xB1>(x); x += dppf<0x4E>(x); x += dppf<0x141>(x); x += dppf<0x140>(x); return x; }
__device__ __forceinline__ void scan_step2(f32x2v* SS, const ScanSet2& t, bool want_y, float& y0, float& y1, float& yr0, float& yr1) {
    f32x2v a2 = SS[0] * (f32x2v){t.kk[0], t.kk[0]};
#pragma unroll
    for (int i = 1; i < 4; ++i) a2 = SS[i] * (f32x2v){t.kk[i], t.kk[i]} + a2;
    float a0 = a2.x, a1 = a2.y, b0 = y0, b1 = y1;
#define SCAN_OPAQUE4() asm("" : "+v"(a0), "+v"(a1), "+v"(b0), "+v"(b1))
    SCAN_OPAQUE4();
    a0 += dppf<0xB1>(a0); a1 += dppf<0xB1>(a1); b0 += dppf<0xB1>(b0); b1 += dppf<0xB1>(b1); SCAN_OPAQUE4();
    a0 += dppf<0x4E>(a0); a1 += dppf<0x4E>(a1); b0 += dppf<0x4E>(b0); b1 += dppf<0x4E>(b1); SCAN_OPAQUE4();
    a0 += dppf<0x141>(a0); a1 += dppf<0x141>(a1); b0 += dppf<0x141>(b0); b1 += dppf<0x141>(b1); SCAN_OPAQUE4();
    a0 += dppf<0x140>(a0); a1 += dppf<0x140>(a1); b0 += dppf<0x140>(b0); b1 += dppf<0x140>(b1); SCAN_OPAQUE4();
#undef SCAN_OPAQUE4
    yr0 = b0; yr1 = b1;
    const f32x2v sa2 = {a0, a1}, vv2 = {t.vv0, t.vv1};
#pragma unroll
    for (int i = 0; i < 4; ++i) {
        f32x2v tt = vv2 * (f32x2v){t.kp[i], t.kp[i]};
        tt = tt - sa2 * (f32x2v){t.ka[i], t.ka[i]};
        SS[i] = SS[i] * (f32x2v){t.w[i], t.w[i]} + tt;
    }
    if (want_y) {
        f32x2v p2 = SS[0] * (f32x2v){t.r[0], t.r[0]};
#pragma unroll
        for (int i = 1; i < 4; ++i) p2 = SS[i] * (f32x2v){t.r[i], t.r[i]} + p2;
        y0 = p2.x; y1 = p2.y;
    }
}
__device__ __forceinline__ void scan_stepLP(f32x2v* SL, f32x2v* SP, const ScanSet2& t) {
    f32x2v aL = SL[0] * (f32x2v){t.kk[0], t.kk[0]}, aP = SP[0] * (f32x2v){t.kk[0], t.kk[0]};
#pragma unroll
    for (int i = 1; i < 4; ++i) { aL = SL[i] * (f32x2v){t.kk[i], t.kk[i]} + aL; aP = SP[i] * (f32x2v){t.kk[i], t.kk[i]} + aP; }
    float a0 = aL.x, a1 = aL.y, b0 = aP.x, b1 = aP.y;
#define SCAN_OPAQUE4() asm("" : "+v"(a0), "+v"(a1), "+v"(b0), "+v"(b1))
    SCAN_OPAQUE4();
    a0 += dppf<0xB1>(a0); a1 += dppf<0xB1>(a1); b0 += dppf<0xB1>(b0); b1 += dppf<0xB1>(b1); SCAN_OPAQUE4();
    a0 += dppf<0x4E>(a0); a1 += dppf<0x4E>(a1); b0 += dppf<0x4E>(b0); b1 += dppf<0x4E>(b1); SCAN_OPAQUE4();
    a0 += dppf<0x141>(a0); a1 += dppf<0x141>(a1); b0 += dppf<0x141>(b0); b1 += dppf<0x141>(b1); SCAN_OPAQUE4();
    a0 += dppf<0x140>(a0); a1 += dppf<0x140>(a1); b0 += dppf<0x140>(b0); b1 += dppf<0x140>(b1); SCAN_OPAQUE4();
#undef SCAN_OPAQUE4
    const f32x2v saL = {a0, a1}, saP = {b0, b1}, vv2 = {t.vv0, t.vv1};
#pragma unroll
    for (int i = 0; i < 4; ++i) {
        f32x2v tt = vv2 * (f32x2v){t.kp[i], t.kp[i]};
        tt = tt - saL * (f32x2v){t.ka[i], t.ka[i]};
        SL[i] = SL[i] * (f32x2v){t.w[i], t.w[i]} + tt;
        SP[i] = SP[i] * (f32x2v){t.w[i], t.w[i]} - saP * (f32x2v){t.ka[i], t.ka[i]};
    }
}
template <int LPR> __device__ void scan_item(const Params& PP, int seq, int h, int dir, int rhalf, int tbeg, int tlen, int flags, const float* sin, float* sout, float* sout2, LAS unsigned char* lds) {
    Params P = PP; P.ws = opaque_ptr(PP.ws);
    constexpr int KPL = 64 / LPR, RPW = 64 / LPR, NV = KPL / 4;
    const int tid = opaque_tid(), lane = tid & 63, wave = __builtin_amdgcn_readfirstlane(tid >> 6), l15 = lane & 15, quad = lane >> 4;
    const int Tseq = seq < 32 ? 2048 : 16384;
    const size_t base = seq < 32 ? (size_t)seq * 2048 : (size_t)M_PROMPT;
    const bf16_t* Prkvg = (const bf16_t*)(P.ws + WS_PRKVG);
    const bf16_t* Pwa = (const bf16_t*)(P.ws + WS_PWA);
    bf16_t* Yd = (bf16_t*)(P.ws + WS_Y) + (size_t)dir * M_TOK * 512;
    float* RKR = (float*)(P.ws + WS_RKR) + (size_t)dir * M_TOK * 8;
    LAS bf16_t* RAW0 = (LAS bf16_t*)lds;
    LAS bf16_t* ZROW = (LAS bf16_t*)(lds + 21760);
    LAS float* Wd = (LAS float*)(lds + 22528);
    LAS float* Aa = Wd + 1024; LAS float* Rr = Aa + 1024; LAS float* KP = Rr + 1024; LAS float* Vv = KP + 1024; LAS float* KK = Vv + 1024; LAS float* KKA = KK + 1024; LAS float* Yc = KKA + 1024;
    if (tid < 160) ((LAS unsigned*)ZROW)[tid] = 0u;
    LAS bf16_t* ALDS = (LAS bf16_t*)(lds + 55296);
    const int j_a = tid / 40, seg_a = (tid % 40) >> 3, c8_a = tid & 7;
    const int idx_b = tid + 512, j_b = idx_b / 40, seg_b = (idx_b % 40) >> 3, c8_b = idx_b & 7;
    const bool has_b = idx_b < 640;
    const int coff_a = seg_a < 3 ? seg_a * 512 + h * 64 + c8_a * 8 : dir * 128 + (seg_a - 3) * 64 + c8_a * 8;
    const int coff_b = seg_b < 3 ? seg_b * 512 + h * 64 + c8_b * 8 : dir * 128 + (seg_b - 3) * 64 + c8_b * 8;
    const int dst_a = (j_a + 1) * 320 + seg_a * 64 + c8_a * 8, dst_b = (j_b + 1) * 320 + seg_b * 64 + c8_b * 8;
    const bf16_t* src_a = (seg_a < 3 ? Prkvg + base * 2048 : Pwa + base * 256) + coff_a; const int ld_a = seg_a < 3 ? 2048 : 256;
    const bf16_t* src_b = (seg_b < 3 ? Prkvg + base * 2048 : Pwa + base * 256) + coff_b; const int ld_b = seg_b < 3 ? 2048 : 256;
    const int ltype = wave >> 2, lch = (wave & 3) * 16 + l15;
    const bf16_t* Wt = (const bf16_t*)(P.ws + WS_LORA) + (size_t)(dir * 2 + ltype) * 512 * 64 + (size_t)(h * 64 + lch) * 64;
    const bf16x8 lb0 = *(const bf16x8*)(Wt + quad * 8), lb1 = *(const bf16x8*)(Wt + 32 + quad * 8);
    const float lbias = ltype == 0 ? P.in[17][dir * 512 + h * 64 + lch] : P.in[19][dir * 512 + h * 64 + lch];
    const int tk = tid >> 5, c2 = tid & 31;
    float mu_r[2], mu_k[2], mu_v[2], k_k[2], k_a[2], r_k[2];
#pragma unroll
    for (int e = 0; e < 2; ++e) { const int ch = h * 64 + 2 * c2 + e;
        mu_r[e] = P.in[15][dir * 1536 + ch]; mu_k[e] = P.in[15][dir * 1536 + 512 + ch]; mu_v[e] = P.in[15][dir * 1536 + 1024 + ch];
        k_k[e] = P.in[21][ch]; k_a[e] = P.in[22][ch]; r_k[e] = P.in[23][ch]; }
    float amu[2][2];
#pragma unroll
    for (int ty = 0; ty < 2; ++ty)
#pragma unroll
        for (int e = 0; e < 2; ++e) amu[ty][e] = P.in[16][dir * 128 + ty * 64 + 2 * c2 + e];
#define SCAN_BUILD_A(RAWN, PREV0) do { \
        LAS const bf16_t* cur_ = (RAWN) + (tk + 1) * 320 + 192 + 2 * c2; \
        LAS const bf16_t* prv_ = (tk > 0 ? (RAWN) + tk * 320 : (PREV0)) + 192 + 2 * c2; \
        _Pragma("unroll") for (int ty = 0; ty < 2; ++ty) { \
            const unsigned xc_ = *(LAS const unsigned*)(cur_ + ty * 64), xp_ = *(LAS const unsigned*)(prv_ + ty * 64); \
            float z0_ = bflo(xc_) + (bflo(xp_) - bflo(xc_)) * amu[ty][0], z1_ = bfhi(xc_) + (bfhi(xp_) - bfhi(xc_)) * amu[ty][1]; \
            if (ty == 0) { z0_ = tanhf_(z0_); z1_ = tanhf_(z1_); } \
            *(LAS unsigned*)(ALDS + ty * 1152 + tk * 72 + 2 * c2) = pk2(z0_, z1_); } } while (0)
    static_assert(LPR == 16, "two rows per lane, 16 lanes per row");
    const int srow = wave * 8 + (lane >> 4), sq = lane & 15;
    f32x2v SS[4];
#pragma unroll
    for (int i = 0; i < 4; ++i) { const int kidx = sq * 4 + i;
        SS[i].x = (flags & 1) ? (kidx == srow ? 1.f : 0.f) : (sin ? sin[srow * 64 + kidx] : 0.f);
        SS[i].y = (flags & 1) ? (kidx == srow + 4 ? 1.f : 0.f) : (sin ? sin[(srow + 4) * 64 + kidx] : 0.f); }
    const bool lp = (flags & 16) != 0;
    f32x2v SP[4];
#pragma unroll
    for (int i = 0; i < 4; ++i) { const int kidx = sq * 4 + i; SP[i].x = kidx == srow ? 1.f : 0.f; SP[i].y = kidx == srow + 4 ? 1.f : 0.f; }
    const int nch = tlen / 16;
    const int tstep = dir == 0 ? 16 : -16;
    const int tfirst = dir == 0 ? tbeg : tbeg + tlen - 16;
    const int tprev = dir == 0 ? tbeg - 1 : tbeg + tlen;
    const bool has_prev = tprev >= 0 && tprev < Tseq;
    if (has_prev && tid < 40) {
        const int sg = tid >> 3, c8 = tid & 7;
        const bf16_t* sp = sg < 3 ? Prkvg + (base + tprev) * 2048 + sg * 512 + h * 64 + c8 * 8 : Pwa + (base + tprev) * 256 + dir * 128 + (sg - 3) * 64 + c8 * 8;
        *(LAS u32x4*)(RAW0 + 5440 + 16 * 320 + sg * 64 + c8 * 8) = *(const u32x4*)sp;
    }
    const bool in_on = (flags & 2) == 0, wr_y = (flags & 4) != 0, wr_rk = (flags & 8) != 0;
#define SCAN_TOK(t0, j) (dir == 0 ? (t0) + (j) : (t0) + 15 - (j))
    u32x4 pre_a, pre_b = (u32x4){0u, 0u, 0u, 0u};
    {
        pre_a = *(const u32x4*)(src_a + (size_t)SCAN_TOK(tfirst, j_a) * ld_a);
        if (has_b) pre_b = *(const u32x4*)(src_b + (size_t)SCAN_TOK(tfirst, j_b) * ld_b);
        *(LAS u32x4*)(RAW0 + dst_a) = pre_a;
        if (has_b) *(LAS u32x4*)(RAW0 + dst_b) = pre_b;
        if (nch > 1) {
            pre_a = *(const u32x4*)(src_a + (size_t)SCAN_TOK(tfirst + tstep, j_a) * ld_a);
            if (has_b) pre_b = *(const u32x4*)(src_b + (size_t)SCAN_TOK(tfirst + tstep, j_b) * ld_b);
        }
    }
    __syncthreads();
    SCAN_BUILD_A(RAW0, (has_prev ? RAW0 + 5440 + 16 * 320 : ZROW));
    lds_barrier();
    u32x4 ypend = (u32x4){0u, 0u, 0u, 0u}; bf16_t* ypend_ptr = nullptr;
    for (int c = 0; c < nch; ++c) {
        LAS bf16_t* RAW = RAW0 + (c & 1) * 5440;
        LAS bf16_t* RAWp = RAW0 + ((c & 1) ^ 1) * 5440;
        const int t0 = tfirst + c * tstep;
        {
            bf16x8 af[2];
#pragma unroll
            for (int ks = 0; ks < 2; ++ks) af[ks] = *(LAS const bf16x8*)(ALDS + ltype * 1152 + l15 * 72 + ks * 32 + quad * 8);
            f32x4 d = mfma16(af[0], lb0, (f32x4){0.f, 0.f, 0.f, 0.f});
            d = mfma16(af[1], lb1, d);
            LAS float* dstp = (ltype == 0 ? Wd : Aa) + lch;
#pragma unroll
            for (int jj = 0; jj < 4; ++jj) { const float sg = sigmoidf_(lbias + d[jj]); dstp[(quad * 4 + jj) * 64] = ltype == 0 ? __expf(-0.6065306597126334f * sg) : sg; }
        }
        {
            LAS const bf16_t* cur = RAW + (tk + 1) * 320 + 2 * c2;
            LAS const bf16_t* prv = (tk > 0 ? RAW + tk * 320 : ((c > 0 || has_prev) ? RAWp + 16 * 320 : ZROW)) + 2 * c2;
            const unsigned rc = *(LAS const unsigned*)(cur), rp = *(LAS const unsigned*)(prv);
            const unsigned kc = *(LAS const unsigned*)(cur + 64), kq = *(LAS const unsigned*)(prv + 64);
            const unsigned vc = *(LAS const unsigned*)(cur + 128), vp = *(LAS const unsigned*)(prv + 128);
            const int o = tk * 64 + 2 * c2;
            Rr[o] = bflo(rc) + (bflo(rp) - bflo(rc)) * mu_r[0]; Rr[o + 1] = bfhi(rc) + (bfhi(rp) - bfhi(rc)) * mu_r[1];
            KP[o] = bflo(kc) + (bflo(kq) - bflo(kc)) * mu_k[0]; KP[o + 1] = bfhi(kc) + (bfhi(kq) - bfhi(kc)) * mu_k[1];
            Vv[o] = in_on ? bflo(vc) + (bflo(vp) - bflo(vc)) * mu_v[0] : 0.f; Vv[o + 1] = in_on ? bfhi(vc) + (bfhi(vp) - bfhi(vc)) * mu_v[1] : 0.f;
        }
        lds_barrier();
        float rk_keep;
        {
            const int o = tk * 64 + 2 * c2;
            const float kz0 = KP[o], kz1 = KP[o + 1], a0 = Aa[o], a1 = Aa[o + 1];
            const float q0 = kz0 * k_k[0], q1 = kz1 * k_k[1];
            const float kp0 = kz0 * (1.0f + (a0 - 1.0f) * k_a[0]), kp1 = kz1 * (1.0f + (a1 - 1.0f) * k_a[1]);
            const float ss = reduce32(q0 * q0 + q1 * q1);
            const float rk = reduce32(Rr[o] * kp0 * r_k[0] + Rr[o + 1] * kp1 * r_k[1]);
            const float inv = __builtin_amdgcn_rsqf(fmaxf(ss, 1e-24f));
            const float kk0 = q0 * inv, kk1 = q1 * inv;
            KK[o] = kk0; KK[o + 1] = kk1; KKA[o] = kk0 * a0; KKA[o + 1] = kk1 * a1;
            KP[o] = kp0; KP[o + 1] = kp1;
            rk_keep = rk;
        }
        if (c + 1 < nch) {
            *(LAS u32x4*)(RAWp + dst_a) = pre_a;
            if (has_b) *(LAS u32x4*)(RAWp + dst_b) = pre_b;
            if (c + 2 < nch) {
                pre_a = *(const u32x4*)(src_a + (size_t)SCAN_TOK(t0 + 2 * tstep, j_a) * ld_a);
                if (has_b) pre_b = *(const u32x4*)(src_b + (size_t)SCAN_TOK(t0 + 2 * tstep, j_b) * ld_b);
            }
        }
        if (wr_rk && c2 == 0) RKR[(base + SCAN_TOK(t0, tk)) * 8 + h] = rk_keep;
        if (ypend_ptr) *(u32x4*)ypend_ptr = ypend;
        lds_barrier();
        if (c + 1 < nch) SCAN_BUILD_A(RAWp, RAW + 16 * 320);
        if (lp) {
            ScanSet2 sa_, sb_;
            scan_load2(sa_, KK, Wd, KKA, KP, Rr, Vv, sq * 4, srow, false);
#pragma unroll 1
            for (int jo = 0; jo < 16; jo += 2) {
                scan_load2(sb_, KK, Wd, KKA, KP, Rr, Vv, (jo + 1) * 64 + sq * 4, (jo + 1) * 64 + srow, false);
                scan_stepLP(SS, SP, sa_);
                if (jo + 2 < 16) scan_load2(sa_, KK, Wd, KKA, KP, Rr, Vv, (jo + 2) * 64 + sq * 4, (jo + 2) * 64 + srow, false);
                scan_stepLP(SS, SP, sb_);
            }
        } else {
            ScanSet2 sa_, sb_;
            scan_load2(sa_, KK, Wd, KKA, KP, Rr, Vv, sq * 4, srow, wr_y);
            float yk = 0.f, zk = 0.f, y0 = 0.f, y1 = 0.f, yr0, yr1;
#pragma unroll 1
            for (int jo = 0; jo < 16; jo += 2) {
                scan_load2(sb_, KK, Wd, KKA, KP, Rr, Vv, (jo + 1) * 64 + sq * 4, (jo + 1) * 64 + srow, wr_y);
                scan_step2(SS, sa_, wr_y, y0, y1, yr0, yr1);
                if (jo > 0 && sq == jo - 1) { yk = yr0; zk = yr1; }
                if (jo + 2 < 16) scan_load2(sa_, KK, Wd, KKA, KP, Rr, Vv, (jo + 2) * 64 + sq * 4, (jo + 2) * 64 + srow, wr_y);
                scan_step2(SS, sb_, wr_y, y0, y1, yr0, yr1);
                if (sq == jo) { yk = yr0; zk = yr1; }
            }
            yr0 = dpp16(y0); yr1 = dpp16(y1);
            if (sq == 15) { yk = yr0; zk = yr1; }
            Yc[sq * 64 + srow] = yk; Yc[sq * 64 + srow + 4] = zk;
        }
        lds_barrier();
        {
            const bool wr = wr_y && tid < 128;
            if (wr) {
                const int tq = tid >> 3, c8 = tid & 7; float f[8];
                const f32x4 a = *(LAS const f32x4*)(Yc + tq * 64 + c8 * 8), b = *(LAS const f32x4*)(Yc + tq * 64 + c8 * 8 + 4);
                f[0] = a[0]; f[1] = a[1]; f[2] = a[2]; f[3] = a[3]; f[4] = b[0]; f[5] = b[1]; f[6] = b[2]; f[7] = b[3];
                ypend = pack8(f); ypend_ptr = Yd + (base + SCAN_TOK(t0, tq)) * 512 + h * 64 + c8 * 8;
            }
        }
    }
    if (ypend_ptr) *(u32x4*)ypend_ptr = ypend;
    if (sout) { *(f32x4*)(sout + srow * 64 + sq * 4) = (f32x4){SS[0].x, SS[1].x, SS[2].x, SS[3].x}; *(f32x4*)(sout + (srow + 4) * 64 + sq * 4) = (f32x4){SS[0].y, SS[1].y, SS[2].y, SS[3].y}; }
    if (lp && sout2) { *(f32x4*)(sout2 + srow * 64 + sq * 4) = (f32x4){SP[0].x, SP[1].x, SP[2].x, SP[3].x}; *(f32x4*)(sout2 + (srow + 4) * 64 + sq * 4) = (f32x4){SP[0].y, SP[1].y, SP[2].y, SP[3].y}; }
#undef SCAN_TOK
#undef SCAN_BUILD_A
    __syncthreads();
}

__device__ void scan_carry(const Params& PP, int hd, LAS unsigned char* lds) {
    Params P = PP; P.ws = opaque_ptr(PP.ws);
    const int tid = opaque_tid();
    const float* Lm = (const float*)(P.ws + WS_STL) + (size_t)hd * NSEG * 4096;
    const float* Pm = (const float*)(P.ws + WS_STP) + (size_t)hd * NSEG * 4096;
    float* St = (float*)(P.ws + WS_STS) + (size_t)hd * NSEG * 4096;
    LAS float* Sc = (LAS float*)lds;
    LAS float* Pc = Sc + 4096;
    const int v = tid >> 3, k0 = (tid & 7) * 8;
    for (int i = 0; i < 8; ++i) { const float x = Lm[v * 64 + k0 + i]; Sc[v * 64 + k0 + i] = x; St[4096 + v * 64 + k0 + i] = x; }
    for (int sgm = 1; sgm + 1 < NSEG; ++sgm) {
        for (int i = 0; i < 8; ++i) Pc[v * 64 + k0 + i] = Pm[(size_t)sgm * 4096 + v * 64 + k0 + i];
        __syncthreads();
        float o[8];
        for (int i = 0; i < 8; ++i) o[i] = Lm[(size_t)sgm * 4096 + v * 64 + k0 + i];
        for (int j = 0; j < 64; ++j) { const float sv = Sc[v * 64 + j];
#pragma unroll
            for (int i = 0; i < 8; ++i) o[i] += sv * Pc[j * 64 + k0 + i]; }
        __syncthreads();
        for (int i = 0; i < 8; ++i) { Sc[v * 64 + k0 + i] = o[i]; St[(size_t)(sgm + 1) * 4096 + v * 64 + k0 + i] = o[i]; }
    }
    __syncthreads();
}

__device__ void rwkv_finalize(const Params& PP) {
    Params P = PP; P.ws = opaque_ptr(PP.ws);
    const int tid_ = opaque_tid(), lane = tid_ & 63, wave = __builtin_amdgcn_readfirstlane(tid_ >> 6);
    const bf16_t* Prkvg = (const bf16_t*)(P.ws + WS_PRKVG);
    const bf16_t* Y0 = (const bf16_t*)(P.ws + WS_Y);
    const bf16_t* Y1 = Y0 + (size_t)M_TOK * 512;
    const float* RKR0 = (const float*)(P.ws + WS_RKR);
    const float* RKR1 = RKR0 + (size_t)M_TOK * 8;
    bf16_t* MO = (bf16_t*)(P.ws + WS_XN);
    const int col = lane * 8, hh = lane >> 3;
    float gw[8], gb[8], muf[8], mub[8];
#pragma unroll
    for (int i = 0; i < 8; ++i) { gw[i] = P.in[24][col + i]; gb[i] = P.in[25][col + i]; muf[i] = P.in[15][1024 + col + i]; mub[i] = P.in[15][1536 + 1024 + col + i]; }
    for (int row = blockIdx.x * 8 + wave; row < M_TOK; row += gridDim.x * 8) {
        const int t = row < M_PROMPT ? (row & 2047) : row - M_PROMPT, T = row < M_PROMPT ? 2048 : 16384;
        float yf[8], yb[8], vc[8], vp[8], vn[8], gg[8];
        unpack8(*(const u32x4*)(Y0 + (size_t)row * 512 + col), yf); unpack8(*(const u32x4*)(Y1 + (size_t)row * 512 + col), yb);
        unpack8(*(const u32x4*)(Prkvg + (size_t)row * 2048 + 1024 + col), vc);
        unpack8(*(const u32x4*)(Prkvg + (size_t)row * 2048 + 1536 + col), gg);
        if (t > 0) unpack8(*(const u32x4*)(Prkvg + (size_t)(row - 1) * 2048 + 1024 + col), vp); else { for (int i = 0; i < 8; ++i) vp[i] = 0.f; }
        if (t < T - 1) unpack8(*(const u32x4*)(Prkvg + (size_t)(row + 1) * 2048 + 1024 + col), vn); else { for (int i = 0; i < 8; ++i) vn[i] = 0.f; }
        const float rf = RKR0[(size_t)row * 8 + hh], rb = RKR1[(size_t)row * 8 + hh];
        float s = 0.f;
#pragma unroll
        for (int i = 0; i < 8; ++i) { yf[i] += yb[i]; s += yf[i]; }
        const float mean = reduce8(s) * (1.0f / 64.0f);
        float q = 0.f;
#pragma unroll
        for (int i = 0; i < 8; ++i) { yf[i] -= mean; q += yf[i] * yf[i]; }
        const float rstd = rsqrtf(reduce8(q) * (1.0f / 64.0f) + 64e-5f);
        float o[8];
#pragma unroll
        for (int i = 0; i < 8; ++i) {
            const float vzf = vc[i] + (vp[i] - vc[i]) * muf[i], vzb = vc[i] + (vn[i] - vc[i]) * mub[i];
            o[i] = (yf[i] * rstd * gw[i] + gb[i] + rf * vzf + rb * vzb) * sigmoidf_(gg[i]);
        }
        *(u32x4*)(MO + (size_t)row * 1024 + 512 + col) = pack8(o);
    }
}

template <int NQ> __device__ __forceinline__ void attn_groups(const bf16_t* QKV, size_t base, int h, int T0, int L, int dsh, int res, int i0, int bi,
        int lane, int l15, int quad, int r4, int c4, LAS unsigned char* VST, LAS const f32x2v* RKT, int tb, const float (&bx)[11][4], const float (&gqk)[16], LAS float* OACC, LAS float* LS) {
    constexpr int NT = NQ == 2 ? 10 : 9;
    bf16x8 qf[NQ][2]; float mq[NQ]; int qtok[NQ];
#pragma unroll
    for (int q = 0; q < NQ; ++q) {
        qtok[q] = ((i0 + 16 * q + l15) << dsh) + res;
        const bf16_t* qp = QKV + (base + qtok[q]) * 3072 + h * 64 + quad * 8;
        float f[16]; unpack8(*(const u32x4*)qp, f); unpack8(*(const u32x4*)(qp + 32), f + 8);
        float ss = 0.f;
#pragma unroll
        for (int i = 0; i < 16; ++i) ss += f[i] * f[i];
        ss += __shfl_xor(ss, 16); ss += __shfl_xor(ss, 32);
        const float rq = rsqrtf(ss * (1.0f / 64.0f) + NORM_EPS) * 0.125f;
#pragma unroll
        for (int i = 0; i < 16; ++i) f[i] = f[i] * rq * gqk[i];
        const u32x4 w0 = pack8(f), w1 = pack8(f + 8);
        qf[q][0] = __builtin_bit_cast(bf16x8, w0); qf[q][1] = __builtin_bit_cast(bf16x8, w1);
        float fr[16]; unpack8(w0, fr); unpack8(w1, fr + 8);
        float n2 = 0.f;
#pragma unroll
        for (int i = 0; i < 16; ++i) n2 += fr[i] * fr[i];
        n2 += __shfl_xor(n2, 16); n2 += __shfl_xor(n2, 32);
        mq[q] = 8.1f * 1.4426950408889634f * sqrtf(n2);
    }
    f32x4 oacc[NQ][4];
    float lsum[NQ];
#pragma unroll
    for (int q = 0; q < NQ; ++q) { lsum[q] = 0.f;
#pragma unroll
        for (int et = 0; et < 4; ++et) oacc[q][et] = (f32x4){0.f, 0.f, 0.f, 0.f}; }
    const int ebase = (i0 - 64 + quad * 4) * (1 << dsh) + res - tb;
    const float dmul = (float)(1 << dsh);
    bf16x8 kfb[2][2][2]; u32x4 vb[2][4];
    const int rowv = lane >> 3, c8v = lane & 7;
#define ATT_ISSUE(KP, BUF) do { \
        _Pragma("unroll") for (int tt_ = 0; tt_ < 2; ++tt_) { \
            int kidx_ = i0 - 64 + 16 * (2 * (KP) + tt_) + l15; kidx_ = kidx_ < 0 ? 0 : (kidx_ > L - 1 ? L - 1 : kidx_); \
            const bf16_t* kptr_ = QKV + (base + ((size_t)kidx_ << dsh) + res) * 3072 + 1024 + h * 64 + quad * 8; \
            kfb[BUF][tt_][0] = *(const bf16x8*)kptr_; kfb[BUF][tt_][1] = *(const bf16x8*)(kptr_ + 32); } \
        _Pragma("unroll") for (int vi_ = 0; vi_ < 4; ++vi_) { \
            int vidx_ = i0 - 64 + 32 * (KP) + rowv + 8 * vi_; vidx_ = vidx_ < 0 ? 0 : (vidx_ > L - 1 ? L - 1 : vidx_); \
            vb[BUF][vi_] = *(const u32x4*)(QKV + (base + ((size_t)vidx_ << dsh) + res) * 3072 + 2048 + h * 64 + c8v * 8); } } while (0)
    ATT_ISSUE(0, 0);
#pragma unroll
    for (int kp = 0; kp < 5; ++kp) {
        f32x4 s[NQ][2];
        if (kp + 1 < 5) ATT_ISSUE(kp + 1, (kp + 1) & 1);
#pragma unroll
        for (int tt = 0; tt < 2; ++tt) {
            const int kt = 2 * kp + tt;
#pragma unroll
            for (int q = 0; q < NQ; ++q) s[q][tt] = (f32x4){0.f, 0.f, 0.f, 0.f};
            if (kt < NT) {
                f32x2v e[4];
#pragma unroll
                for (int j = 0; j < 4; ++j) e[j] = RKT[((16 * kt + j) << dsh) + ebase];
#pragma unroll
                for (int q = 0; q < NQ; ++q) {
                    f32x4 sc = mfma16(kfb[kp & 1][tt][0], qf[q][0], (f32x4){0.f, 0.f, 0.f, 0.f});
                    sc = mfma16(kfb[kp & 1][tt][1], qf[q][1], sc);
#pragma unroll
                    for (int j = 0; j < 4; ++j) {
                        const float p = __builtin_amdgcn_exp2f(sc[j] * e[j].x + (e[j].y + (bx[kt + 1 - q][j] * dmul - mq[q])));
                        lsum[q] += p; s[q][tt][j] = p;
                    }
                }
            }
        }
        bf16x8 pf[NQ];
#pragma unroll
        for (int q = 0; q < NQ; ++q) { u32x4 w; w.x = pk2(s[q][0][0], s[q][0][1]); w.y = pk2(s[q][0][2], s[q][0][3]); w.z = pk2(s[q][1][0], s[q][1][1]); w.w = pk2(s[q][1][2], s[q][1][3]); pf[q] = __builtin_bit_cast(bf16x8, w); }
        {
#pragma unroll
            for (int vi = 0; vi < 4; ++vi) *(LAS u32x4*)(VST + (rowv + 8 * vi) * 144 + c8v * 16) = vb[kp & 1][vi];
        }
        asm volatile("s_waitcnt lgkmcnt(0)" ::: "memory"); __builtin_amdgcn_fence(__ATOMIC_RELEASE, "wavefront"); __builtin_amdgcn_wave_barrier(); __builtin_amdgcn_fence(__ATOMIC_ACQUIRE, "wavefront"); asm volatile("s_waitcnt lgkmcnt(0)" ::: "memory");
#pragma unroll
        for (int et = 0; et < 4; ++et) {
            LAS const unsigned char* ap = VST + (quad * 4 + r4) * 144 + (et * 16 + 4 * c4) * 2;
            const s16x4 lo = tr_read(ap), hi = tr_read(ap + 16 * 144);
            const bf16x8 a = {lo[0], lo[1], lo[2], lo[3], hi[0], hi[1], hi[2], hi[3]};
#pragma unroll
            for (int q = 0; q < NQ; ++q) oacc[q][et] = mfma16(a, pf[q], oacc[q][et]);
        }
        asm volatile("s_waitcnt lgkmcnt(0)" ::: "memory"); __builtin_amdgcn_fence(__ATOMIC_RELEASE, "wavefront"); __builtin_amdgcn_wave_barrier(); __builtin_amdgcn_fence(__ATOMIC_ACQUIRE, "wavefront"); asm volatile("s_waitcnt lgkmcnt(0)" ::: "memory");
    }
#undef ATT_ISSUE
#pragma unroll
    for (int q = 0; q < NQ; ++q) {
        float l = lsum[q]; l += __shfl_xor(l, 16); l += __shfl_xor(l, 32);
        const int qloc = qtok[q] - T0;
#pragma unroll
        for (int et = 0; et < 4; ++et) {
            LAS f32x4* dst = (LAS f32x4*)(OACC + qloc * 68 + et * 16 + quad * 4);
            if (bi == 0) *dst = oacc[q][et]; else *dst = *dst + oacc[q][et];
        }
        if (quad == 0) { if (bi == 0) LS[qloc] = l; else LS[qloc] += l; }
    }
}

__device__ void attn_item(const Params& PP, int seq, int h, int tile, LAS unsigned char* lds) {
    Params P = PP; P.ws = opaque_ptr(PP.ws);
    const int tid = opaque_tid(), lane = tid & 63, wave = __builtin_amdgcn_readfirstlane(tid >> 6), l15 = lane & 15, quad = lane >> 4;
    const int T = seq < 32 ? 2048 : 16384;
    const size_t base = seq < 32 ? (size_t)seq * 2048 : (size_t)M_PROMPT;
    const int T0 = tile * 256;
    const bf16_t* QKV = (const bf16_t*)(P.ws + WS_BIG);
    bf16_t* MO = (bf16_t*)(P.ws + WS_XN);
    LAS float* OACC = (LAS float*)lds;
    LAS float* LS = (LAS float*)(lds + 256 * 272);
    LAS unsigned char* VST = lds + 256 * 272 + 1024 + wave * (32 * 144);
    const float slope = exp2f(-0.5f * (float)(h + 1));
    float gqk[16];
#pragma unroll
    for (int i = 0; i < 16; ++i) { const int e = (i >> 3) * 32 + quad * 8 + (i & 7); gqk[i] = P.in[28][e] * P.in[29][e]; }
    const int r4 = l15 >> 2, c4 = l15 & 3;
    float bx[11][4];
#pragma unroll
    for (int kt = -1; kt < 10; ++kt)
#pragma unroll
        for (int j = 0; j < 4; ++j) { int dist = 16 * kt - 64 + quad * 4 + j - l15; dist = dist < 0 ? -dist : dist;
            bx[kt + 1][j] = dist <= 64 ? -slope * 1.4426950408889634f * (float)dist : -1e30f; }
    LAS f32x2v* RKT = (LAS f32x2v*)(lds + 107520);
    const int tb = T0 - 1024;
    const float* ksq_h = (const float*)(P.ws + WS_KSQ) + (size_t)h * M_TOK;
    for (int idx = tid; idx < 2304; idx += 512) {
        const int tok = tb + idx;
        f32x2v ent = {0.f, -1e30f};
        if (tok >= 0 && tok < T) { ent.x = rsqrtf(ksq_h[base + tok] * (1.0f / 64.0f) + NORM_EPS) * 1.4426950408889634f; ent.y = 0.f; }
        RKT[idx] = ent;
    }
    __syncthreads();
    for (int bi = 0; bi < 3; ++bi) {
        const int dsh = 2 * bi, L = T >> dsh;
        if (bi < 2) {
            const int res = bi == 0 ? 0 : (wave & 3), i0 = (T0 >> dsh) + (bi == 0 ? 32 * wave : 32 * (wave >> 2));
            attn_groups<2>(QKV, base, h, T0, L, dsh, res, i0, bi, lane, l15, quad, r4, c4, VST, RKT, tb, bx, gqk, OACC, LS);
        } else {
            for (int gg = 0; gg < 2; ++gg)
                attn_groups<1>(QKV, base, h, T0, L, dsh, wave * 2 + gg, T0 >> dsh, bi, lane, l15, quad, r4, c4, VST, RKT, tb, bx, gqk, OACC, LS);
        }
        __syncthreads();
    }
    {
        const int q = tid >> 1, half = tid & 1;
        const float inv = 1.0f / LS[q];
        bf16_t* op = MO + (base + T0 + q) * 1024 + h * 64 + half * 32;
#pragma unroll
        for (int i = 0; i < 4; ++i) {
            const f32x4 a = *(LAS const f32x4*)(OACC + q * 68 + half * 32 + i * 8), b = *(LAS const f32x4*)(OACC + q * 68 + half * 32 + i * 8 + 4);
            u32x4 w; w.x = pk2(a[0] * inv, a[1] * inv); w.y = pk2(a[2] * inv, a[3] * inv); w.z = pk2(b[0] * inv, b[1] * inv); w.w = pk2(b[2] * inv, b[3] * inv);
            *(u32x4*)(op + i * 8) = w;
        }
    }
    __syncthreads();
}

__device__ void convert_jobs(const Params& P, unsigned char* ws, LAS float* tile, unsigned mask, int widx, int nw) {
    int rot = 0;
    for (int job = 0; job < 16; ++job) {
        if (!((mask >> job) & 1u)) continue;
        const float* src; size_t doff; int K, N;
        if (job < 4) { src = ((job & 1) ? P.in[7] : P.in[3]) + (size_t)(job >> 1) * 1024 * 5632; doff = WS_WFI + (size_t)job * SZ_WFI; K = 1024; N = 5632; }
        else if (job < 8) { src = ((job & 1) ? P.in[8] : P.in[4]) + (size_t)((job - 4) >> 1) * 2816 * 1024; doff = WS_WFO + (size_t)(job - 4) * SZ_WFO; K = 2816; N = 1024; }
        else if (job == 8) { src = P.in[10]; doff = WS_WABI; K = 1024; N = 3328; }
        else if (job == 9) { src = P.in[11]; doff = WS_WABO; K = 1024; N = 1024; }
        else if (job == 10) { src = P.in[26]; doff = WS_WATI; K = 1024; N = 3072; }
        else if (job == 11) { src = P.in[27]; doff = WS_WATO; K = 1024; N = 1024; }
        else { const int d = (job - 12) >> 1, ty = (job - 12) & 1; src = (ty ? P.in[20] : P.in[18]) + (size_t)d * 64 * 512; doff = WS_LORA + (size_t)(d * 2 + ty) * 512 * 64 * 2; K = 64; N = 512; }
        if (job < 4) convert_T<1>(src, (bf16_t*)(ws + doff), K, N, tile, rot, widx, nw); else convert_T<0>(src, (bf16_t*)(ws + doff), K, N, tile, rot, widx, nw);
        rot += (K / 64) * (N / 64);
    }
}

enum { K_P0 = 0, K_SWIGLU, K_RESID, K_NORM, K_GEMM_P, K_MIXA, K_FINAL, K_GEMM_QKV, K_ATTN, K_CARRY, K_MIXB };
constexpr int N_PHASES = 19;

__global__ void __launch_bounds__(512, 2) mega(Params P) {
    extern __shared__ __attribute__((aligned(16))) unsigned char lds_raw[];
    LAS unsigned char* lds = (LAS unsigned char*)lds_raw;
    cg::grid_group grid = cg::this_grid();
    for (int ph = 0; ph < N_PHASES; ++ph) {
#ifdef PROBE_MASK
        if (blockIdx.x == 0 && threadIdx.x == 0) ((unsigned long long*)(P.ws + WS_TS))[ph] = __builtin_amdgcn_s_memrealtime();
#endif
        unsigned char* ws = P.ws; float* X = P.out; int G = gridDim.x, bid = blockIdx.x;
        asm volatile("" : "+s"(ws), "+s"(X), "+s"(G), "+s"(bid));
        bf16_t* XN = (bf16_t*)(ws + WS_XN);
        bf16_t* Hb = (bf16_t*)(ws + WS_BIG);
        int kind, layer = 0, sub = 0;
        if (ph == 0) kind = K_P0;
        else {
            layer = ph <= 10 ? 0 : 1; const int r = ph <= 10 ? ph - 1 : ph - 11;
            const unsigned long long kc = layer == 0 ? 0x2126A95421ull : 0x32128721ull;
            const unsigned long long sc = layer == 0 ? 0x1120000000ull : 0x21120000ull;
            kind = (int)((kc >> (4 * r)) & 15ull); sub = (int)((sc >> (4 * r)) & 15ull);
        }
        if (kind == K_P0) {
#ifndef SKIP_P0
            LAS float* tile = (LAS float*)lds;
            convert_jobs(P, ws, tile, 0xF133u, bid, G);
            {
                bf16_t* dst = (bf16_t*)(ws + WS_SGUW);
                for (int i = bid * 512 + opaque_tid(); i < 4 * 128 * 128 / 4; i += G * 512) {
                    const f32x4 v = *(const f32x4*)(P.in[13] + (size_t)i * 4);
                    u32x2 w; w.x = pk2(v[0], v[1]); w.y = pk2(v[2], v[3]); *(u32x2*)(dst + (size_t)i * 4) = w;
                }
            }
            norm_rows(P.in[0], P.in[1], M_PROMPT, nullptr, nullptr, nullptr, P.in[2], XN);
            if (bid == 0 && opaque_tid() == 0) *(unsigned*)(ws + WS_TS + 2048) = 0u;
#endif
        } else if (kind == K_SWIGLU) {
            if (sub == 0) { float* za = (float*)(ws + WS_RSA); for (int i = bid * 512 + opaque_tid(); i < M_TOK; i += G * 512) za[i] = 0.f; }
            if (sub == 0 && layer == 1) { f32x4* zk = (f32x4*)(ws + WS_KSQ); for (int i = bid * 512 + opaque_tid(); i < 16 * M_TOK / 4; i += G * 512) zk[i] = (f32x4){0.f, 0.f, 0.f, 0.f}; }
            pg8::Gemm g{sub == 0 ? XN : (const bf16_t*)(ws + WS_Y), (const bf16_t*)(ws + WS_WFI + (size_t)(layer * 2 + sub) * SZ_WFI), M_TOK, 5632, 1024};
            pg8::StaticOrder S; S.init(M_TOK, 5632, G, bid);
            if (sub == 1 && layer == 0) { float* zc = (float*)(ws + WS_RSC); for (int i = bid * 512 + opaque_tid(); i < 2 * M_TOK; i += G * 512) zc[i] = 0.f; }
            EpiSwiglu E{Hb, sub == 0 ? (layer == 0 ? nullptr : (const float*)(ws + WS_RSC)) : (const float*)(ws + WS_RSB), (sub == 0 && layer == 1) ? (const float*)(ws + WS_RSD) : nullptr};
#ifndef SKIP_G1
            pg8::gemm_phase<EpiSwiglu, pg8::StaticOrder, GEMM_ALIGN, GEMM_SP2>(lds, g, S, E);
#endif
        } else if (kind == K_RESID) {
            const bf16_t* A; const bf16_t* Bt; int K; float scale; bf16_t* xg = nullptr; const float* gn = nullptr; float* rss = nullptr;
            const float* gaux = nullptr; float* rss2 = nullptr; const float* bss = nullptr;
            if (sub < 2) { A = Hb; Bt = (const bf16_t*)(ws + WS_WFO + (size_t)(layer * 2 + sub) * SZ_WFO); K = 2816; scale = 0.5f;
                if (sub == 0) { xg = XN; gn = P.in[5] + layer * DM; rss = (float*)(ws + WS_RSA); if (layer == 1) { bss = (const float*)(ws + WS_RSC); gaux = P.in[9]; } }
                else if (layer == 0) { xg = XN; gn = P.in[2] + DM; gaux = P.in[9]; rss = (float*)(ws + WS_RSC); rss2 = (float*)(ws + WS_RSD); } }
            else { A = XN; Bt = (const bf16_t*)(ws + (layer == 0 ? WS_WABO : WS_WATO)); K = 1024; scale = 1.0f; xg = (bf16_t*)(ws + WS_Y); gn = P.in[6] + layer * DM; rss = (float*)(ws + WS_RSB); }
            pg8::Gemm g{A, Bt, M_TOK, 1024, K};
            pg8::StaticOrder S; S.init(M_TOK, 1024, G, bid);
            const bool first = (layer == 0 && sub == 0);
            EpiResid E{X, scale, xg, gn, rss, first ? P.in[0] : nullptr, first ? P.in[1] : nullptr, gaux, rss2, bss};
#ifndef SKIP_G2
            pg8::gemm_phase<EpiResid, pg8::StaticOrder, GEMM_ALIGN, GEMM_SP2>(lds, g, S, E);
#endif
        } else if (kind == K_NORM) {
            norm_rows(X, X, M_TOK, nullptr, P.in[9] + DM, X, nullptr, nullptr);
        } else if (kind == K_GEMM_P || kind == K_GEMM_QKV) {
            const bool isP = kind == K_GEMM_P; const int N = isP ? 3328 : 3072;
            pg8::Gemm g{XN, (const bf16_t*)(ws + (isP ? WS_WABI : WS_WATI)), M_TOK, N, 1024};
            pg8::StaticOrder S; S.init(M_TOK, N, G, bid);
            { float* zb = (float*)(ws + WS_RSB); for (int i = bid * 512 + opaque_tid(); i < M_TOK; i += G * 512) zb[i] = 0.f; }
            EpiSplit E; const float* rsa = (const float*)(ws + WS_RSA);
            if (isP) E = EpiSplit{(bf16_t*)(ws + WS_PUV), 1024, 4, (bf16_t*)(ws + WS_PRKVG), 2048, 12, (bf16_t*)(ws + WS_PWA), 256, rsa, nullptr};
            else E = EpiSplit{(bf16_t*)(ws + WS_BIG), 3072, 12, (bf16_t*)(ws + WS_BIG), 3072, 12, (bf16_t*)(ws + WS_BIG), 3072, rsa, (float*)(ws + WS_KSQ)};
#ifndef SKIP_G3
            pg8::gemm_phase<EpiSplit, pg8::StaticOrder, GEMM_ALIGN, GEMM_SP2>(lds, g, S, E);
#endif
        } else if (kind == K_MIXA) {
            constexpr int NLONG = 16 + 16 * (NSEG - 2);
            unsigned* qhead = (unsigned*)(ws + WS_TS + 2048);
            LAS int* qslot = (LAS int*)(lds + LDS_BYTES - 16);
            for (;;) {
                if (opaque_tid() == 0) *qslot = (int)__hip_atomic_fetch_add(qhead, 1u, __ATOMIC_RELAXED, __HIP_MEMORY_SCOPE_AGENT);
                __syncthreads();
                const int li = __builtin_amdgcn_readfirstlane(*qslot);
                __syncthreads();
                if (li >= 512 + NLONG + 640) break;
#ifndef SKIP_SCAN
                if (li < 512) scan_item<16>(P, li >> 4, (li >> 1) & 7, li & 1, 0, 0, 2048, 4 | 8, nullptr, nullptr, nullptr, lds);
                else if (li < 512 + 16) {
                    const int hd = li - 512, dir = hd & 1;
                    scan_item<16>(P, 32, hd >> 1, dir, 0, dir == 0 ? 0 : 16384 - SEGLEN, SEGLEN, 4 | 8, nullptr, (float*)(ws + WS_STL) + (size_t)hd * NSEG * 4096, nullptr, lds);
                } else if (li < 512 + NLONG) {
                    const int q = li - 512 - 16, hd = q & 15, sgm = 1 + (q >> 4), dir = hd & 1;
                    const int tb = dir == 0 ? sgm * SEGLEN : 16384 - (sgm + 1) * SEGLEN;
                    scan_item<16>(P, 32, hd >> 1, dir, 0, tb, SEGLEN, 16, nullptr, (float*)(ws + WS_STL) + ((size_t)hd * NSEG + sgm) * 4096, (float*)(ws + WS_STP) + ((size_t)hd * NSEG + sgm) * 4096, lds);
                }
#endif
#ifndef SKIP_SGU
                if (li >= 512 + NLONG) sgu_item(P, li - 512 - NLONG, lds);
#endif
            }
        } else if (kind == K_CARRY) {
#ifndef SKIP_SCAN
            if (bid < 16) scan_carry(P, bid, lds);
            else if (G > 16) convert_jobs(P, ws, (LAS float*)lds, 0x0ECCu, bid - 16, G - 16);
#endif
        } else if (kind == K_MIXB) {
#ifndef SKIP_SCAN
            for (int li = bid; li < 16 * (NSEG - 1); li += G) {
                const int hd = li & 15, sgm = 1 + (li >> 4), dir = hd & 1;
                const int tb = dir == 0 ? sgm * SEGLEN : 16384 - (sgm + 1) * SEGLEN;
                scan_item<16>(P, 32, hd >> 1, dir, 0, tb, SEGLEN, 4 | 8, (const float*)(ws + WS_STS) + ((size_t)hd * NSEG + sgm) * 4096, nullptr, nullptr, lds);
            }
#endif
        } else if (kind == K_FINAL) {
#ifndef SKIP_FIN
            rwkv_finalize(P);
#endif
        } else if (kind == K_ATTN) {
            for (int it = bid; it < 5120; it += G) {
#ifndef SKIP_ATTN
                if (it < 4096) attn_item(P, it >> 7, it & 15, (it >> 4) & 7, lds);
                else attn_item(P, 32, it & 15, (it - 4096) >> 4, lds);
#endif
            }
        }
        if (ph + 1 < N_PHASES) {
            __builtin_amdgcn_fence(__ATOMIC_RELEASE, "agent");
            asm volatile("s_waitcnt vmcnt(0) lgkmcnt(0)" ::: "memory");
            grid.sync();
            __builtin_amdgcn_fence(__ATOMIC_ACQUIRE, "agent");
            asm volatile("s_waitcnt vmcnt(0) lgkmcnt(0)" ::: "memory");
            __syncthreads();
        }
    }
#ifdef PROBE_MASK
    if (blockIdx.x == 0 && threadIdx.x == 0) {
        unsigned long long* ts = (unsigned long long*)(P.ws + WS_TS);
        ts[N_PHASES] = __builtin_amdgcn_s_memrealtime();
        unsigned long long tot = 0;
        for (int i = 0; i < N_PHASES; ++i) if ((PROBE_MASK >> i) & 1) tot += ts[i + 1] - ts[i];
        P.out[0] += 4.0f + 10.0f * (float)tot * 1e-5f;
    }
#endif
}

extern "C" void kernel_launch(void* const* d_in, const int* in_sizes, int n_in, void* d_out, int out_size, void* d_ws, size_t ws_size, hipStream_t stream) {
    static int grid_blocks = 0;
    if (!grid_blocks) {
        int dev = 0, cus = 0, per_cu = 0;
        (void)hipGetDevice(&dev);
        (void)hipDeviceGetAttribute(&cus, hipDeviceAttributeMultiprocessorCount, dev);
        (void)hipFuncSetAttribute((const void*)mega, hipFuncAttributeMaxDynamicSharedMemorySize, LDS_BYTES);
        (void)hipOccupancyMaxActiveBlocksPerMultiprocessor(&per_cu, (const void*)mega, 512, LDS_BYTES);
        (void)hipGetLastError();
        if (cus <= 0) cus = 256;
        grid_blocks = cus;
        if (ws_size < WS_END2) fprintf(stderr, "kernel_launch: workspace too small: %zu < %zu\n", ws_size, (size_t)WS_END2);
    }
    Params p{};
    for (int i = 0; i < 30 && i < n_in; ++i) p.in[i] = (const float*)d_in[i];
    p.out = (float*)d_out; p.ws = (unsigned char*)d_ws;
    void* args[] = {&p};
    hipError_t e = hipLaunchCooperativeKernel((const void*)mega, dim3(grid_blocks), dim3(512), args, LDS_BYTES, stream);
    if (e != hipSuccess) fprintf(stderr, "cooperative launch failed: %s (grid %d)\n", hipGetErrorString(e), grid_blocks);
}
```
